# Optimizing an MI355X kernel written in HIP

```python
import jax, jax.numpy as jnp
from jax import lax
import numpy as np

D_MODEL = 2048
BATCH = 1
SEQ = 8192
DEPTH = 2

GDN_HEADS = 6
GDN_HEAD_DIM = 128
GDN_WIDTH = GDN_HEADS * GDN_HEAD_DIM
GDN_CONV = 4
GDN_CHUNK = 64
CONF_WIDTH = 768
CONF_CONV = 31
ATT_PATTERNS = ((128, 1), (512, 4), (2048, 16))
ATT_N_GROUPS = 3
ATT_HEADS = 6
ATT_HEAD_DIM = 128
ATT_WIDTH = ATT_HEADS * ATT_HEAD_DIM
ATT_BLOCK = 128
ROPE_THETA = 10000.0
POOL_WINDOWS = (2, 4, 8, 16)
POOL_GROUP_WIDTH = 192
POOL_WIDTH = 4 * POOL_GROUP_WIDTH
N_BRANCHES = 4
BRANCH_WIDTH = 768
IN_SPLIT_SIZES = (3 * GDN_WIDTH, GDN_WIDTH, GDN_HEADS, GDN_HEADS, 2 * CONF_WIDTH,
                  3 * ATT_N_GROUPS * ATT_WIDTH, POOL_WIDTH, N_BRANCHES * D_MODEL)
N_IN = 3 * GDN_WIDTH + GDN_WIDTH + 2 * GDN_HEADS + 2 * CONF_WIDTH + 3 * ATT_N_GROUPS * ATT_WIDTH + POOL_WIDTH + N_BRANCHES * D_MODEL
N_EXPERT_GROUPS = 8
EXPERTS_PER_GROUP = 8
N_EXPERTS = N_EXPERT_GROUPS * EXPERTS_PER_GROUP
TOP_K = 2
EXPERT_HIDDEN = 512
MOE_BLOCK = 128
NORM_EPS = 1e-6
LN_EPS = 1e-5

kernel_name = 'hybrid_gated_branch_hier_moe'


def rms_norm(x, g):
    x32 = x.astype(jnp.float32)
    y = x32 * lax.rsqrt(jnp.mean(x32 * x32, axis=-1, keepdims=True) + NORM_EPS)
    return (y * g.astype(jnp.float32)).astype(x.dtype)


def l2_normalize(t):
    return t * lax.rsqrt(jnp.sum(t * t, axis=-1, keepdims=True) + 1e-6)


def causal_depthwise_conv(x, w):
    kw, c = w.shape
    xp = jnp.pad(x, ((0, 0), (kw - 1, 0), (0, 0)))
    return lax.conv_general_dilated(xp, w[:, None, :].astype(x.dtype), (1,), 'VALID',
                                    dimension_numbers=('NWC', 'WIO', 'NWC'), feature_group_count=c)


def rotary(x, pos):
    hd = x.shape[-1]
    half = hd // 2
    inv = ROPE_THETA ** (-jnp.arange(half, dtype=jnp.float32) * 2.0 / hd)
    ang = pos.astype(jnp.float32)[..., None] * inv
    ang = ang.reshape(ang.shape[:2] + (1,) * (x.ndim - 3) + (half,))
    cos, sin = jnp.cos(ang), jnp.sin(ang)
    x32 = x.astype(jnp.float32)
    x1, x2 = x32[..., :half], x32[..., half:]
    return jnp.concatenate([x1 * cos - x2 * sin, x2 * cos + x1 * sin], axis=-1).astype(x.dtype)


def gated_delta_rule_chunked(q, k, v, g, beta):
    b_, s_, h_, dk = q.shape
    dv = v.shape[-1]
    c = GDN_CHUNK
    n = s_ // c

    def chunks(t):
        t = jnp.moveaxis(t, 2, 1)
        return t.reshape((b_, h_, n, c) + t.shape[3:])

    q, k, v, g, beta = (chunks(t) for t in (q, k, v, g, beta))
    gc = jnp.cumsum(g, axis=-1)
    idx = jnp.arange(c)
    incl = idx[:, None] >= idx[None, :]
    strict = idx[:, None] > idx[None, :]
    decay = jnp.exp(jnp.where(incl, gc[..., :, None] - gc[..., None, :], -jnp.inf))
    kk = jnp.einsum('bhncd,bhnmd->bhncm', k, k)
    a_mat = jnp.where(strict, beta[..., :, None] * kk * decay, 0.0)
    t_mat = a_mat + jnp.eye(c, dtype=jnp.float32)
    rhs = jnp.concatenate([v * beta[..., None], k * (beta * jnp.exp(gc))[..., None]], axis=-1)
    sol = lax.linalg.triangular_solve(t_mat, rhs, left_side=True, lower=True, unit_diagonal=True)
    u_c, w_c = sol[..., :dv], sol[..., dv:]
    qk = jnp.einsum('bhncd,bhnmd->bhncm', q, k) * decay
    q_dec = q * jnp.exp(gc)[..., None]
    k_dec = k * jnp.exp(gc[..., -1:] - gc)[..., None]
    g_last = jnp.exp(gc[..., -1])
    xs = tuple(jnp.moveaxis(t, 2, 0) for t in (qk, q_dec, k_dec, u_c, w_c, g_last))

    def step(state, inp):
        qk_c, qd_c, kd_c, uu, ww, gl = inp
        v_new = uu - jnp.einsum('bhcd,bhde->bhce', ww, state)
        o = jnp.einsum('bhcd,bhde->bhce', qd_c, state) + jnp.einsum('bhcm,bhme->bhce', qk_c, v_new)
        state = state * gl[..., None, None] + jnp.einsum('bhcd,bhce->bhde', kd_c, v_new)
        return state, o

    s0 = jnp.zeros((b_, h_, dk, dv), jnp.float32)
    _, o = lax.scan(step, s0, xs)
    o = jnp.moveaxis(o, 0, 2).reshape(b_, h_, s_, dv)
    return jnp.moveaxis(o, 1, 2)


def dilated_window_attention(q, k, v, window, dilation):
    b_, s_, h_, hd = q.shape
    length = s_ // dilation
    steps = window // dilation
    blk = ATT_BLOCK
    nb = -(-length // blk)
    lp = nb * blk

    def to_blocks(t):
        t = t.reshape(b_, length, dilation, h_, hd).transpose(0, 2, 1, 3, 4)
        t = jnp.pad(t, ((0, 0), (0, 0), (0, lp - length), (0, 0), (0, 0)))
        return t.reshape(b_, dilation, nb, blk, h_, hd).astype(jnp.float32)

    def with_prev(t):
        prev = jnp.pad(t, ((0, 0), (0, 0), (1, 0), (0, 0), (0, 0), (0, 0)))[:, :, :-1]
        return jnp.concatenate([prev, t], axis=3)

    qb = to_blocks(q)
    kb = with_prev(to_blocks(k))
    vb = with_prev(to_blocks(v))
    qpos = jnp.arange(nb)[:, None, None] * blk + jnp.arange(blk)[None, :, None]
    kpos = jnp.arange(nb)[:, None, None] * blk - blk + jnp.arange(2 * blk)[None, None, :]
    dist = qpos - kpos
    mask = (dist >= 0) & (dist <= steps) & (kpos >= 0)
    s = jnp.einsum('bdnqhe,bdnkhe->bdnhqk', qb, kb) * (hd ** -0.5)
    s = jnp.where(mask[:, None], s, -jnp.inf)
    m = jnp.max(s, axis=-1, keepdims=True)
    p = jnp.exp(s - m)
    l = jnp.sum(p, axis=-1)
    o = jnp.einsum('bdnhqk,bdnkhe->bdnqhe', p, vb) / jnp.moveaxis(l, 3, 4)[..., None]
    lse = jnp.moveaxis(m[..., 0] + jnp.log(l), 3, 4)

    def from_blocks(t):
        t = t.reshape((b_, dilation, lp) + t.shape[4:])[:, :, :length]
        t = jnp.moveaxis(t, 1, 2)
        return t.reshape((b_, s_) + t.shape[3:])

    return from_blocks(o), from_blocks(lse)


def trailing_mean_minus_self(x, w):
    s_ = x.shape[1]
    cs = jnp.cumsum(x, axis=1)
    lower = jnp.pad(cs, ((0, 0), (w, 0), (0, 0)))[:, :s_]
    count = jnp.minimum(jnp.arange(1, s_ + 1), w).astype(jnp.float32)[None, :, None]
    return (cs - lower) / count - x


def hybrid_mixer(h, pos, w_in, conv_a_w, a_log, dt_bias, gdn_norm_g, conv_b_w, conv_b_b,
                 ln_b_g, ln_b_b, pool_w, pool_scale, w_branch, w_out):
    b_, s_, _ = h.shape
    f32 = jnp.float32
    u = h @ w_in
    points = [int(p) for p in np.cumsum(IN_SPLIT_SIZES)[:-1]]
    u_qkv_a, u_z_a, u_beta_a, u_decay_a, u_b, u_c, u_d, u_gate = jnp.split(u, points, axis=-1)

    qkv = jax.nn.silu(causal_depthwise_conv(u_qkv_a, conv_a_w))
    qa, ka, va = (t.reshape(b_, s_, GDN_HEADS, GDN_HEAD_DIM).astype(f32) for t in jnp.split(qkv, 3, axis=-1))
    qa = l2_normalize(qa) * (GDN_HEAD_DIM ** -0.5)
    ka = l2_normalize(ka)
    beta = jax.nn.sigmoid(u_beta_a.astype(f32))
    g = -jnp.exp(a_log) * jax.nn.softplus(u_decay_a.astype(f32) + dt_bias)
    oa = gated_delta_rule_chunked(qa, ka, va, g, beta)
    oa = oa * lax.rsqrt(jnp.mean(oa * oa, axis=-1, keepdims=True) + NORM_EPS) * gdn_norm_g
    oa = oa * jax.nn.silu(u_z_a.astype(f32).reshape(b_, s_, GDN_HEADS, GDN_HEAD_DIM))
    y_a = oa.reshape(b_, s_, GDN_WIDTH)

    ga, gb = jnp.split(u_b, 2, axis=-1)
    glu = ga * jax.nn.sigmoid(gb)
    cb = (causal_depthwise_conv(glu, conv_b_w) + conv_b_b).astype(f32)
    mu = jnp.mean(cb, axis=-1, keepdims=True)
    var = jnp.mean(jnp.square(cb - mu), axis=-1, keepdims=True)
    y_b = jax.nn.silu((cb - mu) * lax.rsqrt(var + LN_EPS) * ln_b_g + ln_b_b)

    qc, kc, vc = (t.reshape(b_, s_, ATT_N_GROUPS, ATT_HEADS, ATT_HEAD_DIM) for t in jnp.split(u_c, 3, axis=-1))
    qc = rotary(qc, pos)
    kc = rotary(kc, pos)
    outs, lses = [], []
    for gi, (window, dilation) in enumerate(ATT_PATTERNS):
        o_g, lse_g = dilated_window_attention(qc[:, :, gi], kc[:, :, gi], vc[:, :, gi], window, dilation)
        outs.append(o_g)
        lses.append(lse_g)
    alpha = jax.nn.softmax(jnp.stack(lses, axis=2), axis=2)
    y_c = jnp.sum(alpha[..., None] * jnp.stack(outs, axis=2), axis=2).reshape(b_, s_, ATT_WIDTH)

    xd = u_d.astype(f32).reshape(b_, s_, len(POOL_WINDOWS), POOL_GROUP_WIDTH)
    pooled = jnp.stack([trailing_mean_minus_self(xd[:, :, i], w) for i, w in enumerate(POOL_WINDOWS)], axis=2)
    y_d = jnp.einsum('bsgc,gce->bsge', pooled, pool_w).reshape(b_, s_, POOL_WIDTH) * pool_scale

    branches = jnp.stack([y_a, y_b, y_c, y_d], axis=2).astype(h.dtype)
    proj = jnp.einsum('bskc,kcd->bskd', branches, w_branch)
    gates = jax.nn.sigmoid(u_gate.reshape(b_, s_, N_BRANCHES, D_MODEL))
    merged = jnp.sum(gates * proj, axis=2)
    return merged @ w_out


def hierarchical_moe(h, wg, bg, we, be, w_up, w_down):
    b_, s_, d_ = h.shape
    t_ = b_ * s_
    ht = h.reshape(t_, d_)
    gprob = jax.nn.softmax((ht @ wg).astype(jnp.float32) + bg, axis=-1)
    gp, gi = lax.top_k(gprob, 1)
    elog = ((ht @ we).astype(jnp.float32) + be).reshape(t_, N_EXPERT_GROUPS, EXPERTS_PER_GROUP)
    sel = jnp.broadcast_to(gi[:, :, None], (t_, 1, EXPERTS_PER_GROUP))
    eprob = jax.nn.softmax(jnp.take_along_axis(elog, sel, axis=1)[:, 0], axis=-1)
    ep, ei = lax.top_k(eprob, TOP_K)
    wts = gp * ep / jnp.sum(ep, axis=-1, keepdims=True)
    eid = gi * EXPERTS_PER_GROUP + ei

    n_assign = t_ * TOP_K
    flat_e = eid.reshape(n_assign)
    flat_w = wts.reshape(n_assign)
    flat_t = jnp.repeat(jnp.arange(t_, dtype=jnp.int32), TOP_K)
    order = jnp.argsort(flat_e)
    se, st, sw = flat_e[order], flat_t[order], flat_w[order]
    counts = jnp.zeros((N_EXPERTS,), jnp.int32).at[flat_e].add(1)
    padded = (counts + MOE_BLOCK - 1) // MOE_BLOCK * MOE_BLOCK
    pad_end = jnp.cumsum(padded)
    pad_start = pad_end - padded
    start = jnp.cumsum(counts) - counts
    dest = pad_start[se] + jnp.arange(n_assign, dtype=jnp.int32) - start[se]
    n_slots = -(-(n_assign + N_EXPERTS * (MOE_BLOCK - 1)) // MOE_BLOCK) * MOE_BLOCK
    n_blocks = n_slots // MOE_BLOCK
    slot_tok = jnp.zeros((n_slots,), jnp.int32).at[dest].set(st)
    slot_w = jnp.zeros((n_slots,), jnp.float32).at[dest].set(sw)
    block_e = jnp.minimum(jnp.searchsorted(pad_end, jnp.arange(n_blocks, dtype=jnp.int32) * MOE_BLOCK, side='right'),
                          N_EXPERTS - 1)
    xs = ht[slot_tok].reshape(n_blocks, MOE_BLOCK, d_)

    def expert_block(args):
        xb, e = args
        gate, up = jnp.split(xb @ w_up[e], 2, axis=-1)
        return (jax.nn.silu(gate) * up) @ w_down[e]

    ys = lax.map(expert_block, (xs, block_e)).reshape(n_slots, d_)
    out = jnp.zeros((t_, d_), jnp.float32).at[slot_tok].add(ys.astype(jnp.float32) * slot_w[:, None])
    return out.reshape(b_, s_, d_).astype(h.dtype)


def setup_inputs(seed: int = 0) -> dict:
    key = jax.random.key(seed)
    ks = jax.random.split(key, 24)
    nrm = jax.random.normal
    f32 = jnp.float32
    dt = jnp.exp(jax.random.uniform(ks[5], (DEPTH, GDN_HEADS), f32, jnp.log(1e-3), jnp.log(1e-1)))
    return {
        'x': nrm(ks[0], (BATCH, SEQ, D_MODEL), f32),
        'positions': jnp.broadcast_to(jnp.arange(SEQ, dtype=jnp.int32), (BATCH, SEQ)),
        'norm1_g': 1.0 + 0.02 * nrm(ks[1], (DEPTH, D_MODEL), f32),
        'w_in': nrm(ks[2], (DEPTH, D_MODEL, N_IN), f32) * D_MODEL ** -0.5,
        'conv_a_w': nrm(ks[3], (DEPTH, GDN_CONV, 3 * GDN_WIDTH), f32) * GDN_CONV ** -0.5,
        'a_log': jnp.log(jax.random.uniform(ks[4], (DEPTH, GDN_HEADS), f32, 1.0, 16.0)),
        'dt_bias': dt + jnp.log(-jnp.expm1(-dt)),
        'gdn_norm_g': 1.0 + 0.02 * nrm(ks[6], (DEPTH, GDN_HEAD_DIM), f32),
        'conv_b_w': nrm(ks[7], (DEPTH, CONF_CONV, CONF_WIDTH), f32) * CONF_CONV ** -0.5,
        'conv_b_b': 0.02 * nrm(ks[8], (DEPTH, CONF_WIDTH), f32),
        'ln_b_g': 1.0 + 0.02 * nrm(ks[9], (DEPTH, CONF_WIDTH), f32),
        'ln_b_b': 0.02 * nrm(ks[10], (DEPTH, CONF_WIDTH), f32),
        'pool_w': nrm(ks[11], (DEPTH, len(POOL_WINDOWS), POOL_GROUP_WIDTH, POOL_GROUP_WIDTH), f32) * POOL_GROUP_WIDTH ** -0.5,
        'pool_scale': 1.0 + 0.1 * nrm(ks[12], (DEPTH, POOL_WIDTH), f32),
        'w_branch': nrm(ks[13], (DEPTH, N_BRANCHES, BRANCH_WIDTH, D_MODEL), f32) * BRANCH_WIDTH ** -0.5,
        'w_out': nrm(ks[14], (DEPTH, D_MODEL, D_MODEL), f32) * D_MODEL ** -0.5,
        'norm2_g': 1.0 + 0.02 * nrm(ks[15], (DEPTH, D_MODEL), f32),
        'router_group_w': nrm(ks[16], (DEPTH, D_MODEL, N_EXPERT_GROUPS), f32) * D_MODEL ** -0.5,
        'router_group_b': 0.01 * nrm(ks[17], (DEPTH, N_EXPERT_GROUPS), f32),
        'router_expert_w': nrm(ks[18], (DEPTH, D_MODEL, N_EXPERTS), f32) * D_MODEL ** -0.5,
        'router_expert_b': 0.01 * nrm(ks[19], (DEPTH, N_EXPERTS), f32),
        'w_up': nrm(ks[20], (DEPTH, N_EXPERTS, D_MODEL, 2 * EXPERT_HIDDEN), f32) * D_MODEL ** -0.5,
        'w_down': nrm(ks[21], (DEPTH, N_EXPERTS, EXPERT_HIDDEN, D_MODEL), f32) * EXPERT_HIDDEN ** -0.5,
        'final_norm_g': 1.0 + 0.02 * nrm(ks[22], (D_MODEL,), f32),
    }


def reference(x, positions, norm1_g, w_in, conv_a_w, a_log, dt_bias, gdn_norm_g, conv_b_w, conv_b_b,
              ln_b_g, ln_b_b, pool_w, pool_scale, w_branch, w_out, norm2_g, router_group_w,
              router_group_b, router_expert_w, router_expert_b, w_up, w_down, final_norm_g):
    for layer in range(DEPTH):
        h = rms_norm(x, norm1_g[layer])
        x = x + hybrid_mixer(h, positions, w_in[layer], conv_a_w[layer], a_log[layer], dt_bias[layer],
                             gdn_norm_g[layer], conv_b_w[layer], conv_b_b[layer], ln_b_g[layer], ln_b_b[layer],
                             pool_w[layer], pool_scale[layer], w_branch[layer], w_out[layer])
        h = rms_norm(x, norm2_g[layer])
        x = x + hierarchical_moe(h, router_group_w[layer], router_group_b[layer], router_expert_w[layer],
                                 router_expert_b[layer], w_up[layer], w_down[layer])
    return rms_norm(x, final_norm_g)
```

```cpp
#include <hip/hip_runtime.h>
#include <cstdio>
#include <cstdint>

#ifndef PROBE_SUB
#define PROBE_SUB 0
#endif
#ifndef PROBE_PHASE
#define PROBE_PHASE -1
#endif
#ifndef MK_ONE_LAUNCH
#define MK_ONE_LAUNCH 1
#endif

#define LAS __attribute__((address_space(3)))
typedef unsigned short bf16_t;
typedef short bf16x8 __attribute__((ext_vector_type(8)));
typedef float f32x4 __attribute__((ext_vector_type(4)));
typedef unsigned u32x4 __attribute__((ext_vector_type(4)));
typedef unsigned u32x2 __attribute__((ext_vector_type(2)));
typedef short s16x4 __attribute__((ext_vector_type(4)));
typedef float f32x2 __attribute__((ext_vector_type(2)));

constexpr int T = 8192, D = 2048, NL = 2;
constexpr int NIN = 20492, NU = 20480;
constexpr int UC_QKV = 0, UC_Z = 2304, UC_B = 3072, UC_C = 4608, UC_D = 11520, UC_G = 12288;
constexpr int NE = 64, EH = 512;
constexpr int NTHREADS = 512;
constexpr int LDS_STAGE = 131072;
constexpr int LDS_MISC = LDS_STAGE;
constexpr int LDS_OSTG = LDS_STAGE + 8192;
constexpr int LDS_BYTES = LDS_OSTG + 16384;

constexpr size_t al256(size_t x) { return (x + 255) & ~(size_t)255; }
constexpr size_t WS_CTL = 0;
constexpr size_t CTL_BYTES = 65536;
constexpr size_t CTL_CNT = 32768;
constexpr size_t WS_WINT = WS_CTL + CTL_BYTES;
constexpr size_t WS_WBRT = WS_WINT + (size_t)NL * NU * D * 2;
constexpr size_t WS_WOUTT = WS_WBRT + (size_t)NL * 4 * D * 768 * 2;
constexpr size_t WS_WUPT = WS_WOUTT + (size_t)NL * D * D * 2;
constexpr size_t WS_WDNT = WS_WUPT + (size_t)NL * NE * 1024 * D * 2;
constexpr size_t WS_H = WS_WDNT + (size_t)NL * NE * D * EH * 2;
constexpr size_t WS_U = WS_H + (size_t)T * D * 2;
constexpr size_t WS_XA = WS_U + (size_t)T * NU * 2;
constexpr size_t WS_XB = WS_XA + (size_t)T * D * 4;
constexpr size_t WS_BETA = WS_XB + (size_t)T * D * 4;
constexpr size_t WS_GLOG = WS_BETA + (size_t)T * 8 * 4;
constexpr int GB_WC = 0, GB_QD = 16384, GB_KDT = 32768, GB_QK = 49152, GB_BYTES = 57344;
constexpr size_t WS_GBLK = WS_GLOG + (size_t)T * 8 * 4;
constexpr size_t WS_UCP = WS_GBLK + (size_t)768 * GB_BYTES;
constexpr size_t WS_GL = WS_UCP + (size_t)768 * 8192 * 4;
constexpr size_t WS_OGDN = WS_GL + 4096;
constexpr size_t WS_QR = WS_OGDN + (size_t)T * 768 * 4;
constexpr size_t WS_KR = WS_QR + (size_t)T * 2304 * 2;
constexpr size_t WS_ATTO = WS_KR + (size_t)T * 2304 * 2;
constexpr size_t WS_LSE = WS_ATTO + (size_t)3 * T * 768 * 2;
constexpr size_t WS_YBR = WS_LSE + (size_t)3 * T * 8 * 4;
constexpr size_t WS_M32 = WS_YBR + (size_t)4 * T * 768 * 2;
constexpr size_t WS_MERGED = WS_M32 + (size_t)T * D * 4;
constexpr size_t WS_TOK = WS_MERGED + (size_t)T * D * 2;
constexpr size_t WS_WTS = WS_TOK + (size_t)NE * 8192 * 4;
constexpr size_t WS_HID = WS_WTS + (size_t)T * 2 * 4;
constexpr size_t WS_YMOE = WS_HID + (size_t)32768 * EH * 2;
constexpr size_t WS_PWT = WS_YMOE + (size_t)T * 2 * D * 4;
constexpr size_t WS_WRT = WS_PWT + (size_t)NL * 4 * 192 * 192 * 2;
constexpr size_t WS_WSM = WS_WRT + (size_t)NL * 2 * 80 * 2048 * 2;
constexpr size_t WS_WSL = WS_WSM + (size_t)NL * 12 * 2048 * 4;
constexpr size_t WS_END = WS_WSL + (size_t)NE * 8192 * 4;

__constant__ float ROPE_INV[64] = {1.000000000e+00f, 8.659643531e-01f, 7.498942018e-01f, 6.493816376e-01f, 5.623413324e-01f, 4.869675338e-01f, 4.216965139e-01f, 3.651741147e-01f, 3.162277639e-01f, 2.738419771e-01f, 2.371373773e-01f, 2.053525001e-01f, 1.778279394e-01f, 1.539926529e-01f, 1.333521456e-01f, 1.154781953e-01f, 1.000000015e-01f, 8.659642935e-02f, 7.498942316e-02f, 6.493816525e-02f, 5.623413250e-02f, 4.869675264e-02f, 4.216964915e-02f, 3.651741147e-02f, 3.162277490e-02f, 2.738419548e-02f, 2.371373773e-02f, 2.053525113e-02f, 1.778279431e-02f, 1.539926510e-02f, 1.333521400e-02f, 1.154781971e-02f, 9.999999776e-03f, 8.659643121e-03f, 7.498942316e-03f, 6.493816152e-03f, 5.623413250e-03f, 4.869675264e-03f, 4.216964822e-03f, 3.651741194e-03f, 3.162277630e-03f, 2.738419687e-03f, 2.371373819e-03f, 2.053525066e-03f, 1.778279431e-03f, 1.539926510e-03f, 1.333521446e-03f, 1.154782018e-03f, 1.000000047e-03f, 8.659643354e-04f, 7.498941850e-04f, 6.493816036e-04f, 5.623413017e-04f, 4.869675322e-04f, 4.216965172e-04f, 3.651741135e-04f, 3.162277571e-04f, 2.738419571e-04f, 2.371373703e-04f, 2.053525095e-04f, 1.778279402e-04f, 1.539926598e-04f, 1.333521504e-04f, 1.154782003e-04f};

__device__ __forceinline__ float bf2f(unsigned short b) { return __uint_as_float(((unsigned)b) << 16); }
__device__ __forceinline__ float bflo(unsigned w) { return __uint_as_float(w << 16); }
__device__ __forceinline__ float bfhi(unsigned w) { return __uint_as_float(w & 0xffff0000u); }
typedef __bf16 bf16x2_t __attribute__((ext_vector_type(2)));
__device__ __forceinline__ unsigned cvt_pk_bf16(float lo, float hi) { bf16x2_t v; v.x = (__bf16)lo; v.y = (__bf16)hi; return __builtin_bit_cast(unsigned, v); }
__device__ __forceinline__ bf16_t f2bf(float f) { return (bf16_t)(cvt_pk_bf16(f, 0.f) & 0xffffu); }
__device__ __forceinline__ float shx(float v, int o, int lane) { return __int_as_float(__builtin_amdgcn_ds_bpermute((lane ^ o) << 2, __float_as_int(v))); }
__device__ __forceinline__ float wave_sum(float v, int lane) {
#pragma unroll
    for (int o = 32; o; o >>= 1) v += shx(v, o, lane);
    return v; }
__device__ __forceinline__ float wave_max(float v, int lane) {
#pragma unroll
    for (int o = 32; o; o >>= 1) v = fmaxf(v, shx(v, o, lane));
    return v; }
__device__ __forceinline__ float sigmoidf_(float x) { return 1.0f / (1.0f + __expf(-x)); }
__device__ __forceinline__ float siluf_(float x) { return x / (1.0f + __expf(-x)); }

__device__ __forceinline__ bf16x8 tr_pair(const LAS unsigned char* p0, const LAS unsigned char* p1) {
    const s16x4 a = __builtin_amdgcn_ds_read_tr16_b64_v4i16((LAS s16x4*)p0), b = __builtin_amdgcn_ds_read_tr16_b64_v4i16((LAS s16x4*)p1);
    return __builtin_shufflevector(a, b, 0, 1, 2, 3, 4, 5, 6, 7); }
#define XB_TMO      128
#define XB_XCNT(j)  (256  + 64 * (j))
#define XB_XSUB(j)  (1280 + 64 * (j))
#define XB_XGEN(j)  (2304 + 64 * (j))
#define XB_TOP      3328
#define XB_TOPGEN   3392
#define XCD_BAR_WORDS 3456
#define XB_SPIN_CAP (1u << 18)
__device__ __forceinline__ unsigned xb_ld(unsigned* p)              { return __hip_atomic_load(p, __ATOMIC_RELAXED, __HIP_MEMORY_SCOPE_AGENT); }
__device__ __forceinline__ unsigned xb_add(unsigned* p, unsigned v) { return __hip_atomic_fetch_add(p, v, __ATOMIC_RELAXED, __HIP_MEMORY_SCOPE_AGENT); }
__device__ __forceinline__ unsigned xb_xcc_id() { return (unsigned)__builtin_amdgcn_s_getreg((3 << 11) | 20) & 0xFu; }
#define XB_SPIN(cond, bar) do { unsigned _sp = 0; while (cond) { __builtin_amdgcn_s_sleep(1); \
    if ((++_sp & 255u) == 0u) { if (xb_ld(&(bar)[XB_TMO])) break; if (_sp > XB_SPIN_CAP) { atomicAdd(&(bar)[XB_TMO], 1u); break; } } } } while (0)
struct XcdBarrier { unsigned* bar; unsigned x; volatile LAS unsigned* st; };
__device__ __forceinline__ XcdBarrier xcd_barrier_post(unsigned* bar, volatile LAS unsigned* st) {
    XcdBarrier b; b.bar = bar; b.x = xb_xcc_id(); b.st = st;
    if (threadIdx.x == 0) (void)xb_add(&bar[XB_XCNT(b.x)], 1u);
    return b;
}
__device__ __forceinline__ void xcd_barrier_complete(unsigned* bar, unsigned x, unsigned& nloc, unsigned& nx) {
    const unsigned G = gridDim.x * gridDim.y * gridDim.z;
    unsigned sum, cnt, mine, sp = 0u;
    for (;;) {
        sum = 0u; cnt = 0u; mine = 0u;
#pragma unroll
        for (unsigned j = 0; j < 16; ++j) { const unsigned c = xb_ld(&bar[XB_XCNT(j)]); sum += c; cnt += (c > 0u) ? 1u : 0u; mine = (j == x) ? c : mine; }
        if (sum == G) break;
        __builtin_amdgcn_s_sleep(1);
        if ((++sp & 255u) == 0u) { if (xb_ld(&bar[XB_TMO])) break; if (sp > XB_SPIN_CAP) { atomicAdd(&bar[XB_TMO], 1u); break; } }
    }
    nloc = mine > 0u ? mine : 1u; nx = cnt > 0u ? cnt : 1u;
}
__device__ __forceinline__ void xcd_barrier(const XcdBarrier& b) {
    asm volatile("s_waitcnt vmcnt(0)" ::: "memory");
    __syncthreads();
    if (threadIdx.x == 0) {
        unsigned* bar = b.bar;
        __builtin_amdgcn_s_waitcnt(0);
        unsigned nloc = b.st[0], nx = b.st[1];
        if (nloc == 0u) { xcd_barrier_complete(bar, b.x, nloc, nx); b.st[0] = nloc; b.st[1] = nx; }
        const unsigned old = xb_add(&bar[XB_XSUB(b.x)], 1u);
        const unsigned gen = old / nloc;
        if (old + 1u == (gen + 1u) * nloc) {
            __builtin_amdgcn_fence(__ATOMIC_RELEASE, "agent");
            asm volatile("s_waitcnt vmcnt(0)" ::: "memory");
            const unsigned og = xb_add(&bar[XB_TOP], 1u);
            const unsigned tg = og / nx;
            if (og + 1u == (tg + 1u) * nx) xb_add(&bar[XB_TOPGEN], 1u);
            else XB_SPIN(xb_ld(&bar[XB_TOPGEN]) == tg, bar);
            __builtin_amdgcn_fence(__ATOMIC_ACQUIRE, "agent");
            xb_add(&bar[XB_XGEN(b.x)], 1u);
            asm volatile("s_waitcnt vmcnt(0)" ::: "memory");
        } else {
            XB_SPIN(xb_ld(&bar[XB_XGEN(b.x)]) == gen, bar);
            __builtin_amdgcn_fence(__ATOMIC_ACQUIRE, "agent");
            asm volatile("s_waitcnt vmcnt(0)" ::: "memory");
        }
    }
    __syncthreads();
}

namespace pg8 {
constexpr int BM = 256, BK = 64, HALF = 128, HTB = HALF * BK * 2, STAGE_BYTES = 8 * HTB, NXCD = 8, WGM = 8;
__host__ __device__ __forceinline__ int lds_byte(int r, int c) { const int st = (r >> 4) * 2 + (c >> 5), rr = r & 15, cc = c & 31, ob = rr * 64 + cc * 2; return st * 1024 + (ob ^ (((ob >> 9) & 1) << 5)); }
__host__ __device__ __forceinline__ void stage_rc(int b, int& R, int& C) { const int st = b / 1024, sb = b % 1024, swz = sb ^ (((sb >> 9) & 1) << 5); R = (st >> 1) * 16 + swz / 64; C = (st & 1) * 32 + (swz % 64) / 2; }
__host__ __device__ __forceinline__ int perm32(int rho) { const int n = rho >> 4, i = rho & 15; return 8 * (i >> 2) + 4 * n + (i & 3); }
struct Unit { int pm, pn; };
struct Gemm { const bf16_t* A; const bf16_t* Bt; int K; };
struct StaticOrder {
    int nM, nN, nwg, G, c;
    __device__ void init(int M, int N, int G_, int c_) { nM = M / BM; nN = N / BM; nwg = nM * nN; G = G_; c = c_; }
    __device__ bool next(int i, Unit& u) const {
        const long L = (long)i * G + c; if (L >= nwg) return false;
        int wgid = (int)L; { const int q = nwg / NXCD, r = nwg % NXCD, xcd = wgid % NXCD, off = wgid / NXCD; wgid = (xcd < r ? xcd * (q + 1) : r * (q + 1) + (xcd - r) * q) + off; }
        const int nig = WGM * nN, gid = wgid / nig, fm = gid * WGM, gsz = (nM - fm) < WGM ? (nM - fm) : WGM;
        u.pm = fm + ((wgid % nig) % gsz); u.pn = (wgid % nig) / gsz; return true;
    }
    __device__ __forceinline__ int arow(const Unit& u, int r) const { return u.pm * BM + r; }
};

template <class Epi, class Sched, bool GATHER>
__device__ __forceinline__ void gemm_phase(LAS unsigned char* lds, const Gemm g, const Sched& S, const Epi& E) {
    int tid = threadIdx.x; asm volatile("" : "+v"(tid));
    const int wid = __builtin_amdgcn_readfirstlane(tid >> 6), lane = tid & 63, wr = wid >> 2, wc = wid & 3, fr = lane & 15, fq = lane >> 4;
    const int K = g.K, nt = K / BK;
    unsigned voffA[2], voffB[2]; int RA[2], CA[2];
#pragma unroll
    for (int i = 0; i < 2; ++i) { int R, C; stage_rc(tid * 16 + i * 8192, R, C); const int Rb = Epi::PERM ? ((R & ~31) + perm32(R & 31)) : R;
        voffA[i] = (unsigned)(R * K + C) * 2u; voffB[i] = (unsigned)(Rb * K + C) * 2u; RA[i] = R; CA[i] = C; }
    const size_t kstep = (size_t)(BK * 2);
    const size_t hstep = (size_t)HALF * K * 2;
    const size_t tstep = 2 * hstep;
    const unsigned ldsw = (unsigned)wid * 1024u;
    const int aoff = lds_byte(wr * 64 + fr, fq * 8), boff = lds_byte(wc * 32 + fr, fq * 8);
#define PG8_SA(b, h) (((b) * 2 + (h)) * HTB)
#define PG8_SB(b, h) ((4 + (b) * 2 + (h)) * HTB)
#define PG8_STAGE(bufoff, gbase, voff) do { _Pragma("unroll") for (int _i = 0; _i < 2; ++_i) \
        __builtin_amdgcn_global_load_lds((const unsigned*)((const char*)(gbase) + (voff)[_i]), (LAS unsigned*)(lds + (bufoff) + ldsw + _i * 8192), 16, 0, 0); } while (0)
#define PG8_STAGE2(bufoff, gbase, o0, o1) do { \
        __builtin_amdgcn_global_load_lds((const unsigned*)((const char*)(gbase) + (o0)), (LAS unsigned*)(lds + (bufoff) + ldsw), 16, 0, 0); \
        __builtin_amdgcn_global_load_lds((const unsigned*)((const char*)(gbase) + (o1)), (LAS unsigned*)(lds + (bufoff) + ldsw + 8192), 16, 0, 0); } while (0)
#define PG8_LDA(dst, b, h) do { _Pragma("unroll") for (int m = 0; m < 4; ++m) _Pragma("unroll") for (int k = 0; k < 2; ++k) dst[m][k] = *(const LAS bf16x8*)(lds + PG8_SA(b, h) + aoff + m * 2048 + k * 1024); } while (0)
#define PG8_LDB(dst, b, h) do { _Pragma("unroll") for (int n = 0; n < 2; ++n) _Pragma("unroll") for (int k = 0; k < 2; ++k) dst[n][k] = *(const LAS bf16x8*)(lds + PG8_SB(b, h) + boff + n * 2048 + k * 1024); } while (0)
#define PG8_MMA(ai, bj, At, Bt) do { __builtin_amdgcn_s_setprio(1); _Pragma("unroll") for (int m = 0; m < 4; ++m) _Pragma("unroll") for (int n = 0; n < 2; ++n) _Pragma("unroll") for (int k = 0; k < 2; ++k) \
        acc[ai][bj][m][n] = __builtin_amdgcn_mfma_f32_16x16x32_bf16(Bt[n][k], At[m][k], acc[ai][bj][m][n], 0, 0, 0); __builtin_amdgcn_s_setprio(0); } while (0)
#define PG8_WAIT_V(n) asm volatile("s_waitcnt vmcnt(" #n ")" ::: "memory")
#define PG8_WAIT_L(n) asm volatile("s_waitcnt lgkmcnt(" #n ")" ::: "memory")
#define PG8_BAR __builtin_amdgcn_s_barrier()
#define PG8_SCHED __builtin_amdgcn_sched_barrier(0)
    Unit cur, nxt; int ui = 0;
    if (!S.next(0, cur)) return;
    f32x4 acc[2][2][4][2];
#pragma unroll
    for (int a = 0; a < 2; ++a)
#pragma unroll
        for (int b = 0; b < 2; ++b)
#pragma unroll
            for (int m = 0; m < 4; ++m)
#pragma unroll
                for (int n = 0; n < 2; ++n) acc[a][b][m][n] = (f32x4){0.f, 0.f, 0.f, 0.f};
    bf16x8 At[4][2], B0[2][2], B1[2][2];
    unsigned c00 = 0, c01 = 0, c10 = 0, c11 = 0, n00 = 0, n01 = 0, n10 = 0, n11 = 0;
    if constexpr (GATHER) {
        c00 = (unsigned)(S.arow(cur, RA[0]) * K + CA[0]) * 2u; c01 = (unsigned)(S.arow(cur, RA[1]) * K + CA[1]) * 2u;
        c10 = (unsigned)(S.arow(cur, HALF + RA[0]) * K + CA[0]) * 2u; c11 = (unsigned)(S.arow(cur, HALF + RA[1]) * K + CA[1]) * 2u;
    }
    const char* cA = GATHER ? (const char*)g.A : (const char*)g.A + (size_t)cur.pm * tstep; const char* cB = (const char*)g.Bt + (size_t)cur.pn * tstep;
    if constexpr (GATHER) {
        PG8_STAGE(PG8_SB(0, 0), cB, voffB); PG8_STAGE2(PG8_SA(0, 0), cA, c00, c01); PG8_STAGE(PG8_SB(0, 1), cB + hstep, voffB); PG8_STAGE2(PG8_SA(0, 1), cA, c10, c11);
    } else {
        PG8_STAGE(PG8_SB(0, 0), cB, voffB); PG8_STAGE(PG8_SA(0, 0), cA, voffA); PG8_STAGE(PG8_SB(0, 1), cB + hstep, voffB); PG8_STAGE(PG8_SA(0, 1), cA + hstep, voffA);
    }
    if (wr == 1) PG8_BAR;
    PG8_WAIT_V(4); PG8_BAR;
    if constexpr (GATHER) {
        PG8_STAGE(PG8_SB(1, 0), cB + kstep, voffB); PG8_STAGE2(PG8_SA(1, 0), cA + kstep, c00, c01); PG8_STAGE(PG8_SB(1, 1), cB + hstep + kstep, voffB);
    } else {
        PG8_STAGE(PG8_SB(1, 0), cB + kstep, voffB); PG8_STAGE(PG8_SA(1, 0), cA + kstep, voffA); PG8_STAGE(PG8_SB(1, 1), cB + hstep + kstep, voffB);
    }
    PG8_WAIT_V(6); PG8_BAR;
    for (;;) {
        const bool has_next = S.next(ui + 1, nxt);
        if constexpr (GATHER) {
            if (has_next) {
                n00 = (unsigned)(S.arow(nxt, RA[0]) * K + CA[0]) * 2u; n01 = (unsigned)(S.arow(nxt, RA[1]) * K + CA[1]) * 2u;
                n10 = (unsigned)(S.arow(nxt, HALF + RA[0]) * K + CA[0]) * 2u; n11 = (unsigned)(S.arow(nxt, HALF + RA[1]) * K + CA[1]) * 2u;
            } else { n00 = c00; n01 = c01; n10 = c10; n11 = c11; }
        }
        const char* nA = GATHER ? cA : (has_next ? (const char*)g.A + (size_t)nxt.pm * tstep : cA);
        const char* nB = has_next ? (const char*)g.Bt + (size_t)nxt.pn * tstep : cB;
        for (int t = 0; t < nt; t += 2) {
            const bool last = (t == nt - 2);
            const char* a1 = cA + (size_t)(t + 1) * kstep;
            const char* a2 = last ? nA : cA + (size_t)(t + 2) * kstep; const char* b2 = last ? nB : cB + (size_t)(t + 2) * kstep;
            const char* a3 = a2 + kstep; const char* b3 = b2 + kstep;
            unsigned s00 = 0, s01 = 0, s10 = 0, s11 = 0;
            if constexpr (GATHER) { s00 = last ? n00 : c00; s01 = last ? n01 : c01; s10 = last ? n10 : c10; s11 = last ? n11 : c11; }
            PG8_LDB(B0, 0, 0); PG8_SCHED; PG8_LDA(At, 0, 0);
            if constexpr (GATHER) PG8_STAGE2(PG8_SA(1, 1), a1, c10, c11); else PG8_STAGE(PG8_SA(1, 1), a1 + hstep, voffA);
            PG8_WAIT_L(8); PG8_BAR; PG8_WAIT_L(0); PG8_MMA(0, 0, At, B0); PG8_BAR; PG8_SCHED;
            PG8_LDB(B1, 0, 1); PG8_STAGE(PG8_SB(0, 0), b2, voffB);
            PG8_BAR; PG8_WAIT_L(0); PG8_MMA(0, 1, At, B1); PG8_BAR;
            PG8_LDA(At, 0, 1);
            if constexpr (GATHER) PG8_STAGE2(PG8_SA(0, 0), a2, s00, s01); else PG8_STAGE(PG8_SA(0, 0), a2, voffA);
            PG8_BAR; PG8_WAIT_L(0); PG8_MMA(1, 0, At, B0); PG8_BAR; PG8_SCHED;
            PG8_STAGE(PG8_SB(0, 1), b2 + hstep, voffB);
            PG8_WAIT_V(6); PG8_BAR; PG8_MMA(1, 1, At, B1); PG8_BAR;
            PG8_LDB(B0, 1, 0); PG8_SCHED; PG8_LDA(At, 1, 0);
            if constexpr (GATHER) PG8_STAGE2(PG8_SA(0, 1), a2, s10, s11); else PG8_STAGE(PG8_SA(0, 1), a2 + hstep, voffA);
            PG8_WAIT_L(8); PG8_BAR; PG8_WAIT_L(0); PG8_MMA(0, 0, At, B0); PG8_BAR; PG8_SCHED;
            PG8_LDB(B1, 1, 1); PG8_STAGE(PG8_SB(1, 0), b3, voffB);
            PG8_BAR; PG8_WAIT_L(0); PG8_MMA(0, 1, At, B1); PG8_BAR;
            PG8_LDA(At, 1, 1);
            if constexpr (GATHER) PG8_STAGE2(PG8_SA(1, 0), a3, s00, s01); else PG8_STAGE(PG8_SA(1, 0), a3, voffA);
            PG8_BAR; PG8_WAIT_L(0); PG8_MMA(1, 0, At, B0); PG8_BAR; PG8_SCHED;
            PG8_STAGE(PG8_SB(1, 1), b3 + hstep, voffB);
            PG8_WAIT_V(6); PG8_BAR; PG8_MMA(1, 1, At, B1); PG8_BAR;
        }
        E(acc, cur, wr, wc, fr, fq);
        if (!has_next) break;
#pragma unroll
        for (int a = 0; a < 2; ++a)
#pragma unroll
            for (int b = 0; b < 2; ++b)
#pragma unroll
                for (int m = 0; m < 4; ++m)
#pragma unroll
                    for (int n = 0; n < 2; ++n) acc[a][b][m][n] = (f32x4){0.f, 0.f, 0.f, 0.f};
        cur = nxt; cA = nA; cB = nB; ++ui;
        if constexpr (GATHER) { c00 = n00; c01 = n01; c10 = n10; c11 = n11; }
    }
    PG8_WAIT_V(0);
    if (wr == 0) PG8_BAR;
    PG8_BAR;
#undef PG8_SA
#undef PG8_SB
#undef PG8_STAGE
#undef PG8_STAGE2
#undef PG8_LDA
#undef PG8_LDB
#undef PG8_MMA
#undef PG8_WAIT_V
#undef PG8_WAIT_L
#undef PG8_BAR
#undef PG8_SCHED
}
}

struct Params {
    const float* x; const int* pos; const float* norm1_g; const float* w_in; const float* conv_a_w; const float* a_log; const float* dt_bias; const float* gdn_norm_g;
    const float* conv_b_w; const float* conv_b_b; const float* ln_b_g; const float* ln_b_b; const float* pool_w; const float* pool_scale; const float* w_branch; const float* w_out;
    const float* norm2_g; const float* rg_w; const float* rg_b; const float* re_w; const float* re_b; const float* w_up; const float* w_down; const float* final_g;
    float* out; unsigned char* ws; int ph_lo, ph_hi, probe, pad;
};

struct Ctx { int tid, lane, wave, bid, G; LAS unsigned char* lds; };
constexpr int LDS_PTAB = LDS_MISC + 512;
__device__ __forceinline__ const void* lds_ptr_get(const LAS unsigned* tab, int i) {
    const unsigned lo = __builtin_amdgcn_readfirstlane(tab[2 * i]), hi = __builtin_amdgcn_readfirstlane(tab[2 * i + 1]);
    return (const void*)(((unsigned long long)hi << 32) | lo); }
__device__ __forceinline__ Params load_params(const Ctx& c, unsigned char* ws, int lo, int hi) {
    const LAS unsigned* tab = (const LAS unsigned*)(c.lds + LDS_PTAB); asm volatile("" : "+v"(tab));
    Params q;
    q.x = (const float*)lds_ptr_get(tab, 0); q.pos = (const int*)lds_ptr_get(tab, 1); q.norm1_g = (const float*)lds_ptr_get(tab, 2); q.w_in = (const float*)lds_ptr_get(tab, 3);
    q.conv_a_w = (const float*)lds_ptr_get(tab, 4); q.a_log = (const float*)lds_ptr_get(tab, 5); q.dt_bias = (const float*)lds_ptr_get(tab, 6); q.gdn_norm_g = (const float*)lds_ptr_get(tab, 7);
    q.conv_b_w = (const float*)lds_ptr_get(tab, 8); q.conv_b_b = (const float*)lds_ptr_get(tab, 9); q.ln_b_g = (const float*)lds_ptr_get(tab, 10); q.ln_b_b = (const float*)lds_ptr_get(tab, 11);
    q.pool_w = (const float*)lds_ptr_get(tab, 12); q.pool_scale = (const float*)lds_ptr_get(tab, 13); q.w_branch = (const float*)lds_ptr_get(tab, 14); q.w_out = (const float*)lds_ptr_get(tab, 15);
    q.norm2_g = (const float*)lds_ptr_get(tab, 16); q.rg_w = (const float*)lds_ptr_get(tab, 17); q.rg_b = (const float*)lds_ptr_get(tab, 18); q.re_w = (const float*)lds_ptr_get(tab, 19);
    q.re_b = (const float*)lds_ptr_get(tab, 20); q.w_up = (const float*)lds_ptr_get(tab, 21); q.w_down = (const float*)lds_ptr_get(tab, 22); q.final_g = (const float*)lds_ptr_get(tab, 23);
    q.out = (float*)lds_ptr_get(tab, 24); q.ws = ws; q.ph_lo = lo; q.ph_hi = hi; q.probe = -1; q.pad = 0; return q; }

__device__ __forceinline__ void cvt_tile(const Ctx& c, const float* __restrict__ src, size_t ld, int k0, int n0s, bf16_t* __restrict__ dst, int K, int n0d) {
    LAS float* tile = (LAS float*)c.lds;
    const int tid = c.tid;
#pragma unroll
    for (int rr = 0; rr < 2; ++rr) {
        const int r = (tid >> 4) + rr * 32, cc = (tid & 15) * 4;
        const float4 v = *(const float4*)(src + (size_t)(k0 + r) * ld + n0s + cc);
        tile[r * 65 + cc + 0] = v.x; tile[r * 65 + cc + 1] = v.y; tile[r * 65 + cc + 2] = v.z; tile[r * 65 + cc + 3] = v.w;
    }
    __syncthreads();
    {
        const int n = tid >> 3, ks = tid & 7;
        float f[8];
#pragma unroll
        for (int i = 0; i < 8; ++i) f[i] = tile[(ks * 8 + i) * 65 + n];
        u32x4 w; w.x = cvt_pk_bf16(f[0], f[1]); w.y = cvt_pk_bf16(f[2], f[3]); w.z = cvt_pk_bf16(f[4], f[5]); w.w = cvt_pk_bf16(f[6], f[7]);
        *(u32x4*)(dst + (size_t)(n0d + n) * K + k0 + ks * 8) = w;
    }
    __syncthreads();
}
struct CvtDesc { const float* src; bf16_t* dst; int ld, K; };
__device__ __forceinline__ CvtDesc cvt_desc(const Params& p, int idx) {
    constexpr int T1 = 10240, T2 = 1536, T3 = 1024, TL = T1 + T2 + T3;
    bf16_t* WinT = (bf16_t*)(p.ws + WS_WINT); bf16_t* WbrT = (bf16_t*)(p.ws + WS_WBRT); bf16_t* WoutT = (bf16_t*)(p.ws + WS_WOUTT);
    const int L = idx / TL; int r = idx % TL; CvtDesc d;
    if (r < T1) { const int kt = r % 32, ntile = r / 32, n0d = ntile * 64, n0s = n0d + (n0d >= 3072 ? 12 : 0);
        d.ld = NIN; d.K = D; d.src = p.w_in + (size_t)L * D * NIN + (size_t)(kt * 64) * NIN + n0s; d.dst = WinT + (size_t)L * NU * D + (size_t)n0d * D + kt * 64; return d; }
    r -= T1;
    if (r < T2) { const int kb = r / 384, rr = r % 384, kt = rr % 12, ntile = rr / 12;
        d.ld = D; d.K = 768; d.src = p.w_branch + (size_t)(L * 4 + kb) * 768 * D + (size_t)(kt * 64) * D + ntile * 64; d.dst = WbrT + (size_t)(L * 4 + kb) * D * 768 + (size_t)(ntile * 64) * 768 + kt * 64; return d; }
    r -= T2;
    { const int kt = r % 32, ntile = r / 32;
        d.ld = D; d.K = D; d.src = p.w_out + (size_t)L * D * D + (size_t)(kt * 64) * D + ntile * 64; d.dst = WoutT + (size_t)L * D * D + (size_t)(ntile * 64) * D + kt * 64; return d; }
}
__device__ __forceinline__ void phase_convert(const Ctx& c, const Params& p) {
    constexpr int TL = 10240 + 1536 + 1024;
    {
        const int tid = c.tid, r0 = tid >> 4, cc = (tid & 15) * 4;
        int idx = c.bid; float4 v0 = make_float4(0.f, 0.f, 0.f, 0.f), v1 = v0, m0 = v0, m1 = v0; CvtDesc cur, mid;
        if (idx < NL * TL) { cur = cvt_desc(p, idx); v0 = *(const float4*)(cur.src + (size_t)r0 * cur.ld + cc); v1 = *(const float4*)(cur.src + (size_t)(r0 + 32) * cur.ld + cc); mid = cur; }
        if (idx + c.G < NL * TL) { mid = cvt_desc(p, idx + c.G); m0 = *(const float4*)(mid.src + (size_t)r0 * mid.ld + cc); m1 = *(const float4*)(mid.src + (size_t)(r0 + 32) * mid.ld + cc); }
        int bsel = 0;
        while (idx < NL * TL) {
            const int n2 = idx + 2 * c.G; CvtDesc nxt = mid; float4 n0 = m0, n1 = m1;
            if (n2 < NL * TL) { nxt = cvt_desc(p, n2); n0 = *(const float4*)(nxt.src + (size_t)r0 * nxt.ld + cc); n1 = *(const float4*)(nxt.src + (size_t)(r0 + 32) * nxt.ld + cc); }
            LAS float* tile = (LAS float*)c.lds + bsel * (64 * 65 + 32);
            tile[r0 * 65 + cc + 0] = v0.x; tile[r0 * 65 + cc + 1] = v0.y; tile[r0 * 65 + cc + 2] = v0.z; tile[r0 * 65 + cc + 3] = v0.w;
            tile[(r0 + 32) * 65 + cc + 0] = v1.x; tile[(r0 + 32) * 65 + cc + 1] = v1.y; tile[(r0 + 32) * 65 + cc + 2] = v1.z; tile[(r0 + 32) * 65 + cc + 3] = v1.w;
            __syncthreads();
            { const int n = tid >> 3, ks = tid & 7; float f[8];
#pragma unroll
              for (int i = 0; i < 8; ++i) f[i] = tile[(ks * 8 + i) * 65 + n];
              u32x4 w; w.x = cvt_pk_bf16(f[0], f[1]); w.y = cvt_pk_bf16(f[2], f[3]); w.z = cvt_pk_bf16(f[4], f[5]); w.w = cvt_pk_bf16(f[6], f[7]);
              *(u32x4*)(cur.dst + (size_t)n * cur.K + ks * 8) = w; }
            idx += c.G; cur = mid; v0 = m0; v1 = m1; mid = nxt; m0 = n0; m1 = n1; bsel ^= 1;
        }
        __syncthreads();
    }
    {   float* WSM = (float*)(p.ws + WS_WSM);
        for (int i = c.bid * NTHREADS + c.tid; i < NL * 12 * 2048; i += c.G * NTHREADS) { const int k = i & 2047, j = (i >> 11) % 12, L = i / (12 * 2048);
            WSM[i] = p.w_in[((size_t)L * D + k) * NIN + 3072 + j]; }
    }
    {
        bf16_t* WRT = (bf16_t*)(p.ws + WS_WRT);
        for (int i = c.bid * NTHREADS + c.tid; i < NL * 80 * 2048; i += c.G * NTHREADS) { const int k = i & 2047, j = (i >> 11) % 80, L = i / (80 * 2048);
            const float w = j < 8 ? p.rg_w[((size_t)L * D + k) * 8 + j] : (j < 72 ? p.re_w[((size_t)L * D + k) * 64 + (j - 8)] : 0.f);
            const bf16_t hi = f2bf(w); WRT[((size_t)(L * 2 + 0) * 80 + j) * 2048 + k] = hi; WRT[((size_t)(L * 2 + 1) * 80 + j) * 2048 + k] = f2bf(w - bf2f(hi)); }
    }
    {
        bf16_t* PWT = (bf16_t*)(p.ws + WS_PWT);
        for (int i = c.bid * NTHREADS + c.tid; i < NL * 4 * 192 * 192; i += c.G * NTHREADS) { const int cc = i % 192, e = (i / 192) % 192, lg = i / (192 * 192);
            PWT[i] = f2bf(p.pool_w[(size_t)(lg * 192 + cc) * 192 + e] * p.pool_scale[lg * 192 + e]); }
    }
}

__device__ __forceinline__ void phase_norm1(const Ctx& c, const Params& p, int L) {
    LAS float* wsm = (LAS float*)c.lds;
    { const float4* src = (const float4*)((const float*)(p.ws + WS_WSM) + (size_t)L * 12 * 2048);
      for (int i = c.tid; i < 12 * 2048 / 4; i += NTHREADS) { const float4 v = src[i]; LAS float* d = wsm + 4 * i; d[0] = v.x; d[1] = v.y; d[2] = v.z; d[3] = v.w; } }
    __syncthreads();
    const float* g1 = p.norm1_g + L * D;
    bf16_t* H = (bf16_t*)(p.ws + WS_H); float* XA = (float*)(p.ws + WS_XA); const float* XB = (const float*)(p.ws + WS_XB); const bf16_t* Y = (const bf16_t*)(p.ws + WS_YMOE);
    float* BETA = (float*)(p.ws + WS_BETA); float* GLOG = (float*)(p.ws + WS_GLOG);
    for (int rt = c.bid; rt < T / 32; rt += c.G) {
        for (int i = 0; i < 4; ++i) {
            const int t = rt * 32 + c.wave * 4 + i;
            float4 xv[8]; float ss = 0.f;
#pragma unroll
            for (int q = 0; q < 8; ++q) {
                const int col = q * 256 + c.lane * 4;
                float4 v;
                if (L == 0) v = *(const float4*)(p.x + (size_t)t * D + col);
                else { const float4 a = *(const float4*)(XB + (size_t)t * D + col); const u32x2 y0 = *(const u32x2*)(Y + (size_t)(2 * t) * D + col), y1 = *(const u32x2*)(Y + (size_t)(2 * t + 1) * D + col);
                    v.x = a.x + (bflo(y0.x) + bflo(y1.x)); v.y = a.y + (bfhi(y0.x) + bfhi(y1.x)); v.z = a.z + (bflo(y0.y) + bflo(y1.y)); v.w = a.w + (bfhi(y0.y) + bfhi(y1.y));
                    *(float4*)(XA + (size_t)t * D + col) = v; }
                xv[q] = v; ss += v.x * v.x + v.y * v.y + v.z * v.z + v.w * v.w;
            }
            ss = wave_sum(ss, c.lane);
            const float rstd = rsqrtf(ss * (1.0f / D) + 1e-6f);
            float dots[12];
#pragma unroll
            for (int j = 0; j < 12; ++j) dots[j] = 0.f;
#pragma unroll
            for (int q = 0; q < 8; ++q) {
                const int col = q * 256 + c.lane * 4;
                const float4 g = *(const float4*)(g1 + col);
                float4 h; h.x = xv[q].x * rstd * g.x; h.y = xv[q].y * rstd * g.y; h.z = xv[q].z * rstd * g.z; h.w = xv[q].w * rstd * g.w;
                uint2 o; o.x = cvt_pk_bf16(h.x, h.y); o.y = cvt_pk_bf16(h.z, h.w);
                *(uint2*)(H + (size_t)t * D + col) = o;
#pragma unroll
                for (int j = 0; j < 12; ++j) { const LAS float* wp = wsm + j * 2048 + col; dots[j] += h.x * wp[0] + h.y * wp[1] + h.z * wp[2] + h.w * wp[3]; }
            }
#pragma unroll
            for (int j = 0; j < 12; ++j) dots[j] = wave_sum(dots[j], c.lane);
            if (c.lane < 6) {
                float db = dots[0], dd = dots[6];
#pragma unroll
                for (int j = 1; j < 6; ++j) { if (c.lane == j) { db = dots[j]; dd = dots[6 + j]; } }
                BETA[t * 8 + c.lane] = 1.0f / (1.0f + expf(-db));
                const float xx = dd + p.dt_bias[L * 6 + c.lane];
                const float sp = xx > 20.f ? xx : log1pf(expf(xx));
                GLOG[t * 8 + c.lane] = -expf(p.a_log[L * 6 + c.lane]) * sp;
            }
        }
    }
}

struct EpiU {
    static constexpr bool PERM = true;
    bf16_t* O;
    __device__ __forceinline__ void operator()(const f32x4 (&acc)[2][2][4][2], const pg8::Unit& u, int wr, int wc, int fr, int fq) const {
        const int row0 = u.pm * 256 + wr * 64 + fr, col0 = u.pn * 256 + wc * 32 + 8 * fq; const bool sig = u.pn >= 48;
#pragma unroll
        for (int ai = 0; ai < 2; ++ai)
#pragma unroll
            for (int m = 0; m < 4; ++m) { bf16_t* rowp = O + (size_t)(row0 + ai * 128 + m * 16) * NU + col0;
#pragma unroll
                for (int bj = 0; bj < 2; ++bj) { f32x4 v0 = acc[ai][bj][m][0], v1 = acc[ai][bj][m][1];
                    if (sig) {
#pragma unroll
                        for (int j = 0; j < 4; ++j) { v0[j] = sigmoidf_(v0[j]); v1[j] = sigmoidf_(v1[j]); } }
                    u32x4 w; w.x = cvt_pk_bf16(v0[0], v0[1]); w.y = cvt_pk_bf16(v0[2], v0[3]); w.z = cvt_pk_bf16(v1[0], v1[1]); w.w = cvt_pk_bf16(v1[2], v1[3]);
                    *(u32x4*)(rowp + bj * 128) = w; } }
    }
};
struct MergeOrder {
    int G, c;
    __device__ bool next(int i, pg8::Unit& u) const { const int tile = c + (i >> 2) * G; if (tile >= 256) return false; const int k = i & 3, x = tile & 7, y = tile >> 3;
        u.pm = k * 32 + x * 4 + (y >> 3); u.pn = k * 8 + (y & 7); return true; }
    __device__ __forceinline__ int arow(const pg8::Unit& u, int r) const { return u.pm * 256 + r; }
};
struct EpiMerge {
    static constexpr bool PERM = true;
    const bf16_t* U; float* M32; bf16_t* MG;
    __device__ __forceinline__ void operator()(const f32x4 (&acc)[2][2][4][2], const pg8::Unit& u, int wr, int wc, int fr, int fq) const {
        const int k = u.pm >> 5, tm = u.pm & 31, tn = u.pn & 7;
        const int row0 = tm * 256 + wr * 64 + fr, col0 = tn * 256 + wc * 32 + 8 * fq;
        bf16_t* const MP = (bf16_t*)M32;
#pragma unroll
        for (int ai = 0; ai < 2; ++ai)
#pragma unroll
            for (int mh = 0; mh < 2; ++mh) {
                u32x4 gv[2][2], pv[2][2];
#pragma unroll
                for (int mm = 0; mm < 2; ++mm)
#pragma unroll
                    for (int bj = 0; bj < 2; ++bj) { const size_t row = (size_t)(row0 + ai * 128 + (mh * 2 + mm) * 16); const int col = col0 + bj * 128;
                        gv[mm][bj] = *(const u32x4*)(U + row * NU + UC_G + k * D + col);
                        pv[mm][bj] = (k > 0) ? *(const u32x4*)(MP + row * D + col) : (u32x4){0u, 0u, 0u, 0u}; }
#pragma unroll
                for (int mm = 0; mm < 2; ++mm)
#pragma unroll
                    for (int bj = 0; bj < 2; ++bj) { const int m = mh * 2 + mm; const size_t row = (size_t)(row0 + ai * 128 + m * 16); const int col = col0 + bj * 128;
                        const u32x4 g = gv[mm][bj], pp = pv[mm][bj];
                        f32x4 v0 = acc[ai][bj][m][0], v1 = acc[ai][bj][m][1];
                        v0[0] = v0[0] * bflo(g.x) + bflo(pp.x); v0[1] = v0[1] * bfhi(g.x) + bfhi(pp.x); v0[2] = v0[2] * bflo(g.y) + bflo(pp.y); v0[3] = v0[3] * bfhi(g.y) + bfhi(pp.y);
                        v1[0] = v1[0] * bflo(g.z) + bflo(pp.z); v1[1] = v1[1] * bfhi(g.z) + bfhi(pp.z); v1[2] = v1[2] * bflo(g.w) + bflo(pp.w); v1[3] = v1[3] * bfhi(g.w) + bfhi(pp.w);
                        u32x4 w; w.x = cvt_pk_bf16(v0[0], v0[1]); w.y = cvt_pk_bf16(v0[2], v0[3]); w.z = cvt_pk_bf16(v1[0], v1[1]); w.w = cvt_pk_bf16(v1[2], v1[3]);
                        *(u32x4*)((k < 3 ? MP : MG) + row * D + col) = w; }
            }
    }
};
struct EpiRes {
    static constexpr bool PERM = false;
    const float* X; float* O;
    __device__ __forceinline__ void operator()(const f32x4 (&acc)[2][2][4][2], const pg8::Unit& u, int wr, int wc, int fr, int fq) const {
        const int row0 = u.pm * 256 + wr * 64 + fr, col0 = u.pn * 256 + wc * 32 + 4 * fq;
#pragma unroll
        for (int ai = 0; ai < 2; ++ai)
#pragma unroll
            for (int mh = 0; mh < 2; ++mh) {
                f32x4 xv[2][2][2];
#pragma unroll
                for (int mm = 0; mm < 2; ++mm)
#pragma unroll
                    for (int bj = 0; bj < 2; ++bj)
#pragma unroll
                        for (int n = 0; n < 2; ++n) xv[mm][bj][n] = *(const f32x4*)(X + (size_t)(row0 + ai * 128 + (mh * 2 + mm) * 16) * D + col0 + bj * 128 + n * 16);
#pragma unroll
                for (int mm = 0; mm < 2; ++mm)
#pragma unroll
                    for (int bj = 0; bj < 2; ++bj)
#pragma unroll
                        for (int n = 0; n < 2; ++n) *(f32x4*)(O + (size_t)(row0 + ai * 128 + (mh * 2 + mm) * 16) * D + col0 + bj * 128 + n * 16) = acc[ai][bj][mh * 2 + mm][n] + xv[mm][bj][n];
            }
    }
};
struct MoeTab { const LAS int* mt_e; const LAS int* mt_p0; const LAS int* cnt; const LAS int* ut; int nmt; };
struct MoeOrder {
    MoeTab tb; int nN, G, c; const int* tok;
    __device__ bool next(int i, pg8::Unit& u) const { const int v = (G % 8 == 0) ? (c % 8) * (G / 8) + c / 8 : c; const long L = (long)i * G + v; if (L >= (long)tb.nmt * nN) return false;
        const int e = tb.ut[L]; u.pm = e >> 4; u.pn = tb.mt_e[u.pm] * nN + (e & 15); return true; }
    __device__ __forceinline__ int arow(const pg8::Unit& u, int r) const { const int e = tb.mt_e[u.pm], pos = tb.mt_p0[u.pm] + r; return pos < tb.cnt[e] ? (tok[e * 8192 + pos] >> 1) : 0; }
};
struct EpiUp {
    bf16_t* HID;
    __device__ __forceinline__ void operator()(const f32x4 (&acc)[2][4][2], const pg8::Unit& u, int wr, int wc, int fr, int fq) const {
        const int j = u.pn & 3; const int row0 = u.pm * 128 + wr * 64 + fr, col0 = j * 128 + wc * 32 + 8 * fq;
#pragma unroll
        for (int m = 0; m < 4; ++m) { const f32x4 g0 = acc[0][m][0], g1 = acc[0][m][1], u0 = acc[1][m][0], u1 = acc[1][m][1];
            float h[8];
#pragma unroll
            for (int q = 0; q < 4; ++q) { h[q] = siluf_(g0[q]) * u0[q]; h[4 + q] = siluf_(g1[q]) * u1[q]; }
            u32x4 w; w.x = cvt_pk_bf16(h[0], h[1]); w.y = cvt_pk_bf16(h[2], h[3]); w.z = cvt_pk_bf16(h[4], h[5]); w.w = cvt_pk_bf16(h[6], h[7]);
            *(u32x4*)(HID + (size_t)(row0 + m * 16) * EH + col0) = w; }
    }
};
struct EpiDown {
    MoeTab tb; const int* tok; const float* wsl; bf16_t* Y;
    __device__ __forceinline__ void operator()(const f32x4 (&acc)[2][4][2], const pg8::Unit& u, int wr, int wc, int fr, int fq) const {
        const int e = tb.mt_e[u.pm], p0 = tb.mt_p0[u.pm], ne = tb.cnt[e]; const int col0 = (u.pn & 7) * 256 + wc * 32 + 8 * fq;
        int dst[4]; float w[4];
#pragma unroll
        for (int m = 0; m < 4; ++m) { const int pos = p0 + wr * 64 + fr + m * 16; const int pc = pos < ne ? pos : ne - 1;
            dst[m] = tok[e * 8192 + pc]; w[m] = wsl[e * 8192 + pc]; }
#pragma unroll
        for (int m = 0; m < 4; ++m) { const int pos = p0 + wr * 64 + fr + m * 16;
            if (pos < ne) { bf16_t* yp = Y + (size_t)dst[m] * D + col0; const float ww = w[m];
#pragma unroll
                for (int bj = 0; bj < 2; ++bj) { const f32x4 v0 = acc[bj][m][0] * ww, v1 = acc[bj][m][1] * ww;
                    u32x4 o; o.x = cvt_pk_bf16(v0[0], v0[1]); o.y = cvt_pk_bf16(v0[2], v0[3]); o.z = cvt_pk_bf16(v1[0], v1[1]); o.w = cvt_pk_bf16(v1[2], v1[3]);
                    *(u32x4*)(yp + bj * 128) = o; } } }
    }
};


__device__ __forceinline__ int invperm32(int a) { return a < 16 ? 8 * (a >> 2) + (a & 3) : 8 * ((a - 16) >> 2) + 4 + (a & 3); }
__device__ __forceinline__ bf16x8 pack_bf16x8(const f32x4& a, const f32x4& b) { u32x4 w; w.x = cvt_pk_bf16(a[0], a[1]); w.y = cvt_pk_bf16(a[2], a[3]); w.z = cvt_pk_bf16(b[0], b[1]); w.w = cvt_pk_bf16(b[2], b[3]); return __builtin_bit_cast(bf16x8, w); }
__device__ __forceinline__ void gdn_chunk_local(const Ctx& c, const Params& p, int L, int unit) {
    const int h = unit >> 7, n = unit & 127, t0 = n * 64, tid = c.tid, lane = c.lane;
    const bf16_t* U = (const bf16_t*)(p.ws + WS_U);
    LAS unsigned char* lds = c.lds;
    LAS float* vf = (LAS float*)lds;
    LAS bf16_t* qb = (LAS bf16_t*)(lds + 33280);
    LAS bf16_t* kb = (LAS bf16_t*)(lds + 50688);
    LAS float* Am = (LAS float*)(lds + 68096);
    LAS unsigned char* img = lds + 85504;
    LAS float* gcs = (LAS float*)(lds + 126464);
    const float* cw = p.conv_a_w + (size_t)L * 4 * 2304;
    LAS float* cwl = (LAS float*)(lds + LDS_OSTG);
    for (int i = tid; i < 3 * 4 * 32; i += NTHREADS) { const int c4 = i & 31, j = (i >> 5) & 3, sec = i >> 7;
        const float4 wv4 = *(const float4*)(cw + j * 2304 + sec * 768 + h * 128 + 4 * c4); LAS float* d = cwl + (sec * 4 + j) * 128 + 4 * c4; d[0] = wv4.x; d[1] = wv4.y; d[2] = wv4.z; d[3] = wv4.w; }
    if (tid < 64) {
        float g = ((const float*)(p.ws + WS_GLOG))[(t0 + tid) * 8 + h];
#pragma unroll
        for (int o = 1; o < 64; o <<= 1) { const float v = __int_as_float(__builtin_amdgcn_ds_bpermute(((lane - o) & 63) << 2, __float_as_int(g))); if (lane >= o) g += v; }
        gcs[tid] = g; gcs[64 + tid] = ((const float*)(p.ws + WS_BETA))[(t0 + tid) * 8 + h];
    }
    __syncthreads();
    {
        const int tok = tid >> 3, cg = tid & 7, t = t0 + tok;
        const float eg = __expf(gcs[tok]);
#pragma unroll
        for (int sec = 0; sec < 3; ++sec) {
            const int col = sec * 768 + h * 128 + 16 * cg;
            float a[16];
#pragma unroll
            for (int i = 0; i < 16; ++i) a[i] = 0.f;
            u32x4 xa[4], xb[4];
#pragma unroll
            for (int j = 0; j < 4; ++j) { const int tt = t - 3 + j, tc = tt < 0 ? 0 : tt;
                xa[j] = *(const u32x4*)(U + (size_t)tc * NU + UC_QKV + col); xb[j] = *(const u32x4*)(U + (size_t)tc * NU + UC_QKV + col + 8); }
#pragma unroll
            for (int j = 0; j < 4; ++j) { const float mk = (t - 3 + j) < 0 ? 0.f : 1.f; const u32x4 x0 = xa[j], x1 = xb[j];
                const LAS f32x4* wl = (const LAS f32x4*)(cwl + (sec * 4 + j) * 128 + 16 * cg); const f32x4 w0 = wl[0], w1 = wl[1], w2 = wl[2], w3 = wl[3];
                a[0] += mk * w0[0] * bflo(x0.x); a[1] += mk * w0[1] * bfhi(x0.x); a[2] += mk * w0[2] * bflo(x0.y); a[3] += mk * w0[3] * bfhi(x0.y);
                a[4] += mk * w1[0] * bflo(x0.z); a[5] += mk * w1[1] * bfhi(x0.z); a[6] += mk * w1[2] * bflo(x0.w); a[7] += mk * w1[3] * bfhi(x0.w);
                a[8] += mk * w2[0] * bflo(x1.x); a[9] += mk * w2[1] * bfhi(x1.x); a[10] += mk * w2[2] * bflo(x1.y); a[11] += mk * w2[3] * bfhi(x1.y);
                a[12] += mk * w3[0] * bflo(x1.z); a[13] += mk * w3[1] * bfhi(x1.z); a[14] += mk * w3[2] * bflo(x1.w); a[15] += mk * w3[3] * bfhi(x1.w); }
#pragma unroll
            for (int i = 0; i < 16; ++i) a[i] = siluf_(a[i]);
            if (sec < 2) {
                float sq = 0.f;
#pragma unroll
                for (int i = 0; i < 16; ++i) sq += a[i] * a[i];
                sq += shx(sq, 1, lane); sq += shx(sq, 2, lane); sq += shx(sq, 4, lane);
                const float rn = rsqrtf(sq + 1e-6f) * (sec == 0 ? 0.08838834764831845f : 1.0f);
#pragma unroll
                for (int i = 0; i < 16; ++i) a[i] *= rn;
                LAS bf16_t* dstb = (sec == 0 ? qb : kb) + tok * 136 + 16 * cg;
                u32x4 w;
                w.x = cvt_pk_bf16(a[0], a[1]); w.y = cvt_pk_bf16(a[2], a[3]); w.z = cvt_pk_bf16(a[4], a[5]); w.w = cvt_pk_bf16(a[6], a[7]); *(LAS u32x4*)dstb = w;
                w.x = cvt_pk_bf16(a[8], a[9]); w.y = cvt_pk_bf16(a[10], a[11]); w.z = cvt_pk_bf16(a[12], a[13]); w.w = cvt_pk_bf16(a[14], a[15]); *(LAS u32x4*)(dstb + 8) = w;
                if (sec == 0) {
#pragma unroll
                    for (int g4 = 0; g4 < 4; ++g4) { const int a0 = 16 * cg + 4 * g4, sl = a0 >> 5, pp = invperm32(a0 & 31), chunk = 4 * sl + (pp >> 3), within = pp & 7;
                        u32x2 o; o.x = cvt_pk_bf16(a[4 * g4] * eg, a[4 * g4 + 1] * eg); o.y = cvt_pk_bf16(a[4 * g4 + 2] * eg, a[4 * g4 + 3] * eg);
                        *(LAS u32x2*)(img + tok * 256 + ((chunk ^ (tok & 15)) << 4) + within * 2) = o; }
                }
            } else {
#pragma unroll
                for (int i = 0; i < 16; ++i) vf[tok * 129 + 16 * cg + i] = a[i];
            }
        }
    }
    __syncthreads();
    {
        const float gl = gcs[63];
#pragma unroll
        for (int it = 0; it < 2; ++it) { const int pc = tid + 512 * it, r = pc & 127, ch = pc >> 7, sp = ch >> 2, q = ch & 3; float v[8];
#pragma unroll
            for (int i = 0; i < 8; ++i) { const int cc = 32 * sp + (i < 4 ? 4 * q + i : 16 + 4 * q + (i - 4)); v[i] = bf2f(kb[cc * 136 + r]) * __expf(gl - gcs[cc]); }
            u32x4 w; w.x = cvt_pk_bf16(v[0], v[1]); w.y = cvt_pk_bf16(v[2], v[3]); w.z = cvt_pk_bf16(v[4], v[5]); w.w = cvt_pk_bf16(v[6], v[7]);
            *(LAS u32x4*)(img + 16384 + r * 128 + ((ch ^ ((r >> 1) & 7)) << 4)) = w; }
    }
    {
        const int m = lane & 15, q = lane >> 4;
        for (int i4 = 0; i4 < 4; ++i4) {
            const int id = c.wave * 4 + i4, which = id >> 4, tile = id & 15, mt = tile >> 2, ntl = tile & 3;
            f32x4 acc = (f32x4){0.f, 0.f, 0.f, 0.f};
            if (ntl <= mt) {
                const LAS bf16_t* Ab = which ? qb : kb;
#pragma unroll
                for (int s = 0; s < 4; ++s) { const bf16x8 av = *(const LAS bf16x8*)(Ab + (16 * mt + m) * 136 + 32 * s + 8 * q), bv = *(const LAS bf16x8*)(kb + (16 * ntl + m) * 136 + 32 * s + 8 * q);
                    acc = __builtin_amdgcn_mfma_f32_16x16x32_bf16(av, bv, acc, 0, 0, 0); }
            }
            const int j_ = 16 * ntl + m;
#pragma unroll
            for (int jj = 0; jj < 4; ++jj) { const int i_ = 16 * mt + 4 * q + jj;
                const float dec = (i_ >= j_) ? __expf(gcs[i_] - gcs[j_]) : 0.f;
                if (which == 0) { if (ntl <= mt) Am[j_ * 68 + i_] = (i_ > j_) ? gcs[64 + i_] * acc[jj] * dec : 0.f; }
                else { const int sp = j_ >> 5, pp = invperm32(j_ & 31), chunk = 4 * sp + (pp >> 3), within = pp & 7;
                    *(LAS bf16_t*)(img + 32768 + i_ * 128 + ((chunk ^ ((i_ >> 1) & 7)) << 4) + within * 2) = f2bf((i_ >= j_) ? acc[jj] * dec : 0.f); } }
        }
    }
    __syncthreads();
    float x[64];
    if (tid < 256) {
        if (tid < 128) {
#pragma unroll
            for (int r = 0; r < 64; ++r) x[r] = vf[r * 129 + tid] * gcs[64 + r];
        } else {
#pragma unroll
            for (int r = 0; r < 64; ++r) x[r] = bf2f(kb[r * 136 + (tid - 128)]) * gcs[64 + r] * __expf(gcs[r]);
        }
    }
    __syncthreads();
    if (tid < 256) {
        int zoff = 0; asm volatile("" : "+v"(zoff));
        const LAS float* Amz = Am + zoff;
#pragma unroll
        for (int j = 0; j < 63; ++j) {
            const float xj = x[j];
#pragma unroll
            for (int ib = (j + 1) / 4; ib < 16; ++ib) { const f32x4 a4 = *(const LAS f32x4*)(Amz + j * 68 + 4 * ib);
                if (4 * ib + 0 > j) x[4 * ib + 0] -= a4[0] * xj;
                if (4 * ib + 1 > j) x[4 * ib + 1] -= a4[1] * xj;
                if (4 * ib + 2 > j) x[4 * ib + 2] -= a4[2] * xj;
                if (4 * ib + 3 > j) x[4 * ib + 3] -= a4[3] * xj; }
        }
        if (tid < 128) {
            float* ucp = (float*)(p.ws + WS_UCP) + (size_t)unit * 8192 + (size_t)(tid >> 4) * 1024 + (tid & 15) * 4;
#pragma unroll
            for (int mt = 0; mt < 4; ++mt)
#pragma unroll
                for (int q = 0; q < 4; ++q) *(f32x4*)(ucp + mt * 256 + q * 64) = (f32x4){x[16 * mt + 4 * q], x[16 * mt + 4 * q + 1], x[16 * mt + 4 * q + 2], x[16 * mt + 4 * q + 3]};
        } else {
            const int kc = tid - 128, s = kc >> 5, pp = invperm32(kc & 31), chunk = 4 * s + (pp >> 3), within = pp & 7;
#pragma unroll
            for (int r = 0; r < 64; ++r) *(LAS bf16_t*)(lds + r * 256 + ((chunk ^ (r & 15)) << 4) + within * 2) = f2bf(-x[r]);
        }
    }
    __syncthreads();
    {
        unsigned char* dst = p.ws + WS_GBLK + (size_t)unit * GB_BYTES;
#pragma unroll
        for (int it = 0; it < 7; ++it) { const int pc = tid + 512 * it; const LAS unsigned char* src = pc < 1024 ? lds + pc * 16 : img + (pc - 1024) * 16;
            *(u32x4*)(dst + pc * 16) = *(const LAS u32x4*)src; }
        if (tid == 0) ((float*)(p.ws + WS_GL))[unit] = __expf(gcs[63]);
    }
    __syncthreads();
}


__device__ __forceinline__ void gdn_scan(const Ctx& c, const Params& p, int sidx) {
    const int h = sidx >> 1, half = sidx & 1;
    const unsigned char* blk = p.ws + WS_GBLK + (size_t)h * 128 * GB_BYTES;
    bf16_t* OG = (bf16_t*)(p.ws + WS_OGDN);
    LAS unsigned char* lds = c.lds;
    LAS unsigned char* ost = c.lds + LDS_OSTG;
    if (c.wave >= 4) {
        const int par = (c.wave - 4) >> 1, st = c.tid - 256 - 128 * par;
        const unsigned char* src = blk + (size_t)st * 16;
        u32x4 sr[28];
        if (par == 0) {
#pragma unroll
            for (int i = 0; i < 28; ++i) sr[i] = *(const u32x4*)(src + i * 2048);
#pragma unroll
            for (int i = 0; i < 28; ++i) *(LAS u32x4*)(lds + st * 16 + i * 2048) = sr[i];
#pragma unroll
            for (int i = 0; i < 28; ++i) sr[i] = *(const u32x4*)(src + 2 * (size_t)GB_BYTES + i * 2048);
        } else {
#pragma unroll
            for (int i = 0; i < 28; ++i) sr[i] = *(const u32x4*)(src + (size_t)GB_BYTES + i * 2048);
        }
        __syncthreads();
        for (int n = 0; n < 128; ++n) {
            if (((n + 1) & 1) == par) {
                if (n + 1 < 128) {
#pragma unroll
                    for (int i = 0; i < 28; ++i) *(LAS u32x4*)(lds + ((n + 1) & 1) * GB_BYTES + st * 16 + i * 2048) = sr[i];
                }
                if (n + 3 < 128) {
#pragma unroll
                    for (int i = 0; i < 28; ++i) sr[i] = *(const u32x4*)(src + (size_t)(n + 3) * GB_BYTES + i * 2048);
                }
            } else if (n > 0) {
#pragma unroll
                for (int i = 0; i < 4; ++i) { const int pc = st + 128 * i, r = pc >> 3, ch = pc & 7;
                    *(u32x4*)(OG + (size_t)((n - 1) * 64 + r) * 768 + h * 128 + 64 * half + 8 * ch) = *(const LAS u32x4*)(ost + ((n - 1) & 1) * 8192 + r * 128 + ch * 16); }
            }
            __syncthreads();
        }
        if (par == 0) {
#pragma unroll
            for (int i = 0; i < 4; ++i) { const int pc = st + 128 * i, r = pc >> 3, ch = pc & 7;
                *(u32x4*)(OG + (size_t)(127 * 64 + r) * 768 + h * 128 + 64 * half + 8 * ch) = *(const LAS u32x4*)(ost + 8192 + r * 128 + ch * 16); }
        }
        return;
    }
    const int wg = 4 * half + c.wave;
    const float* UCp = (const float*)(p.ws + WS_UCP) + (size_t)h * 128 * 8192 + (size_t)wg * 1024 + c.lane * 4;
    const float* GL = (const float*)(p.ws + WS_GL) + h * 128;
    const int lane = c.lane, m = lane & 15, q = lane >> 4;
    int o128[4], o64[2];
#pragma unroll
    for (int s = 0; s < 4; ++s) o128[s] = m * 256 + (((4 * s + q) ^ m) << 4);
#pragma unroll
    for (int s = 0; s < 2; ++s) o64[s] = m * 128 + (((4 * s + q) ^ (m >> 1)) << 4);
    f32x4 S[8];
#pragma unroll
    for (int i = 0; i < 8; ++i) S[i] = (f32x4){0.f, 0.f, 0.f, 0.f};
    f32x4 ucA[4], ucB[4]; float glA, glB;
#pragma unroll
    for (int mt = 0; mt < 4; ++mt) { ucA[mt] = *(const f32x4*)(UCp + mt * 256); ucB[mt] = *(const f32x4*)(UCp + 8192 + mt * 256); }
    glA = GL[0]; glB = GL[1];
    __syncthreads();
#define SCAN_LD(pp) (*(const LAS bf16x8*)(pp))
#define SCAN_STEP(NN, BUF, UC, GLV) do { \
        const LAS unsigned char* B = lds + (BUF) * GB_BYTES; \
        bf16x8 Sb[4]; \
        _Pragma("unroll") for (int s = 0; s < 4; ++s) Sb[s] = pack_bf16x8(S[2 * s], S[2 * s + 1]); \
        bf16x8 Aw[16], Aq[16]; \
        _Pragma("unroll") for (int mt = 0; mt < 4; ++mt) _Pragma("unroll") for (int s = 0; s < 4; ++s) Aw[mt * 4 + s] = SCAN_LD(B + GB_WC + mt * 4096 + o128[s]); \
        _Pragma("unroll") for (int mt = 0; mt < 4; ++mt) _Pragma("unroll") for (int s = 0; s < 4; ++s) Aq[mt * 4 + s] = SCAN_LD(B + GB_QD + mt * 4096 + o128[s]); \
        f32x4 vn[4]; \
        _Pragma("unroll") for (int mt = 0; mt < 4; ++mt) vn[mt] = UC[mt]; \
        _Pragma("unroll") for (int s = 0; s < 4; ++s) _Pragma("unroll") for (int mt = 0; mt < 4; ++mt) vn[mt] = __builtin_amdgcn_mfma_f32_16x16x32_bf16(Aw[mt * 4 + s], Sb[s], vn[mt], 0, 0, 0); \
        bf16x8 Ak[16]; \
        _Pragma("unroll") for (int i = 0; i < 8; ++i) _Pragma("unroll") for (int s = 0; s < 2; ++s) Ak[i * 2 + s] = SCAN_LD(B + GB_KDT + i * 2048 + o64[s]); \
        f32x4 Oa[4]; \
        _Pragma("unroll") for (int mt = 0; mt < 4; ++mt) Oa[mt] = (f32x4){0.f, 0.f, 0.f, 0.f}; \
        _Pragma("unroll") for (int s = 0; s < 4; ++s) _Pragma("unroll") for (int mt = 0; mt < 4; ++mt) Oa[mt] = __builtin_amdgcn_mfma_f32_16x16x32_bf16(Aq[mt * 4 + s], Sb[s], Oa[mt], 0, 0, 0); \
        bf16x8 Vb[2]; Vb[0] = pack_bf16x8(vn[0], vn[1]); Vb[1] = pack_bf16x8(vn[2], vn[3]); \
        bf16x8 Ap[8]; \
        _Pragma("unroll") for (int mt = 0; mt < 4; ++mt) _Pragma("unroll") for (int s = 0; s < 2; ++s) Ap[mt * 2 + s] = SCAN_LD(B + GB_QK + mt * 2048 + o64[s]); \
        _Pragma("unroll") for (int i = 0; i < 8; ++i) S[i] = S[i] * (GLV); \
        _Pragma("unroll") for (int s = 0; s < 2; ++s) _Pragma("unroll") for (int i = 0; i < 8; ++i) S[i] = __builtin_amdgcn_mfma_f32_16x16x32_bf16(Ak[i * 2 + s], Vb[s], S[i], 0, 0, 0); \
        _Pragma("unroll") for (int s = 0; s < 2; ++s) _Pragma("unroll") for (int mt = 0; mt < 4; ++mt) Oa[mt] = __builtin_amdgcn_mfma_f32_16x16x32_bf16(Ap[mt * 2 + s], Vb[s], Oa[mt], 0, 0, 0); \
        _Pragma("unroll") for (int mt = 0; mt < 4; ++mt) _Pragma("unroll") for (int jj = 0; jj < 4; ++jj) \
            *(LAS bf16_t*)(ost + (BUF) * 8192 + (16 * mt + 4 * q + jj) * 128 + (16 * c.wave + m) * 2) = f2bf(Oa[mt][jj]); \
    } while (0)
    for (int n = 0; n < 128; n += 2) {
        SCAN_STEP(n, 0, ucA, glA);
        if (n + 2 < 128) {
#pragma unroll
            for (int mt = 0; mt < 4; ++mt) ucA[mt] = *(const f32x4*)(UCp + (size_t)(n + 2) * 8192 + mt * 256);
            glA = GL[n + 2]; }
        __syncthreads();
        SCAN_STEP(n + 1, 1, ucB, glB);
        if (n + 3 < 128) {
#pragma unroll
            for (int mt = 0; mt < 4; ++mt) ucB[mt] = *(const f32x4*)(UCp + (size_t)(n + 3) * 8192 + mt * 256);
            glB = GL[n + 3]; }
        __syncthreads();
    }
#undef SCAN_STEP
#undef SCAN_LD
}


template <class Epi, bool UP>
__device__ __forceinline__ void moe_gemm(const Ctx& c, const bf16_t* A, const float* Wl, const MoeOrder& S, const Epi& E) {
    constexpr int K = UP ? D : EH, NW = UP ? 1024 : D, NSTEP = K / 64, STG = 49152;
    int tid = threadIdx.x; asm volatile("" : "+v"(tid));
    const int wid = __builtin_amdgcn_readfirstlane(tid >> 6), lane = tid & 63, wr = wid >> 2, wc = wid & 3, fr = lane & 15, fq = lane >> 4;
    LAS unsigned char* lds = c.lds;
    const int par = wid & 1, tp = lane + 64 * (wid >> 1);
    const int bk = tp >> 6, bc4 = tp & 63;
    const int ar = tp >> 3, ach = tp & 7;
    const unsigned a_rd0 = (unsigned)((64 * wr + fr) * 128 + (((0 + fq) ^ ((fr >> 1) & 7)) << 4)), a_rd1 = (unsigned)((64 * wr + fr) * 128 + (((4 + fq) ^ ((fr >> 1) & 7)) << 4));
    const unsigned q4 = (lane & 15) >> 2, p4 = lane & 3, qb = fq & 1;
    const unsigned b_base = 16384u + (8u * fq + q4) * 512u + 64u * ((unsigned)wc ^ q4) + 16u * p4;
    const unsigned b00 = b_base + 8u * qb, b01 = b_base + 8u * (1u - qb), b10 = b00 + 4u * 512u, b11 = b01 + 4u * 512u;
    pg8::Unit u;
    for (int ui = 0; S.next(ui, u); ++ui) {
        const int e = S.tb.mt_e[u.pm], j = u.pn - e * S.nN;
        const float* Wb = Wl + (size_t)e * K * NW + (UP ? ((bc4 < 32) ? 128 * j + 4 * bc4 : 512 + 128 * j + 4 * (bc4 - 32)) : 256 * j + 4 * bc4) + (size_t)bk * NW;
        const bf16_t* Ap[4];
#pragma unroll
        for (int i = 0; i < 4; ++i) { const int row = ar + 32 * i; Ap[i] = (UP ? A + (size_t)S.arow(u, row) * K : A + (size_t)(u.pm * 128 + row) * K) + 8 * (ach ^ ((row >> 1) & 7)); }
        f32x4 acc[2][4][2];
#pragma unroll
        for (int b = 0; b < 2; ++b)
#pragma unroll
            for (int m = 0; m < 4; ++m)
#pragma unroll
                for (int n = 0; n < 2; ++n) acc[b][m][n] = (f32x4){0.f, 0.f, 0.f, 0.f};
        f32x4 wv[16]; u32x4 av[4];
#define MOE_LOAD(T) do { _Pragma("unroll") for (int i = 0; i < 16; ++i) wv[i] = *(const f32x4*)(Wb + (size_t)((T) * 64 + 4 * i) * NW); \
        _Pragma("unroll") for (int i = 0; i < 4; ++i) av[i] = *(const u32x4*)(Ap[i] + (T) * 64); } while (0)
#define MOE_WRITE(T) do { LAS unsigned char* sb = lds + ((T) & 1) * STG; \
        _Pragma("unroll") for (int i = 0; i < 4; ++i) *(LAS u32x4*)(sb + (ar + 32 * i) * 128 + ach * 16) = av[i]; \
        _Pragma("unroll") for (int i = 0; i < 16; ++i) { const int kk = bk + 4 * i; u32x2 w2; w2.x = cvt_pk_bf16(wv[i][0], wv[i][1]); w2.y = cvt_pk_bf16(wv[i][2], wv[i][3]); \
            *(LAS u32x2*)(sb + 16384 + kk * 512 + ((8 * bc4) ^ ((((kk >> 3) & 1) << 3) | ((kk & 3) << 6)))) = w2; } } while (0)
        if (par == 0) { MOE_LOAD(0); MOE_WRITE(0); if (2 < NSTEP) MOE_LOAD(2); }
        else { if (1 < NSTEP) MOE_LOAD(1); }
        for (int t = 0; t < NSTEP; ++t) {
            __syncthreads();
            if (((t + 1) & 1) == par) { if (t + 1 < NSTEP) MOE_WRITE(t + 1); if (t + 3 < NSTEP) MOE_LOAD(t + 3); }
            const unsigned so = (unsigned)(t & 1) * STG;
#pragma unroll
            for (int s2 = 0; s2 < 2; ++s2) {
                bf16x8 Bf[2][2];
#pragma unroll
                for (int bj = 0; bj < 2; ++bj) { Bf[bj][0] = tr_pair(lds + so + b00 + 256 * bj + 16384 * s2, lds + so + b10 + 256 * bj + 16384 * s2);
                                                 Bf[bj][1] = tr_pair(lds + so + b01 + 256 * bj + 16384 * s2, lds + so + b11 + 256 * bj + 16384 * s2); }
                bf16x8 Af[4];
#pragma unroll
                for (int m = 0; m < 4; ++m) Af[m] = *(const LAS bf16x8*)(lds + so + (s2 ? a_rd1 : a_rd0) + m * 2048);
#pragma unroll
                for (int bj = 0; bj < 2; ++bj)
#pragma unroll
                    for (int m = 0; m < 4; ++m)
#pragma unroll
                        for (int n = 0; n < 2; ++n) acc[bj][m][n] = __builtin_amdgcn_mfma_f32_16x16x32_bf16(Bf[bj][n], Af[m], acc[bj][m][n], 0, 0, 0);
            }
        }
#undef MOE_LOAD
#undef MOE_WRITE
        E(acc, u, wr, wc, fr, fq);
        __syncthreads();
    }
}

__device__ __forceinline__ void phase_local(const Ctx& c, const Params& p, int L) {
    const bf16_t* U = (const bf16_t*)(p.ws + WS_U);
    const int gw = c.bid * 8 + c.wave, GW = c.G * 8, lane = c.lane;
    for (int rep = 0; rep < 1 + (p.pad == 1); ++rep)
    for (int unit = c.bid; unit < 768; unit += c.G) gdn_chunk_local(c, p, L, unit);
    for (int rep = 0; rep < 1 + (p.pad == 2); ++rep) {
        bf16_t* YB = (bf16_t*)(p.ws + WS_YBR) + (size_t)1 * T * 768;
        const float* cbw = p.conv_b_w + (size_t)L * 31 * 768; const float* cbb = p.conv_b_b + L * 768; const float* lg = p.ln_b_g + L * 768; const float* lb = p.ln_b_b + L * 768;
        LAS unsigned char* glu = c.lds;
        LAS unsigned char* cbs = c.lds + 70656;
        for (int tile = c.bid; tile < T / 16; tile += c.G) {
            const int t0 = tile * 16;
            for (int it = c.tid; it < 46 * 96; it += NTHREADS) { const int rr = it / 96, c8 = it - rr * 96, tt = t0 - 30 + rr; u32x4 w = (u32x4){0u, 0u, 0u, 0u};
                if (tt >= 0) { const u32x4 ga = *(const u32x4*)(U + (size_t)tt * NU + UC_B + 8 * c8), gb = *(const u32x4*)(U + (size_t)tt * NU + UC_B + 768 + 8 * c8);
                    w.x = cvt_pk_bf16(bflo(ga.x) * sigmoidf_(bflo(gb.x)), bfhi(ga.x) * sigmoidf_(bfhi(gb.x))); w.y = cvt_pk_bf16(bflo(ga.y) * sigmoidf_(bflo(gb.y)), bfhi(ga.y) * sigmoidf_(bfhi(gb.y)));
                    w.z = cvt_pk_bf16(bflo(ga.z) * sigmoidf_(bflo(gb.z)), bfhi(ga.z) * sigmoidf_(bfhi(gb.z))); w.w = cvt_pk_bf16(bflo(ga.w) * sigmoidf_(bflo(gb.w)), bfhi(ga.w) * sigmoidf_(bfhi(gb.w))); }
                *(LAS u32x4*)(glu + rr * 1536 + c8 * 16) = w; }
            __syncthreads();
            if (c.tid < 384) {
                float w0[31], w1[31], a0[16], a1[16];
#pragma unroll
                for (int j = 0; j < 31; ++j) { const float2 wv = *(const float2*)(cbw + j * 768 + 2 * c.tid); w0[j] = wv.x; w1[j] = wv.y; }
#pragma unroll
                for (int t = 0; t < 16; ++t) { a0[t] = 0.f; a1[t] = 0.f; }
#pragma unroll
                for (int rr = 0; rr < 46; ++rr) { const unsigned g2 = *(const LAS unsigned*)(glu + rr * 1536 + c.tid * 4); const float lo = bflo(g2), hi = bfhi(g2);
#pragma unroll
                    for (int t = 0; t < 16; ++t) { const int j = rr - t; if (j >= 0 && j <= 30) { a0[t] += w0[j] * lo; a1[t] += w1[j] * hi; } } }
                const float2 bv = *(const float2*)(cbb + 2 * c.tid);
#pragma unroll
                for (int t = 0; t < 16; ++t) *(LAS f32x2*)(cbs + t * 3072 + c.tid * 8) = (f32x2){a0[t] + bv.x, a1[t] + bv.y};
            }
            __syncthreads();
            for (int i = 0; i < 2; ++i) { const int tl = c.wave * 2 + i; f32x2 v[6]; float sm = 0.f;
#pragma unroll
                for (int k = 0; k < 6; ++k) { v[k] = *(const LAS f32x2*)(cbs + tl * 3072 + (lane + 64 * k) * 8); sm += v[k].x + v[k].y; }
                const float mu = wave_sum(sm, lane) * (1.0f / 768.f); float vs = 0.f;
#pragma unroll
                for (int k = 0; k < 6; ++k) { const float d0 = v[k].x - mu, d1 = v[k].y - mu; vs += d0 * d0 + d1 * d1; }
                const float rs = rsqrtf(wave_sum(vs, lane) * (1.0f / 768.f) + 1e-5f);
#pragma unroll
                for (int k = 0; k < 6; ++k) { const int ch = 2 * (lane + 64 * k); const float2 gg = *(const float2*)(lg + ch), bb = *(const float2*)(lb + ch);
                    const float y0 = (v[k].x - mu) * rs * gg.x + bb.x, y1 = (v[k].y - mu) * rs * gg.y + bb.y;
                    *(unsigned*)(YB + (size_t)(t0 + tl) * 768 + ch) = cvt_pk_bf16(siluf_(y0), siluf_(y1)); } }
            __syncthreads();
        }
    }
    for (int rep = 0; rep < 1 + (p.pad == 3); ++rep) {
        bf16_t* QR = (bf16_t*)(p.ws + WS_QR); bf16_t* KR = (bf16_t*)(p.ws + WS_KR);
        for (int it = c.bid * NTHREADS + c.tid; it < T * 8; it += c.G * NTHREADS) {
            const int t = it >> 3, c8 = it & 7; const float ps = (float)p.pos[t]; float cs[8], sn[8];
#pragma unroll
            for (int i = 0; i < 8; ++i) {
                double rev = (double)ps * (double)ROPE_INV[8 * c8 + i] * 0.15915494309189535; rev -= floor(rev);
                const float fr = (float)rev; cs[i] = __builtin_amdgcn_cosf(fr); sn[i] = __builtin_amdgcn_sinf(fr); }
            for (int hb = 0; hb < 36; hb += 4) {
                u32x4 x1[4], x2[4];
#pragma unroll
                for (int j = 0; j < 4; ++j) { const int hv = hb + j, isk = hv >= 18, hh = hv - 18 * isk; const bf16_t* src = U + (size_t)t * NU + UC_C + isk * 2304 + hh * 128 + 8 * c8;
                    x1[j] = *(const u32x4*)src; x2[j] = *(const u32x4*)(src + 64); }
#pragma unroll
                for (int j = 0; j < 4; ++j) { const int hv = hb + j, isk = hv >= 18, hh = hv - 18 * isk; const float sc = isk ? 1.0f : 0.08838834764831845f;
                    float a[8], b[8];
                    a[0] = bflo(x1[j].x); a[1] = bfhi(x1[j].x); a[2] = bflo(x1[j].y); a[3] = bfhi(x1[j].y); a[4] = bflo(x1[j].z); a[5] = bfhi(x1[j].z); a[6] = bflo(x1[j].w); a[7] = bfhi(x1[j].w);
                    b[0] = bflo(x2[j].x); b[1] = bfhi(x2[j].x); b[2] = bflo(x2[j].y); b[3] = bfhi(x2[j].y); b[4] = bflo(x2[j].z); b[5] = bfhi(x2[j].z); b[6] = bflo(x2[j].w); b[7] = bfhi(x2[j].w);
                    float o1[8], o2[8];
#pragma unroll
                    for (int i = 0; i < 8; ++i) { o1[i] = (a[i] * cs[i] - b[i] * sn[i]) * sc; o2[i] = (b[i] * cs[i] + a[i] * sn[i]) * sc; }
                    bf16_t* dst = (isk ? KR : QR) + (size_t)t * 2304 + hh * 128 + 8 * c8;
                    u32x4 w1, w2; w1.x = cvt_pk_bf16(o1[0], o1[1]); w1.y = cvt_pk_bf16(o1[2], o1[3]); w1.z = cvt_pk_bf16(o1[4], o1[5]); w1.w = cvt_pk_bf16(o1[6], o1[7]);
                    w2.x = cvt_pk_bf16(o2[0], o2[1]); w2.y = cvt_pk_bf16(o2[2], o2[3]); w2.z = cvt_pk_bf16(o2[4], o2[5]); w2.w = cvt_pk_bf16(o2[6], o2[7]);
                    *(u32x4*)dst = w1; *(u32x4*)(dst + 64) = w2; }
            }
        }
    }
    for (int rep = 0; rep < 1 + (p.pad == 4); ++rep) {
        bf16_t* YD = (bf16_t*)(p.ws + WS_YBR) + (size_t)3 * T * 768;
        const bf16_t* PWT = (const bf16_t*)(p.ws + WS_PWT) + (size_t)L * 4 * 192 * 192;
        LAS unsigned char* pim = c.lds;
        const int m = lane & 15, q = lane >> 4;
        for (int tile = c.bid; tile < T / 32; tile += c.G) {
            const int t0 = tile * 32;
            for (int it = c.tid; it < 32 * 96; it += NTHREADS) { const int rr = it / 96, c8 = it - rr * 96, t = t0 + rr, g = c8 / 24, w = 2 << g, cnt = (t + 1) < w ? (t + 1) : w;
                float sacc[8];
#pragma unroll
                for (int i = 0; i < 8; ++i) sacc[i] = 0.f;
                const bf16_t* up = U + (size_t)t * NU + UC_D + 8 * c8; u32x4 x0 = (u32x4){0u, 0u, 0u, 0u};
#pragma unroll
                for (int d = 0; d < 16; ++d) { if (d >= cnt) break; const u32x4 xv = *(const u32x4*)(up - (size_t)d * NU); if (d == 0) x0 = xv;
                    sacc[0] += bflo(xv.x); sacc[1] += bfhi(xv.x); sacc[2] += bflo(xv.y); sacc[3] += bfhi(xv.y); sacc[4] += bflo(xv.z); sacc[5] += bfhi(xv.z); sacc[6] += bflo(xv.w); sacc[7] += bfhi(xv.w); }
                const float ic = 1.0f / (float)cnt; u32x4 o;
                o.x = cvt_pk_bf16(sacc[0] * ic - bflo(x0.x), sacc[1] * ic - bfhi(x0.x)); o.y = cvt_pk_bf16(sacc[2] * ic - bflo(x0.y), sacc[3] * ic - bfhi(x0.y));
                o.z = cvt_pk_bf16(sacc[4] * ic - bflo(x0.z), sacc[5] * ic - bfhi(x0.z)); o.w = cvt_pk_bf16(sacc[6] * ic - bflo(x0.w), sacc[7] * ic - bfhi(x0.w));
                *(LAS u32x4*)(pim + rr * 1536 + ((c8 ^ (rr & 15)) << 4)) = o; }
            __syncthreads();
            f32x4 pa0[6], pa1[6];
#pragma unroll
            for (int pr = 0; pr < 6; ++pr) { const int pair = c.wave * 6 + pr, g = pair / 12, ntl = pair - g * 12;
                f32x4 acc0 = (f32x4){0.f, 0.f, 0.f, 0.f}, acc1 = (f32x4){0.f, 0.f, 0.f, 0.f};
                const bf16_t* bp = PWT + (size_t)(g * 192 + 16 * ntl + m) * 192 + 8 * q;
#pragma unroll
                for (int s6 = 0; s6 < 6; ++s6) { const bf16x8 bv = *(const bf16x8*)(bp + 32 * s6); const int ch = g * 24 + 4 * s6 + q;
                    const bf16x8 a0v = *(const LAS bf16x8*)(pim + m * 1536 + ((ch ^ m) << 4)), a1v = *(const LAS bf16x8*)(pim + (16 + m) * 1536 + ((ch ^ m) << 4));
                    acc0 = __builtin_amdgcn_mfma_f32_16x16x32_bf16(a0v, bv, acc0, 0, 0, 0); acc1 = __builtin_amdgcn_mfma_f32_16x16x32_bf16(a1v, bv, acc1, 0, 0, 0); }
                pa0[pr] = acc0; pa1[pr] = acc1; }
#pragma unroll
            for (int pr = 0; pr < 6; ++pr) { const int pair = c.wave * 6 + pr, g = pair / 12, ntl = pair - g * 12;
                bf16_t* yp = YD + (size_t)(t0 + 4 * q) * 768 + g * 192 + 16 * ntl + m;
#pragma unroll
                for (int jj = 0; jj < 4; ++jj) { yp[(size_t)jj * 768] = f2bf(pa0[pr][jj]); yp[(size_t)(16 + jj) * 768] = f2bf(pa1[pr][jj]); } }
            __syncthreads();
        }
    }
}

__device__ __forceinline__ unsigned off_b(unsigned row, unsigned ch) { return 256u * row + 16u * (ch ^ (((row & 3) << 2) | ((row >> 2) & 3))); }
#define ATT_PV4(OFF, A, DT0) do { \
    _Pragma("unroll") for (int i4 = 0; i4 < 4; ++i4) { \
        const bf16x8 vt = tr_pair(Vs + (vb0 + 32u * (unsigned)(((DT0) + i4) ^ cm0) + (OFF)), Vs + (vb1 + 32u * (unsigned)(((DT0) + i4) ^ cm1) + (OFF))); \
        O[(DT0) + i4] = __builtin_amdgcn_mfma_f32_16x16x32_bf16(vt, Pb[A], O[(DT0) + i4], 0, 0, 0); } } while (0)
#define ATT_PV(OFF, A) do { ATT_PV4(OFF, A, 0); ATT_PV4(OFF, A, 4); } while (0)
struct AttnRegs { u32x4 kv[8], vv[8]; bf16x8 Qb[4]; };
__device__ __forceinline__ void attn_issue_k(const Ctx& c, const Params& p, int u, AttnRegs& r) {
    const int h = u % 6, rbi = (u / 6) & 63, g = u / 384;
    const int dl = g == 0 ? 1 : (g == 1 ? 4 : 16), nb = 64 / dl, rs = rbi / nb, b = rbi % nb, gh = g * 6 + h;
    const bf16_t* KR = (const bf16_t*)(p.ws + WS_KR);
#pragma unroll
    for (int it = 0; it < 8; ++it) { const int pc = c.tid + 512 * it, j = pc >> 4, ch = pc & 15, pos = 128 * (b - 1) + j;
        r.kv[it] = (u32x4){0u, 0u, 0u, 0u};
        if (pos >= 0) { const size_t t = (size_t)pos * dl + rs; r.kv[it] = *(const u32x4*)(KR + t * 2304 + gh * 128 + 8 * ch); } }
}
__device__ __forceinline__ void attn_issue_vq(const Ctx& c, const Params& p, int u, AttnRegs& r) {
    const int h = u % 6, rbi = (u / 6) & 63, g = u / 384;
    const int dl = g == 0 ? 1 : (g == 1 ? 4 : 16), nb = 64 / dl, rs = rbi / nb, b = rbi % nb, gh = g * 6 + h;
    const bf16_t* U = (const bf16_t*)(p.ws + WS_U); const bf16_t* QR = (const bf16_t*)(p.ws + WS_QR);
    const int lane = c.lane, n = lane & 15, qd = lane >> 4;
#pragma unroll
    for (int it = 0; it < 8; ++it) { const int pc = c.tid + 512 * it, j = pc >> 4, ch = pc & 15, pos = 128 * (b - 1) + j;
        r.vv[it] = (u32x4){0u, 0u, 0u, 0u};
        if (pos >= 0) { const size_t t = (size_t)pos * dl + rs; r.vv[it] = *(const u32x4*)(U + t * NU + UC_C + 4608 + gh * 128 + 8 * ch); } }
    const int iq = 16 * c.wave + n; const size_t tq = (size_t)(128 * b + iq) * dl + rs;
#pragma unroll
    for (int s = 0; s < 4; ++s) r.Qb[s] = *(const bf16x8*)(QR + tq * 2304 + gh * 128 + 32 * s + 8 * qd);
}
__device__ __forceinline__ void attn_stage(const Ctx& c, const AttnRegs& r) {
    LAS unsigned char* Ks = c.lds; LAS unsigned char* Vs = c.lds + 65536;
#pragma unroll
    for (int it = 0; it < 8; ++it) { const int pc = c.tid + 512 * it, j = pc >> 4, ch = pc & 15;
        *(LAS u32x4*)(Ks + off_b(j, ch)) = r.kv[it]; *(LAS u32x4*)(Vs + off_b((j & ~31) + invperm32(j & 31), ch)) = r.vv[it]; }
}
__device__ __forceinline__ void attn_compute(const Ctx& c, const Params& p, int u, AttnRegs& ar, int un) {
    const int h = u % 6, rbi = (u / 6) & 63, g = u / 384;
    const int dl = g == 0 ? 1 : (g == 1 ? 4 : 16), nb = 64 / dl, r = rbi / nb, b = rbi % nb;
    LAS unsigned char* Ks = c.lds; LAS unsigned char* Vs = c.lds + 65536;
    const int lane = c.lane, n = lane & 15, qd = lane >> 4;
    const int iq = 16 * c.wave + n;
    const size_t tq = (size_t)(128 * b + iq) * dl + r;
    const int f = c.wave & ~1;
    f32x4 S[10];
    {
        const unsigned mask = ((n & 3) << 2) | ((n >> 2) & 3);
        unsigned ka[4];
#pragma unroll
        for (int s = 0; s < 4; ++s) ka[s] = 256u * n + 16u * ((4 * s + qd) ^ mask) + (unsigned)f * 4096u;
#pragma unroll
        for (int jj = 0; jj < 10; ++jj) { f32x4 acc = (f32x4){0.f, 0.f, 0.f, 0.f};
#pragma unroll
            for (int s = 0; s < 4; ++s) acc = __builtin_amdgcn_mfma_f32_16x16x32_bf16(*(const LAS bf16x8*)(Ks + ka[s] + jj * 4096), ar.Qb[s], acc, 0, 0, 0);
            S[jj] = acc; }
    }
    float mx = -INFINITY;
#pragma unroll
    for (int jj = 0; jj < 10; ++jj)
#pragma unroll
        for (int e = 0; e < 4; ++e) { const int j = 16 * (f + jj) + 4 * qd + e; const bool ok = (j >= iq) && (j <= iq + 128) && (b > 0 || j >= 128);
            S[jj][e] = ok ? S[jj][e] : -INFINITY; mx = fmaxf(mx, S[jj][e]); }
    mx = fmaxf(mx, shx(mx, 16, lane)); mx = fmaxf(mx, shx(mx, 32, lane));
    float l = 0.f;
#pragma unroll
    for (int jj = 0; jj < 10; ++jj)
#pragma unroll
        for (int e = 0; e < 4; ++e) { const float pv = __expf(S[jj][e] - mx); S[jj][e] = pv; l += pv; }
    l += shx(l, 16, lane); l += shx(l, 32, lane);
    bf16x8 Pb[5];
#pragma unroll
    for (int a = 0; a < 5; ++a) Pb[a] = pack_bf16x8(S[2 * a], S[2 * a + 1]);
    if (un < 1152) attn_issue_vq(c, p, un, ar);
    f32x4 O[8];
#pragma unroll
    for (int dt = 0; dt < 8; ++dt) O[dt] = (f32x4){0.f, 0.f, 0.f, 0.f};
    {
        const unsigned q = (lane & 15) >> 2, pp = lane & 3;
        const unsigned m0 = (q << 2) | ((2 * qd + 0) & 3), m1 = (q << 2) | ((2 * qd + 1) & 3);
        const unsigned cm0 = m0 >> 1, cm1 = m1 >> 1;
        const unsigned vbase = (unsigned)(f >> 1) * 8192u + 8u * (pp & 1);
        const unsigned vb0 = vbase + 256u * (8 * qd + 0 + q) + 16u * ((pp >> 1) ^ (m0 & 1)), vb1 = vbase + 256u * (8 * qd + 4 + q) + 16u * ((pp >> 1) ^ (m1 & 1));
        ATT_PV(0, 0); ATT_PV(8192, 1); ATT_PV(16384, 2); ATT_PV(24576, 3); ATT_PV(32768, 4);
    }
    {
        const float il = 1.0f / l;
        bf16_t* op = (bf16_t*)(p.ws + WS_ATTO) + ((size_t)g * T + tq) * 768 + h * 128 + 4 * qd;
#pragma unroll
        for (int dt = 0; dt < 8; ++dt) { u32x2 w; w.x = cvt_pk_bf16(O[dt][0] * il, O[dt][1] * il); w.y = cvt_pk_bf16(O[dt][2] * il, O[dt][3] * il); *(u32x2*)(op + 16 * dt) = w; }
        if (qd == 0) ((float*)(p.ws + WS_LSE))[((size_t)g * T + tq) * 8 + h] = mx + logf(l);
    }
}

struct GateOrder {
    int Gn, j;
    __device__ bool next(int i, pg8::Unit& u) const { const int id = i * Gn + j; if (id >= 1024) return false; u.pm = id & 31; u.pn = 48 + (id >> 5); return true; }
    __device__ __forceinline__ int arow(const pg8::Unit& u, int r) const { return u.pm * 256 + r; }
};
__device__ __forceinline__ void phase_attn_gdn(const Ctx& c, const Params& p, int L) {
    const bf16_t* U = (const bf16_t*)(p.ws + WS_U);
    const int lane = c.lane;
    const int nrec = (c.G >= 24) ? 12 : 0;
    if (nrec) { if (c.bid < nrec) { gdn_scan(c, p, c.bid);
            return; } }
    else { for (int h = c.bid; h < 12; h += c.G) gdn_scan(c, p, h); }
    {
        const int Gn = c.G - nrec, j = c.bid - nrec, heavy = (Gn > 0 && Gn < 1024) ? (1024 % Gn) : 0, na = Gn - heavy;
        for (int rep = 0; rep < 1 + (p.pad == 5); ++rep) {
            int u = 1152, us = 1;
            if (na > 0) { if (j >= heavy) { u = j - heavy; us = na; } } else { u = j; us = Gn; }
            AttnRegs ar;
            if (u < 1152) { attn_issue_k(c, p, u, ar); attn_issue_vq(c, p, u, ar); }
            while (u < 1152) {
                attn_stage(c, ar);
                __syncthreads();
                const int un = u + us;
                if (un < 1152) attn_issue_k(c, p, un, ar);
                attn_compute(c, p, u, ar, un);
                __syncthreads();
                u = un;
            }
        }
    }
    for (int rep = 0; rep < 1 + (p.pad == 6); ++rep) {
        pg8::Gemm g{(const bf16_t*)(p.ws + WS_H), (const bf16_t*)(p.ws + WS_WINT) + (size_t)L * NU * D, D}; GateOrder S{c.G - nrec, c.bid - nrec};
        EpiU E{(bf16_t*)(p.ws + WS_U)}; pg8::gemm_phase<EpiU, GateOrder, false>(c.lds, g, S, E);
    }
}

__device__ __forceinline__ void phase_combine(const Ctx& c, const Params& p, int L) {
    const bf16_t* U = (const bf16_t*)(p.ws + WS_U); const bf16_t* AO = (const bf16_t*)(p.ws + WS_ATTO); const float* LSE = (const float*)(p.ws + WS_LSE);
    const bf16_t* OG = (const bf16_t*)(p.ws + WS_OGDN); bf16_t* YA = (bf16_t*)(p.ws + WS_YBR); bf16_t* YC = YA + (size_t)2 * T * 768;
    const float* gn = p.gdn_norm_g + L * 128; const int lane = c.lane;
    for (int it0 = (c.bid * 8 + c.wave) * 4; it0 < T * 6; it0 += c.G * 8 * 4) {
        float l0[4], l1[4], l2[4]; unsigned a0[4], a1[4], a2[4], z2[4]; float2 og[4]; size_t o[4];
#pragma unroll
        for (int i = 0; i < 4; ++i) { const int it = it0 + i, t = it / 6, h = it % 6; o[i] = (size_t)t * 768 + h * 128 + 2 * lane;
            l0[i] = LSE[(size_t)t * 8 + h]; l1[i] = LSE[((size_t)T + t) * 8 + h]; l2[i] = LSE[((size_t)2 * T + t) * 8 + h];
            a0[i] = *(const unsigned*)(AO + o[i]); a1[i] = *(const unsigned*)(AO + (size_t)T * 768 + o[i]); a2[i] = *(const unsigned*)(AO + (size_t)2 * T * 768 + o[i]);
            { const unsigned ow = *(const unsigned*)(OG + o[i]); og[i] = make_float2(bflo(ow), bfhi(ow)); } z2[i] = *(const unsigned*)(U + (size_t)t * NU + UC_Z + h * 128 + 2 * lane); }
#pragma unroll
        for (int i = 0; i < 4; ++i) {
            const float mx = fmaxf(l0[i], fmaxf(l1[i], l2[i])); const float e0 = __expf(l0[i] - mx), e1 = __expf(l1[i] - mx), e2 = __expf(l2[i] - mx); const float is = 1.0f / (e0 + e1 + e2);
            *(unsigned*)(YC + o[i]) = cvt_pk_bf16((e0 * bflo(a0[i]) + e1 * bflo(a1[i]) + e2 * bflo(a2[i])) * is, (e0 * bfhi(a0[i]) + e1 * bfhi(a1[i]) + e2 * bfhi(a2[i])) * is);
            const float ss = wave_sum(og[i].x * og[i].x + og[i].y * og[i].y, lane); const float r = rsqrtf(ss * (1.0f / 128.f) + 1e-6f);
            *(unsigned*)(YA + o[i]) = cvt_pk_bf16(og[i].x * r * gn[2 * lane] * siluf_(bflo(z2[i])), og[i].y * r * gn[2 * lane + 1] * siluf_(bfhi(z2[i]))); }
    }
}

__device__ __forceinline__ void phase_norm2_router(const Ctx& c, const Params& p, int L) {
    const float* XB = (const float*)(p.ws + WS_XB); bf16_t* H = (bf16_t*)(p.ws + WS_H); const float* g2 = p.norm2_g + L * D;
    const bf16_t* WH = (const bf16_t*)(p.ws + WS_WRT) + (size_t)L * 2 * 80 * 2048; const bf16_t* WL = WH + 80 * 2048;
    unsigned* cnt = (unsigned*)(p.ws + WS_CTL + CTL_CNT) + L * 64; int* TOK = (int*)(p.ws + WS_TOK); float* WTS = (float*)(p.ws + WS_WSL);
    LAS float* lgp = (LAS float*)c.lds;
    LAS float* ssp = (LAS float*)c.lds + 2 * 4 * 16 * 80;
    const int lane = c.lane, m = lane & 15, q = lane >> 4, tl = c.wave >> 2, kq = c.wave & 3;
    for (int tp = c.bid; tp < T / 32; tp += c.G) {
        const int task = tp * 2 + tl;
        const int t = task * 16 + m; const float* xr = XB + (size_t)t * D + 512 * kq + 8 * q; const float* gr = g2 + 512 * kq + 8 * q;
        float ss = 0.f;
#pragma unroll 8
        for (int s = 0; s < 16; ++s) { const float4 a = *(const float4*)(xr + 32 * s), b = *(const float4*)(xr + 32 * s + 4);
            ss += a.x * a.x + a.y * a.y + a.z * a.z + a.w * a.w + b.x * b.x + b.y * b.y + b.z * b.z + b.w * b.w; }
        ss += shx(ss, 16, lane); ss += shx(ss, 32, lane);
        if (q == 0) ssp[(tl * 4 + kq) * 16 + m] = ss;
        __syncthreads();
        ss = ssp[(tl * 4 + 0) * 16 + m] + ssp[(tl * 4 + 1) * 16 + m] + ssp[(tl * 4 + 2) * 16 + m] + ssp[(tl * 4 + 3) * 16 + m];
        const float rstd = rsqrtf(ss * (1.0f / D) + 1e-6f);
        f32x4 acc[5];
#pragma unroll
        for (int nt = 0; nt < 5; ++nt) acc[nt] = (f32x4){0.f, 0.f, 0.f, 0.f};
        float4 na = *(const float4*)(xr), nb = *(const float4*)(xr + 4), nga = *(const float4*)(gr), ngb = *(const float4*)(gr + 4);
        bf16x8 nbh[5], nbl[5];
#pragma unroll
        for (int nt = 0; nt < 5; ++nt) { const size_t wo = (size_t)(16 * nt + m) * 2048 + 512 * kq + 8 * q; nbh[nt] = *(const bf16x8*)(WH + wo); nbl[nt] = *(const bf16x8*)(WL + wo); }
        for (int s = 0; s < 16; ++s) {
            const float4 a = na, b = nb, ga = nga, gb = ngb; bf16x8 bh[5], bl[5];
#pragma unroll
            for (int nt = 0; nt < 5; ++nt) { bh[nt] = nbh[nt]; bl[nt] = nbl[nt]; }
            if (s + 1 < 16) { const int s1 = s + 1;
                na = *(const float4*)(xr + 32 * s1); nb = *(const float4*)(xr + 32 * s1 + 4); nga = *(const float4*)(gr + 32 * s1); ngb = *(const float4*)(gr + 32 * s1 + 4);
#pragma unroll
                for (int nt = 0; nt < 5; ++nt) { const size_t wo = (size_t)(16 * nt + m) * 2048 + 512 * kq + 32 * s1 + 8 * q; nbh[nt] = *(const bf16x8*)(WH + wo); nbl[nt] = *(const bf16x8*)(WL + wo); } }
            float h[8]; h[0] = a.x * rstd * ga.x; h[1] = a.y * rstd * ga.y; h[2] = a.z * rstd * ga.z; h[3] = a.w * rstd * ga.w; h[4] = b.x * rstd * gb.x; h[5] = b.y * rstd * gb.y; h[6] = b.z * rstd * gb.z; h[7] = b.w * rstd * gb.w;
            u32x4 hi; hi.x = cvt_pk_bf16(h[0], h[1]); hi.y = cvt_pk_bf16(h[2], h[3]); hi.z = cvt_pk_bf16(h[4], h[5]); hi.w = cvt_pk_bf16(h[6], h[7]);
            u32x4 lo; lo.x = cvt_pk_bf16(h[0] - bflo(hi.x), h[1] - bfhi(hi.x)); lo.y = cvt_pk_bf16(h[2] - bflo(hi.y), h[3] - bfhi(hi.y));
            lo.z = cvt_pk_bf16(h[4] - bflo(hi.z), h[5] - bfhi(hi.z)); lo.w = cvt_pk_bf16(h[6] - bflo(hi.w), h[7] - bfhi(hi.w));
            const bf16x8 ah = __builtin_bit_cast(bf16x8, hi), al = __builtin_bit_cast(bf16x8, lo);
#pragma unroll
            for (int nt = 0; nt < 5; ++nt) {
                acc[nt] = __builtin_amdgcn_mfma_f32_16x16x32_bf16(ah, bh[nt], acc[nt], 0, 0, 0);
                acc[nt] = __builtin_amdgcn_mfma_f32_16x16x32_bf16(ah, bl[nt], acc[nt], 0, 0, 0);
                acc[nt] = __builtin_amdgcn_mfma_f32_16x16x32_bf16(al, bh[nt], acc[nt], 0, 0, 0); }
            *(u32x4*)(H + (size_t)t * D + 512 * kq + 32 * s + 8 * q) = hi;
        }
        LAS float* lgw = lgp + (tl * 4 + kq) * (16 * 80);
#pragma unroll
        for (int nt = 0; nt < 5; ++nt)
#pragma unroll
            for (int jj = 0; jj < 4; ++jj) lgw[(4 * q + jj) * 80 + 16 * nt + m] = acc[nt][jj];
        __syncthreads();
        if (kq == 0) {
            for (int i = lane; i < 16 * 80; i += 64) lgw[i] = lgw[i] + lgw[i + 16 * 80] + lgw[i + 2 * 16 * 80] + lgw[i + 3 * 16 * 80];
            asm volatile("s_waitcnt lgkmcnt(0)" ::: "memory");
        }
        if (kq == 0)
        if (lane < 16) {
            const int tt = task * 16 + lane; const LAS float* l = lgw + lane * 80;
            float gl[8]; float gm = -INFINITY; int gi = 0;
#pragma unroll
            for (int j = 0; j < 8; ++j) { gl[j] = l[j] + p.rg_b[L * 8 + j]; if (gl[j] > gm) { gm = gl[j]; gi = j; } }
            float gs = 0.f;
#pragma unroll
            for (int j = 0; j < 8; ++j) gs += expf(gl[j] - gm);
            const float gp = 1.0f / gs;
            float el[8]; float em = -INFINITY; int i1 = 0;
#pragma unroll
            for (int j = 0; j < 8; ++j) { el[j] = l[8 + gi * 8 + j] + p.re_b[L * 64 + gi * 8 + j]; if (el[j] > em) { em = el[j]; i1 = j; } }
            float e2m = -INFINITY; int i2 = 0;
#pragma unroll
            for (int j = 0; j < 8; ++j) { if (j != i1 && el[j] > e2m) { e2m = el[j]; i2 = j; } }
            const float p2 = expf(e2m - em);
            const float w1 = gp / (1.0f + p2), w2 = gp * p2 / (1.0f + p2);
            const int e1 = gi * 8 + i1, e2 = gi * 8 + i2;
            const unsigned q1 = atomicAdd(&cnt[e1], 1u); TOK[e1 * 8192 + q1] = tt * 2; WTS[e1 * 8192 + q1] = w1;
            const unsigned q2 = atomicAdd(&cnt[e2], 1u); TOK[e2 * 8192 + q2] = tt * 2 + 1; WTS[e2 * 8192 + q2] = w2;
        }
        __syncthreads();
    }
}

__device__ __forceinline__ MoeTab moe_tables(const Ctx& c, const Params& p, int L, int nN) {
    LAS int* base = (LAS int*)(c.lds + LDS_MISC + 1024);
    LAS int* mt_e = base, * mt_p0 = base + 192, * cn = base + 384, * nm = base + 448, * first = base + 452, * ut = base + 520;
    const unsigned* cnt = (const unsigned*)(p.ws + WS_CTL + CTL_CNT) + L * 64;
    __syncthreads();
    if (c.tid < 64) cn[c.tid] = (int)cnt[c.tid];
    __syncthreads();
    if (c.tid == 0) { int n = 0; for (int e = 0; e < 64; ++e) { first[e] = n; const int ntile = (cn[e] + 127) >> 7; for (int i = 0; i < ntile; ++i) { mt_e[n] = e; mt_p0[n] = i * 128; ++n; } } nm[0] = n; }
    __syncthreads();
    if (c.tid < 64) { const int e = c.tid, f0 = first[e], ntile = (cn[e] + 127) >> 7; int o = f0 * nN;
        for (int j = 0; j < nN; ++j) for (int m = 0; m < ntile; ++m) ut[o++] = ((f0 + m) << 4) | j; }
    __syncthreads();
    MoeTab tb; tb.mt_e = mt_e; tb.mt_p0 = mt_p0; tb.cnt = cn; tb.ut = ut; tb.nmt = nm[0]; return tb;
}

__device__ __forceinline__ void phase_final(const Ctx& c, const Params& p) {
    const float* XB = (const float*)(p.ws + WS_XB); const bf16_t* Y = (const bf16_t*)(p.ws + WS_YMOE);
    for (int t = c.bid * 8 + c.wave; t < T; t += c.G * 8) {
        float4 xv[8]; float ss = 0.f;
#pragma unroll
        for (int q = 0; q < 8; ++q) { const int col = q * 256 + c.lane * 4;
            const float4 a = *(const float4*)(XB + (size_t)t * D + col); const u32x2 y0 = *(const u32x2*)(Y + (size_t)(2 * t) * D + col), y1 = *(const u32x2*)(Y + (size_t)(2 * t + 1) * D + col);
            float4 v; v.x = a.x + (bflo(y0.x) + bflo(y1.x)); v.y = a.y + (bfhi(y0.x) + bfhi(y1.x)); v.z = a.z + (bflo(y0.y) + bflo(y1.y)); v.w = a.w + (bfhi(y0.y) + bfhi(y1.y));
            xv[q] = v; ss += v.x * v.x + v.y * v.y + v.z * v.z + v.w * v.w; }
        const float rstd = rsqrtf(wave_sum(ss, c.lane) * (1.0f / D) + 1e-6f);
#pragma unroll
        for (int q = 0; q < 8; ++q) { const int col = q * 256 + c.lane * 4; const float4 g = *(const float4*)(p.final_g + col);
            float4 o; o.x = xv[q].x * rstd * g.x; o.y = xv[q].y * rstd * g.y; o.z = xv[q].z * rstd * g.z; o.w = xv[q].w * rstd * g.w;
            *(float4*)(p.out + (size_t)t * D + col) = o; }
    }
}

constexpr int NPH_LAYER = 10, NPHASES = 1 + NL * NPH_LAYER + 1;
static_assert(NL == 2, "LAYER_BODY is instantiated twice");
#define LAYER_BODY(L) {         const int b = 1 + L * NPH_LAYER; \
        if (PHON(1) && IN(b + 0)) { for (int rep = 0; rep < 1 + (probe == b + 0); ++rep) { FRESH(); phase_norm1(c, p, L); } SEAM(b + 0); } \
        if (PHON(2) && IN(b + 1)) { for (int rep = 0; rep < 1 + (probe == b + 1); ++rep) { FRESH(); \
            pg8::Gemm g{(const bf16_t*)(p.ws + WS_H), (const bf16_t*)(p.ws + WS_WINT) + (size_t)L * NU * D, D}; pg8::StaticOrder S; S.init(T, UC_G, c.G, c.bid); \
            EpiU E{(bf16_t*)(p.ws + WS_U)}; pg8::gemm_phase<EpiU, pg8::StaticOrder, false>(c.lds, g, S, E); } SEAM(b + 1); } \
        if (PHON(3) && IN(b + 2)) { for (int rep = 0; rep < 1 + (probe == b + 2); ++rep) { FRESH(); phase_local(c, p, L); } SEAM(b + 2); } \
        if (PHON(4) && IN(b + 3)) { for (int rep = 0; rep < 1 + (probe == b + 3); ++rep) { FRESH(); phase_attn_gdn(c, p, L); } SEAM(b + 3); } \
        if (PHON(5) && IN(b + 4)) { for (int rep = 0; rep < 1 + (probe == b + 4); ++rep) { FRESH(); phase_combine(c, p, L); } SEAM(b + 4); } \
        if (PHON(6) && IN(b + 5)) { for (int rep = 0; rep < 1 + (probe == b + 5); ++rep) { FRESH(); \
            pg8::Gemm g{(const bf16_t*)(p.ws + WS_YBR), (const bf16_t*)(p.ws + WS_WBRT) + (size_t)L * 4 * D * 768, 768}; MergeOrder S{c.G, c.bid}; \
            EpiMerge E{(const bf16_t*)(p.ws + WS_U), (float*)(p.ws + WS_M32), (bf16_t*)(p.ws + WS_MERGED)}; pg8::gemm_phase<EpiMerge, MergeOrder, false>(c.lds, g, S, E); } SEAM(b + 5); } \
        if (PHON(7) && IN(b + 6)) { for (int rep = 0; rep < 1 + (probe == b + 6); ++rep) { FRESH(); \
            pg8::Gemm g{(const bf16_t*)(p.ws + WS_MERGED), (const bf16_t*)(p.ws + WS_WOUTT) + (size_t)L * D * D, D}; pg8::StaticOrder S; S.init(T, D, c.G, c.bid); \
            EpiRes E{L == 0 ? p.x : (const float*)(p.ws + WS_XA), (float*)(p.ws + WS_XB)}; pg8::gemm_phase<EpiRes, pg8::StaticOrder, false>(c.lds, g, S, E); } SEAM(b + 6); } \
        if (PHON(8) && IN(b + 7)) { FRESH(); phase_norm2_router(c, p, L); SEAM(b + 7); } \
        if (PHON(9) && IN(b + 8)) { for (int rep = 0; rep < 1 + (probe == b + 8); ++rep) { FRESH(); \
            const MoeTab tb = moe_tables(c, p, L, 4); \
            MoeOrder S{tb, 4, c.G, c.bid, (const int*)(p.ws + WS_TOK)}; \
            EpiUp E{(bf16_t*)(p.ws + WS_HID)}; moe_gemm<EpiUp, true>(c, (const bf16_t*)(p.ws + WS_H), p.w_up + (size_t)L * NE * D * 1024, S, E); } SEAM(b + 8); } \
        if (PHON(10) && IN(b + 9)) { for (int rep = 0; rep < 1 + (probe == b + 9); ++rep) { FRESH(); \
            const MoeTab tb = moe_tables(c, p, L, 8); \
            MoeOrder S{tb, 8, c.G, c.bid, (const int*)(p.ws + WS_TOK)}; \
            EpiDown E{tb, (const int*)(p.ws + WS_TOK), (const float*)(p.ws + WS_WSL), (bf16_t*)(p.ws + WS_YMOE)}; moe_gemm<EpiDown, false>(c, (const bf16_t*)(p.ws + WS_HID), p.w_down + (size_t)L * NE * EH * D, S, E); } SEAM(b + 9); } \
 }
__global__ void __launch_bounds__(NTHREADS, 2) fwd(Params p0) {
    extern __shared__ __attribute__((aligned(16))) unsigned char lds_raw[];
    Ctx c; c.tid = threadIdx.x; c.lane = c.tid & 63; c.wave = __builtin_amdgcn_readfirstlane(c.tid >> 6); c.bid = blockIdx.x; c.G = gridDim.x; c.lds = (LAS unsigned char*)lds_raw;
    volatile LAS unsigned* misc = (volatile LAS unsigned*)(c.lds + LDS_MISC);
    if (c.tid < 4) misc[c.tid] = 0u;
    if (c.tid == 0) {
        LAS unsigned long long* tab = (LAS unsigned long long*)(c.lds + LDS_PTAB);
        tab[0] = (unsigned long long)p0.x; tab[1] = (unsigned long long)p0.pos; tab[2] = (unsigned long long)p0.norm1_g; tab[3] = (unsigned long long)p0.w_in; tab[4] = (unsigned long long)p0.conv_a_w;
        tab[5] = (unsigned long long)p0.a_log; tab[6] = (unsigned long long)p0.dt_bias; tab[7] = (unsigned long long)p0.gdn_norm_g; tab[8] = (unsigned long long)p0.conv_b_w; tab[9] = (unsigned long long)p0.conv_b_b;
        tab[10] = (unsigned long long)p0.ln_b_g; tab[11] = (unsigned long long)p0.ln_b_b; tab[12] = (unsigned long long)p0.pool_w; tab[13] = (unsigned long long)p0.pool_scale; tab[14] = (unsigned long long)p0.w_branch;
        tab[15] = (unsigned long long)p0.w_out; tab[16] = (unsigned long long)p0.norm2_g; tab[17] = (unsigned long long)p0.rg_w; tab[18] = (unsigned long long)p0.rg_b; tab[19] = (unsigned long long)p0.re_w;
        tab[20] = (unsigned long long)p0.re_b; tab[21] = (unsigned long long)p0.w_up; tab[22] = (unsigned long long)p0.w_down; tab[23] = (unsigned long long)p0.final_g; tab[24] = (unsigned long long)p0.out;
    }
    __syncthreads();
    const int lo = p0.ph_lo, hi = p0.ph_hi, probe = p0.probe, psub = p0.pad; unsigned char* const wsb = p0.ws;
    const bool multi = (hi - lo) > 1;
    XcdBarrier bar; bar.bar = (unsigned*)(wsb + WS_CTL); bar.x = 0; bar.st = misc;
    if (multi) bar = xcd_barrier_post((unsigned*)(wsb + WS_CTL), misc);
#define IN(k) (lo <= (k) && (k) < hi)
#define FRESH() int _t = threadIdx.x; asm volatile("" : "+v"(_t)); c.tid = _t; c.lane = _t & 63; \
    { int _b = blockIdx.x, _g = gridDim.x, _w = __builtin_amdgcn_readfirstlane(_t >> 6); asm volatile("" : "+s"(_b), "+s"(_g), "+s"(_w)); c.bid = _b; c.G = _g; c.wave = _w; } \
    unsigned char* _ws = wsb; asm volatile("" : "+s"(_ws)); Params p = load_params(c, _ws, lo, hi); p.pad = psub
#define SEAM(k) do { if (IN((k) + 1)) { XcdBarrier _bb = bar; asm volatile("" : "+s"(_bb.bar)); xcd_barrier(_bb); } } while (0)
#ifndef PHMASK
#define PHMASK 0xFFFFF
#endif
#define PHON(k) ((PHMASK >> (k)) & 1)
    if (PHON(0) && IN(0)) { for (int rep = 0; rep < 1 + (probe == 0); ++rep) { FRESH(); phase_convert(c, p); } SEAM(0); }
    for (int L = 0; L < NL; ++L) LAYER_BODY(L)
    if (PHON(11) && IN(NPHASES - 1)) { FRESH(); phase_final(c, p); }
#undef IN
#undef SEAM
}

extern "C" void kernel_launch(void* const* d_in, const int* in_sizes, int n_in, void* d_out, int out_size, void* d_ws, size_t ws_size, hipStream_t stream) {
    static int grid = 0;
    if (grid == 0) {
        if (n_in != 24 || out_size != T * D || ws_size < WS_END) { fprintf(stderr, "kernel_launch: unexpected shapes (n_in %d, out %d, ws %zu < %zu)\n", n_in, out_size, ws_size, (size_t)WS_END); grid = -1; return; }
        int dev = 0, cus = 0, per_cu = 0;
        if (hipGetDevice(&dev) != hipSuccess || hipDeviceGetAttribute(&cus, hipDeviceAttributeMultiprocessorCount, dev) != hipSuccess) { grid = -1; return; }
        if (hipFuncSetAttribute((const void*)fwd, hipFuncAttributeMaxDynamicSharedMemorySize, LDS_BYTES) != hipSuccess) { fprintf(stderr, "kernel_launch: hipFuncSetAttribute failed\n"); grid = -1; return; }
        if (hipOccupancyMaxActiveBlocksPerMultiprocessor(&per_cu, (const void*)fwd, NTHREADS, LDS_BYTES) != hipSuccess || per_cu < 1) { fprintf(stderr, "kernel_launch: occupancy query says %d\n", per_cu); (void)hipGetLastError(); }
        grid = cus;
    }
    if (grid < 0) return;
    (void)hipMemsetAsync((char*)d_ws + WS_CTL, 0, CTL_BYTES, stream);
    Params p{};
    p.x = (const float*)d_in[0]; p.pos = (const int*)d_in[1]; p.norm1_g = (const float*)d_in[2]; p.w_in = (const float*)d_in[3]; p.conv_a_w = (const float*)d_in[4];
    p.a_log = (const float*)d_in[5]; p.dt_bias = (const float*)d_in[6]; p.gdn_norm_g = (const float*)d_in[7]; p.conv_b_w = (const float*)d_in[8]; p.conv_b_b = (const float*)d_in[9];
    p.ln_b_g = (const float*)d_in[10]; p.ln_b_b = (const float*)d_in[11]; p.pool_w = (const float*)d_in[12]; p.pool_scale = (const float*)d_in[13]; p.w_branch = (const float*)d_in[14];
    p.w_out = (const float*)d_in[15]; p.norm2_g = (const float*)d_in[16]; p.rg_w = (const float*)d_in[17]; p.rg_b = (const float*)d_in[18]; p.re_w = (const float*)d_in[19];
    p.re_b = (const float*)d_in[20]; p.w_up = (const float*)d_in[21]; p.w_down = (const float*)d_in[22]; p.final_g = (const float*)d_in[23];
    p.out = (float*)d_out; p.ws = (unsigned char*)d_ws; p.probe = PROBE_PHASE; p.pad = PROBE_SUB;
#if MK_ONE_LAUNCH
    p.ph_lo = 0; p.ph_hi = NPHASES;
    hipLaunchKernelGGL(fwd, dim3(grid), dim3(NTHREADS), LDS_BYTES, stream, p);
#else
    for (int ph = 0; ph < NPHASES; ++ph) { p.ph_lo = ph; p.ph_hi = ph + 1; hipLaunchKernelGGL(fwd, dim3(grid), dim3(NTHREADS), LDS_BYTES, stream, p); }
#endif
}
```

```cpp
#include <hip/hip_runtime.h>
#include <cstdio>
#include <cstdint>

#ifndef PROBE_SUB
#define PROBE_SUB 0
#endif
#ifndef PROBE_PHASE
#define PROBE_PHASE -1
#endif
#ifndef MK_ONE_LAUNCH
#define MK_ONE_LAUNCH 1
#endif

#define LAS __attribute__((address_space(3)))
typedef unsigned short bf16_t;
typedef short bf16x8 __attribute__((ext_vector_type(8)));
typedef float f32x4 __attribute__((ext_vector_type(4)));
typedef unsigned u32x4 __attribute__((ext_vector_type(4)));
typedef unsigned u32x2 __attribute__((ext_vector_type(2)));
typedef short s16x4 __attribute__((ext_vector_type(4)));
typedef float f32x2 __attribute__((ext_vector_type(2)));

constexpr int T = 8192, D = 2048, NL = 2;
constexpr int NIN = 20492, NU = 20480;
constexpr int UC_QKV = 0, UC_Z = 2304, UC_B = 3072, UC_C = 4608, UC_D = 11520, UC_G = 12288;
constexpr int NE = 64, EH = 512;
constexpr int NTHREADS = 512;
constexpr int LDS_STAGE = 131072;
constexpr int LDS_MISC = LDS_STAGE;
constexpr int LDS_OSTG = LDS_STAGE + 8192;
constexpr int LDS_BYTES = LDS_OSTG + 16384;

constexpr size_t al256(size_t x) { return (x + 255) & ~(size_t)255; }
constexpr size_t WS_CTL = 0;
constexpr size_t CTL_BYTES = 65536;
constexpr size_t CTL_CNT = 32768;
constexpr size_t WS_WINT = WS_CTL + CTL_BYTES;
constexpr size_t WS_WBRT = WS_WINT + (size_t)NL * NU * D * 2;
constexpr size_t WS_WOUTT = WS_WBRT + (size_t)NL * 4 * D * 768 * 2;
constexpr size_t WS_WUPT = WS_WOUTT + (size_t)NL * D * D * 2;
constexpr size_t WS_WDNT = WS_WUPT + (size_t)NL * NE * 1024 * D * 2;
constexpr size_t WS_H = WS_WDNT + (size_t)NL * NE * D * EH * 2;
constexpr size_t WS_U = WS_H + (size_t)T * D * 2;
constexpr size_t WS_XA = WS_U + (size_t)T * NU * 2;
constexpr size_t WS_XB = WS_XA + (size_t)T * D * 4;
constexpr size_t WS_BETA = WS_XB + (size_t)T * D * 4;
constexpr size_t WS_GLOG = WS_BETA + (size_t)T * 8 * 4;
constexpr int GB_WC = 0, GB_QD = 16384, GB_KDT = 32768, GB_QK = 49152, GB_BYTES = 57344;
constexpr size_t WS_GBLK = WS_GLOG + (size_t)T * 8 * 4;
constexpr size_t WS_UCP = WS_GBLK + (size_t)768 * GB_BYTES;
constexpr size_t WS_GL = WS_UCP + (size_t)768 * 8192 * 4;
constexpr size_t WS_OGDN = WS_GL + 4096;
constexpr size_t WS_QR = WS_OGDN + (size_t)T * 768 * 4;
constexpr size_t WS_KR = WS_QR + (size_t)T * 2304 * 2;
constexpr size_t WS_ATTO = WS_KR + (size_t)T * 2304 * 2;
constexpr size_t WS_LSE = WS_ATTO + (size_t)3 * T * 768 * 2;
constexpr size_t WS_YBR = WS_LSE + (size_t)3 * T * 8 * 4;
constexpr size_t WS_M32 = WS_YBR + (size_t)4 * T * 768 * 2;
constexpr size_t WS_MERGED = WS_M32 + (size_t)T * D * 4;
constexpr size_t WS_TOK = WS_MERGED + (size_t)T * D * 2;
constexpr size_t WS_WTS = WS_TOK + (size_t)NE * 8192 * 4;
constexpr size_t WS_HID = WS_WTS + (size_t)T * 2 * 4;
constexpr size_t WS_YMOE = WS_HID + (size_t)32768 * EH * 2;
constexpr size_t WS_PWT = WS_YMOE + (size_t)T * 2 * D * 4;
constexpr size_t WS_WRT = WS_PWT + (size_t)NL * 4 * 192 * 192 * 2;
constexpr size_t WS_WSM = WS_WRT + (size_t)NL * 2 * 80 * 2048 * 2;
constexpr size_t WS_WSL = WS_WSM + (size_t)NL * 12 * 2048 * 4;
constexpr size_t WS_END = WS_WSL + (size_t)NE * 8192 * 4;

__constant__ float ROPE_INV[64] = {1.000000000e+00f, 8.659643531e-01f, 7.498942018e-01f, 6.493816376e-01f, 5.623413324e-01f, 4.869675338e-01f, 4.216965139e-01f, 3.651741147e-01f, 3.162277639e-01f, 2.738419771e-01f, 2.371373773e-01f, 2.053525001e-01f, 1.778279394e-01f, 1.539926529e-01f, 1.333521456e-01f, 1.154781953e-01f, 1.000000015e-01f, 8.659642935e-02f, 7.498942316e-02f, 6.493816525e-02f, 5.623413250e-02f, 4.869675264e-02f, 4.216964915e-02f, 3.651741147e-02f, 3.162277490e-02f, 2.738419548e-02f, 2.371373773e-02f, 2.053525113e-02f, 1.778279431e-02f, 1.539926510e-02f, 1.333521400e-02f, 1.154781971e-02f, 9.999999776e-03f, 8.659643121e-03f, 7.498942316e-03f, 6.493816152e-03f, 5.623413250e-03f, 4.869675264e-03f, 4.216964822e-03f, 3.651741194e-03f, 3.162277630e-03f, 2.738419687e-03f, 2.371373819e-03f, 2.053525066e-03f, 1.778279431e-03f, 1.539926510e-03f, 1.333521446e-03f, 1.154782018e-03f, 1.000000047e-03f, 8.659643354e-04f, 7.498941850e-04f, 6.493816036e-04f, 5.623413017e-04f, 4.869675322e-04f, 4.216965172e-04f, 3.651741135e-04f, 3.162277571e-04f, 2.738419571e-04f, 2.371373703e-04f, 2.053525095e-04f, 1.778279402e-04f, 1.539926598e-04f, 1.333521504e-04f, 1.154782003e-04f};

__device__ __forceinline__ float bf2f(unsigned short b) { return __uint_as_float(((unsigned)b) << 16); }
__device__ __forceinline__ float bflo(unsigned w) { return __uint_as_float(w << 16); }
__device__ __forceinline__ float bfhi(unsigned w) { return __uint_as_float(w & 0xffff0000u); }
typedef __bf16 bf16x2_t __attribute__((ext_vector_type(2)));
__device__ __forceinline__ unsigned cvt_pk_bf16(float lo, float hi) { bf16x2_t v; v.x = (__bf16)lo; v.y = (__bf16)hi; return __builtin_bit_cast(unsigned, v); }
__device__ __forceinline__ bf16_t f2bf(float f) { return (bf16_t)(cvt_pk_bf16(f, 0.f) & 0xffffu); }
__device__ __forceinline__ float shx(float v, int o, int lane) { return __int_as_float(__builtin_amdgcn_ds_bpermute((lane ^ o) << 2, __float_as_int(v))); }
__device__ __forceinline__ float wave_sum(float v, int lane) {
#pragma unroll
    for (int o = 32; o; o >>= 1) v += shx(v, o, lane);
    return v; }
__device__ __forceinline__ float wave_max(float v, int lane) {
#pragma unroll
    for (int o = 32; o; o >>= 1) v = fmaxf(v, shx(v, o, lane));
    return v; }
__device__ __forceinline__ float sigmoidf_(float x) { return 1.0f / (1.0f + __expf(-x)); }
__device__ __forceinline__ float siluf_(float x) { return x / (1.0f + __expf(-x)); }

__device__ __forceinline__ bf16x8 tr_pair(const LAS unsigned char* p0, const LAS unsigned char* p1) {
    const s16x4 a = __builtin_amdgcn_ds_read_tr16_b64_v4i16((LAS s16x4*)p0), b = __builtin_amdgcn_ds_read_tr16_b64_v4i16((LAS s16x4*)p1);
    return __builtin_shufflevector(a, b, 0, 1, 2, 3, 4, 5, 6, 7); }
#define XB_TMO      128
#define XB_XCNT(j)  (256  + 64 * (j))
#define XB_XSUB(j)  (1280 + 64 * (j))
#define XB_XGEN(j)  (2304 + 64 * (j))
#define XB_TOP      3328
#define XB_TOPGEN   3392
#define XCD_BAR_WORDS 3456
#define XB_SPIN_CAP (1u << 18)
__device__ __forceinline__ unsigned xb_ld(unsigned* p)              { return __hip_atomic_load(p, __ATOMIC_RELAXED, __HIP_MEMORY_SCOPE_AGENT); }
__device__ __forceinline__ unsigned xb_add(unsigned* p, unsigned v) { return __hip_atomic_fetch_add(p, v, __ATOMIC_RELAXED, __HIP_MEMORY_SCOPE_AGENT); }
__device__ __forceinline__ unsigned xb_xcc_id() { return (unsigned)__builtin_amdgcn_s_getreg((3 << 11) | 20) & 0xFu; }
#define XB_SPIN(cond, bar) do { unsigned _sp = 0; while (cond) { __builtin_amdgcn_s_sleep(1); \
    if ((++_sp & 255u) == 0u) { if (xb_ld(&(bar)[XB_TMO])) break; if (_sp > XB_SPIN_CAP) { atomicAdd(&(bar)[XB_TMO], 1u); break; } } } } while (0)
struct XcdBarrier { unsigned* bar; unsigned x; volatile LAS unsigned* st; };
__device__ __forceinline__ XcdBarrier xcd_barrier_post(unsigned* bar, volatile LAS unsigned* st) {
    XcdBarrier b; b.bar = bar; b.x = xb_xcc_id(); b.st = st;
    if (threadIdx.x == 0) (void)xb_add(&bar[XB_XCNT(b.x)], 1u);
    return b;
}
__device__ __forceinline__ void xcd_barrier_complete(unsigned* bar, unsigned x, unsigned& nloc, unsigned& nx) {
    const unsigned G = gridDim.x * gridDim.y * gridDim.z;
    unsigned sum, cnt, mine, sp = 0u;
    for (;;) {
        sum = 0u; cnt = 0u; mine = 0u;
#pragma unroll
        for (unsigned j = 0; j < 16; ++j) { const unsigned c = xb_ld(&bar[XB_XCNT(j)]); sum += c; cnt += (c > 0u) ? 1u : 0u; mine = (j == x) ? c : mine; }
        if (sum == G) break;
        __builtin_amdgcn_s_sleep(1);
        if ((++sp & 255u) == 0u) { if (xb_ld(&bar[XB_TMO])) break; if (sp > XB_SPIN_CAP) { atomicAdd(&bar[XB_TMO], 1u); break; } }
    }
    nloc = mine > 0u ? mine : 1u; nx = cnt > 0u ? cnt : 1u;
}
__device__ __forceinline__ void xcd_barrier(const XcdBarrier& b) {
    asm volatile("s_waitcnt vmcnt(0)" ::: "memory");
    __syncthreads();
    if (threadIdx.x == 0) {
        unsigned* bar = b.bar;
        __builtin_amdgcn_s_waitcnt(0);
        unsigned nloc = b.st[0], nx = b.st[1];
        if (nloc == 0u) { xcd_barrier_complete(bar, b.x, nloc, nx); b.st[0] = nloc; b.st[1] = nx; }
        const unsigned old = xb_add(&bar[XB_XSUB(b.x)], 1u);
        const unsigned gen = old / nloc;
        if (old + 1u == (gen + 1u) * nloc) {
            __builtin_amdgcn_fence(__ATOMIC_RELEASE, "agent");
            asm volatile("s_waitcnt vmcnt(0)" ::: "memory");
            const unsigned og = xb_add(&bar[XB_TOP], 1u);
            const unsigned tg = og / nx;
            if (og + 1u == (tg + 1u) * nx) xb_add(&bar[XB_TOPGEN], 1u);
            else XB_SPIN(xb_ld(&bar[XB_TOPGEN]) == tg, bar);
            __builtin_amdgcn_fence(__ATOMIC_ACQUIRE, "agent");
            xb_add(&bar[XB_XGEN(b.x)], 1u);
            asm volatile("s_waitcnt vmcnt(0)" ::: "memory");
        } else {
            XB_SPIN(xb_ld(&bar[XB_XGEN(b.x)]) == gen, bar);
            __builtin_amdgcn_fence(__ATOMIC_ACQUIRE, "agent");
            asm volatile("s_waitcnt vmcnt(0)" ::: "memory");
        }
    }
    __syncthreads();
}

namespace pg8 {
constexpr int BM = 256, BK = 64, HALF = 128, HTB = HALF * BK * 2, STAGE_BYTES = 8 * HTB, NXCD = 8, WGM = 8;
__host__ __device__ __forceinline__ int lds_byte(int r, int c) { const int st = (r >> 4) * 2 + (c >> 5), rr = r & 15, cc = c & 31, ob = rr * 64 + cc * 2; return st * 1024 + (ob ^ (((ob >> 9) & 1) << 5)); }
__host__ __device__ __forceinline__ void stage_rc(int b, int& R, int& C) { const int st = b / 1024, sb = b % 1024, swz = sb ^ (((sb >> 9) & 1) << 5); R = (st >> 1) * 16 + swz / 64; C = (st & 1) * 32 + (swz % 64) / 2; }
__host__ __device__ __forceinline__ int perm32(int rho) { const int n = rho >> 4, i = rho & 15; return 8 * (i >> 2) + 4 * n + (i & 3); }
struct Unit { int pm, pn; };
struct Gemm { const bf16_t* A; const bf16_t* Bt; int K; };
struct StaticOrder {
    int nM, nN, nwg, G, c;
    __device__ void init(int M, int N, int G_, int c_) { nM = M / BM; nN = N / BM; nwg = nM * nN; G = G_; c = c_; }
    __device__ bool next(int i, Unit& u) const {
        const long L = (long)i * G + c; if (L >= nwg) return false;
        int wgid = (int)L; { const int q = nwg / NXCD, r = nwg % NXCD, xcd = wgid % NXCD, off = wgid / NXCD; wgid = (xcd < r ? xcd * (q + 1) : r * (q + 1) + (xcd - r) * q) + off; }
        const int nig = WGM * nN, gid = wgid / nig, fm = gid * WGM, gsz = (nM - fm) < WGM ? (nM - fm) : WGM;
        u.pm = fm + ((wgid % nig) % gsz); u.pn = (wgid % nig) / gsz; return true;
    }
    __device__ __forceinline__ int arow(const Unit& u, int r) const { return u.pm * BM + r; }
};

template <class Epi, class Sched, bool GATHER>
__device__ __forceinline__ void gemm_phase(LAS unsigned char* lds, const Gemm g, const Sched& S, const Epi& E) {
    int tid = threadIdx.x; asm volatile("" : "+v"(tid));
    const int wid = __builtin_amdgcn_readfirstlane(tid >> 6), lane = tid & 63, wr = wid >> 2, wc = wid & 3, fr = lane & 15, fq = lane >> 4;
    const int K = g.K, nt = K / BK;
    unsigned voffA[2], voffB[2]; int RA[2], CA[2];
#pragma unroll
    for (int i = 0; i < 2; ++i) { int R, C; stage_rc(tid * 16 + i * 8192, R, C); const int Rb = Epi::PERM ? ((R & ~31) + perm32(R & 31)) : R;
        voffA[i] = (unsigned)(R * K + C) * 2u; voffB[i] = (unsigned)(Rb * K + C) * 2u; RA[i] = R; CA[i] = C; }
    const size_t kstep = (size_t)(BK * 2);
    const size_t hstep = (size_t)HALF * K * 2;
    const size_t tstep = 2 * hstep;
    const unsigned ldsw = (unsigned)wid * 1024u;
    const int aoff = lds_byte(wr * 64 + fr, fq * 8), boff = lds_byte(wc * 32 + fr, fq * 8);
#define PG8_SA(b, h) (((b) * 2 + (h)) * HTB)
#define PG8_SB(b, h) ((4 + (b) * 2 + (h)) * HTB)
#define PG8_STAGE(bufoff, gbase, voff) do { _Pragma("unroll") for (int _i = 0; _i < 2; ++_i) \
        __builtin_amdgcn_global_load_lds((const unsigned*)((const char*)(gbase) + (voff)[_i]), (LAS unsigned*)(lds + (bufoff) + ldsw + _i * 8192), 16, 0, 0); } while (0)
#define PG8_STAGE2(bufoff, gbase, o0, o1) do { \
        __builtin_amdgcn_global_load_lds((const unsigned*)((const char*)(gbase) + (o0)), (LAS unsigned*)(lds + (bufoff) + ldsw), 16, 0, 0); \
        __builtin_amdgcn_global_load_lds((const unsigned*)((const char*)(gbase) + (o1)), (LAS unsigned*)(lds + (bufoff) + ldsw + 8192), 16, 0, 0); } while (0)
#define PG8_LDA(dst, b, h) do { _Pragma("unroll") for (int m = 0; m < 4; ++m) _Pragma("unroll") for (int k = 0; k < 2; ++k) dst[m][k] = *(const LAS bf16x8*)(lds + PG8_SA(b, h) + aoff + m * 2048 + k * 1024); } while (0)
#define PG8_LDB(dst, b, h) do { _Pragma("unroll") for (int n = 0; n < 2; ++n) _Pragma("unroll") for (int k = 0; k < 2; ++k) dst[n][k] = *(const LAS bf16x8*)(lds + PG8_SB(b, h) + boff + n * 2048 + k * 1024); } while (0)
#define PG8_MMA(ai, bj, At, Bt) do { __builtin_amdgcn_s_setprio(1); _Pragma("unroll") for (int m = 0; m < 4; ++m) _Pragma("unroll") for (int n = 0; n < 2; ++n) _Pragma("unroll") for (int k = 0; k < 2; ++k) \
        acc[ai][bj][m][n] = __builtin_amdgcn_mfma_f32_16x16x32_bf16(Bt[n][k], At[m][k], acc[ai][bj][m][n], 0, 0, 0); __builtin_amdgcn_s_setprio(0); } while (0)
#define PG8_WAIT_V(n) asm volatile("s_waitcnt vmcnt(" #n ")" ::: "memory")
#define PG8_WAIT_L(n) asm volatile("s_waitcnt lgkmcnt(" #n ")" ::: "memory")
#define PG8_BAR __builtin_amdgcn_s_barrier()
#define PG8_SCHED __builtin_amdgcn_sched_barrier(0)
    Unit cur, nxt; int ui = 0;
    if (!S.next(0, cur)) return;
    f32x4 acc[2][2][4][2];
#pragma unroll
    for (int a = 0; a < 2; ++a)
#pragma unroll
        for (int b = 0; b < 2; ++b)
#pragma unroll
            for (int m = 0; m < 4; ++m)
#pragma unroll
                for (int n = 0; n < 2; ++n) acc[a][b][m][n] = (f32x4){0.f, 0.f, 0.f, 0.f};
    bf16x8 At[4][2], B0[2][2], B1[2][2];
    unsigned c00 = 0, c01 = 0, c10 = 0, c11 = 0, n00 = 0, n01 = 0, n10 = 0, n11 = 0;
    if constexpr (GATHER) {
        c00 = (unsigned)(S.arow(cur, RA[0]) * K + CA[0]) * 2u; c01 = (unsigned)(S.arow(cur, RA[1]) * K + CA[1]) * 2u;
        c10 = (unsigned)(S.arow(cur, HALF + RA[0]) * K + CA[0]) * 2u; c11 = (unsigned)(S.arow(cur, HALF + RA[1]) * K + CA[1]) * 2u;
    }
    const char* cA = GATHER ? (const char*)g.A : (const char*)g.A + (size_t)cur.pm * tstep; const char* cB = (const char*)g.Bt + (size_t)cur.pn * tstep;
    if constexpr (GATHER) {
        PG8_STAGE(PG8_SB(0, 0), cB, voffB); PG8_STAGE2(PG8_SA(0, 0), cA, c00, c01); PG8_STAGE(PG8_SB(0, 1), cB + hstep, voffB); PG8_STAGE2(PG8_SA(0, 1), cA, c10, c11);
    } else {
        PG8_STAGE(PG8_SB(0, 0), cB, voffB); PG8_STAGE(PG8_SB(0, 1), cB + hstep, voffB); PG8_STAGE(PG8_SA(0, 0), cA, voffA); PG8_STAGE(PG8_SA(0, 1), cA + hstep, voffA);
    }
    if (wr == 1) PG8_BAR;
    if constexpr (GATHER) PG8_WAIT_V(4); else PG8_WAIT_V(2);
    PG8_BAR;
    if constexpr (GATHER) {
        PG8_STAGE(PG8_SB(1, 0), cB + kstep, voffB); PG8_STAGE2(PG8_SA(1, 0), cA + kstep, c00, c01); PG8_STAGE(PG8_SB(1, 1), cB + hstep + kstep, voffB);
    } else {
        PG8_STAGE(PG8_SB(1, 0), cB + kstep, voffB); PG8_STAGE(PG8_SA(1, 0), cA + kstep, voffA); PG8_STAGE(PG8_SB(1, 1), cB + hstep + kstep, voffB);
    }
    PG8_WAIT_V(6); PG8_BAR;
    for (;;) {
        const bool has_next = S.next(ui + 1, nxt);
        if constexpr (GATHER) {
            if (has_next) {
                n00 = (unsigned)(S.arow(nxt, RA[0]) * K + CA[0]) * 2u; n01 = (unsigned)(S.arow(nxt, RA[1]) * K + CA[1]) * 2u;
                n10 = (unsigned)(S.arow(nxt, HALF + RA[0]) * K + CA[0]) * 2u; n11 = (unsigned)(S.arow(nxt, HALF + RA[1]) * K + CA[1]) * 2u;
            } else { n00 = c00; n01 = c01; n10 = c10; n11 = c11; }
        }
        const char* nA = GATHER ? cA : (has_next ? (const char*)g.A + (size_t)nxt.pm * tstep : cA);
        const char* nB = has_next ? (const char*)g.Bt + (size_t)nxt.pn * tstep : cB;
        for (int t = 0; t < nt; t += 2) {
            const bool last = (t == nt - 2);
            const char* a1 = cA + (size_t)(t + 1) * kstep;
            const char* a2 = last ? nA : cA + (size_t)(t + 2) * kstep; const char* b2 = last ? nB : cB + (size_t)(t + 2) * kstep;
            const char* a3 = a2 + kstep; const char* b3 = b2 + kstep;
            unsigned s00 = 0, s01 = 0, s10 = 0, s11 = 0;
            if constexpr (GATHER) { s00 = last ? n00 : c00; s01 = last ? n01 : c01; s10 = last ? n10 : c10; s11 = last ? n11 : c11; }
            if constexpr (!GATHER) {
            PG8_LDB(B0, 0, 0); PG8_LDB(B1, 0, 1); PG8_SCHED; PG8_LDA(At, 0, 0); PG8_STAGE(PG8_SA(1, 1), a1 + hstep, voffA);
            PG8_WAIT_V(8); PG8_WAIT_L(0); PG8_BAR; PG8_MMA(0, 0, At, B0); PG8_MMA(0, 1, At, B1); PG8_BAR; PG8_SCHED;
            PG8_LDA(At, 0, 1); PG8_STAGE(PG8_SB(0, 0), b2, voffB); PG8_STAGE(PG8_SB(0, 1), b2 + hstep, voffB); PG8_STAGE(PG8_SA(0, 0), a2, voffA);
            PG8_WAIT_V(8); PG8_WAIT_L(0); PG8_BAR; PG8_MMA(1, 0, At, B0); PG8_MMA(1, 1, At, B1); PG8_BAR; PG8_SCHED;
            PG8_LDB(B0, 1, 0); PG8_LDB(B1, 1, 1); PG8_SCHED; PG8_LDA(At, 1, 0); PG8_STAGE(PG8_SA(0, 1), a2 + hstep, voffA);
            PG8_WAIT_V(8); PG8_WAIT_L(0); PG8_BAR; PG8_MMA(0, 0, At, B0); PG8_MMA(0, 1, At, B1); PG8_BAR; PG8_SCHED;
            PG8_LDA(At, 1, 1); PG8_STAGE(PG8_SB(1, 0), b3, voffB); PG8_STAGE(PG8_SB(1, 1), b3 + hstep, voffB); PG8_STAGE(PG8_SA(1, 0), a3, voffA);
            PG8_WAIT_V(8); PG8_WAIT_L(0); PG8_BAR; PG8_MMA(1, 0, At, B0); PG8_MMA(1, 1, At, B1); PG8_BAR; PG8_SCHED;
            } else {
            PG8_LDB(B0, 0, 0); PG8_SCHED; PG8_LDA(At, 0, 0);
            if constexpr (GATHER) PG8_STAGE2(PG8_SA(1, 1), a1, c10, c11); else PG8_STAGE(PG8_SA(1, 1), a1 + hstep, voffA);
            PG8_WAIT_L(8); PG8_BAR; PG8_WAIT_L(0); PG8_MMA(0, 0, At, B0); PG8_BAR; PG8_SCHED;
            PG8_LDB(B1, 0, 1); PG8_STAGE(PG8_SB(0, 0), b2, voffB);
            PG8_BAR; PG8_WAIT_L(0); PG8_MMA(0, 1, At, B1); PG8_BAR;
            PG8_LDA(At, 0, 1);
            if constexpr (GATHER) PG8_STAGE2(PG8_SA(0, 0), a2, s00, s01); else PG8_STAGE(PG8_SA(0, 0), a2, voffA);
            PG8_BAR; PG8_WAIT_L(0); PG8_MMA(1, 0, At, B0); PG8_BAR; PG8_SCHED;
            PG8_STAGE(PG8_SB(0, 1), b2 + hstep, voffB);
            PG8_WAIT_V(6); PG8_BAR; PG8_MMA(1, 1, At, B1); PG8_BAR;
            PG8_LDB(B0, 1, 0); PG8_SCHED; PG8_LDA(At, 1, 0);
            if constexpr (GATHER) PG8_STAGE2(PG8_SA(0, 1), a2, s10, s11); else PG8_STAGE(PG8_SA(0, 1), a2 + hstep, voffA);
            PG8_WAIT_L(8); PG8_BAR; PG8_WAIT_L(0); PG8_MMA(0, 0, At, B0); PG8_BAR; PG8_SCHED;
            PG8_LDB(B1, 1, 1); PG8_STAGE(PG8_SB(1, 0), b3, voffB);
            PG8_BAR; PG8_WAIT_L(0); PG8_MMA(0, 1, At, B1); PG8_BAR;
            PG8_LDA(At, 1, 1);
            if constexpr (GATHER) PG8_STAGE2(PG8_SA(1, 0), a3, s00, s01); else PG8_STAGE(PG8_SA(1, 0), a3, voffA);
            PG8_BAR; PG8_WAIT_L(0); PG8_MMA(1, 0, At, B0); PG8_BAR; PG8_SCHED;
            PG8_STAGE(PG8_SB(1, 1), b3 + hstep, voffB);
            PG8_WAIT_V(6); PG8_BAR; PG8_MMA(1, 1, At, B1); PG8_BAR;
                    }
        }
        if (wr == 0) PG8_BAR;
        E(acc, cur, wr, wc, fr, fq);
        if (!has_next) break;
#pragma unroll
        for (int a = 0; a < 2; ++a)
#pragma unroll
            for (int b = 0; b < 2; ++b)
#pragma unroll
                for (int m = 0; m < 4; ++m)
#pragma unroll
                    for (int n = 0; n < 2; ++n) acc[a][b][m][n] = (f32x4){0.f, 0.f, 0.f, 0.f};
        cur = nxt; cA = nA; cB = nB; ++ui;
        if constexpr (GATHER) { c00 = n00; c01 = n01; c10 = n10; c11 = n11; }
        if (wr == 1) PG8_BAR;
    }
    PG8_WAIT_V(0);
    PG8_BAR;
#undef PG8_SA
#undef PG8_SB
#undef PG8_STAGE
#undef PG8_STAGE2
#undef PG8_LDA
#undef PG8_LDB
#undef PG8_MMA
#undef PG8_WAIT_V
#undef PG8_WAIT_L
#undef PG8_BAR
#undef PG8_SCHED
}
}

struct Params {
    const float* x; const int* pos; const float* norm1_g; const float* w_in; const float* conv_a_w; const float* a_log; const float* dt_bias; const float* gdn_norm_g;
    const float* conv_b_w; const float* conv_b_b; const float* ln_b_g; const float* ln_b_b; const float* pool_w; const float* pool_scale; const float* w_branch; const float* w_out;
    const float* norm2_g; const float* rg_w; const float* rg_b; const float* re_w; const float* re_b; const float* w_up; const float* w_down; const float* final_g;
    float* out; unsigned char* ws; int ph_lo, ph_hi, probe, pad;
};

struct Ctx { int tid, lane, wave, bid, G; LAS unsigned char* lds; };
constexpr int LDS_PTAB = LDS_MISC + 512;
__device__ __forceinline__ const void* lds_ptr_get(const LAS unsigned* tab, int i) {
    const unsigned lo = __builtin_amdgcn_readfirstlane(tab[2 * i]), hi = __builtin_amdgcn_readfirstlane(tab[2 * i + 1]);
    return (const void*)(((unsigned long long)hi << 32) | lo); }
__device__ __forceinline__ Params load_params(const Ctx& c, unsigned char* ws, int lo, int hi) {
    const LAS unsigned* tab = (const LAS unsigned*)(c.lds + LDS_PTAB); asm volatile("" : "+v"(tab));
    Params q;
    q.x = (const float*)lds_ptr_get(tab, 0); q.pos = (const int*)lds_ptr_get(tab, 1); q.norm1_g = (const float*)lds_ptr_get(tab, 2); q.w_in = (const float*)lds_ptr_get(tab, 3);
    q.conv_a_w = (const float*)lds_ptr_get(tab, 4); q.a_log = (const float*)lds_ptr_get(tab, 5); q.dt_bias = (const float*)lds_ptr_get(tab, 6); q.gdn_norm_g = (const float*)lds_ptr_get(tab, 7);
    q.conv_b_w = (const float*)lds_ptr_get(tab, 8); q.conv_b_b = (const float*)lds_ptr_get(tab, 9); q.ln_b_g = (const float*)lds_ptr_get(tab, 10); q.ln_b_b = (const float*)lds_ptr_get(tab, 11);
    q.pool_w = (const float*)lds_ptr_get(tab, 12); q.pool_scale = (const float*)lds_ptr_get(tab, 13); q.w_branch = (const float*)lds_ptr_get(tab, 14); q.w_out = (const float*)lds_ptr_get(tab, 15);
    q.norm2_g = (const float*)lds_ptr_get(tab, 16); q.rg_w = (const float*)lds_ptr_get(tab, 17); q.rg_b = (const float*)lds_ptr_get(tab, 18); q.re_w = (const float*)lds_ptr_get(tab, 19);
    q.re_b = (const float*)lds_ptr_get(tab, 20); q.w_up = (const float*)lds_ptr_get(tab, 21); q.w_down = (const float*)lds_ptr_get(tab, 22); q.final_g = (const float*)lds_ptr_get(tab, 23);
    q.out = (float*)lds_ptr_get(tab, 24); q.ws = ws; q.ph_lo = lo; q.ph_hi = hi; q.probe = -1; q.pad = 0; return q; }

__device__ __forceinline__ void cvt_tile(const Ctx& c, const float* __restrict__ src, size_t ld, int k0, int n0s, bf16_t* __restrict__ dst, int K, int n0d) {
    LAS float* tile = (LAS float*)c.lds;
    const int tid = c.tid;
#pragma unroll
    for (int rr = 0; rr < 2; ++rr) {
        const int r = (tid >> 4) + rr * 32, cc = (tid & 15) * 4;
        const float4 v = *(const float4*)(src + (size_t)(k0 + r) * ld + n0s + cc);
        tile[r * 65 + cc + 0] = v.x; tile[r * 65 + cc + 1] = v.y; tile[r * 65 + cc + 2] = v.z; tile[r * 65 + cc + 3] = v.w;
    }
    __syncthreads();
    {
        const int n = tid >> 3, ks = tid & 7;
        float f[8];
#pragma unroll
        for (int i = 0; i < 8; ++i) f[i] = tile[(ks * 8 + i) * 65 + n];
        u32x4 w; w.x = cvt_pk_bf16(f[0], f[1]); w.y = cvt_pk_bf16(f[2], f[3]); w.z = cvt_pk_bf16(f[4], f[5]); w.w = cvt_pk_bf16(f[6], f[7]);
        *(u32x4*)(dst + (size_t)(n0d + n) * K + k0 + ks * 8) = w;
    }
    __syncthreads();
}
struct CvtDesc { const float* src; bf16_t* dst; int ld, K; };
__device__ __forceinline__ CvtDesc cvt_desc(const Params& p, int idx) {
    constexpr int T1 = 10240, T2 = 1536, T3 = 1024, TL = T1 + T2 + T3;
    bf16_t* WinT = (bf16_t*)(p.ws + WS_WINT); bf16_t* WbrT = (bf16_t*)(p.ws + WS_WBRT); bf16_t* WoutT = (bf16_t*)(p.ws + WS_WOUTT);
    const int L = idx / TL; int r = idx % TL; CvtDesc d;
    if (r < T1) { const int kt = r % 32, ntile = r / 32, n0d = ntile * 64, n0s = n0d + (n0d >= 3072 ? 12 : 0);
        d.ld = NIN; d.K = D; d.src = p.w_in + (size_t)L * D * NIN + (size_t)(kt * 64) * NIN + n0s; d.dst = WinT + (size_t)L * NU * D + (size_t)n0d * D + kt * 64; return d; }
    r -= T1;
    if (r < T2) { const int kb = r / 384, rr = r % 384, kt = rr % 12, ntile = rr / 12;
        d.ld = D; d.K = 768; d.src = p.w_branch + (size_t)(L * 4 + kb) * 768 * D + (size_t)(kt * 64) * D + ntile * 64; d.dst = WbrT + (size_t)(L * 4 + kb) * D * 768 + (size_t)(ntile * 64) * 768 + kt * 64; return d; }
    r -= T2;
    { const int kt = r % 32, ntile = r / 32;
        d.ld = D; d.K = D; d.src = p.w_out + (size_t)L * D * D + (size_t)(kt * 64) * D + ntile * 64; d.dst = WoutT + (size_t)L * D * D + (size_t)(ntile * 64) * D + kt * 64; return d; }
}
__device__ __forceinline__ void phase_convert(const Ctx& c, const Params& p) {
    constexpr int TL = 10240 + 1536 + 1024;
    {
        const int tid = c.tid, r0 = tid >> 4, cc = (tid & 15) * 4;
        int idx = c.bid; float4 v0 = make_float4(0.f, 0.f, 0.f, 0.f), v1 = v0, m0 = v0, m1 = v0; CvtDesc cur, mid;
        if (idx < NL * TL) { cur = cvt_desc(p, idx); v0 = *(const float4*)(cur.src + (size_t)r0 * cur.ld + cc); v1 = *(const float4*)(cur.src + (size_t)(r0 + 32) * cur.ld + cc); mid = cur; }
        if (idx + c.G < NL * TL) { mid = cvt_desc(p, idx + c.G); m0 = *(const float4*)(mid.src + (size_t)r0 * mid.ld + cc); m1 = *(const float4*)(mid.src + (size_t)(r0 + 32) * mid.ld + cc); }
        int bsel = 0;
        while (idx < NL * TL) {
            const int n2 = idx + 2 * c.G; CvtDesc nxt = mid; float4 n0 = m0, n1 = m1;
            if (n2 < NL * TL) { nxt = cvt_desc(p, n2); n0 = *(const float4*)(nxt.src + (size_t)r0 * nxt.ld + cc); n1 = *(const float4*)(nxt.src + (size_t)(r0 + 32) * nxt.ld + cc); }
            LAS float* tile = (LAS float*)c.lds + bsel * (64 * 65 + 32);
            tile[r0 * 65 + cc + 0] = v0.x; tile[r0 * 65 + cc + 1] = v0.y; tile[r0 * 65 + cc + 2] = v0.z; tile[r0 * 65 + cc + 3] = v0.w;
            tile[(r0 + 32) * 65 + cc + 0] = v1.x; tile[(r0 + 32) * 65 + cc + 1] = v1.y; tile[(r0 + 32) * 65 + cc + 2] = v1.z; tile[(r0 + 32) * 65 + cc + 3] = v1.w;
            __syncthreads();
            { const int n = tid >> 3, ks = tid & 7; float f[8];
#pragma unroll
              for (int i = 0; i < 8; ++i) f[i] = tile[(ks * 8 + i) * 65 + n];
              u32x4 w; w.x = cvt_pk_bf16(f[0], f[1]); w.y = cvt_pk_bf16(f[2], f[3]); w.z = cvt_pk_bf16(f[4], f[5]); w.w = cvt_pk_bf16(f[6], f[7]);
              *(u32x4*)(cur.dst + (size_t)n * cur.K + ks * 8) = w; }
            idx += c.G; cur = mid; v0 = m0; v1 = m1; mid = nxt; m0 = n0; m1 = n1; bsel ^= 1;
        }
        __syncthreads();
    }
    {   float* WSM = (float*)(p.ws + WS_WSM);
        for (int i = c.bid * NTHREADS + c.tid; i < NL * 12 * 2048; i += c.G * NTHREADS) { const int k = i & 2047, j = (i >> 11) % 12, L = i / (12 * 2048);
            WSM[i] = p.w_in[((size_t)L * D + k) * NIN + 3072 + j]; }
    }
    {
        bf16_t* WRT = (bf16_t*)(p.ws + WS_WRT);
        for (int i = c.bid * NTHREADS + c.tid; i < NL * 80 * 2048; i += c.G * NTHREADS) { const int k = i & 2047, j = (i >> 11) % 80, L = i / (80 * 2048);
            const float w = j < 8 ? p.rg_w[((size_t)L * D + k) * 8 + j] : (j < 72 ? p.re_w[((size_t)L * D + k) * 64 + (j - 8)] : 0.f);
            const bf16_t hi = f2bf(w); WRT[((size_t)(L * 2 + 0) * 80 + j) * 2048 + k] = hi; WRT[((size_t)(L * 2 + 1) * 80 + j) * 2048 + k] = f2bf(w - bf2f(hi)); }
    }
    {
        bf16_t* PWT = (bf16_t*)(p.ws + WS_PWT);
        for (int i = c.bid * NTHREADS + c.tid; i < NL * 4 * 192 * 192; i += c.G * NTHREADS) { const int cc = i % 192, e = (i / 192) % 192, lg = i / (192 * 192);
            PWT[i] = f2bf(p.pool_w[(size_t)(lg * 192 + cc) * 192 + e] * p.pool_scale[lg * 192 + e]); }
    }
}

__device__ __forceinline__ void phase_norm1(const Ctx& c, const Params& p, int L) {
    LAS float* wsm = (LAS float*)c.lds;
    { const float4* src = (const float4*)((const float*)(p.ws + WS_WSM) + (size_t)L * 12 * 2048);
      for (int i = c.tid; i < 12 * 2048 / 4; i += NTHREADS) { const float4 v = src[i]; LAS float* d = wsm + 4 * i; d[0] = v.x; d[1] = v.y; d[2] = v.z; d[3] = v.w; } }
    __syncthreads();
    const float* g1 = p.norm1_g + L * D;
    bf16_t* H = (bf16_t*)(p.ws + WS_H); float* XA = (float*)(p.ws + WS_XA); const float* XB = (const float*)(p.ws + WS_XB); const bf16_t* Y = (const bf16_t*)(p.ws + WS_YMOE);
    float* BETA = (float*)(p.ws + WS_BETA); float* GLOG = (float*)(p.ws + WS_GLOG);
    for (int rt = c.bid; rt < T / 32; rt += c.G) {
        for (int i = 0; i < 4; ++i) {
            const int t = rt * 32 + c.wave * 4 + i;
            float4 xv[8]; float ss = 0.f;
#pragma unroll
            for (int q = 0; q < 8; ++q) {
                const int col = q * 256 + c.lane * 4;
                float4 v;
                if (L == 0) v = *(const float4*)(p.x + (size_t)t * D + col);
                else { const float4 a = *(const float4*)(XB + (size_t)t * D + col); const u32x2 y0 = *(const u32x2*)(Y + (size_t)(2 * t) * D + col), y1 = *(const u32x2*)(Y + (size_t)(2 * t + 1) * D + col);
                    v.x = a.x + (bflo(y0.x) + bflo(y1.x)); v.y = a.y + (bfhi(y0.x) + bfhi(y1.x)); v.z = a.z + (bflo(y0.y) + bflo(y1.y)); v.w = a.w + (bfhi(y0.y) + bfhi(y1.y));
                    *(float4*)(XA + (size_t)t * D + col) = v; }
                xv[q] = v; ss += v.x * v.x + v.y * v.y + v.z * v.z + v.w * v.w;
            }
            ss = wave_sum(ss, c.lane);
            const float rstd = rsqrtf(ss * (1.0f / D) + 1e-6f);
            float dots[12];
#pragma unroll
            for (int j = 0; j < 12; ++j) dots[j] = 0.f;
#pragma unroll
            for (int q = 0; q < 8; ++q) {
                const int col = q * 256 + c.lane * 4;
                const float4 g = *(const float4*)(g1 + col);
                float4 h; h.x = xv[q].x * rstd * g.x; h.y = xv[q].y * rstd * g.y; h.z = xv[q].z * rstd * g.z; h.w = xv[q].w * rstd * g.w;
                uint2 o; o.x = cvt_pk_bf16(h.x, h.y); o.y = cvt_pk_bf16(h.z, h.w);
                *(uint2*)(H + (size_t)t * D + col) = o;
#pragma unroll
                for (int j = 0; j < 12; ++j) { const LAS float* wp = wsm + j * 2048 + col; dots[j] += h.x * wp[0] + h.y * wp[1] + h.z * wp[2] + h.w * wp[3]; }
            }
#pragma unroll
            for (int j = 0; j < 12; ++j) dots[j] = wave_sum(dots[j], c.lane);
            if (c.lane < 6) {
                float db = dots[0], dd = dots[6];
#pragma unroll
                for (int j = 1; j < 6; ++j) { if (c.lane == j) { db = dots[j]; dd = dots[6 + j]; } }
                BETA[t * 8 + c.lane] = 1.0f / (1.0f + expf(-db));
                const float xx = dd + p.dt_bias[L * 6 + c.lane];
                const float sp = xx > 20.f ? xx : log1pf(expf(xx));
                GLOG[t * 8 + c.lane] = -expf(p.a_log[L * 6 + c.lane]) * sp;
            }
        }
    }
}

struct EpiU {
    static constexpr bool PERM = true;
    bf16_t* O;
    __device__ __forceinline__ void operator()(const f32x4 (&acc)[2][2][4][2], const pg8::Unit& u, int wr, int wc, int fr, int fq) const {
        const int row0 = u.pm * 256 + wr * 64 + fr, col0 = u.pn * 256 + wc * 32 + 8 * fq; const bool sig = u.pn >= 48;
#pragma unroll
        for (int ai = 0; ai < 2; ++ai)
#pragma unroll
            for (int m = 0; m < 4; ++m) { bf16_t* rowp = O + (size_t)(row0 + ai * 128 + m * 16) * NU + col0;
#pragma unroll
                for (int bj = 0; bj < 2; ++bj) { f32x4 v0 = acc[ai][bj][m][0], v1 = acc[ai][bj][m][1];
                    if (sig) {
#pragma unroll
                        for (int j = 0; j < 4; ++j) { v0[j] = sigmoidf_(v0[j]); v1[j] = sigmoidf_(v1[j]); } }
                    u32x4 w; w.x = cvt_pk_bf16(v0[0], v0[1]); w.y = cvt_pk_bf16(v0[2], v0[3]); w.z = cvt_pk_bf16(v1[0], v1[1]); w.w = cvt_pk_bf16(v1[2], v1[3]);
                    *(u32x4*)(rowp + bj * 128) = w; } }
    }
};
struct MergeOrder {
    int G, c;
    __device__ bool next(int i, pg8::Unit& u) const { const int tile = c + (i >> 2) * G; if (tile >= 256) return false; const int k = i & 3, x = tile & 7, y = tile >> 3;
        u.pm = k * 32 + x * 4 + (y >> 3); u.pn = k * 8 + (y & 7); return true; }
    __device__ __forceinline__ int arow(const pg8::Unit& u, int r) const { return u.pm * 256 + r; }
};
struct EpiMerge {
    static constexpr bool PERM = true;
    const bf16_t* U; float* M32; bf16_t* MG;
    __device__ __forceinline__ void operator()(const f32x4 (&acc)[2][2][4][2], const pg8::Unit& u, int wr, int wc, int fr, int fq) const {
        const int k = u.pm >> 5, tm = u.pm & 31, tn = u.pn & 7;
        const int row0 = tm * 256 + wr * 64 + fr, col0 = tn * 256 + wc * 32 + 8 * fq;
        bf16_t* const MP = (bf16_t*)M32;
#pragma unroll
        for (int ai = 0; ai < 2; ++ai)
#pragma unroll
            for (int mh = 0; mh < 2; ++mh) {
                u32x4 gv[2][2], pv[2][2];
#pragma unroll
                for (int mm = 0; mm < 2; ++mm)
#pragma unroll
                    for (int bj = 0; bj < 2; ++bj) { const size_t row = (size_t)(row0 + ai * 128 + (mh * 2 + mm) * 16); const int col = col0 + bj * 128;
                        gv[mm][bj] = *(const u32x4*)(U + row * NU + UC_G + k * D + col);
                        pv[mm][bj] = (k > 0) ? *(const u32x4*)(MP + row * D + col) : (u32x4){0u, 0u, 0u, 0u}; }
#pragma unroll
                for (int mm = 0; mm < 2; ++mm)
#pragma unroll
                    for (int bj = 0; bj < 2; ++bj) { const int m = mh * 2 + mm; const size_t row = (size_t)(row0 + ai * 128 + m * 16); const int col = col0 + bj * 128;
                        const u32x4 g = gv[mm][bj], pp = pv[mm][bj];
                        f32x4 v0 = acc[ai][bj][m][0], v1 = acc[ai][bj][m][1];
                        v0[0] = v0[0] * bflo(g.x) + bflo(pp.x); v0[1] = v0[1] * bfhi(g.x) + bfhi(pp.x); v0[2] = v0[2] * bflo(g.y) + bflo(pp.y); v0[3] = v0[3] * bfhi(g.y) + bfhi(pp.y);
                        v1[0] = v1[0] * bflo(g.z) + bflo(pp.z); v1[1] = v1[1] * bfhi(g.z) + bfhi(pp.z); v1[2] = v1[2] * bflo(g.w) + bflo(pp.w); v1[3] = v1[3] * bfhi(g.w) + bfhi(pp.w);
                        u32x4 w; w.x = cvt_pk_bf16(v0[0], v0[1]); w.y = cvt_pk_bf16(v0[2], v0[3]); w.z = cvt_pk_bf16(v1[0], v1[1]); w.w = cvt_pk_bf16(v1[2], v1[3]);
                        *(u32x4*)((k < 3 ? MP : MG) + row * D + col) = w; }
            }
    }
};
struct EpiRes {
    static constexpr bool PERM = false;
    const float* X; float* O;
    __device__ __forceinline__ void operator()(const f32x4 (&acc)[2][2][4][2], const pg8::Unit& u, int wr, int wc, int fr, int fq) const {
        const int row0 = u.pm * 256 + wr * 64 + fr, col0 = u.pn * 256 + wc * 32 + 4 * fq;
#pragma unroll
        for (int ai = 0; ai < 2; ++ai)
#pragma unroll
            for (int mh = 0; mh < 2; ++mh) {
                f32x4 xv[2][2][2];
#pragma unroll
                for (int mm = 0; mm < 2; ++mm)
#pragma unroll
                    for (int bj = 0; bj < 2; ++bj)
#pragma unroll
                        for (int n = 0; n < 2; ++n) xv[mm][bj][n] = *(const f32x4*)(X + (size_t)(row0 + ai * 128 + (mh * 2 + mm) * 16) * D + col0 + bj * 128 + n * 16);
#pragma unroll
                for (int mm = 0; mm < 2; ++mm)
#pragma unroll
                    for (int bj = 0; bj < 2; ++bj)
#pragma unroll
                        for (int n = 0; n < 2; ++n) *(f32x4*)(O + (size_t)(row0 + ai * 128 + (mh * 2 + mm) * 16) * D + col0 + bj * 128 + n * 16) = acc[ai][bj][mh * 2 + mm][n] + xv[mm][bj][n];
            }
    }
};
struct MoeTab { const LAS int* mt_e; const LAS int* mt_p0; const LAS int* cnt; const LAS int* ut; int nmt; };
struct MoeOrder {
    MoeTab tb; int nN, G, c; const int* tok;
    __device__ bool next(int i, pg8::Unit& u) const { const int v = (G % 8 == 0) ? (c % 8) * (G / 8) + c / 8 : c; const long L = (long)i * G + v; if (L >= (long)tb.nmt * nN) return false;
        const int e = tb.ut[L]; u.pm = e >> 4; u.pn = tb.mt_e[u.pm] * nN + (e & 15); return true; }
    __device__ __forceinline__ int arow(const pg8::Unit& u, int r) const { const int e = tb.mt_e[u.pm], pos = tb.mt_p0[u.pm] + r; return pos < tb.cnt[e] ? (tok[e * 8192 + pos] >> 1) : 0; }
};
struct EpiUp {
    bf16_t* HID;
    __device__ __forceinline__ void operator()(const f32x4 (&acc)[2][4][2], const pg8::Unit& u, int wr, int wc, int fr, int fq) const {
        const int j = u.pn & 3; const int row0 = u.pm * 128 + wr * 64 + fr, col0 = j * 128 + wc * 32 + 8 * fq;
#pragma unroll
        for (int m = 0; m < 4; ++m) { const f32x4 g0 = acc[0][m][0], g1 = acc[0][m][1], u0 = acc[1][m][0], u1 = acc[1][m][1];
            float h[8];
#pragma unroll
            for (int q = 0; q < 4; ++q) { h[q] = siluf_(g0[q]) * u0[q]; h[4 + q] = siluf_(g1[q]) * u1[q]; }
            u32x4 w; w.x = cvt_pk_bf16(h[0], h[1]); w.y = cvt_pk_bf16(h[2], h[3]); w.z = cvt_pk_bf16(h[4], h[5]); w.w = cvt_pk_bf16(h[6], h[7]);
            *(u32x4*)(HID + (size_t)(row0 + m * 16) * EH + col0) = w; }
    }
};
struct EpiDown {
    MoeTab tb; const int* tok; const float* wsl; bf16_t* Y;
    __device__ __forceinline__ void operator()(const f32x4 (&acc)[2][4][2], const pg8::Unit& u, int wr, int wc, int fr, int fq) const {
        const int e = tb.mt_e[u.pm], p0 = tb.mt_p0[u.pm], ne = tb.cnt[e]; const int col0 = (u.pn & 7) * 256 + wc * 32 + 8 * fq;
        int dst[4]; float w[4];
#pragma unroll
        for (int m = 0; m < 4; ++m) { const int pos = p0 + wr * 64 + fr + m * 16; const int pc = pos < ne ? pos : ne - 1;
            dst[m] = tok[e * 8192 + pc]; w[m] = wsl[e * 8192 + pc]; }
#pragma unroll
        for (int m = 0; m < 4; ++m) { const int pos = p0 + wr * 64 + fr + m * 16;
            if (pos < ne) { bf16_t* yp = Y + (size_t)dst[m] * D + col0; const float ww = w[m];
#pragma unroll
                for (int bj = 0; bj < 2; ++bj) { const f32x4 v0 = acc[bj][m][0] * ww, v1 = acc[bj][m][1] * ww;
                    u32x4 o; o.x = cvt_pk_bf16(v0[0], v0[1]); o.y = cvt_pk_bf16(v0[2], v0[3]); o.z = cvt_pk_bf16(v1[0], v1[1]); o.w = cvt_pk_bf16(v1[2], v1[3]);
                    *(u32x4*)(yp + bj * 128) = o; } } }
    }
};


__device__ __forceinline__ int invperm32(int a) { return a < 16 ? 8 * (a >> 2) + (a & 3) : 8 * ((a - 16) >> 2) + 4 + (a & 3); }
__device__ __forceinline__ bf16x8 pack_bf16x8(const f32x4& a, const f32x4& b) { u32x4 w; w.x = cvt_pk_bf16(a[0], a[1]); w.y = cvt_pk_bf16(a[2], a[3]); w.z = cvt_pk_bf16(b[0], b[1]); w.w = cvt_pk_bf16(b[2], b[3]); return __builtin_bit_cast(bf16x8, w); }
__device__ __forceinline__ void gdn_chunk_local(const Ctx& c, const Params& p, int L, int unit) {
    const int h = unit >> 7, n = unit & 127, t0 = n * 64, tid = c.tid, lane = c.lane;
    const bf16_t* U = (const bf16_t*)(p.ws + WS_U);
    LAS unsigned char* lds = c.lds;
    LAS float* vf = (LAS float*)lds;
    LAS bf16_t* qb = (LAS bf16_t*)(lds + 33280);
    LAS bf16_t* kb = (LAS bf16_t*)(lds + 50688);
    LAS float* Am = (LAS float*)(lds + 68096);
    LAS unsigned char* img = lds + 85504;
    LAS float* gcs = (LAS float*)(lds + 126464);
    const float* cw = p.conv_a_w + (size_t)L * 4 * 2304;
    LAS float* cwl = (LAS float*)(lds + LDS_OSTG);
    for (int i = tid; i < 3 * 4 * 32; i += NTHREADS) { const int c4 = i & 31, j = (i >> 5) & 3, sec = i >> 7;
        const float4 wv4 = *(const float4*)(cw + j * 2304 + sec * 768 + h * 128 + 4 * c4); LAS float* d = cwl + (sec * 4 + j) * 128 + 4 * c4; d[0] = wv4.x; d[1] = wv4.y; d[2] = wv4.z; d[3] = wv4.w; }
    if (tid < 64) {
        float g = ((const float*)(p.ws + WS_GLOG))[(t0 + tid) * 8 + h];
#pragma unroll
        for (int o = 1; o < 64; o <<= 1) { const float v = __int_as_float(__builtin_amdgcn_ds_bpermute(((lane - o) & 63) << 2, __float_as_int(g))); if (lane >= o) g += v; }
        gcs[tid] = g; gcs[64 + tid] = ((const float*)(p.ws + WS_BETA))[(t0 + tid) * 8 + h];
    }
    __syncthreads();
    {
        const int tok = tid >> 3, cg = tid & 7, t = t0 + tok;
        const float eg = __expf(gcs[tok]);
#pragma unroll
        for (int sec = 0; sec < 3; ++sec) {
            const int col = sec * 768 + h * 128 + 16 * cg;
            float a[16];
#pragma unroll
            for (int i = 0; i < 16; ++i) a[i] = 0.f;
            u32x4 xa[4], xb[4];
#pragma unroll
            for (int j = 0; j < 4; ++j) { const int tt = t - 3 + j, tc = tt < 0 ? 0 : tt;
                xa[j] = *(const u32x4*)(U + (size_t)tc * NU + UC_QKV + col); xb[j] = *(const u32x4*)(U + (size_t)tc * NU + UC_QKV + col + 8); }
#pragma unroll
            for (int j = 0; j < 4; ++j) { const float mk = (t - 3 + j) < 0 ? 0.f : 1.f; const u32x4 x0 = xa[j], x1 = xb[j];
                const LAS f32x4* wl = (const LAS f32x4*)(cwl + (sec * 4 + j) * 128 + 16 * cg); const f32x4 w0 = wl[0], w1 = wl[1], w2 = wl[2], w3 = wl[3];
                a[0] += mk * w0[0] * bflo(x0.x); a[1] += mk * w0[1] * bfhi(x0.x); a[2] += mk * w0[2] * bflo(x0.y); a[3] += mk * w0[3] * bfhi(x0.y);
                a[4] += mk * w1[0] * bflo(x0.z); a[5] += mk * w1[1] * bfhi(x0.z); a[6] += mk * w1[2] * bflo(x0.w); a[7] += mk * w1[3] * bfhi(x0.w);
                a[8] += mk * w2[0] * bflo(x1.x); a[9] += mk * w2[1] * bfhi(x1.x); a[10] += mk * w2[2] * bflo(x1.y); a[11] += mk * w2[3] * bfhi(x1.y);
                a[12] += mk * w3[0] * bflo(x1.z); a[13] += mk * w3[1] * bfhi(x1.z); a[14] += mk * w3[2] * bflo(x1.w); a[15] += mk * w3[3] * bfhi(x1.w); }
#pragma unroll
            for (int i = 0; i < 16; ++i) a[i] = siluf_(a[i]);
            if (sec < 2) {
                float sq = 0.f;
#pragma unroll
                for (int i = 0; i < 16; ++i) sq += a[i] * a[i];
                sq += shx(sq, 1, lane); sq += shx(sq, 2, lane); sq += shx(sq, 4, lane);
                const float rn = rsqrtf(sq + 1e-6f) * (sec == 0 ? 0.08838834764831845f : 1.0f);
#pragma unroll
                for (int i = 0; i < 16; ++i) a[i] *= rn;
                LAS bf16_t* dstb = (sec == 0 ? qb : kb) + tok * 136 + 16 * cg;
                u32x4 w;
                w.x = cvt_pk_bf16(a[0], a[1]); w.y = cvt_pk_bf16(a[2], a[3]); w.z = cvt_pk_bf16(a[4], a[5]); w.w = cvt_pk_bf16(a[6], a[7]); *(LAS u32x4*)dstb = w;
                w.x = cvt_pk_bf16(a[8], a[9]); w.y = cvt_pk_bf16(a[10], a[11]); w.z = cvt_pk_bf16(a[12], a[13]); w.w = cvt_pk_bf16(a[14], a[15]); *(LAS u32x4*)(dstb + 8) = w;
                if (sec == 0) {
#pragma unroll
                    for (int g4 = 0; g4 < 4; ++g4) { const int a0 = 16 * cg + 4 * g4, sl = a0 >> 5, pp = invperm32(a0 & 31), chunk = 4 * sl + (pp >> 3), within = pp & 7;
                        u32x2 o; o.x = cvt_pk_bf16(a[4 * g4] * eg, a[4 * g4 + 1] * eg); o.y = cvt_pk_bf16(a[4 * g4 + 2] * eg, a[4 * g4 + 3] * eg);
                        *(LAS u32x2*)(img + tok * 256 + ((chunk ^ (tok & 15)) << 4) + within * 2) = o; }
                }
            } else {
#pragma unroll
                for (int i = 0; i < 16; ++i) vf[tok * 129 + 16 * cg + i] = a[i];
            }
        }
    }
    __syncthreads();
    {
        const float gl = gcs[63];
#pragma unroll
        for (int it = 0; it < 2; ++it) { const int pc = tid + 512 * it, r = pc & 127, ch = pc >> 7, sp = ch >> 2, q = ch & 3; float v[8];
#pragma unroll
            for (int i = 0; i < 8; ++i) { const int cc = 32 * sp + (i < 4 ? 4 * q + i : 16 + 4 * q + (i - 4)); v[i] = bf2f(kb[cc * 136 + r]) * __expf(gl - gcs[cc]); }
            u32x4 w; w.x = cvt_pk_bf16(v[0], v[1]); w.y = cvt_pk_bf16(v[2], v[3]); w.z = cvt_pk_bf16(v[4], v[5]); w.w = cvt_pk_bf16(v[6], v[7]);
            *(LAS u32x4*)(img + 16384 + r * 128 + ((ch ^ ((r >> 1) & 7)) << 4)) = w; }
    }
    {
        const int m = lane & 15, q = lane >> 4;
        for (int i4 = 0; i4 < 4; ++i4) {
            const int id = c.wave * 4 + i4, which = id >> 4, tile = id & 15, mt = tile >> 2, ntl = tile & 3;
            f32x4 acc = (f32x4){0.f, 0.f, 0.f, 0.f};
            if (ntl <= mt) {
                const LAS bf16_t* Ab = which ? qb : kb;
#pragma unroll
                for (int s = 0; s < 4; ++s) { const bf16x8 av = *(const LAS bf16x8*)(Ab + (16 * mt + m) * 136 + 32 * s + 8 * q), bv = *(const LAS bf16x8*)(kb + (16 * ntl + m) * 136 + 32 * s + 8 * q);
                    acc = __builtin_amdgcn_mfma_f32_16x16x32_bf16(av, bv, acc, 0, 0, 0); }
            }
            const int j_ = 16 * ntl + m;
#pragma unroll
            for (int jj = 0; jj < 4; ++jj) { const int i_ = 16 * mt + 4 * q + jj;
                const float dec = (i_ >= j_) ? __expf(gcs[i_] - gcs[j_]) : 0.f;
                if (which == 0) { if (ntl <= mt) Am[j_ * 68 + i_] = (i_ > j_) ? gcs[64 + i_] * acc[jj] * dec : 0.f; }
                else { const int sp = j_ >> 5, pp = invperm32(j_ & 31), chunk = 4 * sp + (pp >> 3), within = pp & 7;
                    *(LAS bf16_t*)(img + 32768 + i_ * 128 + ((chunk ^ ((i_ >> 1) & 7)) << 4) + within * 2) = f2bf((i_ >= j_) ? acc[jj] * dec : 0.f); } }
        }
    }
    __syncthreads();
    float x[64];
    if (tid < 256) {
        if (tid < 128) {
#pragma unroll
            for (int r = 0; r < 64; ++r) x[r] = vf[r * 129 + tid] * gcs[64 + r];
        } else {
#pragma unroll
            for (int r = 0; r < 64; ++r) x[r] = bf2f(kb[r * 136 + (tid - 128)]) * gcs[64 + r] * __expf(gcs[r]);
        }
    }
    __syncthreads();
    if (tid < 256) {
        int zoff = 0; asm volatile("" : "+v"(zoff));
        const LAS float* Amz = Am + zoff;
#pragma unroll
        for (int j = 0; j < 63; ++j) {
            const float xj = x[j];
#pragma unroll
            for (int ib = (j + 1) / 4; ib < 16; ++ib) { const f32x4 a4 = *(const LAS f32x4*)(Amz + j * 68 + 4 * ib);
                if (4 * ib + 0 > j) x[4 * ib + 0] -= a4[0] * xj;
                if (4 * ib + 1 > j) x[4 * ib + 1] -= a4[1] * xj;
                if (4 * ib + 2 > j) x[4 * ib + 2] -= a4[2] * xj;
                if (4 * ib + 3 > j) x[4 * ib + 3] -= a4[3] * xj; }
        }
        if (tid < 128) {
            float* ucp = (float*)(p.ws + WS_UCP) + (size_t)unit * 8192 + (size_t)(tid >> 4) * 1024 + (tid & 15) * 4;
#pragma unroll
            for (int mt = 0; mt < 4; ++mt)
#pragma unroll
                for (int q = 0; q < 4; ++q) *(f32x4*)(ucp + mt * 256 + q * 64) = (f32x4){x[16 * mt + 4 * q], x[16 * mt + 4 * q + 1], x[16 * mt + 4 * q + 2], x[16 * mt + 4 * q + 3]};
        } else {
            const int kc = tid - 128, s = kc >> 5, pp = invperm32(kc & 31), chunk = 4 * s + (pp >> 3), within = pp & 7;
#pragma unroll
            for (int r = 0; r < 64; ++r) *(LAS bf16_t*)(lds + r * 256 + ((chunk ^ (r & 15)) << 4) + within * 2) = f2bf(-x[r]);
        }
    }
    __syncthreads();
    {
        unsigned char* dst = p.ws + WS_GBLK + (size_t)unit * GB_BYTES;
#pragma unroll
        for (int it = 0; it < 7; ++it) { const int pc = tid + 512 * it; const LAS unsigned char* src = pc < 1024 ? lds + pc * 16 : img + (pc - 1024) * 16;
            *(u32x4*)(dst + pc * 16) = *(const LAS u32x4*)src; }
        if (tid == 0) ((float*)(p.ws + WS_GL))[unit] = __expf(gcs[63]);
    }
    __syncthreads();
}


__device__ __forceinline__ void gdn_scan(const Ctx& c, const Params& p, int sidx) {
    const int h = sidx >> 1, half = sidx & 1;
    const unsigned char* blk = p.ws + WS_GBLK + (size_t)h * 128 * GB_BYTES;
    bf16_t* OG = (bf16_t*)(p.ws + WS_OGDN);
    LAS unsigned char* lds = c.lds;
    LAS unsigned char* ost = c.lds + LDS_OSTG;
    if (c.wave >= 4) {
        const int par = (c.wave - 4) >> 1, st = c.tid - 256 - 128 * par;
        const unsigned char* src = blk + (size_t)st * 16;
        u32x4 sr[28];
        if (par == 0) {
#pragma unroll
            for (int i = 0; i < 28; ++i) sr[i] = *(const u32x4*)(src + i * 2048);
#pragma unroll
            for (int i = 0; i < 28; ++i) *(LAS u32x4*)(lds + st * 16 + i * 2048) = sr[i];
#pragma unroll
            for (int i = 0; i < 28; ++i) sr[i] = *(const u32x4*)(src + 2 * (size_t)GB_BYTES + i * 2048);
        } else {
#pragma unroll
            for (int i = 0; i < 28; ++i) sr[i] = *(const u32x4*)(src + (size_t)GB_BYTES + i * 2048);
        }
        __syncthreads();
        for (int n = 0; n < 128; ++n) {
            if (((n + 1) & 1) == par) {
                if (n + 1 < 128) {
#pragma unroll
                    for (int i = 0; i < 28; ++i) *(LAS u32x4*)(lds + ((n + 1) & 1) * GB_BYTES + st * 16 + i * 2048) = sr[i];
                }
                if (n + 3 < 128) {
#pragma unroll
                    for (int i = 0; i < 28; ++i) sr[i] = *(const u32x4*)(src + (size_t)(n + 3) * GB_BYTES + i * 2048);
                }
            } else if (n > 0) {
#pragma unroll
                for (int i = 0; i < 4; ++i) { const int pc = st + 128 * i, r = pc >> 3, ch = pc & 7;
                    *(u32x4*)(OG + (size_t)((n - 1) * 64 + r) * 768 + h * 128 + 64 * half + 8 * ch) = *(const LAS u32x4*)(ost + ((n - 1) & 1) * 8192 + r * 128 + ch * 16); }
            }
            __syncthreads();
        }
        if (par == 0) {
#pragma unroll
            for (int i = 0; i < 4; ++i) { const int pc = st + 128 * i, r = pc >> 3, ch = pc & 7;
                *(u32x4*)(OG + (size_t)(127 * 64 + r) * 768 + h * 128 + 64 * half + 8 * ch) = *(const LAS u32x4*)(ost + 8192 + r * 128 + ch * 16); }
        }
        return;
    }
    const int wg = 4 * half + c.wave;
    const float* UCp = (const float*)(p.ws + WS_UCP) + (size_t)h * 128 * 8192 + (size_t)wg * 1024 + c.lane * 4;
    const float* GL = (const float*)(p.ws + WS_GL) + h * 128;
    const int lane = c.lane, m = lane & 15, q = lane >> 4;
    int o128[4], o64[2];
#pragma unroll
    for (int s = 0; s < 4; ++s) o128[s] = m * 256 + (((4 * s + q) ^ m) << 4);
#pragma unroll
    for (int s = 0; s < 2; ++s) o64[s] = m * 128 + (((4 * s + q) ^ (m >> 1)) << 4);
    f32x4 S[8];
#pragma unroll
    for (int i = 0; i < 8; ++i) S[i] = (f32x4){0.f, 0.f, 0.f, 0.f};
    f32x4 ucA[4], ucB[4]; float glA, glB;
#pragma unroll
    for (int mt = 0; mt < 4; ++mt) { ucA[mt] = *(const f32x4*)(UCp + mt * 256); ucB[mt] = *(const f32x4*)(UCp + 8192 + mt * 256); }
    glA = GL[0]; glB = GL[1];
    __syncthreads();
#define SCAN_LD(pp) (*(const LAS bf16x8*)(pp))
#define SCAN_STEP(NN, BUF, UC, GLV) do { \
        const LAS unsigned char* B = lds + (BUF) * GB_BYTES; \
        bf16x8 Sb[4]; \
        _Pragma("unroll") for (int s = 0; s < 4; ++s) Sb[s] = pack_bf16x8(S[2 * s], S[2 * s + 1]); \
        bf16x8 Aw[16], Aq[16]; \
        _Pragma("unroll") for (int mt = 0; mt < 4; ++mt) _Pragma("unroll") for (int s = 0; s < 4; ++s) Aw[mt * 4 + s] = SCAN_LD(B + GB_WC + mt * 4096 + o128[s]); \
        _Pragma("unroll") for (int mt = 0; mt < 4; ++mt) _Pragma("unroll") for (int s = 0; s < 4; ++s) Aq[mt * 4 + s] = SCAN_LD(B + GB_QD + mt * 4096 + o128[s]); \
        f32x4 vn[4]; \
        _Pragma("unroll") for (int mt = 0; mt < 4; ++mt) vn[mt] = UC[mt]; \
        _Pragma("unroll") for (int s = 0; s < 4; ++s) _Pragma("unroll") for (int mt = 0; mt < 4; ++mt) vn[mt] = __builtin_amdgcn_mfma_f32_16x16x32_bf16(Aw[mt * 4 + s], Sb[s], vn[mt], 0, 0, 0); \
        bf16x8 Ak[16]; \
        _Pragma("unroll") for (int i = 0; i < 8; ++i) _Pragma("unroll") for (int s = 0; s < 2; ++s) Ak[i * 2 + s] = SCAN_LD(B + GB_KDT + i * 2048 + o64[s]); \
        f32x4 Oa[4]; \
        _Pragma("unroll") for (int mt = 0; mt < 4; ++mt) Oa[mt] = (f32x4){0.f, 0.f, 0.f, 0.f}; \
        _Pragma("unroll") for (int s = 0; s < 4; ++s) _Pragma("unroll") for (int mt = 0; mt < 4; ++mt) Oa[mt] = __builtin_amdgcn_mfma_f32_16x16x32_bf16(Aq[mt * 4 + s], Sb[s], Oa[mt], 0, 0, 0); \
        bf16x8 Vb[2]; Vb[0] = pack_bf16x8(vn[0], vn[1]); Vb[1] = pack_bf16x8(vn[2], vn[3]); \
        bf16x8 Ap[8]; \
        _Pragma("unroll") for (int mt = 0; mt < 4; ++mt) _Pragma("unroll") for (int s = 0; s < 2; ++s) Ap[mt * 2 + s] = SCAN_LD(B + GB_QK + mt * 2048 + o64[s]); \
        _Pragma("unroll") for (int i = 0; i < 8; ++i) S[i] = S[i] * (GLV); \
        _Pragma("unroll") for (int s = 0; s < 2; ++s) _Pragma("unroll") for (int i = 0; i < 8; ++i) S[i] = __builtin_amdgcn_mfma_f32_16x16x32_bf16(Ak[i * 2 + s], Vb[s], S[i], 0, 0, 0); \
        _Pragma("unroll") for (int s = 0; s < 2; ++s) _Pragma("unroll") for (int mt = 0; mt < 4; ++mt) Oa[mt] = __builtin_amdgcn_mfma_f32_16x16x32_bf16(Ap[mt * 2 + s], Vb[s], Oa[mt], 0, 0, 0); \
        _Pragma("unroll") for (int mt = 0; mt < 4; ++mt) _Pragma("unroll") for (int jj = 0; jj < 4; ++jj) \
            *(LAS bf16_t*)(ost + (BUF) * 8192 + (16 * mt + 4 * q + jj) * 128 + (16 * c.wave + m) * 2) = f2bf(Oa[mt][jj]); \
    } while (0)
    for (int n = 0; n < 128; n += 2) {
        SCAN_STEP(n, 0, ucA, glA);
        if (n + 2 < 128) {
#pragma unroll
            for (int mt = 0; mt < 4; ++mt) ucA[mt] = *(const f32x4*)(UCp + (size_t)(n + 2) * 8192 + mt * 256);
            glA = GL[n + 2]; }
        __syncthreads();
        SCAN_STEP(n + 1, 1, ucB, glB);
        if (n + 3 < 128) {
#pragma unroll
            for (int mt = 0; mt < 4; ++mt) ucB[mt] = *(const f32x4*)(UCp + (size_t)(n + 3) * 8192 + mt * 256);
            glB = GL[n + 3]; }
        __syncthreads();
    }
#undef SCAN_STEP
#undef SCAN_LD
}


template <class Epi, bool UP>
__device__ __forceinline__ void moe_gemm(const Ctx& c, const bf16_t* A, const float* Wl, const MoeOrder& S, const Epi& E) {
    constexpr int K = UP ? D : EH, NW = UP ? 1024 : D, NSTEP = K / 64, STG = 49152;
    int tid = threadIdx.x; asm volatile("" : "+v"(tid));
    const int wid = __builtin_amdgcn_readfirstlane(tid >> 6), lane = tid & 63, wr = wid >> 2, wc = wid & 3, fr = lane & 15, fq = lane >> 4;
    LAS unsigned char* lds = c.lds;
    const int par = wid & 1, tp = lane + 64 * (wid >> 1);
    const int bk = tp >> 6, bc4 = tp & 63;
    const int ar = tp >> 3, ach = tp & 7;
    const unsigned a_rd0 = (unsigned)((64 * wr + fr) * 128 + (((0 + fq) ^ ((fr >> 1) & 7)) << 4)), a_rd1 = (unsigned)((64 * wr + fr) * 128 + (((4 + fq) ^ ((fr >> 1) & 7)) << 4));
    const unsigned q4 = (lane & 15) >> 2, p4 = lane & 3, qb = fq & 1;
    const unsigned b_base = 16384u + (8u * fq + q4) * 512u + 64u * ((unsigned)wc ^ q4) + 16u * p4;
    const unsigned b00 = b_base + 8u * qb, b01 = b_base + 8u * (1u - qb), b10 = b00 + 4u * 512u, b11 = b01 + 4u * 512u;
    pg8::Unit u;
    for (int ui = 0; S.next(ui, u); ++ui) {
        const int e = S.tb.mt_e[u.pm], j = u.pn - e * S.nN;
        const float* Wb = Wl + (size_t)e * K * NW + (UP ? ((bc4 < 32) ? 128 * j + 4 * bc4 : 512 + 128 * j + 4 * (bc4 - 32)) : 256 * j + 4 * bc4) + (size_t)bk * NW;
        const bf16_t* Ap[4];
#pragma unroll
        for (int i = 0; i < 4; ++i) { const int row = ar + 32 * i; Ap[i] = (UP ? A + (size_t)S.arow(u, row) * K : A + (size_t)(u.pm * 128 + row) * K) + 8 * (ach ^ ((row >> 1) & 7)); }
        f32x4 acc[2][4][2];
#pragma unroll
        for (int b = 0; b < 2; ++b)
#pragma unroll
            for (int m = 0; m < 4; ++m)
#pragma unroll
                for (int n = 0; n < 2; ++n) acc[b][m][n] = (f32x4){0.f, 0.f, 0.f, 0.f};
        f32x4 wv[16]; u32x4 av[4];
#define MOE_LOAD(T) do { _Pragma("unroll") for (int i = 0; i < 16; ++i) wv[i] = *(const f32x4*)(Wb + (size_t)((T) * 64 + 4 * i) * NW); \
        _Pragma("unroll") for (int i = 0; i < 4; ++i) av[i] = *(const u32x4*)(Ap[i] + (T) * 64); } while (0)
#define MOE_WRITE(T) do { LAS unsigned char* sb = lds + ((T) & 1) * STG; \
        _Pragma("unroll") for (int i = 0; i < 4; ++i) *(LAS u32x4*)(sb + (ar + 32 * i) * 128 + ach * 16) = av[i]; \
        _Pragma("unroll") for (int i = 0; i < 16; ++i) { const int kk = bk + 4 * i; u32x2 w2; w2.x = cvt_pk_bf16(wv[i][0], wv[i][1]); w2.y = cvt_pk_bf16(wv[i][2], wv[i][3]); \
            *(LAS u32x2*)(sb + 16384 + kk * 512 + ((8 * bc4) ^ ((((kk >> 3) & 1) << 3) | ((kk & 3) << 6)))) = w2; } } while (0)
        if (par == 0) { MOE_LOAD(0); MOE_WRITE(0); if (2 < NSTEP) MOE_LOAD(2); }
        else { if (1 < NSTEP) MOE_LOAD(1); }
        for (int t = 0; t < NSTEP; ++t) {
            __syncthreads();
            if (((t + 1) & 1) == par) { if (t + 1 < NSTEP) MOE_WRITE(t + 1); if (t + 3 < NSTEP) MOE_LOAD(t + 3); }
            const unsigned so = (unsigned)(t & 1) * STG;
#pragma unroll
            for (int s2 = 0; s2 < 2; ++s2) {
                bf16x8 Bf[2][2];
#pragma unroll
                for (int bj = 0; bj < 2; ++bj) { Bf[bj][0] = tr_pair(lds + so + b00 + 256 * bj + 16384 * s2, lds + so + b10 + 256 * bj + 16384 * s2);
                                                 Bf[bj][1] = tr_pair(lds + so + b01 + 256 * bj + 16384 * s2, lds + so + b11 + 256 * bj + 16384 * s2); }
                bf16x8 Af[4];
#pragma unroll
                for (int m = 0; m < 4; ++m) Af[m] = *(const LAS bf16x8*)(lds + so + (s2 ? a_rd1 : a_rd0) + m * 2048);
#pragma unroll
                for (int bj = 0; bj < 2; ++bj)
#pragma unroll
                    for (int m = 0; m < 4; ++m)
#pragma unroll
                        for (int n = 0; n < 2; ++n) acc[bj][m][n] = __builtin_amdgcn_mfma_f32_16x16x32_bf16(Bf[bj][n], Af[m], acc[bj][m][n], 0, 0, 0);
            }
        }
#undef MOE_LOAD
#undef MOE_WRITE
        E(acc, u, wr, wc, fr, fq);
        __syncthreads();
    }
}

__device__ __forceinline__ void phase_local(const Ctx& c, const Params& p, int L) {
    const bf16_t* U = (const bf16_t*)(p.ws + WS_U);
    const int gw = c.bid * 8 + c.wave, GW = c.G * 8, lane = c.lane;
    for (int rep = 0; rep < 1 + (p.pad == 1); ++rep)
    for (int unit = c.bid; unit < 768; unit += c.G) gdn_chunk_local(c, p, L, unit);
    for (int rep = 0; rep < 1 + (p.pad == 2); ++rep) {
        bf16_t* YB = (bf16_t*)(p.ws + WS_YBR) + (size_t)1 * T * 768;
        const float* cbw = p.conv_b_w + (size_t)L * 31 * 768; const float* cbb = p.conv_b_b + L * 768; const float* lg = p.ln_b_g + L * 768; const float* lb = p.ln_b_b + L * 768;
        LAS unsigned char* glu = c.lds;
        LAS unsigned char* cbs = c.lds + 70656;
        for (int tile = c.bid; tile < T / 16; tile += c.G) {
            const int t0 = tile * 16;
            for (int it = c.tid; it < 46 * 96; it += NTHREADS) { const int rr = it / 96, c8 = it - rr * 96, tt = t0 - 30 + rr; u32x4 w = (u32x4){0u, 0u, 0u, 0u};
                if (tt >= 0) { const u32x4 ga = *(const u32x4*)(U + (size_t)tt * NU + UC_B + 8 * c8), gb = *(const u32x4*)(U + (size_t)tt * NU + UC_B + 768 + 8 * c8);
                    w.x = cvt_pk_bf16(bflo(ga.x) * sigmoidf_(bflo(gb.x)), bfhi(ga.x) * sigmoidf_(bfhi(gb.x))); w.y = cvt_pk_bf16(bflo(ga.y) * sigmoidf_(bflo(gb.y)), bfhi(ga.y) * sigmoidf_(bfhi(gb.y)));
                    w.z = cvt_pk_bf16(bflo(ga.z) * sigmoidf_(bflo(gb.z)), bfhi(ga.z) * sigmoidf_(bfhi(gb.z))); w.w = cvt_pk_bf16(bflo(ga.w) * sigmoidf_(bflo(gb.w)), bfhi(ga.w) * sigmoidf_(bfhi(gb.w))); }
                *(LAS u32x4*)(glu + rr * 1536 + c8 * 16) = w; }
            __syncthreads();
            if (c.tid < 384) {
                float w0[31], w1[31], a0[16], a1[16];
#pragma unroll
                for (int j = 0; j < 31; ++j) { const float2 wv = *(const float2*)(cbw + j * 768 + 2 * c.tid); w0[j] = wv.x; w1[j] = wv.y; }
#pragma unroll
                for (int t = 0; t < 16; ++t) { a0[t] = 0.f; a1[t] = 0.f; }
#pragma unroll
                for (int rr = 0; rr < 46; ++rr) { const unsigned g2 = *(const LAS unsigned*)(glu + rr * 1536 + c.tid * 4); const float lo = bflo(g2), hi = bfhi(g2);
#pragma unroll
                    for (int t = 0; t < 16; ++t) { const int j = rr - t; if (j >= 0 && j <= 30) { a0[t] += w0[j] * lo; a1[t] += w1[j] * hi; } } }
                const float2 bv = *(const float2*)(cbb + 2 * c.tid);
#pragma unroll
                for (int t = 0; t < 16; ++t) *(LAS f32x2*)(cbs + t * 3072 + c.tid * 8) = (f32x2){a0[t] + bv.x, a1[t] + bv.y};
            }
            __syncthreads();
            for (int i = 0; i < 2; ++i) { const int tl = c.wave * 2 + i; f32x2 v[6]; float sm = 0.f;
#pragma unroll
                for (int k = 0; k < 6; ++k) { v[k] = *(const LAS f32x2*)(cbs + tl * 3072 + (lane + 64 * k) * 8); sm += v[k].x + v[k].y; }
                const float mu = wave_sum(sm, lane) * (1.0f / 768.f); float vs = 0.f;
#pragma unroll
                for (int k = 0; k < 6; ++k) { const float d0 = v[k].x - mu, d1 = v[k].y - mu; vs += d0 * d0 + d1 * d1; }
                const float rs = rsqrtf(wave_sum(vs, lane) * (1.0f / 768.f) + 1e-5f);
#pragma unroll
                for (int k = 0; k < 6; ++k) { const int ch = 2 * (lane + 64 * k); const float2 gg = *(const float2*)(lg + ch), bb = *(const float2*)(lb + ch);
                    const float y0 = (v[k].x - mu) * rs * gg.x + bb.x, y1 = (v[k].y - mu) * rs * gg.y + bb.y;
                    *(unsigned*)(YB + (size_t)(t0 + tl) * 768 + ch) = cvt_pk_bf16(siluf_(y0), siluf_(y1)); } }
            __syncthreads();
        }
    }
    for (int rep = 0; rep < 1 + (p.pad == 3); ++rep) {
        bf16_t* QR = (bf16_t*)(p.ws + WS_QR); bf16_t* KR = (bf16_t*)(p.ws + WS_KR);
        for (int it = c.bid * NTHREADS + c.tid; it < T * 8; it += c.G * NTHREADS) {
            const int t = it >> 3, c8 = it & 7; const float ps = (float)p.pos[t]; float cs[8], sn[8];
#pragma unroll
            for (int i = 0; i < 8; ++i) {
                double rev = (double)ps * (double)ROPE_INV[8 * c8 + i] * 0.15915494309189535; rev -= floor(rev);
                const float fr = (float)rev; cs[i] = __builtin_amdgcn_cosf(fr); sn[i] = __builtin_amdgcn_sinf(fr); }
            for (int hb = 0; hb < 36; hb += 4) {
                u32x4 x1[4], x2[4];
#pragma unroll
                for (int j = 0; j < 4; ++j) { const int hv = hb + j, isk = hv >= 18, hh = hv - 18 * isk; const bf16_t* src = U + (size_t)t * NU + UC_C + isk * 2304 + hh * 128 + 8 * c8;
                    x1[j] = *(const u32x4*)src; x2[j] = *(const u32x4*)(src + 64); }
#pragma unroll
                for (int j = 0; j < 4; ++j) { const int hv = hb + j, isk = hv >= 18, hh = hv - 18 * isk; const float sc = isk ? 1.0f : 0.08838834764831845f;
                    float a[8], b[8];
                    a[0] = bflo(x1[j].x); a[1] = bfhi(x1[j].x); a[2] = bflo(x1[j].y); a[3] = bfhi(x1[j].y); a[4] = bflo(x1[j].z); a[5] = bfhi(x1[j].z); a[6] = bflo(x1[j].w); a[7] = bfhi(x1[j].w);
                    b[0] = bflo(x2[j].x); b[1] = bfhi(x2[j].x); b[2] = bflo(x2[j].y); b[3] = bfhi(x2[j].y); b[4] = bflo(x2[j].z); b[5] = bfhi(x2[j].z); b[6] = bflo(x2[j].w); b[7] = bfhi(x2[j].w);
                    float o1[8], o2[8];
#pragma unroll
                    for (int i = 0; i < 8; ++i) { o1[i] = (a[i] * cs[i] - b[i] * sn[i]) * sc; o2[i] = (b[i] * cs[i] + a[i] * sn[i]) * sc; }
                    bf16_t* dst = (isk ? KR : QR) + (size_t)t * 2304 + hh * 128 + 8 * c8;
                    u32x4 w1, w2; w1.x = cvt_pk_bf16(o1[0], o1[1]); w1.y = cvt_pk_bf16(o1[2], o1[3]); w1.z = cvt_pk_bf16(o1[4], o1[5]); w1.w = cvt_pk_bf16(o1[6], o1[7]);
                    w2.x = cvt_pk_bf16(o2[0], o2[1]); w2.y = cvt_pk_bf16(o2[2], o2[3]); w2.z = cvt_pk_bf16(o2[4], o2[5]); w2.w = cvt_pk_bf16(o2[6], o2[7]);
                    *(u32x4*)dst = w1; *(u32x4*)(dst + 64) = w2; }
            }
        }
    }
    for (int rep = 0; rep < 1 + (p.pad == 4); ++rep) {
        bf16_t* YD = (bf16_t*)(p.ws + WS_YBR) + (size_t)3 * T * 768;
        const bf16_t* PWT = (const bf16_t*)(p.ws + WS_PWT) + (size_t)L * 4 * 192 * 192;
        LAS unsigned char* pim = c.lds;
        const int m = lane & 15, q = lane >> 4;
        for (int tile = c.bid; tile < T / 32; tile += c.G) {
            const int t0 = tile * 32;
            for (int it = c.tid; it < 32 * 96; it += NTHREADS) { const int rr = it / 96, c8 = it - rr * 96, t = t0 + rr, g = c8 / 24, w = 2 << g, cnt = (t + 1) < w ? (t + 1) : w;
                float sacc[8];
#pragma unroll
                for (int i = 0; i < 8; ++i) sacc[i] = 0.f;
                const bf16_t* up = U + (size_t)t * NU + UC_D + 8 * c8; u32x4 x0 = (u32x4){0u, 0u, 0u, 0u};
#pragma unroll
                for (int d = 0; d < 16; ++d) { if (d >= cnt) break; const u32x4 xv = *(const u32x4*)(up - (size_t)d * NU); if (d == 0) x0 = xv;
                    sacc[0] += bflo(xv.x); sacc[1] += bfhi(xv.x); sacc[2] += bflo(xv.y); sacc[3] += bfhi(xv.y); sacc[4] += bflo(xv.z); sacc[5] += bfhi(xv.z); sacc[6] += bflo(xv.w); sacc[7] += bfhi(xv.w); }
                const float ic = 1.0f / (float)cnt; u32x4 o;
                o.x = cvt_pk_bf16(sacc[0] * ic - bflo(x0.x), sacc[1] * ic - bfhi(x0.x)); o.y = cvt_pk_bf16(sacc[2] * ic - bflo(x0.y), sacc[3] * ic - bfhi(x0.y));
                o.z = cvt_pk_bf16(sacc[4] * ic - bflo(x0.z), sacc[5] * ic - bfhi(x0.z)); o.w = cvt_pk_bf16(sacc[6] * ic - bflo(x0.w), sacc[7] * ic - bfhi(x0.w));
                *(LAS u32x4*)(pim + rr * 1536 + ((c8 ^ (rr & 15)) << 4)) = o; }
            __syncthreads();
            f32x4 pa0[6], pa1[6];
#pragma unroll
            for (int pr = 0; pr < 6; ++pr) { const int pair = c.wave * 6 + pr, g = pair / 12, ntl = pair - g * 12;
                f32x4 acc0 = (f32x4){0.f, 0.f, 0.f, 0.f}, acc1 = (f32x4){0.f, 0.f, 0.f, 0.f};
                const bf16_t* bp = PWT + (size_t)(g * 192 + 16 * ntl + m) * 192 + 8 * q;
#pragma unroll
                for (int s6 = 0; s6 < 6; ++s6) { const bf16x8 bv = *(const bf16x8*)(bp + 32 * s6); const int ch = g * 24 + 4 * s6 + q;
                    const bf16x8 a0v = *(const LAS bf16x8*)(pim + m * 1536 + ((ch ^ m) << 4)), a1v = *(const LAS bf16x8*)(pim + (16 + m) * 1536 + ((ch ^ m) << 4));
                    acc0 = __builtin_amdgcn_mfma_f32_16x16x32_bf16(a0v, bv, acc0, 0, 0, 0); acc1 = __builtin_amdgcn_mfma_f32_16x16x32_bf16(a1v, bv, acc1, 0, 0, 0); }
                pa0[pr] = acc0; pa1[pr] = acc1; }
#pragma unroll
            for (int pr = 0; pr < 6; ++pr) { const int pair = c.wave * 6 + pr, g = pair / 12, ntl = pair - g * 12;
                bf16_t* yp = YD + (size_t)(t0 + 4 * q) * 768 + g * 192 + 16 * ntl + m;
#pragma unroll
                for (int jj = 0; jj < 4; ++jj) { yp[(size_t)jj * 768] = f2bf(pa0[pr][jj]); yp[(size_t)(16 + jj) * 768] = f2bf(pa1[pr][jj]); } }
            __syncthreads();
        }
    }
}

__device__ __forceinline__ unsigned off_b(unsigned row, unsigned ch) { return 256u * row + 16u * (ch ^ (((row & 3) << 2) | ((row >> 2) & 3))); }
#define ATT_PV4(OFF, A, DT0) do { \
    _Pragma("unroll") for (int i4 = 0; i4 < 4; ++i4) { \
        const bf16x8 vt = tr_pair(Vs + (vb0 + 32u * (unsigned)(((DT0) + i4) ^ cm0) + (OFF)), Vs + (vb1 + 32u * (unsigned)(((DT0) + i4) ^ cm1) + (OFF))); \
        O[(DT0) + i4] = __builtin_amdgcn_mfma_f32_16x16x32_bf16(vt, Pb[A], O[(DT0) + i4], 0, 0, 0); } } while (0)
#define ATT_PV(OFF, A) do { ATT_PV4(OFF, A, 0); ATT_PV4(OFF, A, 4); } while (0)
struct AttnRegs { u32x4 kv[8], vv[8]; bf16x8 Qb[4]; };
__device__ __forceinline__ void attn_issue_k(const Ctx& c, const Params& p, int u, AttnRegs& r) {
    const int h = u % 6, rbi = (u / 6) & 63, g = u / 384;
    const int dl = g == 0 ? 1 : (g == 1 ? 4 : 16), nb = 64 / dl, rs = rbi / nb, b = rbi % nb, gh = g * 6 + h;
    const bf16_t* KR = (const bf16_t*)(p.ws + WS_KR);
#pragma unroll
    for (int it = 0; it < 8; ++it) { const int pc = c.tid + 512 * it, j = pc >> 4, ch = pc & 15, pos = 128 * (b - 1) + j;
        r.kv[it] = (u32x4){0u, 0u, 0u, 0u};
        if (pos >= 0) { const size_t t = (size_t)pos * dl + rs; r.kv[it] = *(const u32x4*)(KR + t * 2304 + gh * 128 + 8 * ch); } }
}
__device__ __forceinline__ void attn_issue_vq(const Ctx& c, const Params& p, int u, AttnRegs& r) {
    const int h = u % 6, rbi = (u / 6) & 63, g = u / 384;
    const int dl = g == 0 ? 1 : (g == 1 ? 4 : 16), nb = 64 / dl, rs = rbi / nb, b = rbi % nb, gh = g * 6 + h;
    const bf16_t* U = (const bf16_t*)(p.ws + WS_U); const bf16_t* QR = (const bf16_t*)(p.ws + WS_QR);
    const int lane = c.lane, n = lane & 15, qd = lane >> 4;
#pragma unroll
    for (int it = 0; it < 8; ++it) { const int pc = c.tid + 512 * it, j = pc >> 4, ch = pc & 15, pos = 128 * (b - 1) + j;
        r.vv[it] = (u32x4){0u, 0u, 0u, 0u};
        if (pos >= 0) { const size_t t = (size_t)pos * dl + rs; r.vv[it] = *(const u32x4*)(U + t * NU + UC_C + 4608 + gh * 128 + 8 * ch); } }
    const int iq = 16 * c.wave + n; const size_t tq = (size_t)(128 * b + iq) * dl + rs;
#pragma unroll
    for (int s = 0; s < 4; ++s) r.Qb[s] = *(const bf16x8*)(QR + tq * 2304 + gh * 128 + 32 * s + 8 * qd);
}
__device__ __forceinline__ void attn_stage(const Ctx& c, const AttnRegs& r) {
    LAS unsigned char* Ks = c.lds; LAS unsigned char* Vs = c.lds + 65536;
#pragma unroll
    for (int it = 0; it < 8; ++it) { const int pc = c.tid + 512 * it, j = pc >> 4, ch = pc & 15;
        *(LAS u32x4*)(Ks + off_b(j, ch)) = r.kv[it]; *(LAS u32x4*)(Vs + off_b((j & ~31) + invperm32(j & 31), ch)) = r.vv[it]; }
}
__device__ __forceinline__ void attn_compute(const Ctx& c, const Params& p, int u, AttnRegs& ar, int un) {
    const int h = u % 6, rbi = (u / 6) & 63, g = u / 384;
    const int dl = g == 0 ? 1 : (g == 1 ? 4 : 16), nb = 64 / dl, r = rbi / nb, b = rbi % nb;
    LAS unsigned char* Ks = c.lds; LAS unsigned char* Vs = c.lds + 65536;
    const int lane = c.lane, n = lane & 15, qd = lane >> 4;
    const int iq = 16 * c.wave + n;
    const size_t tq = (size_t)(128 * b + iq) * dl + r;
    const int f = c.wave & ~1;
    f32x4 S[10];
    {
        const unsigned mask = ((n & 3) << 2) | ((n >> 2) & 3);
        unsigned ka[4];
#pragma unroll
        for (int s = 0; s < 4; ++s) ka[s] = 256u * n + 16u * ((4 * s + qd) ^ mask) + (unsigned)f * 4096u;
#pragma unroll
        for (int jj = 0; jj < 10; ++jj) { f32x4 acc = (f32x4){0.f, 0.f, 0.f, 0.f};
#pragma unroll
            for (int s = 0; s < 4; ++s) acc = __builtin_amdgcn_mfma_f32_16x16x32_bf16(*(const LAS bf16x8*)(Ks + ka[s] + jj * 4096), ar.Qb[s], acc, 0, 0, 0);
            S[jj] = acc; }
    }
    float mx = -INFINITY;
#pragma unroll
    for (int jj = 0; jj < 10; ++jj)
#pragma unroll
        for (int e = 0; e < 4; ++e) { const int j = 16 * (f + jj) + 4 * qd + e; const bool ok = (j >= iq) && (j <= iq + 128) && (b > 0 || j >= 128);
            S[jj][e] = ok ? S[jj][e] : -INFINITY; mx = fmaxf(mx, S[jj][e]); }
    mx = fmaxf(mx, shx(mx, 16, lane)); mx = fmaxf(mx, shx(mx, 32, lane));
    float l = 0.f;
#pragma unroll
    for (int jj = 0; jj < 10; ++jj)
#pragma unroll
        for (int e = 0; e < 4; ++e) { const float pv = __expf(S[jj][e] - mx); S[jj][e] = pv; l += pv; }
    l += shx(l, 16, lane); l += shx(l, 32, lane);
    bf16x8 Pb[5];
#pragma unroll
    for (int a = 0; a < 5; ++a) Pb[a] = pack_bf16x8(S[2 * a], S[2 * a + 1]);
    if (un < 1152) attn_issue_vq(c, p, un, ar);
    f32x4 O[8];
#pragma unroll
    for (int dt = 0; dt < 8; ++dt) O[dt] = (f32x4){0.f, 0.f, 0.f, 0.f};
    {
        const unsigned q = (lane & 15) >> 2, pp = lane & 3;
        const unsigned m0 = (q << 2) | ((2 * qd + 0) & 3), m1 = (q << 2) | ((2 * qd + 1) & 3);
        const unsigned cm0 = m0 >> 1, cm1 = m1 >> 1;
        const unsigned vbase = (unsigned)(f >> 1) * 8192u + 8u * (pp & 1);
        const unsigned vb0 = vbase + 256u * (8 * qd + 0 + q) + 16u * ((pp >> 1) ^ (m0 & 1)), vb1 = vbase + 256u * (8 * qd + 4 + q) + 16u * ((pp >> 1) ^ (m1 & 1));
        ATT_PV(0, 0); ATT_PV(8192, 1); ATT_PV(16384, 2); ATT_PV(24576, 3); ATT_PV(32768, 4);
    }
    {
        const float il = 1.0f / l;
        bf16_t* op = (bf16_t*)(p.ws + WS_ATTO) + ((size_t)g * T + tq) * 768 + h * 128 + 4 * qd;
#pragma unroll
        for (int dt = 0; dt < 8; ++dt) { u32x2 w; w.x = cvt_pk_bf16(O[dt][0] * il, O[dt][1] * il); w.y = cvt_pk_bf16(O[dt][2] * il, O[dt][3] * il); *(u32x2*)(op + 16 * dt) = w; }
        if (qd == 0) ((float*)(p.ws + WS_LSE))[((size_t)g * T + tq) * 8 + h] = mx + logf(l);
    }
}

struct GateOrder {
    int Gn, j;
    __device__ bool next(int i, pg8::Unit& u) const { const int id = i * Gn + j; if (id >= 1024) return false; u.pm = id & 31; u.pn = 48 + (id >> 5); return true; }
    __device__ __forceinline__ int arow(const pg8::Unit& u, int r) const { return u.pm * 256 + r; }
};
__device__ __forceinline__ void phase_attn_gdn(const Ctx& c, const Params& p, int L) {
    const bf16_t* U = (const bf16_t*)(p.ws + WS_U);
    const int lane = c.lane;
    const int nrec = (c.G >= 24) ? 12 : 0;
    if (nrec) { if (c.bid < nrec) { gdn_scan(c, p, c.bid);
            return; } }
    else { for (int h = c.bid; h < 12; h += c.G) gdn_scan(c, p, h); }
    {
        const int Gn = c.G - nrec, j = c.bid - nrec, heavy = (Gn > 0 && Gn < 1024) ? (1024 % Gn) : 0, na = Gn - heavy;
        for (int rep = 0; rep < 1 + (p.pad == 5); ++rep) {
            int u = 1152, us = 1;
            if (na > 0) { if (j >= heavy) { u = j - heavy; us = na; } } else { u = j; us = Gn; }
            AttnRegs ar;
            if (u < 1152) { attn_issue_k(c, p, u, ar); attn_issue_vq(c, p, u, ar); }
            while (u < 1152) {
                attn_stage(c, ar);
                __syncthreads();
                const int un = u + us;
                if (un < 1152) attn_issue_k(c, p, un, ar);
                attn_compute(c, p, u, ar, un);
                __syncthreads();
                u = un;
            }
        }
    }
    for (int rep = 0; rep < 1 + (p.pad == 6); ++rep) {
        pg8::Gemm g{(const bf16_t*)(p.ws + WS_H), (const bf16_t*)(p.ws + WS_WINT) + (size_t)L * NU * D, D}; GateOrder S{c.G - nrec, c.bid - nrec};
        EpiU E{(bf16_t*)(p.ws + WS_U)}; pg8::gemm_phase<EpiU, GateOrder, false>(c.lds, g, S, E);
    }
}

__device__ __forceinline__ void phase_combine(const Ctx& c, const Params& p, int L) {
    const bf16_t* U = (const bf16_t*)(p.ws + WS_U); const bf16_t* AO = (const bf16_t*)(p.ws + WS_ATTO); const float* LSE = (const float*)(p.ws + WS_LSE);
    const bf16_t* OG = (const bf16_t*)(p.ws + WS_OGDN); bf16_t* YA = (bf16_t*)(p.ws + WS_YBR); bf16_t* YC = YA + (size_t)2 * T * 768;
    const float* gn = p.gdn_norm_g + L * 128; const int lane = c.lane;
    for (int it0 = (c.bid * 8 + c.wave) * 4; it0 < T * 6; it0 += c.G * 8 * 4) {
        float l0[4], l1[4], l2[4]; unsigned a0[4], a1[4], a2[4], z2[4]; float2 og[4]; size_t o[4];
#pragma unroll
        for (int i = 0; i < 4; ++i) { const int it = it0 + i, t = it / 6, h = it % 6; o[i] = (size_t)t * 768 + h * 128 + 2 * lane;
            l0[i] = LSE[(size_t)t * 8 + h]; l1[i] = LSE[((size_t)T + t) * 8 + h]; l2[i] = LSE[((size_t)2 * T + t) * 8 + h];
            a0[i] = *(const unsigned*)(AO + o[i]); a1[i] = *(const unsigned*)(AO + (size_t)T * 768 + o[i]); a2[i] = *(const unsigned*)(AO + (size_t)2 * T * 768 + o[i]);
            { const unsigned ow = *(const unsigned*)(OG + o[i]); og[i] = make_float2(bflo(ow), bfhi(ow)); } z2[i] = *(const unsigned*)(U + (size_t)t * NU + UC_Z + h * 128 + 2 * lane); }
#pragma unroll
        for (int i = 0; i < 4; ++i) {
            const float mx = fmaxf(l0[i], fmaxf(l1[i], l2[i])); const float e0 = __expf(l0[i] - mx), e1 = __expf(l1[i] - mx), e2 = __expf(l2[i] - mx); const float is = 1.0f / (e0 + e1 + e2);
            *(unsigned*)(YC + o[i]) = cvt_pk_bf16((e0 * bflo(a0[i]) + e1 * bflo(a1[i]) + e2 * bflo(a2[i])) * is, (e0 * bfhi(a0[i]) + e1 * bfhi(a1[i]) + e2 * bfhi(a2[i])) * is);
            const float ss = wave_sum(og[i].x * og[i].x + og[i].y * og[i].y, lane); const float r = rsqrtf(ss * (1.0f / 128.f) + 1e-6f);
            *(unsigned*)(YA + o[i]) = cvt_pk_bf16(og[i].x * r * gn[2 * lane] * siluf_(bflo(z2[i])), og[i].y * r * gn[2 * lane + 1] * siluf_(bfhi(z2[i]))); }
    }
}

__device__ __forceinline__ void phase_norm2_router(const Ctx& c, const Params& p, int L) {
    const float* XB = (const float*)(p.ws + WS_XB); bf16_t* H = (bf16_t*)(p.ws + WS_H); const float* g2 = p.norm2_g + L * D;
    const bf16_t* WH = (const bf16_t*)(p.ws + WS_WRT) + (size_t)L * 2 * 80 * 2048; const bf16_t* WL = WH + 80 * 2048;
    unsigned* cnt = (unsigned*)(p.ws + WS_CTL + CTL_CNT) + L * 64; int* TOK = (int*)(p.ws + WS_TOK); float* WTS = (float*)(p.ws + WS_WSL);
    LAS float* lgp = (LAS float*)c.lds;
    LAS float* ssp = (LAS float*)c.lds + 2 * 4 * 16 * 80;
    const int lane = c.lane, m = lane & 15, q = lane >> 4, tl = c.wave >> 2, kq = c.wave & 3;
    for (int tp = c.bid; tp < T / 32; tp += c.G) {
        const int task = tp * 2 + tl;
        const int t = task * 16 + m; const float* xr = XB + (size_t)t * D + 512 * kq + 8 * q; const float* gr = g2 + 512 * kq + 8 * q;
        float ss = 0.f;
#pragma unroll 8
        for (int s = 0; s < 16; ++s) { const float4 a = *(const float4*)(xr + 32 * s), b = *(const float4*)(xr + 32 * s + 4);
            ss += a.x * a.x + a.y * a.y + a.z * a.z + a.w * a.w + b.x * b.x + b.y * b.y + b.z * b.z + b.w * b.w; }
        ss += shx(ss, 16, lane); ss += shx(ss, 32, lane);
        if (q == 0) ssp[(tl * 4 + kq) * 16 + m] = ss;
        __syncthreads();
        ss = ssp[(tl * 4 + 0) * 16 + m] + ssp[(tl * 4 + 1) * 16 + m] + ssp[(tl * 4 + 2) * 16 + m] + ssp[(tl * 4 + 3) * 16 + m];
        const float rstd = rsqrtf(ss * (1.0f / D) + 1e-6f);
        f32x4 acc[5];
#pragma unroll
        for (int nt = 0; nt < 5; ++nt) acc[nt] = (f32x4){0.f, 0.f, 0.f, 0.f};
        float4 na = *(const float4*)(xr), nb = *(const float4*)(xr + 4), nga = *(const float4*)(gr), ngb = *(const float4*)(gr + 4);
        bf16x8 nbh[5], nbl[5];
#pragma unroll
        for (int nt = 0; nt < 5; ++nt) { const size_t wo = (size_t)(16 * nt + m) * 2048 + 512 * kq + 8 * q; nbh[nt] = *(const bf16x8*)(WH + wo); nbl[nt] = *(const bf16x8*)(WL + wo); }
        for (int s = 0; s < 16; ++s) {
            const float4 a = na, b = nb, ga = nga, gb = ngb; bf16x8 bh[5], bl[5];
#pragma unroll
            for (int nt = 0; nt < 5; ++nt) { bh[nt] = nbh[nt]; bl[nt] = nbl[nt]; }
            if (s + 1 < 16) { const int s1 = s + 1;
                na = *(const float4*)(xr + 32 * s1); nb = *(const float4*)(xr + 32 * s1 + 4); nga = *(const float4*)(gr + 32 * s1); ngb = *(const float4*)(gr + 32 * s1 + 4);
#pragma unroll
                for (int nt = 0; nt < 5; ++nt) { const size_t wo = (size_t)(16 * nt + m) * 2048 + 512 * kq + 32 * s1 + 8 * q; nbh[nt] = *(const bf16x8*)(WH + wo); nbl[nt] = *(const bf16x8*)(WL + wo); } }
            float h[8]; h[0] = a.x * rstd * ga.x; h[1] = a.y * rstd * ga.y; h[2] = a.z * rstd * ga.z; h[3] = a.w * rstd * ga.w; h[4] = b.x * rstd * gb.x; h[5] = b.y * rstd * gb.y; h[6] = b.z * rstd * gb.z; h[7] = b.w * rstd * gb.w;
            u32x4 hi; hi.x = cvt_pk_bf16(h[0], h[1]); hi.y = cvt_pk_bf16(h[2], h[3]); hi.z = cvt_pk_bf16(h[4], h[5]); hi.w = cvt_pk_bf16(h[6], h[7]);
            u32x4 lo; lo.x = cvt_pk_bf16(h[0] - bflo(hi.x), h[1] - bfhi(hi.x)); lo.y = cvt_pk_bf16(h[2] - bflo(hi.y), h[3] - bfhi(hi.y));
            lo.z = cvt_pk_bf16(h[4] - bflo(hi.z), h[5] - bfhi(hi.z)); lo.w = cvt_pk_bf16(h[6] - bflo(hi.w), h[7] - bfhi(hi.w));
            const bf16x8 ah = __builtin_bit_cast(bf16x8, hi), al = __builtin_bit_cast(bf16x8, lo);
#pragma unroll
            for (int nt = 0; nt < 5; ++nt) {
                acc[nt] = __builtin_amdgcn_mfma_f32_16x16x32_bf16(ah, bh[nt], acc[nt], 0, 0, 0);
                acc[nt] = __builtin_amdgcn_mfma_f32_16x16x32_bf16(ah, bl[nt], acc[nt], 0, 0, 0);
                acc[nt] = __builtin_amdgcn_mfma_f32_16x16x32_bf16(al, bh[nt], acc[nt], 0, 0, 0); }
            *(u32x4*)(H + (size_t)t * D + 512 * kq + 32 * s + 8 * q) = hi;
        }
        LAS float* lgw = lgp + (tl * 4 + kq) * (16 * 80);
#pragma unroll
        for (int nt = 0; nt < 5; ++nt)
#pragma unroll
            for (int jj = 0; jj < 4; ++jj) lgw[(4 * q + jj) * 80 + 16 * nt + m] = acc[nt][jj];
        __syncthreads();
        if (kq == 0) {
            for (int i = lane; i < 16 * 80; i += 64) lgw[i] = lgw[i] + lgw[i + 16 * 80] + lgw[i + 2 * 16 * 80] + lgw[i + 3 * 16 * 80];
            asm volatile("s_waitcnt lgkmcnt(0)" ::: "memory");
        }
        if (kq == 0)
        if (lane < 16) {
            const int tt = task * 16 + lane; const LAS float* l = lgw + lane * 80;
            float gl[8]; float gm = -INFINITY; int gi = 0;
#pragma unroll
            for (int j = 0; j < 8; ++j) { gl[j] = l[j] + p.rg_b[L * 8 + j]; if (gl[j] > gm) { gm = gl[j]; gi = j; } }
            float gs = 0.f;
#pragma unroll
            for (int j = 0; j < 8; ++j) gs += expf(gl[j] - gm);
            const float gp = 1.0f / gs;
            float el[8]; float em = -INFINITY; int i1 = 0;
#pragma unroll
            for (int j = 0; j < 8; ++j) { el[j] = l[8 + gi * 8 + j] + p.re_b[L * 64 + gi * 8 + j]; if (el[j] > em) { em = el[j]; i1 = j; } }
            float e2m = -INFINITY; int i2 = 0;
#pragma unroll
            for (int j = 0; j < 8; ++j) { if (j != i1 && el[j] > e2m) { e2m = el[j]; i2 = j; } }
            const float p2 = expf(e2m - em);
            const float w1 = gp / (1.0f + p2), w2 = gp * p2 / (1.0f + p2);
            const int e1 = gi * 8 + i1, e2 = gi * 8 + i2;
            const unsigned q1 = atomicAdd(&cnt[e1], 1u); TOK[e1 * 8192 + q1] = tt * 2; WTS[e1 * 8192 + q1] = w1;
            const unsigned q2 = atomicAdd(&cnt[e2], 1u); TOK[e2 * 8192 + q2] = tt * 2 + 1; WTS[e2 * 8192 + q2] = w2;
        }
        __syncthreads();
    }
}

__device__ __forceinline__ MoeTab moe_tables(const Ctx& c, const Params& p, int L, int nN) {
    LAS int* base = (LAS int*)(c.lds + LDS_MISC + 1024);
    LAS int* mt_e = base, * mt_p0 = base + 192, * cn = base + 384, * nm = base + 448, * first = base + 452, * ut = base + 520;
    const unsigned* cnt = (const unsigned*)(p.ws + WS_CTL + CTL_CNT) + L * 64;
    __syncthreads();
    if (c.tid < 64) cn[c.tid] = (int)cnt[c.tid];
    __syncthreads();
    if (c.tid == 0) { int n = 0; for (int e = 0; e < 64; ++e) { first[e] = n; const int ntile = (cn[e] + 127) >> 7; for (int i = 0; i < ntile; ++i) { mt_e[n] = e; mt_p0[n] = i * 128; ++n; } } nm[0] = n; }
    __syncthreads();
    if (c.tid < 64) { const int e = c.tid, f0 = first[e], ntile = (cn[e] + 127) >> 7; int o = f0 * nN;
        for (int j = 0; j < nN; ++j) for (int m = 0; m < ntile; ++m) ut[o++] = ((f0 + m) << 4) | j; }
    __syncthreads();
    MoeTab tb; tb.mt_e = mt_e; tb.mt_p0 = mt_p0; tb.cnt = cn; tb.ut = ut; tb.nmt = nm[0]; return tb;
}

__device__ __forceinline__ void phase_final(const Ctx& c, const Params& p) {
    const float* XB = (const float*)(p.ws + WS_XB); const bf16_t* Y = (const bf16_t*)(p.ws + WS_YMOE);
    for (int t = c.bid * 8 + c.wave; t < T; t += c.G * 8) {
        float4 xv[8]; float ss = 0.f;
#pragma unroll
        for (int q = 0; q < 8; ++q) { const int col = q * 256 + c.lane * 4;
            const float4 a = *(const float4*)(XB + (size_t)t * D + col); const u32x2 y0 = *(const u32x2*)(Y + (size_t)(2 * t) * D + col), y1 = *(const u32x2*)(Y + (size_t)(2 * t + 1) * D + col);
            float4 v; v.x = a.x + (bflo(y0.x) + bflo(y1.x)); v.y = a.y + (bfhi(y0.x) + bfhi(y1.x)); v.z = a.z + (bflo(y0.y) + bflo(y1.y)); v.w = a.w + (bfhi(y0.y) + bfhi(y1.y));
            xv[q] = v; ss += v.x * v.x + v.y * v.y + v.z * v.z + v.w * v.w; }
        const float rstd = rsqrtf(wave_sum(ss, c.lane) * (1.0f / D) + 1e-6f);
#pragma unroll
        for (int q = 0; q < 8; ++q) { const int col = q * 256 + c.lane * 4; const float4 g = *(const float4*)(p.final_g + col);
            float4 o; o.x = xv[q].x * rstd * g.x; o.y = xv[q].y * rstd * g.y; o.z = xv[q].z * rstd * g.z; o.w = xv[q].w * rstd * g.w;
            *(float4*)(p.out + (size_t)t * D + col) = o; }
    }
}

constexpr int NPH_LAYER = 10, NPHASES = 1 + NL * NPH_LAYER + 1;
static_assert(NL == 2, "LAYER_BODY is instantiated twice");
#define LAYER_BODY(L) {         const int b = 1 + L * NPH_LAYER; \
        if (PHON(1) && IN(b + 0)) { for (int rep = 0; rep < 1 + (probe == b + 0); ++rep) { FRESH(); phase_norm1(c, p, L); } SEAM(b + 0); } \
        if (PHON(2) && IN(b + 1)) { for (int rep = 0; rep < 1 + (probe == b + 1); ++rep) { FRESH(); \
            pg8::Gemm g{(const bf16_t*)(p.ws + WS_H), (const bf16_t*)(p.ws + WS_WINT) + (size_t)L * NU * D, D}; pg8::StaticOrder S; S.init(T, UC_G, c.G, c.bid); \
            EpiU E{(bf16_t*)(p.ws + WS_U)}; pg8::gemm_phase<EpiU, pg8::StaticOrder, false>(c.lds, g, S, E); } SEAM(b + 1); } \
        if (PHON(3) && IN(b + 2)) { for (int rep = 0; rep < 1 + (probe == b + 2); ++rep) { FRESH(); phase_local(c, p, L); } SEAM(b + 2); } \
        if (PHON(4) && IN(b + 3)) { for (int rep = 0; rep < 1 + (probe == b + 3); ++rep) { FRESH(); phase_attn_gdn(c, p, L); } SEAM(b + 3); } \
        if (PHON(5) && IN(b + 4)) { for (int rep = 0; rep < 1 + (probe == b + 4); ++rep) { FRESH(); phase_combine(c, p, L); } SEAM(b + 4); } \
        if (PHON(6) && IN(b + 5)) { for (int rep = 0; rep < 1 + (probe == b + 5); ++rep) { FRESH(); \
            pg8::Gemm g{(const bf16_t*)(p.ws + WS_YBR), (const bf16_t*)(p.ws + WS_WBRT) + (size_t)L * 4 * D * 768, 768}; MergeOrder S{c.G, c.bid}; \
            EpiMerge E{(const bf16_t*)(p.ws + WS_U), (float*)(p.ws + WS_M32), (bf16_t*)(p.ws + WS_MERGED)}; pg8::gemm_phase<EpiMerge, MergeOrder, false>(c.lds, g, S, E); } SEAM(b + 5); } \
        if (PHON(7) && IN(b + 6)) { for (int rep = 0; rep < 1 + (probe == b + 6); ++rep) { FRESH(); \
            pg8::Gemm g{(const bf16_t*)(p.ws + WS_MERGED), (const bf16_t*)(p.ws + WS_WOUTT) + (size_t)L * D * D, D}; pg8::StaticOrder S; S.init(T, D, c.G, c.bid); \
            EpiRes E{L == 0 ? p.x : (const float*)(p.ws + WS_XA), (float*)(p.ws + WS_XB)}; pg8::gemm_phase<EpiRes, pg8::StaticOrder, false>(c.lds, g, S, E); } SEAM(b + 6); } \
        if (PHON(8) && IN(b + 7)) { FRESH(); phase_norm2_router(c, p, L); SEAM(b + 7); } \
        if (PHON(9) && IN(b + 8)) { for (int rep = 0; rep < 1 + (probe == b + 8); ++rep) { FRESH(); \
            const MoeTab tb = moe_tables(c, p, L, 4); \
            MoeOrder S{tb, 4, c.G, c.bid, (const int*)(p.ws + WS_TOK)}; \
            EpiUp E{(bf16_t*)(p.ws + WS_HID)}; moe_gemm<EpiUp, true>(c, (const bf16_t*)(p.ws + WS_H), p.w_up + (size_t)L * NE * D * 1024, S, E); } SEAM(b + 8); } \
        if (PHON(10) && IN(b + 9)) { for (int rep = 0; rep < 1 + (probe == b + 9); ++rep) { FRESH(); \
            const MoeTab tb = moe_tables(c, p, L, 8); \
            MoeOrder S{tb, 8, c.G, c.bid, (const int*)(p.ws + WS_TOK)}; \
            EpiDown E{tb, (const int*)(p.ws + WS_TOK), (const float*)(p.ws + WS_WSL), (bf16_t*)(p.ws + WS_YMOE)}; moe_gemm<EpiDown, false>(c, (const bf16_t*)(p.ws + WS_HID), p.w_down + (size_t)L * NE * EH * D, S, E); } SEAM(b + 9); } \
 }
__global__ void __launch_bounds__(NTHREADS, 2) fwd(Params p0) {
    extern __shared__ __attribute__((aligned(16))) unsigned char lds_raw[];
    Ctx c; c.tid = threadIdx.x; c.lane = c.tid & 63; c.wave = __builtin_amdgcn_readfirstlane(c.tid >> 6); c.bid = blockIdx.x; c.G = gridDim.x; c.lds = (LAS unsigned char*)lds_raw;
    volatile LAS unsigned* misc = (volatile LAS unsigned*)(c.lds + LDS_MISC);
    if (c.tid < 4) misc[c.tid] = 0u;
    if (c.tid == 0) {
        LAS unsigned long long* tab = (LAS unsigned long long*)(c.lds + LDS_PTAB);
        tab[0] = (unsigned long long)p0.x; tab[1] = (unsigned long long)p0.pos; tab[2] = (unsigned long long)p0.norm1_g; tab[3] = (unsigned long long)p0.w_in; tab[4] = (unsigned long long)p0.conv_a_w;
        tab[5] = (unsigned long long)p0.a_log; tab[6] = (unsigned long long)p0.dt_bias; tab[7] = (unsigned long long)p0.gdn_norm_g; tab[8] = (unsigned long long)p0.conv_b_w; tab[9] = (unsigned long long)p0.conv_b_b;
        tab[10] = (unsigned long long)p0.ln_b_g; tab[11] = (unsigned long long)p0.ln_b_b; tab[12] = (unsigned long long)p0.pool_w; tab[13] = (unsigned long long)p0.pool_scale; tab[14] = (unsigned long long)p0.w_branch;
        tab[15] = (unsigned long long)p0.w_out; tab[16] = (unsigned long long)p0.norm2_g; tab[17] = (unsigned long long)p0.rg_w; tab[18] = (unsigned long long)p0.rg_b; tab[19] = (unsigned long long)p0.re_w;
        tab[20] = (unsigned long long)p0.re_b; tab[21] = (unsigned long long)p0.w_up; tab[22] = (unsigned long long)p0.w_down; tab[23] = (unsigned long long)p0.final_g; tab[24] = (unsigned long long)p0.out;
    }
    __syncthreads();
    const int lo = p0.ph_lo, hi = p0.ph_hi, probe = p0.probe, psub = p0.pad; unsigned char* const wsb = p0.ws;
    const bool multi = (hi - lo) > 1;
    XcdBarrier bar; bar.bar = (unsigned*)(wsb + WS_CTL); bar.x = 0; bar.st = misc;
    if (multi) bar = xcd_barrier_post((unsigned*)(wsb + WS_CTL), misc);
#define IN(k) (lo <= (k) && (k) < hi)
#define FRESH() int _t = threadIdx.x; asm volatile("" : "+v"(_t)); c.tid = _t; c.lane = _t & 63; \
    { int _b = blockIdx.x, _g = gridDim.x, _w = __builtin_amdgcn_readfirstlane(_t >> 6); asm volatile("" : "+s"(_b), "+s"(_g), "+s"(_w)); c.bid = _b; c.G = _g; c.wave = _w; } \
    unsigned char* _ws = wsb; asm volatile("" : "+s"(_ws)); Params p = load_params(c, _ws, lo, hi); p.pad = psub
#define SEAM(k) do { if (IN((k) + 1)) { XcdBarrier _bb = bar; asm volatile("" : "+s"(_bb.bar)); xcd_barrier(_bb); } } while (0)
#ifndef PHMASK
#define PHMASK 0xFFFFF
#endif
#define PHON(k) ((PHMASK >> (k)) & 1)
    if (PHON(0) && IN(0)) { for (int rep = 0; rep < 1 + (probe == 0); ++rep) { FRESH(); phase_convert(c, p); } SEAM(0); }
    for (int L = 0; L < NL; ++L) LAYER_BODY(L)
    if (PHON(11) && IN(NPHASES - 1)) { FRESH(); phase_final(c, p); }
#undef IN
#undef SEAM
}

extern "C" void kernel_launch(void* const* d_in, const int* in_sizes, int n_in, void* d_out, int out_size, void* d_ws, size_t ws_size, hipStream_t stream) {
    static int grid = 0;
    if (grid == 0) {
        if (n_in != 24 || out_size != T * D || ws_size < WS_END) { fprintf(stderr, "kernel_launch: unexpected shapes (n_in %d, out %d, ws %zu < %zu)\n", n_in, out_size, ws_size, (size_t)WS_END); grid = -1; return; }
        int dev = 0, cus = 0, per_cu = 0;
        if (hipGetDevice(&dev) != hipSuccess || hipDeviceGetAttribute(&cus, hipDeviceAttributeMultiprocessorCount, dev) != hipSuccess) { grid = -1; return; }
        if (hipFuncSetAttribute((const void*)fwd, hipFuncAttributeMaxDynamicSharedMemorySize, LDS_BYTES) != hipSuccess) { fprintf(stderr, "kernel_launch: hipFuncSetAttribute failed\n"); grid = -1; return; }
        if (hipOccupancyMaxActiveBlocksPerMultiprocessor(&per_cu, (const void*)fwd, NTHREADS, LDS_BYTES) != hipSuccess || per_cu < 1) { fprintf(stderr, "kernel_launch: occupancy query says %d\n", per_cu); (void)hipGetLastError(); }
        grid = cus;
    }
    if (grid < 0) return;
    (void)hipMemsetAsync((char*)d_ws + WS_CTL, 0, CTL_BYTES, stream);
    Params p{};
    p.x = (const float*)d_in[0]; p.pos = (const int*)d_in[1]; p.norm1_g = (const float*)d_in[2]; p.w_in = (const float*)d_in[3]; p.conv_a_w = (const float*)d_in[4];
    p.a_log = (const float*)d_in[5]; p.dt_bias = (const float*)d_in[6]; p.gdn_norm_g = (const float*)d_in[7]; p.conv_b_w = (const float*)d_in[8]; p.conv_b_b = (const float*)d_in[9];
    p.ln_b_g = (const float*)d_in[10]; p.ln_b_b = (const float*)d_in[11]; p.pool_w = (const float*)d_in[12]; p.pool_scale = (const float*)d_in[13]; p.w_branch = (const float*)d_in[14];
    p.w_out = (const float*)d_in[15]; p.norm2_g = (const float*)d_in[16]; p.rg_w = (const float*)d_in[17]; p.rg_b = (const float*)d_in[18]; p.re_w = (const float*)d_in[19];
    p.re_b = (const float*)d_in[20]; p.w_up = (const float*)d_in[21]; p.w_down = (const float*)d_in[22]; p.final_g = (const float*)d_in[23];
    p.out = (float*)d_out; p.ws = (unsigned char*)d_ws; p.probe = PROBE_PHASE; p.pad = PROBE_SUB;
#if MK_ONE_LAUNCH
    p.ph_lo = 0; p.ph_hi = NPHASES;
    hipLaunchKernelGGL(fwd, dim3(grid), dim3(NTHREADS), LDS_BYTES, stream, p);
#else
    for (int ph = 0; ph < NPHASES; ++ph) { p.ph_lo = ph; p.ph_hi = ph + 1; hipLaunchKernelGGL(fwd, dim3(grid), dim3(NTHREADS), LDS_BYTES, stream, p); }
#endif
}
```

```cpp
#include <hip/hip_runtime.h>
#include <cstdio>
#include <cstdint>

#ifndef PROBE_SUB
#define PROBE_SUB 0
#endif
#ifndef PROBE_PHASE
#define PROBE_PHASE -1
#endif
#ifndef MK_ONE_LAUNCH
#define MK_ONE_LAUNCH 1
#endif

#define LAS __attribute__((address_space(3)))
typedef unsigned short bf16_t;
typedef short bf16x8 __attribute__((ext_vector_type(8)));
typedef float f32x4 __attribute__((ext_vector_type(4)));
typedef unsigned u32x4 __attribute__((ext_vector_type(4)));
typedef unsigned u32x2 __attribute__((ext_vector_type(2)));
typedef short s16x4 __attribute__((ext_vector_type(4)));
typedef float f32x2 __attribute__((ext_vector_type(2)));

constexpr int T = 8192, D = 2048, NL = 2;
constexpr int NIN = 20492, NU = 20480;
constexpr int UC_QKV = 0, UC_Z = 2304, UC_B = 3072, UC_C = 4608, UC_D = 11520, UC_G = 12288;
constexpr int NE = 64, EH = 512;
constexpr int NTHREADS = 512;
constexpr int LDS_STAGE = 131072;
constexpr int LDS_MISC = LDS_STAGE;
constexpr int LDS_OSTG = LDS_STAGE + 8192;
constexpr int LDS_BYTES = LDS_OSTG + 16384;

constexpr size_t al256(size_t x) { return (x + 255) & ~(size_t)255; }
constexpr size_t WS_CTL = 0;
constexpr size_t CTL_BYTES = 65536;
constexpr size_t CTL_CNT = 32768;
constexpr size_t CTL_MTDONE = 36864;
constexpr size_t CTL_QHEAD = 40960;
constexpr size_t WS_WINT = WS_CTL + CTL_BYTES;
constexpr size_t WS_WBRT = WS_WINT + (size_t)NL * NU * D * 2;
constexpr size_t WS_WOUTT = WS_WBRT + (size_t)NL * 4 * D * 768 * 2;
constexpr size_t WS_WUPT = WS_WOUTT + (size_t)NL * D * D * 2;
constexpr size_t WS_WDNT = WS_WUPT + (size_t)NL * NE * 1024 * D * 2;
constexpr size_t WS_H = WS_WDNT + (size_t)NL * NE * D * EH * 2;
constexpr size_t WS_U = WS_H + (size_t)T * D * 2;
constexpr size_t WS_XA = WS_U + (size_t)T * NU * 2;
constexpr size_t WS_XB = WS_XA + (size_t)T * D * 4;
constexpr size_t WS_BETA = WS_XB + (size_t)T * D * 4;
constexpr size_t WS_GLOG = WS_BETA + (size_t)T * 8 * 4;
constexpr int GB_WC = 0, GB_QD = 16384, GB_KDT = 32768, GB_QK = 49152, GB_BYTES = 57344;
constexpr size_t WS_GBLK = WS_GLOG + (size_t)T * 8 * 4;
constexpr size_t WS_UCP = WS_GBLK + (size_t)768 * GB_BYTES;
constexpr size_t WS_GL = WS_UCP + (size_t)768 * 8192 * 4;
constexpr size_t WS_OGDN = WS_GL + 4096;
constexpr size_t WS_QR = WS_OGDN + (size_t)T * 768 * 4;
constexpr size_t WS_KR = WS_QR + (size_t)T * 2304 * 2;
constexpr size_t WS_ATTO = WS_KR + (size_t)T * 2304 * 2;
constexpr size_t WS_LSE = WS_ATTO + (size_t)3 * T * 768 * 2;
constexpr size_t WS_YBR = WS_LSE + (size_t)3 * T * 8 * 4;
constexpr size_t WS_M32 = WS_YBR + (size_t)4 * T * 768 * 2;
constexpr size_t WS_MERGED = WS_M32 + (size_t)T * D * 4;
constexpr size_t WS_TOK = WS_MERGED + (size_t)T * D * 2;
constexpr size_t WS_WTS = WS_TOK + (size_t)NE * 8192 * 4;
constexpr size_t WS_HID = WS_WTS + (size_t)T * 2 * 4;
constexpr size_t WS_YMOE = WS_HID + (size_t)32768 * EH * 2;
constexpr size_t WS_PWT = WS_YMOE + (size_t)T * 2 * D * 4;
constexpr size_t WS_WRT = WS_PWT + (size_t)NL * 4 * 192 * 192 * 2;
constexpr size_t WS_WSM = WS_WRT + (size_t)NL * 2 * 80 * 2048 * 2;
constexpr size_t WS_WSL = WS_WSM + (size_t)NL * 12 * 2048 * 4;
constexpr size_t WS_END = WS_WSL + (size_t)NE * 8192 * 4;

__constant__ float ROPE_INV[64] = {1.000000000e+00f, 8.659643531e-01f, 7.498942018e-01f, 6.493816376e-01f, 5.623413324e-01f, 4.869675338e-01f, 4.216965139e-01f, 3.651741147e-01f, 3.162277639e-01f, 2.738419771e-01f, 2.371373773e-01f, 2.053525001e-01f, 1.778279394e-01f, 1.539926529e-01f, 1.333521456e-01f, 1.154781953e-01f, 1.000000015e-01f, 8.659642935e-02f, 7.498942316e-02f, 6.493816525e-02f, 5.623413250e-02f, 4.869675264e-02f, 4.216964915e-02f, 3.651741147e-02f, 3.162277490e-02f, 2.738419548e-02f, 2.371373773e-02f, 2.053525113e-02f, 1.778279431e-02f, 1.539926510e-02f, 1.333521400e-02f, 1.154781971e-02f, 9.999999776e-03f, 8.659643121e-03f, 7.498942316e-03f, 6.493816152e-03f, 5.623413250e-03f, 4.869675264e-03f, 4.216964822e-03f, 3.651741194e-03f, 3.162277630e-03f, 2.738419687e-03f, 2.371373819e-03f, 2.053525066e-03f, 1.778279431e-03f, 1.539926510e-03f, 1.333521446e-03f, 1.154782018e-03f, 1.000000047e-03f, 8.659643354e-04f, 7.498941850e-04f, 6.493816036e-04f, 5.623413017e-04f, 4.869675322e-04f, 4.216965172e-04f, 3.651741135e-04f, 3.162277571e-04f, 2.738419571e-04f, 2.371373703e-04f, 2.053525095e-04f, 1.778279402e-04f, 1.539926598e-04f, 1.333521504e-04f, 1.154782003e-04f};

__device__ __forceinline__ float bf2f(unsigned short b) { return __uint_as_float(((unsigned)b) << 16); }
__device__ __forceinline__ float bflo(unsigned w) { return __uint_as_float(w << 16); }
__device__ __forceinline__ float bfhi(unsigned w) { return __uint_as_float(w & 0xffff0000u); }
typedef __bf16 bf16x2_t __attribute__((ext_vector_type(2)));
__device__ __forceinline__ unsigned cvt_pk_bf16(float lo, float hi) { bf16x2_t v; v.x = (__bf16)lo; v.y = (__bf16)hi; return __builtin_bit_cast(unsigned, v); }
__device__ __forceinline__ bf16_t f2bf(float f) { return (bf16_t)(cvt_pk_bf16(f, 0.f) & 0xffffu); }
__device__ __forceinline__ float shx(float v, int o, int lane) { return __int_as_float(__builtin_amdgcn_ds_bpermute((lane ^ o) << 2, __float_as_int(v))); }
__device__ __forceinline__ float wave_sum(float v, int lane) {
#pragma unroll
    for (int o = 32; o; o >>= 1) v += shx(v, o, lane);
    return v; }
__device__ __forceinline__ float wave_max(float v, int lane) {
#pragma unroll
    for (int o = 32; o; o >>= 1) v = fmaxf(v, shx(v, o, lane));
    return v; }
__device__ __forceinline__ float sigmoidf_(float x) { return 1.0f / (1.0f + __expf(-x)); }
__device__ __forceinline__ float siluf_(float x) { return x / (1.0f + __expf(-x)); }

__device__ __forceinline__ bf16x8 tr_pair(const LAS unsigned char* p0, const LAS unsigned char* p1) {
    const s16x4 a = __builtin_amdgcn_ds_read_tr16_b64_v4i16((LAS s16x4*)p0), b = __builtin_amdgcn_ds_read_tr16_b64_v4i16((LAS s16x4*)p1);
    return __builtin_shufflevector(a, b, 0, 1, 2, 3, 4, 5, 6, 7); }
#define XB_TMO      128
#define XB_XCNT(j)  (256  + 64 * (j))
#define XB_XSUB(j)  (1280 + 64 * (j))
#define XB_XGEN(j)  (2304 + 64 * (j))
#define XB_TOP      3328
#define XB_TOPGEN   3392
#define XCD_BAR_WORDS 3456
#define XB_SPIN_CAP (1u << 18)
__device__ __forceinline__ unsigned xb_ld(unsigned* p)              { return __hip_atomic_load(p, __ATOMIC_RELAXED, __HIP_MEMORY_SCOPE_AGENT); }
__device__ __forceinline__ unsigned xb_add(unsigned* p, unsigned v) { return __hip_atomic_fetch_add(p, v, __ATOMIC_RELAXED, __HIP_MEMORY_SCOPE_AGENT); }
__device__ __forceinline__ unsigned xb_xcc_id() { return (unsigned)__builtin_amdgcn_s_getreg((3 << 11) | 20) & 0xFu; }
#define XB_SPIN(cond, bar) do { unsigned _sp = 0; while (cond) { __builtin_amdgcn_s_sleep(1); \
    if ((++_sp & 255u) == 0u) { if (xb_ld(&(bar)[XB_TMO])) break; if (_sp > XB_SPIN_CAP) { atomicAdd(&(bar)[XB_TMO], 1u); break; } } } } while (0)
struct XcdBarrier { unsigned* bar; unsigned x; volatile LAS unsigned* st; };
__device__ __forceinline__ XcdBarrier xcd_barrier_post(unsigned* bar, volatile LAS unsigned* st) {
    XcdBarrier b; b.bar = bar; b.x = xb_xcc_id(); b.st = st;
    if (threadIdx.x == 0) (void)xb_add(&bar[XB_XCNT(b.x)], 1u);
    return b;
}
__device__ __forceinline__ void xcd_barrier_complete(unsigned* bar, unsigned x, unsigned& nloc, unsigned& nx) {
    const unsigned G = gridDim.x * gridDim.y * gridDim.z;
    unsigned sum, cnt, mine, sp = 0u;
    for (;;) {
        sum = 0u; cnt = 0u; mine = 0u;
#pragma unroll
        for (unsigned j = 0; j < 16; ++j) { const unsigned c = xb_ld(&bar[XB_XCNT(j)]); sum += c; cnt += (c > 0u) ? 1u : 0u; mine = (j == x) ? c : mine; }
        if (sum == G) break;
        __builtin_amdgcn_s_sleep(1);
        if ((++sp & 255u) == 0u) { if (xb_ld(&bar[XB_TMO])) break; if (sp > XB_SPIN_CAP) { atomicAdd(&bar[XB_TMO], 1u); break; } }
    }
    nloc = mine > 0u ? mine : 1u; nx = cnt > 0u ? cnt : 1u;
}
__device__ __forceinline__ void xcd_barrier(const XcdBarrier& b) {
    asm volatile("s_waitcnt vmcnt(0)" ::: "memory");
    __syncthreads();
    if (threadIdx.x == 0) {
        unsigned* bar = b.bar;
        __builtin_amdgcn_s_waitcnt(0);
        unsigned nloc = b.st[0], nx = b.st[1];
        if (nloc == 0u) { xcd_barrier_complete(bar, b.x, nloc, nx); b.st[0] = nloc; b.st[1] = nx; }
        const unsigned old = xb_add(&bar[XB_XSUB(b.x)], 1u);
        const unsigned gen = old / nloc;
        if (old + 1u == (gen + 1u) * nloc) {
            __builtin_amdgcn_fence(__ATOMIC_RELEASE, "agent");
            asm volatile("s_waitcnt vmcnt(0)" ::: "memory");
            const unsigned og = xb_add(&bar[XB_TOP], 1u);
            const unsigned tg = og / nx;
            if (og + 1u == (tg + 1u) * nx) xb_add(&bar[XB_TOPGEN], 1u);
            else XB_SPIN(xb_ld(&bar[XB_TOPGEN]) == tg, bar);
            __builtin_amdgcn_fence(__ATOMIC_ACQUIRE, "agent");
            xb_add(&bar[XB_XGEN(b.x)], 1u);
            asm volatile("s_waitcnt vmcnt(0)" ::: "memory");
        } else {
            XB_SPIN(xb_ld(&bar[XB_XGEN(b.x)]) == gen, bar);
            __builtin_amdgcn_fence(__ATOMIC_ACQUIRE, "agent");
            asm volatile("s_waitcnt vmcnt(0)" ::: "memory");
        }
    }
    __syncthreads();
}

namespace pg8 {
constexpr int BM = 256, BK = 64, HALF = 128, HTB = HALF * BK * 2, STAGE_BYTES = 8 * HTB, NXCD = 8, WGM = 8;
__host__ __device__ __forceinline__ int lds_byte(int r, int c) { const int st = (r >> 4) * 2 + (c >> 5), rr = r & 15, cc = c & 31, ob = rr * 64 + cc * 2; return st * 1024 + (ob ^ (((ob >> 9) & 1) << 5)); }
__host__ __device__ __forceinline__ void stage_rc(int b, int& R, int& C) { const int st = b / 1024, sb = b % 1024, swz = sb ^ (((sb >> 9) & 1) << 5); R = (st >> 1) * 16 + swz / 64; C = (st & 1) * 32 + (swz % 64) / 2; }
__host__ __device__ __forceinline__ int perm32(int rho) { const int n = rho >> 4, i = rho & 15; return 8 * (i >> 2) + 4 * n + (i & 3); }
struct Unit { int pm, pn; };
struct Gemm { const bf16_t* A; const bf16_t* Bt; int K; };
struct StaticOrder {
    int nM, nN, nwg, G, c;
    __device__ void init(int M, int N, int G_, int c_) { nM = M / BM; nN = N / BM; nwg = nM * nN; G = G_; c = c_; }
    __device__ bool next(int i, Unit& u) const {
        const long L = (long)i * G + c; if (L >= nwg) return false;
        int wgid = (int)L; { const int q = nwg / NXCD, r = nwg % NXCD, xcd = wgid % NXCD, off = wgid / NXCD; wgid = (xcd < r ? xcd * (q + 1) : r * (q + 1) + (xcd - r) * q) + off; }
        const int nig = WGM * nN, gid = wgid / nig, fm = gid * WGM, gsz = (nM - fm) < WGM ? (nM - fm) : WGM;
        u.pm = fm + ((wgid % nig) % gsz); u.pn = (wgid % nig) / gsz; return true;
    }
    __device__ __forceinline__ int arow(const Unit& u, int r) const { return u.pm * BM + r; }
};

template <class Epi, class Sched, bool GATHER>
__device__ __forceinline__ void gemm_phase(LAS unsigned char* lds, const Gemm g, const Sched& S, const Epi& E) {
    int tid = threadIdx.x; asm volatile("" : "+v"(tid));
    const int wid = __builtin_amdgcn_readfirstlane(tid >> 6), lane = tid & 63, wr = wid >> 2, wc = wid & 3, fr = lane & 15, fq = lane >> 4;
    const int K = g.K, nt = K / BK;
    unsigned voffA[2], voffB[2]; int RA[2], CA[2];
#pragma unroll
    for (int i = 0; i < 2; ++i) { int R, C; stage_rc(tid * 16 + i * 8192, R, C); const int Rb = Epi::PERM ? ((R & ~31) + perm32(R & 31)) : R;
        voffA[i] = (unsigned)(R * K + C) * 2u; voffB[i] = (unsigned)(Rb * K + C) * 2u; RA[i] = R; CA[i] = C; }
    const size_t kstep = (size_t)(BK * 2);
    const size_t hstep = (size_t)HALF * K * 2;
    const size_t tstep = 2 * hstep;
    const unsigned ldsw = (unsigned)wid * 1024u;
    const int aoff = lds_byte(wr * 64 + fr, fq * 8), boff = lds_byte(wc * 32 + fr, fq * 8);
#define PG8_SA(b, h) (((b) * 2 + (h)) * HTB)
#define PG8_SB(b, h) ((4 + (b) * 2 + (h)) * HTB)
#define PG8_STAGE(bufoff, gbase, voff) do { _Pragma("unroll") for (int _i = 0; _i < 2; ++_i) \
        __builtin_amdgcn_global_load_lds((const unsigned*)((const char*)(gbase) + (voff)[_i]), (LAS unsigned*)(lds + (bufoff) + ldsw + _i * 8192), 16, 0, 0); } while (0)
#define PG8_STAGE2(bufoff, gbase, o0, o1) do { \
        __builtin_amdgcn_global_load_lds((const unsigned*)((const char*)(gbase) + (o0)), (LAS unsigned*)(lds + (bufoff) + ldsw), 16, 0, 0); \
        __builtin_amdgcn_global_load_lds((const unsigned*)((const char*)(gbase) + (o1)), (LAS unsigned*)(lds + (bufoff) + ldsw + 8192), 16, 0, 0); } while (0)
#define PG8_LDA(dst, b, h) do { _Pragma("unroll") for (int m = 0; m < 4; ++m) _Pragma("unroll") for (int k = 0; k < 2; ++k) dst[m][k] = *(const LAS bf16x8*)(lds + PG8_SA(b, h) + aoff + m * 2048 + k * 1024); } while (0)
#define PG8_LDB(dst, b, h) do { _Pragma("unroll") for (int n = 0; n < 2; ++n) _Pragma("unroll") for (int k = 0; k < 2; ++k) dst[n][k] = *(const LAS bf16x8*)(lds + PG8_SB(b, h) + boff + n * 2048 + k * 1024); } while (0)
#define PG8_MMA(ai, bj, At, Bt) do { __builtin_amdgcn_s_setprio(1); _Pragma("unroll") for (int m = 0; m < 4; ++m) _Pragma("unroll") for (int n = 0; n < 2; ++n) _Pragma("unroll") for (int k = 0; k < 2; ++k) \
        acc[ai][bj][m][n] = __builtin_amdgcn_mfma_f32_16x16x32_bf16(Bt[n][k], At[m][k], acc[ai][bj][m][n], 0, 0, 0); __builtin_amdgcn_s_setprio(0); } while (0)
#define PG8_WAIT_V(n) asm volatile("s_waitcnt vmcnt(" #n ")" ::: "memory")
#define PG8_WAIT_L(n) asm volatile("s_waitcnt lgkmcnt(" #n ")" ::: "memory")
#define PG8_BAR __builtin_amdgcn_s_barrier()
#define PG8_SCHED __builtin_amdgcn_sched_barrier(0)
    Unit cur, nxt; int ui = 0;
    if (!S.next(0, cur)) return;
    f32x4 acc[2][2][4][2];
#pragma unroll
    for (int a = 0; a < 2; ++a)
#pragma unroll
        for (int b = 0; b < 2; ++b)
#pragma unroll
            for (int m = 0; m < 4; ++m)
#pragma unroll
                for (int n = 0; n < 2; ++n) acc[a][b][m][n] = (f32x4){0.f, 0.f, 0.f, 0.f};
    bf16x8 At[4][2], B0[2][2], B1[2][2];
    unsigned c00 = 0, c01 = 0, c10 = 0, c11 = 0, n00 = 0, n01 = 0, n10 = 0, n11 = 0;
    if constexpr (GATHER) {
        c00 = (unsigned)(S.arow(cur, RA[0]) * K + CA[0]) * 2u; c01 = (unsigned)(S.arow(cur, RA[1]) * K + CA[1]) * 2u;
        c10 = (unsigned)(S.arow(cur, HALF + RA[0]) * K + CA[0]) * 2u; c11 = (unsigned)(S.arow(cur, HALF + RA[1]) * K + CA[1]) * 2u;
    }
    const char* cA = GATHER ? (const char*)g.A : (const char*)g.A + (size_t)cur.pm * tstep; const char* cB = (const char*)g.Bt + (size_t)cur.pn * tstep;
    if constexpr (GATHER) {
        PG8_STAGE(PG8_SB(0, 0), cB, voffB); PG8_STAGE2(PG8_SA(0, 0), cA, c00, c01); PG8_STAGE(PG8_SB(0, 1), cB + hstep, voffB); PG8_STAGE2(PG8_SA(0, 1), cA, c10, c11);
    } else {
        PG8_STAGE(PG8_SB(0, 0), cB, voffB); PG8_STAGE(PG8_SB(0, 1), cB + hstep, voffB); PG8_STAGE(PG8_SA(0, 0), cA, voffA); PG8_STAGE(PG8_SA(0, 1), cA + hstep, voffA);
    }
    if (wr == 1) PG8_BAR;
    if constexpr (GATHER) PG8_WAIT_V(4); else PG8_WAIT_V(2);
    PG8_BAR;
    if constexpr (GATHER) {
        PG8_STAGE(PG8_SB(1, 0), cB + kstep, voffB); PG8_STAGE2(PG8_SA(1, 0), cA + kstep, c00, c01); PG8_STAGE(PG8_SB(1, 1), cB + hstep + kstep, voffB);
    } else {
        PG8_STAGE(PG8_SB(1, 0), cB + kstep, voffB); PG8_STAGE(PG8_SA(1, 0), cA + kstep, voffA); PG8_STAGE(PG8_SB(1, 1), cB + hstep + kstep, voffB);
    }
    PG8_WAIT_V(6); PG8_BAR;
    for (;;) {
        const bool has_next = S.next(ui + 1, nxt);
        if constexpr (GATHER) {
            if (has_next) {
                n00 = (unsigned)(S.arow(nxt, RA[0]) * K + CA[0]) * 2u; n01 = (unsigned)(S.arow(nxt, RA[1]) * K + CA[1]) * 2u;
                n10 = (unsigned)(S.arow(nxt, HALF + RA[0]) * K + CA[0]) * 2u; n11 = (unsigned)(S.arow(nxt, HALF + RA[1]) * K + CA[1]) * 2u;
            } else { n00 = c00; n01 = c01; n10 = c10; n11 = c11; }
        }
        const char* nA = GATHER ? cA : (has_next ? (const char*)g.A + (size_t)nxt.pm * tstep : cA);
        const char* nB = has_next ? (const char*)g.Bt + (size_t)nxt.pn * tstep : cB;
        for (int t = 0; t < nt; t += 2) {
            const bool last = (t == nt - 2);
            const char* a1 = cA + (size_t)(t + 1) * kstep;
            const char* a2 = last ? nA : cA + (size_t)(t + 2) * kstep; const char* b2 = last ? nB : cB + (size_t)(t + 2) * kstep;
            const char* a3 = a2 + kstep; const char* b3 = b2 + kstep;
            unsigned s00 = 0, s01 = 0, s10 = 0, s11 = 0;
            if constexpr (GATHER) { s00 = last ? n00 : c00; s01 = last ? n01 : c01; s10 = last ? n10 : c10; s11 = last ? n11 : c11; }
            if constexpr (!GATHER) {
            PG8_LDB(B0, 0, 0); PG8_LDB(B1, 0, 1); PG8_SCHED; PG8_LDA(At, 0, 0); PG8_STAGE(PG8_SA(1, 1), a1 + hstep, voffA);
            PG8_WAIT_V(8); PG8_WAIT_L(0); PG8_BAR; PG8_MMA(0, 0, At, B0); PG8_MMA(0, 1, At, B1); PG8_BAR; PG8_SCHED;
            PG8_LDA(At, 0, 1); PG8_STAGE(PG8_SB(0, 0), b2, voffB); PG8_STAGE(PG8_SB(0, 1), b2 + hstep, voffB); PG8_STAGE(PG8_SA(0, 0), a2, voffA);
            PG8_WAIT_V(8); PG8_WAIT_L(0); PG8_BAR; PG8_MMA(1, 0, At, B0); PG8_MMA(1, 1, At, B1); PG8_BAR; PG8_SCHED;
            PG8_LDB(B0, 1, 0); PG8_LDB(B1, 1, 1); PG8_SCHED; PG8_LDA(At, 1, 0); PG8_STAGE(PG8_SA(0, 1), a2 + hstep, voffA);
            PG8_WAIT_V(8); PG8_WAIT_L(0); PG8_BAR; PG8_MMA(0, 0, At, B0); PG8_MMA(0, 1, At, B1); PG8_BAR; PG8_SCHED;
            PG8_LDA(At, 1, 1); PG8_STAGE(PG8_SB(1, 0), b3, voffB); PG8_STAGE(PG8_SB(1, 1), b3 + hstep, voffB); PG8_STAGE(PG8_SA(1, 0), a3, voffA);
            PG8_WAIT_V(8); PG8_WAIT_L(0); PG8_BAR; PG8_MMA(1, 0, At, B0); PG8_MMA(1, 1, At, B1); PG8_BAR; PG8_SCHED;
            } else {
            PG8_LDB(B0, 0, 0); PG8_SCHED; PG8_LDA(At, 0, 0);
            if constexpr (GATHER) PG8_STAGE2(PG8_SA(1, 1), a1, c10, c11); else PG8_STAGE(PG8_SA(1, 1), a1 + hstep, voffA);
            PG8_WAIT_L(8); PG8_BAR; PG8_WAIT_L(0); PG8_MMA(0, 0, At, B0); PG8_BAR; PG8_SCHED;
            PG8_LDB(B1, 0, 1); PG8_STAGE(PG8_SB(0, 0), b2, voffB);
            PG8_BAR; PG8_WAIT_L(0); PG8_MMA(0, 1, At, B1); PG8_BAR;
            PG8_LDA(At, 0, 1);
            if constexpr (GATHER) PG8_STAGE2(PG8_SA(0, 0), a2, s00, s01); else PG8_STAGE(PG8_SA(0, 0), a2, voffA);
            PG8_BAR; PG8_WAIT_L(0); PG8_MMA(1, 0, At, B0); PG8_BAR; PG8_SCHED;
            PG8_STAGE(PG8_SB(0, 1), b2 + hstep, voffB);
            PG8_WAIT_V(6); PG8_BAR; PG8_MMA(1, 1, At, B1); PG8_BAR;
            PG8_LDB(B0, 1, 0); PG8_SCHED; PG8_LDA(At, 1, 0);
            if constexpr (GATHER) PG8_STAGE2(PG8_SA(0, 1), a2, s10, s11); else PG8_STAGE(PG8_SA(0, 1), a2 + hstep, voffA);
            PG8_WAIT_L(8); PG8_BAR; PG8_WAIT_L(0); PG8_MMA(0, 0, At, B0); PG8_BAR; PG8_SCHED;
            PG8_LDB(B1, 1, 1); PG8_STAGE(PG8_SB(1, 0), b3, voffB);
            PG8_BAR; PG8_WAIT_L(0); PG8_MMA(0, 1, At, B1); PG8_BAR;
            PG8_LDA(At, 1, 1);
            if constexpr (GATHER) PG8_STAGE2(PG8_SA(1, 0), a3, s00, s01); else PG8_STAGE(PG8_SA(1, 0), a3, voffA);
            PG8_BAR; PG8_WAIT_L(0); PG8_MMA(1, 0, At, B0); PG8_BAR; PG8_SCHED;
            PG8_STAGE(PG8_SB(1, 1), b3 + hstep, voffB);
            PG8_WAIT_V(6); PG8_BAR; PG8_MMA(1, 1, At, B1); PG8_BAR;
                    }
        }
        if (wr == 0) PG8_BAR;
        E(acc, cur, wr, wc, fr, fq);
        if (!has_next) break;
#pragma unroll
        for (int a = 0; a < 2; ++a)
#pragma unroll
            for (int b = 0; b < 2; ++b)
#pragma unroll
                for (int m = 0; m < 4; ++m)
#pragma unroll
                    for (int n = 0; n < 2; ++n) acc[a][b][m][n] = (f32x4){0.f, 0.f, 0.f, 0.f};
        cur = nxt; cA = nA; cB = nB; ++ui;
        if constexpr (GATHER) { c00 = n00; c01 = n01; c10 = n10; c11 = n11; }
        if (wr == 1) PG8_BAR;
    }
    PG8_WAIT_V(0);
    PG8_BAR;
#undef PG8_SA
#undef PG8_SB
#undef PG8_STAGE
#undef PG8_STAGE2
#undef PG8_LDA
#undef PG8_LDB
#undef PG8_MMA
#undef PG8_WAIT_V
#undef PG8_WAIT_L
#undef PG8_BAR
#undef PG8_SCHED
}
}

struct Params {
    const float* x; const int* pos; const float* norm1_g; const float* w_in; const float* conv_a_w; const float* a_log; const float* dt_bias; const float* gdn_norm_g;
    const float* conv_b_w; const float* conv_b_b; const float* ln_b_g; const float* ln_b_b; const float* pool_w; const float* pool_scale; const float* w_branch; const float* w_out;
    const float* norm2_g; const float* rg_w; const float* rg_b; const float* re_w; const float* re_b; const float* w_up; const float* w_down; const float* final_g;
    float* out; unsigned char* ws; int ph_lo, ph_hi, probe, pad;
};

struct Ctx { int tid, lane, wave, bid, G; LAS unsigned char* lds; };
constexpr int LDS_PTAB = LDS_MISC + 512;
__device__ __forceinline__ const void* lds_ptr_get(const LAS unsigned* tab, int i) {
    const unsigned lo = __builtin_amdgcn_readfirstlane(tab[2 * i]), hi = __builtin_amdgcn_readfirstlane(tab[2 * i + 1]);
    return (const void*)(((unsigned long long)hi << 32) | lo); }
__device__ __forceinline__ Params load_params(const Ctx& c, unsigned char* ws, int lo, int hi) {
    const LAS unsigned* tab = (const LAS unsigned*)(c.lds + LDS_PTAB); asm volatile("" : "+v"(tab));
    Params q;
    q.x = (const float*)lds_ptr_get(tab, 0); q.pos = (const int*)lds_ptr_get(tab, 1); q.norm1_g = (const float*)lds_ptr_get(tab, 2); q.w_in = (const float*)lds_ptr_get(tab, 3);
    q.conv_a_w = (const float*)lds_ptr_get(tab, 4); q.a_log = (const float*)lds_ptr_get(tab, 5); q.dt_bias = (const float*)lds_ptr_get(tab, 6); q.gdn_norm_g = (const float*)lds_ptr_get(tab, 7);
    q.conv_b_w = (const float*)lds_ptr_get(tab, 8); q.conv_b_b = (const float*)lds_ptr_get(tab, 9); q.ln_b_g = (const float*)lds_ptr_get(tab, 10); q.ln_b_b = (const float*)lds_ptr_get(tab, 11);
    q.pool_w = (const float*)lds_ptr_get(tab, 12); q.pool_scale = (const float*)lds_ptr_get(tab, 13); q.w_branch = (const float*)lds_ptr_get(tab, 14); q.w_out = (const float*)lds_ptr_get(tab, 15);
    q.norm2_g = (const float*)lds_ptr_get(tab, 16); q.rg_w = (const float*)lds_ptr_get(tab, 17); q.rg_b = (const float*)lds_ptr_get(tab, 18); q.re_w = (const float*)lds_ptr_get(tab, 19);
    q.re_b = (const float*)lds_ptr_get(tab, 20); q.w_up = (const float*)lds_ptr_get(tab, 21); q.w_down = (const float*)lds_ptr_get(tab, 22); q.final_g = (const float*)lds_ptr_get(tab, 23);
    q.out = (float*)lds_ptr_get(tab, 24); q.ws = ws; q.ph_lo = lo; q.ph_hi = hi; q.probe = -1; q.pad = 0; return q; }

__device__ __forceinline__ void cvt_tile(const Ctx& c, const float* __restrict__ src, size_t ld, int k0, int n0s, bf16_t* __restrict__ dst, int K, int n0d) {
    LAS float* tile = (LAS float*)c.lds;
    const int tid = c.tid;
#pragma unroll
    for (int rr = 0; rr < 2; ++rr) {
        const int r = (tid >> 4) + rr * 32, cc = (tid & 15) * 4;
        const float4 v = *(const float4*)(src + (size_t)(k0 + r) * ld + n0s + cc);
        tile[r * 65 + cc + 0] = v.x; tile[r * 65 + cc + 1] = v.y; tile[r * 65 + cc + 2] = v.z; tile[r * 65 + cc + 3] = v.w;
    }
    __syncthreads();
    {
        const int n = tid >> 3, ks = tid & 7;
        float f[8];
#pragma unroll
        for (int i = 0; i < 8; ++i) f[i] = tile[(ks * 8 + i) * 65 + n];
        u32x4 w; w.x = cvt_pk_bf16(f[0], f[1]); w.y = cvt_pk_bf16(f[2], f[3]); w.z = cvt_pk_bf16(f[4], f[5]); w.w = cvt_pk_bf16(f[6], f[7]);
        *(u32x4*)(dst + (size_t)(n0d + n) * K + k0 + ks * 8) = w;
    }
    __syncthreads();
}
struct CvtDesc { const float* src; bf16_t* dst; int ld, K; };
__device__ __forceinline__ CvtDesc cvt_desc(const Params& p, int idx) {
    constexpr int T1 = 10240, T2 = 1536, T3 = 1024, TL = T1 + T2 + T3;
    bf16_t* WinT = (bf16_t*)(p.ws + WS_WINT); bf16_t* WbrT = (bf16_t*)(p.ws + WS_WBRT); bf16_t* WoutT = (bf16_t*)(p.ws + WS_WOUTT);
    const int L = idx / TL; int r = idx % TL; CvtDesc d;
    if (r < T1) { const int kt = r % 32, ntile = r / 32, n0d = ntile * 64, n0s = n0d + (n0d >= 3072 ? 12 : 0);
        d.ld = NIN; d.K = D; d.src = p.w_in + (size_t)L * D * NIN + (size_t)(kt * 64) * NIN + n0s; d.dst = WinT + (size_t)L * NU * D + (size_t)n0d * D + kt * 64; return d; }
    r -= T1;
    if (r < T2) { const int kb = r / 384, rr = r % 384, kt = rr % 12, ntile = rr / 12;
        d.ld = D; d.K = 768; d.src = p.w_branch + (size_t)(L * 4 + kb) * 768 * D + (size_t)(kt * 64) * D + ntile * 64; d.dst = WbrT + (size_t)(L * 4 + kb) * D * 768 + (size_t)(ntile * 64) * 768 + kt * 64; return d; }
    r -= T2;
    { const int kt = r % 32, ntile = r / 32;
        d.ld = D; d.K = D; d.src = p.w_out + (size_t)L * D * D + (size_t)(kt * 64) * D + ntile * 64; d.dst = WoutT + (size_t)L * D * D + (size_t)(ntile * 64) * D + kt * 64; return d; }
}
__device__ __forceinline__ void phase_convert(const Ctx& c, const Params& p) {
    constexpr int TL = 10240 + 1536 + 1024;
    {
        const int tid = c.tid, r0 = tid >> 4, cc = (tid & 15) * 4;
        int idx = c.bid; float4 v0 = make_float4(0.f, 0.f, 0.f, 0.f), v1 = v0, m0 = v0, m1 = v0; CvtDesc cur, mid;
        if (idx < NL * TL) { cur = cvt_desc(p, idx); v0 = *(const float4*)(cur.src + (size_t)r0 * cur.ld + cc); v1 = *(const float4*)(cur.src + (size_t)(r0 + 32) * cur.ld + cc); mid = cur; }
        if (idx + c.G < NL * TL) { mid = cvt_desc(p, idx + c.G); m0 = *(const float4*)(mid.src + (size_t)r0 * mid.ld + cc); m1 = *(const float4*)(mid.src + (size_t)(r0 + 32) * mid.ld + cc); }
        int bsel = 0;
        while (idx < NL * TL) {
            const int n2 = idx + 2 * c.G; CvtDesc nxt = mid; float4 n0 = m0, n1 = m1;
            if (n2 < NL * TL) { nxt = cvt_desc(p, n2); n0 = *(const float4*)(nxt.src + (size_t)r0 * nxt.ld + cc); n1 = *(const float4*)(nxt.src + (size_t)(r0 + 32) * nxt.ld + cc); }
            LAS float* tile = (LAS float*)c.lds + bsel * (64 * 65 + 32);
            tile[r0 * 65 + cc + 0] = v0.x; tile[r0 * 65 + cc + 1] = v0.y; tile[r0 * 65 + cc + 2] = v0.z; tile[r0 * 65 + cc + 3] = v0.w;
            tile[(r0 + 32) * 65 + cc + 0] = v1.x; tile[(r0 + 32) * 65 + cc + 1] = v1.y; tile[(r0 + 32) * 65 + cc + 2] = v1.z; tile[(r0 + 32) * 65 + cc + 3] = v1.w;
            __syncthreads();
            { const int n = tid >> 3, ks = tid & 7; float f[8];
#pragma unroll
              for (int i = 0; i < 8; ++i) f[i] = tile[(ks * 8 + i) * 65 + n];
              u32x4 w; w.x = cvt_pk_bf16(f[0], f[1]); w.y = cvt_pk_bf16(f[2], f[3]); w.z = cvt_pk_bf16(f[4], f[5]); w.w = cvt_pk_bf16(f[6], f[7]);
              *(u32x4*)(cur.dst + (size_t)n * cur.K + ks * 8) = w; }
            idx += c.G; cur = mid; v0 = m0; v1 = m1; mid = nxt; m0 = n0; m1 = n1; bsel ^= 1;
        }
        __syncthreads();
    }
    {   float* WSM = (float*)(p.ws + WS_WSM);
        for (int i = c.bid * NTHREADS + c.tid; i < NL * 12 * 2048; i += c.G * NTHREADS) { const int k = i & 2047, j = (i >> 11) % 12, L = i / (12 * 2048);
            WSM[i] = p.w_in[((size_t)L * D + k) * NIN + 3072 + j]; }
    }
    {
        bf16_t* WRT = (bf16_t*)(p.ws + WS_WRT);
        for (int i = c.bid * NTHREADS + c.tid; i < NL * 80 * 2048; i += c.G * NTHREADS) { const int k = i & 2047, j = (i >> 11) % 80, L = i / (80 * 2048);
            const float w = j < 8 ? p.rg_w[((size_t)L * D + k) * 8 + j] : (j < 72 ? p.re_w[((size_t)L * D + k) * 64 + (j - 8)] : 0.f);
            const bf16_t hi = f2bf(w); WRT[((size_t)(L * 2 + 0) * 80 + j) * 2048 + k] = hi; WRT[((size_t)(L * 2 + 1) * 80 + j) * 2048 + k] = f2bf(w - bf2f(hi)); }
    }
    {
        bf16_t* PWT = (bf16_t*)(p.ws + WS_PWT);
        for (int i = c.bid * NTHREADS + c.tid; i < NL * 4 * 192 * 192; i += c.G * NTHREADS) { const int cc = i % 192, e = (i / 192) % 192, lg = i / (192 * 192);
            PWT[i] = f2bf(p.pool_w[(size_t)(lg * 192 + cc) * 192 + e] * p.pool_scale[lg * 192 + e]); }
    }
}

__device__ __forceinline__ void phase_norm1(const Ctx& c, const Params& p, int L) {
    LAS float* wsm = (LAS float*)c.lds;
    { const float4* src = (const float4*)((const float*)(p.ws + WS_WSM) + (size_t)L * 12 * 2048);
      for (int i = c.tid; i < 12 * 2048 / 4; i += NTHREADS) { const float4 v = src[i]; LAS float* d = wsm + 4 * i; d[0] = v.x; d[1] = v.y; d[2] = v.z; d[3] = v.w; } }
    __syncthreads();
    const float* g1 = p.norm1_g + L * D;
    bf16_t* H = (bf16_t*)(p.ws + WS_H); float* XA = (float*)(p.ws + WS_XA); const float* XB = (const float*)(p.ws + WS_XB); const bf16_t* Y = (const bf16_t*)(p.ws + WS_YMOE);
    float* BETA = (float*)(p.ws + WS_BETA); float* GLOG = (float*)(p.ws + WS_GLOG);
    for (int rt = c.bid; rt < T / 32; rt += c.G) {
        for (int i = 0; i < 4; ++i) {
            const int t = rt * 32 + c.wave * 4 + i;
            float4 xv[8]; float ss = 0.f;
#pragma unroll
            for (int q = 0; q < 8; ++q) {
                const int col = q * 256 + c.lane * 4;
                float4 v;
                if (L == 0) v = *(const float4*)(p.x + (size_t)t * D + col);
                else { const float4 a = *(const float4*)(XB + (size_t)t * D + col); const u32x2 y0 = *(const u32x2*)(Y + (size_t)(2 * t) * D + col), y1 = *(const u32x2*)(Y + (size_t)(2 * t + 1) * D + col);
                    v.x = a.x + (bflo(y0.x) + bflo(y1.x)); v.y = a.y + (bfhi(y0.x) + bfhi(y1.x)); v.z = a.z + (bflo(y0.y) + bflo(y1.y)); v.w = a.w + (bfhi(y0.y) + bfhi(y1.y));
                    *(float4*)(XA + (size_t)t * D + col) = v; }
                xv[q] = v; ss += v.x * v.x + v.y * v.y + v.z * v.z + v.w * v.w;
            }
            ss = wave_sum(ss, c.lane);
            const float rstd = rsqrtf(ss * (1.0f / D) + 1e-6f);
            float dots[12];
#pragma unroll
            for (int j = 0; j < 12; ++j) dots[j] = 0.f;
#pragma unroll
            for (int q = 0; q < 8; ++q) {
                const int col = q * 256 + c.lane * 4;
                const float4 g = *(const float4*)(g1 + col);
                float4 h; h.x = xv[q].x * rstd * g.x; h.y = xv[q].y * rstd * g.y; h.z = xv[q].z * rstd * g.z; h.w = xv[q].w * rstd * g.w;
                uint2 o; o.x = cvt_pk_bf16(h.x, h.y); o.y = cvt_pk_bf16(h.z, h.w);
                *(uint2*)(H + (size_t)t * D + col) = o;
#pragma unroll
                for (int j = 0; j < 12; ++j) { const LAS float* wp = wsm + j * 2048 + col; dots[j] += h.x * wp[0] + h.y * wp[1] + h.z * wp[2] + h.w * wp[3]; }
            }
#pragma unroll
            for (int j = 0; j < 12; ++j) dots[j] = wave_sum(dots[j], c.lane);
            if (c.lane < 6) {
                float db = dots[0], dd = dots[6];
#pragma unroll
                for (int j = 1; j < 6; ++j) { if (c.lane == j) { db = dots[j]; dd = dots[6 + j]; } }
                BETA[t * 8 + c.lane] = 1.0f / (1.0f + expf(-db));
                const float xx = dd + p.dt_bias[L * 6 + c.lane];
                const float sp = xx > 20.f ? xx : log1pf(expf(xx));
                GLOG[t * 8 + c.lane] = -expf(p.a_log[L * 6 + c.lane]) * sp;
            }
        }
    }
}

struct EpiU {
    static constexpr bool PERM = true;
    bf16_t* O;
    __device__ __forceinline__ void operator()(const f32x4 (&acc)[2][2][4][2], const pg8::Unit& u, int wr, int wc, int fr, int fq) const {
        const int row0 = u.pm * 256 + wr * 64 + fr, col0 = u.pn * 256 + wc * 32 + 8 * fq; const bool sig = u.pn >= 48;
#pragma unroll
        for (int ai = 0; ai < 2; ++ai)
#pragma unroll
            for (int m = 0; m < 4; ++m) { bf16_t* rowp = O + (size_t)(row0 + ai * 128 + m * 16) * NU + col0;
#pragma unroll
                for (int bj = 0; bj < 2; ++bj) { f32x4 v0 = acc[ai][bj][m][0], v1 = acc[ai][bj][m][1];
                    if (sig) {
#pragma unroll
                        for (int j = 0; j < 4; ++j) { v0[j] = sigmoidf_(v0[j]); v1[j] = sigmoidf_(v1[j]); } }
                    u32x4 w; w.x = cvt_pk_bf16(v0[0], v0[1]); w.y = cvt_pk_bf16(v0[2], v0[3]); w.z = cvt_pk_bf16(v1[0], v1[1]); w.w = cvt_pk_bf16(v1[2], v1[3]);
                    *(u32x4*)(rowp + bj * 128) = w; } }
    }
};
struct MergeOrder {
    int G, c;
    __device__ bool next(int i, pg8::Unit& u) const { const int tile = c + (i >> 2) * G; if (tile >= 256) return false; const int k = i & 3, x = tile & 7, y = tile >> 3;
        u.pm = k * 32 + x * 4 + (y >> 3); u.pn = k * 8 + (y & 7); return true; }
    __device__ __forceinline__ int arow(const pg8::Unit& u, int r) const { return u.pm * 256 + r; }
};
struct EpiMerge {
    static constexpr bool PERM = true;
    const bf16_t* U; float* M32; bf16_t* MG;
    __device__ __forceinline__ void operator()(const f32x4 (&acc)[2][2][4][2], const pg8::Unit& u, int wr, int wc, int fr, int fq) const {
        const int k = u.pm >> 5, tm = u.pm & 31, tn = u.pn & 7;
        const int row0 = tm * 256 + wr * 64 + fr, col0 = tn * 256 + wc * 32 + 8 * fq;
        bf16_t* const MP = (bf16_t*)M32;
#pragma unroll
        for (int ai = 0; ai < 2; ++ai)
#pragma unroll
            for (int mh = 0; mh < 2; ++mh) {
                u32x4 gv[2][2], pv[2][2];
#pragma unroll
                for (int mm = 0; mm < 2; ++mm)
#pragma unroll
                    for (int bj = 0; bj < 2; ++bj) { const size_t row = (size_t)(row0 + ai * 128 + (mh * 2 + mm) * 16); const int col = col0 + bj * 128;
                        gv[mm][bj] = *(const u32x4*)(U + row * NU + UC_G + k * D + col);
                        pv[mm][bj] = (k > 0) ? *(const u32x4*)(MP + row * D + col) : (u32x4){0u, 0u, 0u, 0u}; }
#pragma unroll
                for (int mm = 0; mm < 2; ++mm)
#pragma unroll
                    for (int bj = 0; bj < 2; ++bj) { const int m = mh * 2 + mm; const size_t row = (size_t)(row0 + ai * 128 + m * 16); const int col = col0 + bj * 128;
                        const u32x4 g = gv[mm][bj], pp = pv[mm][bj];
                        f32x4 v0 = acc[ai][bj][m][0], v1 = acc[ai][bj][m][1];
                        v0[0] = v0[0] * bflo(g.x) + bflo(pp.x); v0[1] = v0[1] * bfhi(g.x) + bfhi(pp.x); v0[2] = v0[2] * bflo(g.y) + bflo(pp.y); v0[3] = v0[3] * bfhi(g.y) + bfhi(pp.y);
                        v1[0] = v1[0] * bflo(g.z) + bflo(pp.z); v1[1] = v1[1] * bfhi(g.z) + bfhi(pp.z); v1[2] = v1[2] * bflo(g.w) + bflo(pp.w); v1[3] = v1[3] * bfhi(g.w) + bfhi(pp.w);
                        u32x4 w; w.x = cvt_pk_bf16(v0[0], v0[1]); w.y = cvt_pk_bf16(v0[2], v0[3]); w.z = cvt_pk_bf16(v1[0], v1[1]); w.w = cvt_pk_bf16(v1[2], v1[3]);
                        *(u32x4*)((k < 3 ? MP : MG) + row * D + col) = w; }
            }
    }
};
struct EpiRes {
    static constexpr bool PERM = false;
    const float* X; float* O;
    __device__ __forceinline__ void operator()(const f32x4 (&acc)[2][2][4][2], const pg8::Unit& u, int wr, int wc, int fr, int fq) const {
        const int row0 = u.pm * 256 + wr * 64 + fr, col0 = u.pn * 256 + wc * 32 + 4 * fq;
#pragma unroll
        for (int ai = 0; ai < 2; ++ai)
#pragma unroll
            for (int mh = 0; mh < 2; ++mh) {
                f32x4 xv[2][2][2];
#pragma unroll
                for (int mm = 0; mm < 2; ++mm)
#pragma unroll
                    for (int bj = 0; bj < 2; ++bj)
#pragma unroll
                        for (int n = 0; n < 2; ++n) xv[mm][bj][n] = *(const f32x4*)(X + (size_t)(row0 + ai * 128 + (mh * 2 + mm) * 16) * D + col0 + bj * 128 + n * 16);
#pragma unroll
                for (int mm = 0; mm < 2; ++mm)
#pragma unroll
                    for (int bj = 0; bj < 2; ++bj)
#pragma unroll
                        for (int n = 0; n < 2; ++n) *(f32x4*)(O + (size_t)(row0 + ai * 128 + (mh * 2 + mm) * 16) * D + col0 + bj * 128 + n * 16) = acc[ai][bj][mh * 2 + mm][n] + xv[mm][bj][n];
            }
    }
};
struct MoeTab { const LAS int* mt_e; const LAS int* mt_p0; const LAS int* cnt; const LAS int* ut; int nmt; };
struct MoeOrder {
    MoeTab tb; int nN, G, c; const int* tok; unsigned* done;
    __device__ bool next(int i, pg8::Unit& u) const { const int U = tb.nmt * nN; int Lx;
        if (G % 8 == 0) { const int per = G / 8, x = c % 8, j = c / 8, R = U / G, rem = U - R * G;
            if (i < R) Lx = i * G + x * per + j;
            else if (i == R) { const int px = rem / 8, left = rem - px * 8;
                if (j < px) Lx = R * G + x * px + j; else if (j == px && x < left) Lx = R * G + px * 8 + x; else return false; }
            else return false;
        } else { Lx = i * G + c; if (Lx >= U) return false; }
        const int e = tb.ut[Lx]; u.pm = e >> 4; u.pn = tb.mt_e[u.pm] * nN + (e & 15); return true; }
    __device__ __forceinline__ int arow(const pg8::Unit& u, int r) const { const int e = tb.mt_e[u.pm], pos = tb.mt_p0[u.pm] + r; return pos < tb.cnt[e] ? (tok[e * 8192 + pos] >> 1) : 0; }
};
struct MoeDownQueue {
    MoeTab tb; int nN, G, c; unsigned* qhead; unsigned* done; LAS int* slot; const int* tok;
    __device__ bool next(int, pg8::Unit& u) const {
        __syncthreads();
        if (threadIdx.x == 0) {
            const int U = tb.nmt * 8, per = (G % 8 == 0) ? G / 8 : G, nq = (G % 8 == 0) ? 8 : 1, x0 = (G % 8 == 0) ? c % 8 : 0;
            int xo = slot[1], ent = -1;
            for (; xo < nq; ++xo) { const int x = (x0 + xo) % nq;
                const int q = (int)__hip_atomic_fetch_add(qhead + 16 * x, 1u, __ATOMIC_RELAXED, __HIP_MEMORY_SCOPE_AGENT);
                const int Lq = (q / per) * G + x * per + (q % per);
                if (Lq < U) { ent = tb.ut[Lq]; break; } }
            slot[1] = xo;
            if (ent >= 0) { const int mt = ent >> 4; unsigned sp = 0;
                while (__hip_atomic_load(done + mt, __ATOMIC_RELAXED, __HIP_MEMORY_SCOPE_AGENT) < 4u) { __builtin_amdgcn_s_sleep(2); if (++sp > (1u << 21)) break; }
                __builtin_amdgcn_fence(__ATOMIC_ACQUIRE, "agent"); asm volatile("s_waitcnt vmcnt(0)" ::: "memory"); }
            slot[0] = ent; }
        __syncthreads();
        const int ent = slot[0]; if (ent < 0) return false;
        u.pm = ent >> 4; u.pn = tb.mt_e[u.pm] * 8 + (ent & 15); return true; }
    __device__ __forceinline__ int arow(const pg8::Unit& u, int r) const { return u.pm * 128 + r; }
};
struct EpiUp {
    bf16_t* HID;
    __device__ __forceinline__ void operator()(const f32x4 (&acc)[2][4][2], const pg8::Unit& u, int wr, int wc, int fr, int fq) const {
        const int j = u.pn & 3; const int row0 = u.pm * 128 + wr * 64 + fr, col0 = j * 128 + wc * 32 + 8 * fq;
#pragma unroll
        for (int m = 0; m < 4; ++m) { const f32x4 g0 = acc[0][m][0], g1 = acc[0][m][1], u0 = acc[1][m][0], u1 = acc[1][m][1];
            float h[8];
#pragma unroll
            for (int q = 0; q < 4; ++q) { h[q] = siluf_(g0[q]) * u0[q]; h[4 + q] = siluf_(g1[q]) * u1[q]; }
            u32x4 w; w.x = cvt_pk_bf16(h[0], h[1]); w.y = cvt_pk_bf16(h[2], h[3]); w.z = cvt_pk_bf16(h[4], h[5]); w.w = cvt_pk_bf16(h[6], h[7]);
            *(u32x4*)(HID + (size_t)(row0 + m * 16) * EH + col0) = w; }
    }
};
struct EpiDown {
    MoeTab tb; const int* tok; const float* wsl; bf16_t* Y;
    __device__ __forceinline__ void operator()(const f32x4 (&acc)[2][4][2], const pg8::Unit& u, int wr, int wc, int fr, int fq) const {
        const int e = tb.mt_e[u.pm], p0 = tb.mt_p0[u.pm], ne = tb.cnt[e]; const int col0 = (u.pn & 7) * 256 + wc * 32 + 8 * fq;
        int dst[4]; float w[4];
#pragma unroll
        for (int m = 0; m < 4; ++m) { const int pos = p0 + wr * 64 + fr + m * 16; const int pc = pos < ne ? pos : ne - 1;
            dst[m] = tok[e * 8192 + pc]; w[m] = wsl[e * 8192 + pc]; }
#pragma unroll
        for (int m = 0; m < 4; ++m) { const int pos = p0 + wr * 64 + fr + m * 16;
            if (pos < ne) { bf16_t* yp = Y + (size_t)dst[m] * D + col0; const float ww = w[m];
#pragma unroll
                for (int bj = 0; bj < 2; ++bj) { const f32x4 v0 = acc[bj][m][0] * ww, v1 = acc[bj][m][1] * ww;
                    u32x4 o; o.x = cvt_pk_bf16(v0[0], v0[1]); o.y = cvt_pk_bf16(v0[2], v0[3]); o.z = cvt_pk_bf16(v1[0], v1[1]); o.w = cvt_pk_bf16(v1[2], v1[3]);
                    *(u32x4*)(yp + bj * 128) = o; } } }
    }
};


__device__ __forceinline__ int invperm32(int a) { return a < 16 ? 8 * (a >> 2) + (a & 3) : 8 * ((a - 16) >> 2) + 4 + (a & 3); }
__device__ __forceinline__ bf16x8 pack_bf16x8(const f32x4& a, const f32x4& b) { u32x4 w; w.x = cvt_pk_bf16(a[0], a[1]); w.y = cvt_pk_bf16(a[2], a[3]); w.z = cvt_pk_bf16(b[0], b[1]); w.w = cvt_pk_bf16(b[2], b[3]); return __builtin_bit_cast(bf16x8, w); }
__device__ __forceinline__ void gdn_chunk_local(const Ctx& c, const Params& p, int L, int unit) {
    const int h = unit >> 7, n = unit & 127, t0 = n * 64, tid = c.tid, lane = c.lane;
    const bf16_t* U = (const bf16_t*)(p.ws + WS_U);
    LAS unsigned char* lds = c.lds;
    LAS float* vf = (LAS float*)lds;
    LAS bf16_t* qb = (LAS bf16_t*)(lds + 33280);
    LAS bf16_t* kb = (LAS bf16_t*)(lds + 50688);
    LAS float* Am = (LAS float*)(lds + 68096);
    LAS unsigned char* img = lds + 85504;
    LAS float* gcs = (LAS float*)(lds + 126464);
    const float* cw = p.conv_a_w + (size_t)L * 4 * 2304;
    LAS float* cwl = (LAS float*)(lds + LDS_OSTG);
    for (int i = tid; i < 3 * 4 * 32; i += NTHREADS) { const int c4 = i & 31, j = (i >> 5) & 3, sec = i >> 7;
        const float4 wv4 = *(const float4*)(cw + j * 2304 + sec * 768 + h * 128 + 4 * c4); LAS float* d = cwl + (sec * 4 + j) * 128 + 4 * c4; d[0] = wv4.x; d[1] = wv4.y; d[2] = wv4.z; d[3] = wv4.w; }
    if (tid < 64) {
        float g = ((const float*)(p.ws + WS_GLOG))[(t0 + tid) * 8 + h];
#pragma unroll
        for (int o = 1; o < 64; o <<= 1) { const float v = __int_as_float(__builtin_amdgcn_ds_bpermute(((lane - o) & 63) << 2, __float_as_int(g))); if (lane >= o) g += v; }
        gcs[tid] = g; gcs[64 + tid] = ((const float*)(p.ws + WS_BETA))[(t0 + tid) * 8 + h];
    }
    __syncthreads();
    {
        const int tok = tid >> 3, cg = tid & 7, t = t0 + tok;
        const float eg = __expf(gcs[tok]);
#pragma unroll
        for (int sec = 0; sec < 3; ++sec) {
            const int col = sec * 768 + h * 128 + 16 * cg;
            float a[16];
#pragma unroll
            for (int i = 0; i < 16; ++i) a[i] = 0.f;
            u32x4 xa[4], xb[4];
#pragma unroll
            for (int j = 0; j < 4; ++j) { const int tt = t - 3 + j, tc = tt < 0 ? 0 : tt;
                xa[j] = *(const u32x4*)(U + (size_t)tc * NU + UC_QKV + col); xb[j] = *(const u32x4*)(U + (size_t)tc * NU + UC_QKV + col + 8); }
#pragma unroll
            for (int j = 0; j < 4; ++j) { const float mk = (t - 3 + j) < 0 ? 0.f : 1.f; const u32x4 x0 = xa[j], x1 = xb[j];
                const LAS f32x4* wl = (const LAS f32x4*)(cwl + (sec * 4 + j) * 128 + 16 * cg); const f32x4 w0 = wl[0], w1 = wl[1], w2 = wl[2], w3 = wl[3];
                a[0] += mk * w0[0] * bflo(x0.x); a[1] += mk * w0[1] * bfhi(x0.x); a[2] += mk * w0[2] * bflo(x0.y); a[3] += mk * w0[3] * bfhi(x0.y);
                a[4] += mk * w1[0] * bflo(x0.z); a[5] += mk * w1[1] * bfhi(x0.z); a[6] += mk * w1[2] * bflo(x0.w); a[7] += mk * w1[3] * bfhi(x0.w);
                a[8] += mk * w2[0] * bflo(x1.x); a[9] += mk * w2[1] * bfhi(x1.x); a[10] += mk * w2[2] * bflo(x1.y); a[11] += mk * w2[3] * bfhi(x1.y);
                a[12] += mk * w3[0] * bflo(x1.z); a[13] += mk * w3[1] * bfhi(x1.z); a[14] += mk * w3[2] * bflo(x1.w); a[15] += mk * w3[3] * bfhi(x1.w); }
#pragma unroll
            for (int i = 0; i < 16; ++i) a[i] = siluf_(a[i]);
            if (sec < 2) {
                float sq = 0.f;
#pragma unroll
                for (int i = 0; i < 16; ++i) sq += a[i] * a[i];
                sq += shx(sq, 1, lane); sq += shx(sq, 2, lane); sq += shx(sq, 4, lane);
                const float rn = rsqrtf(sq + 1e-6f) * (sec == 0 ? 0.08838834764831845f : 1.0f);
#pragma unroll
                for (int i = 0; i < 16; ++i) a[i] *= rn;
                LAS bf16_t* dstb = (sec == 0 ? qb : kb) + tok * 136 + 16 * cg;
                u32x4 w;
                w.x = cvt_pk_bf16(a[0], a[1]); w.y = cvt_pk_bf16(a[2], a[3]); w.z = cvt_pk_bf16(a[4], a[5]); w.w = cvt_pk_bf16(a[6], a[7]); *(LAS u32x4*)dstb = w;
                w.x = cvt_pk_bf16(a[8], a[9]); w.y = cvt_pk_bf16(a[10], a[11]); w.z = cvt_pk_bf16(a[12], a[13]); w.w = cvt_pk_bf16(a[14], a[15]); *(LAS u32x4*)(dstb + 8) = w;
                if (sec == 0) {
#pragma unroll
                    for (int g4 = 0; g4 < 4; ++g4) { const int a0 = 16 * cg + 4 * g4, sl = a0 >> 5, pp = invperm32(a0 & 31), chunk = 4 * sl + (pp >> 3), within = pp & 7;
                        u32x2 o; o.x = cvt_pk_bf16(a[4 * g4] * eg, a[4 * g4 + 1] * eg); o.y = cvt_pk_bf16(a[4 * g4 + 2] * eg, a[4 * g4 + 3] * eg);
                        *(LAS u32x2*)(img + tok * 256 + ((chunk ^ (tok & 15)) << 4) + within * 2) = o; }
                }
            } else {
#pragma unroll
                for (int i = 0; i < 16; ++i) vf[tok * 129 + 16 * cg + i] = a[i];
            }
        }
    }
    __syncthreads();
    {
        const float gl = gcs[63];
#pragma unroll
        for (int it = 0; it < 2; ++it) { const int pc = tid + 512 * it, r = pc & 127, ch = pc >> 7, sp = ch >> 2, q = ch & 3; float v[8];
#pragma unroll
            for (int i = 0; i < 8; ++i) { const int cc = 32 * sp + (i < 4 ? 4 * q + i : 16 + 4 * q + (i - 4)); v[i] = bf2f(kb[cc * 136 + r]) * __expf(gl - gcs[cc]); }
            u32x4 w; w.x = cvt_pk_bf16(v[0], v[1]); w.y = cvt_pk_bf16(v[2], v[3]); w.z = cvt_pk_bf16(v[4], v[5]); w.w = cvt_pk_bf16(v[6], v[7]);
            *(LAS u32x4*)(img + 16384 + r * 128 + ((ch ^ ((r >> 1) & 7)) << 4)) = w; }
    }
    {
        const int m = lane & 15, q = lane >> 4;
        for (int i4 = 0; i4 < 4; ++i4) {
            const int id = c.wave * 4 + i4, which = id >> 4, tile = id & 15, mt = tile >> 2, ntl = tile & 3;
            f32x4 acc = (f32x4){0.f, 0.f, 0.f, 0.f};
            if (ntl <= mt) {
                const LAS bf16_t* Ab = which ? qb : kb;
#pragma unroll
                for (int s = 0; s < 4; ++s) { const bf16x8 av = *(const LAS bf16x8*)(Ab + (16 * mt + m) * 136 + 32 * s + 8 * q), bv = *(const LAS bf16x8*)(kb + (16 * ntl + m) * 136 + 32 * s + 8 * q);
                    acc = __builtin_amdgcn_mfma_f32_16x16x32_bf16(av, bv, acc, 0, 0, 0); }
            }
            const int j_ = 16 * ntl + m;
#pragma unroll
            for (int jj = 0; jj < 4; ++jj) { const int i_ = 16 * mt + 4 * q + jj;
                const float dec = (i_ >= j_) ? __expf(gcs[i_] - gcs[j_]) : 0.f;
                if (which == 0) { if (ntl <= mt) Am[j_ * 68 + i_] = (i_ > j_) ? gcs[64 + i_] * acc[jj] * dec : 0.f; }
                else { const int sp = j_ >> 5, pp = invperm32(j_ & 31), chunk = 4 * sp + (pp >> 3), within = pp & 7;
                    *(LAS bf16_t*)(img + 32768 + i_ * 128 + ((chunk ^ ((i_ >> 1) & 7)) << 4) + within * 2) = f2bf((i_ >= j_) ? acc[jj] * dec : 0.f); } }
        }
    }
    __syncthreads();
    float x[64];
    if (tid < 256) {
        if (tid < 128) {
#pragma unroll
            for (int r = 0; r < 64; ++r) x[r] = vf[r * 129 + tid] * gcs[64 + r];
        } else {
#pragma unroll
            for (int r = 0; r < 64; ++r) x[r] = bf2f(kb[r * 136 + (tid - 128)]) * gcs[64 + r] * __expf(gcs[r]);
        }
    }
    __syncthreads();
    if (tid < 256) {
        int zoff = 0; asm volatile("" : "+v"(zoff));
        const LAS float* Amz = Am + zoff;
#pragma unroll
        for (int j = 0; j < 63; ++j) {
            const float xj = x[j];
#pragma unroll
            for (int ib = (j + 1) / 4; ib < 16; ++ib) { const f32x4 a4 = *(const LAS f32x4*)(Amz + j * 68 + 4 * ib);
                if (4 * ib + 0 > j) x[4 * ib + 0] -= a4[0] * xj;
                if (4 * ib + 1 > j) x[4 * ib + 1] -= a4[1] * xj;
                if (4 * ib + 2 > j) x[4 * ib + 2] -= a4[2] * xj;
                if (4 * ib + 3 > j) x[4 * ib + 3] -= a4[3] * xj; }
        }
        if (tid < 128) {
            float* ucp = (float*)(p.ws + WS_UCP) + (size_t)unit * 8192 + (size_t)(tid >> 4) * 1024 + (tid & 15) * 4;
#pragma unroll
            for (int mt = 0; mt < 4; ++mt)
#pragma unroll
                for (int q = 0; q < 4; ++q) *(f32x4*)(ucp + mt * 256 + q * 64) = (f32x4){x[16 * mt + 4 * q], x[16 * mt + 4 * q + 1], x[16 * mt + 4 * q + 2], x[16 * mt + 4 * q + 3]};
        } else {
            const int kc = tid - 128, s = kc >> 5, pp = invperm32(kc & 31), chunk = 4 * s + (pp >> 3), within = pp & 7;
#pragma unroll
            for (int r = 0; r < 64; ++r) *(LAS bf16_t*)(lds + r * 256 + ((chunk ^ (r & 15)) << 4) + within * 2) = f2bf(-x[r]);
        }
    }
    __syncthreads();
    {
        unsigned char* dst = p.ws + WS_GBLK + (size_t)unit * GB_BYTES;
#pragma unroll
        for (int it = 0; it < 7; ++it) { const int pc = tid + 512 * it; const LAS unsigned char* src = pc < 1024 ? lds + pc * 16 : img + (pc - 1024) * 16;
            *(u32x4*)(dst + pc * 16) = *(const LAS u32x4*)src; }
        if (tid == 0) ((float*)(p.ws + WS_GL))[unit] = __expf(gcs[63]);
    }
    __syncthreads();
}


__device__ __forceinline__ void gdn_scan(const Ctx& c, const Params& p, int sidx) {
    const int h = sidx >> 1, half = sidx & 1;
    const unsigned char* blk = p.ws + WS_GBLK + (size_t)h * 128 * GB_BYTES;
    bf16_t* OG = (bf16_t*)(p.ws + WS_OGDN);
    LAS unsigned char* lds = c.lds;
    LAS unsigned char* ost = c.lds + LDS_OSTG;
    if (c.wave >= 4) {
        const int par = (c.wave - 4) >> 1, st = c.tid - 256 - 128 * par;
        const unsigned char* src = blk + (size_t)st * 16;
        u32x4 sr[28];
        if (par == 0) {
#pragma unroll
            for (int i = 0; i < 28; ++i) sr[i] = *(const u32x4*)(src + i * 2048);
#pragma unroll
            for (int i = 0; i < 28; ++i) *(LAS u32x4*)(lds + st * 16 + i * 2048) = sr[i];
#pragma unroll
            for (int i = 0; i < 28; ++i) sr[i] = *(const u32x4*)(src + 2 * (size_t)GB_BYTES + i * 2048);
        } else {
#pragma unroll
            for (int i = 0; i < 28; ++i) sr[i] = *(const u32x4*)(src + (size_t)GB_BYTES + i * 2048);
        }
        __syncthreads();
        for (int n = 0; n < 128; ++n) {
            if (((n + 1) & 1) == par) {
                if (n + 1 < 128) {
#pragma unroll
                    for (int i = 0; i < 28; ++i) *(LAS u32x4*)(lds + ((n + 1) & 1) * GB_BYTES + st * 16 + i * 2048) = sr[i];
                }
                if (n + 3 < 128) {
#pragma unroll
                    for (int i = 0; i < 28; ++i) sr[i] = *(const u32x4*)(src + (size_t)(n + 3) * GB_BYTES + i * 2048);
                }
            } else if (n > 0) {
#pragma unroll
                for (int i = 0; i < 4; ++i) { const int pc = st + 128 * i, r = pc >> 3, ch = pc & 7;
                    *(u32x4*)(OG + (size_t)((n - 1) * 64 + r) * 768 + h * 128 + 64 * half + 8 * ch) = *(const LAS u32x4*)(ost + ((n - 1) & 1) * 8192 + r * 128 + ch * 16); }
            }
            __syncthreads();
        }
        if (par == 0) {
#pragma unroll
            for (int i = 0; i < 4; ++i) { const int pc = st + 128 * i, r = pc >> 3, ch = pc & 7;
                *(u32x4*)(OG + (size_t)(127 * 64 + r) * 768 + h * 128 + 64 * half + 8 * ch) = *(const LAS u32x4*)(ost + 8192 + r * 128 + ch * 16); }
        }
        return;
    }
    const int wg = 4 * half + c.wave;
    const float* UCp = (const float*)(p.ws + WS_UCP) + (size_t)h * 128 * 8192 + (size_t)wg * 1024 + c.lane * 4;
    const float* GL = (const float*)(p.ws + WS_GL) + h * 128;
    const int lane = c.lane, m = lane & 15, q = lane >> 4;
    int o128[4], o64[2];
#pragma unroll
    for (int s = 0; s < 4; ++s) o128[s] = m * 256 + (((4 * s + q) ^ m) << 4);
#pragma unroll
    for (int s = 0; s < 2; ++s) o64[s] = m * 128 + (((4 * s + q) ^ (m >> 1)) << 4);
    f32x4 S[8];
#pragma unroll
    for (int i = 0; i < 8; ++i) S[i] = (f32x4){0.f, 0.f, 0.f, 0.f};
    f32x4 ucA[4], ucB[4]; float glA, glB;
#pragma unroll
    for (int mt = 0; mt < 4; ++mt) { ucA[mt] = *(const f32x4*)(UCp + mt * 256); ucB[mt] = *(const f32x4*)(UCp + 8192 + mt * 256); }
    glA = GL[0]; glB = GL[1];
    __syncthreads();
#define SCAN_LD(pp) (*(const LAS bf16x8*)(pp))
#define SCAN_STEP(NN, BUF, UC, GLV) do { \
        const LAS unsigned char* B = lds + (BUF) * GB_BYTES; \
        bf16x8 Sb[4]; \
        _Pragma("unroll") for (int s = 0; s < 4; ++s) Sb[s] = pack_bf16x8(S[2 * s], S[2 * s + 1]); \
        bf16x8 Aw[16], Aq[16]; \
        _Pragma("unroll") for (int mt = 0; mt < 4; ++mt) _Pragma("unroll") for (int s = 0; s < 4; ++s) Aw[mt * 4 + s] = SCAN_LD(B + GB_WC + mt * 4096 + o128[s]); \
        _Pragma("unroll") for (int mt = 0; mt < 4; ++mt) _Pragma("unroll") for (int s = 0; s < 4; ++s) Aq[mt * 4 + s] = SCAN_LD(B + GB_QD + mt * 4096 + o128[s]); \
        f32x4 vn[4]; \
        _Pragma("unroll") for (int mt = 0; mt < 4; ++mt) vn[mt] = UC[mt]; \
        _Pragma("unroll") for (int s = 0; s < 4; ++s) _Pragma("unroll") for (int mt = 0; mt < 4; ++mt) vn[mt] = __builtin_amdgcn_mfma_f32_16x16x32_bf16(Aw[mt * 4 + s], Sb[s], vn[mt], 0, 0, 0); \
        bf16x8 Ak[16]; \
        _Pragma("unroll") for (int i = 0; i < 8; ++i) _Pragma("unroll") for (int s = 0; s < 2; ++s) Ak[i * 2 + s] = SCAN_LD(B + GB_KDT + i * 2048 + o64[s]); \
        f32x4 Oa[4]; \
        _Pragma("unroll") for (int mt = 0; mt < 4; ++mt) Oa[mt] = (f32x4){0.f, 0.f, 0.f, 0.f}; \
        _Pragma("unroll") for (int s = 0; s < 4; ++s) _Pragma("unroll") for (int mt = 0; mt < 4; ++mt) Oa[mt] = __builtin_amdgcn_mfma_f32_16x16x32_bf16(Aq[mt * 4 + s], Sb[s], Oa[mt], 0, 0, 0); \
        bf16x8 Vb[2]; Vb[0] = pack_bf16x8(vn[0], vn[1]); Vb[1] = pack_bf16x8(vn[2], vn[3]); \
        bf16x8 Ap[8]; \
        _Pragma("unroll") for (int mt = 0; mt < 4; ++mt) _Pragma("unroll") for (int s = 0; s < 2; ++s) Ap[mt * 2 + s] = SCAN_LD(B + GB_QK + mt * 2048 + o64[s]); \
        _Pragma("unroll") for (int i = 0; i < 8; ++i) S[i] = S[i] * (GLV); \
        _Pragma("unroll") for (int s = 0; s < 2; ++s) _Pragma("unroll") for (int i = 0; i < 8; ++i) S[i] = __builtin_amdgcn_mfma_f32_16x16x32_bf16(Ak[i * 2 + s], Vb[s], S[i], 0, 0, 0); \
        _Pragma("unroll") for (int s = 0; s < 2; ++s) _Pragma("unroll") for (int mt = 0; mt < 4; ++mt) Oa[mt] = __builtin_amdgcn_mfma_f32_16x16x32_bf16(Ap[mt * 2 + s], Vb[s], Oa[mt], 0, 0, 0); \
        _Pragma("unroll") for (int mt = 0; mt < 4; ++mt) _Pragma("unroll") for (int jj = 0; jj < 4; ++jj) \
            *(LAS bf16_t*)(ost + (BUF) * 8192 + (16 * mt + 4 * q + jj) * 128 + (16 * c.wave + m) * 2) = f2bf(Oa[mt][jj]); \
    } while (0)
    for (int n = 0; n < 128; n += 2) {
        SCAN_STEP(n, 0, ucA, glA);
        if (n + 2 < 128) {
#pragma unroll
            for (int mt = 0; mt < 4; ++mt) ucA[mt] = *(const f32x4*)(UCp + (size_t)(n + 2) * 8192 + mt * 256);
            glA = GL[n + 2]; }
        __syncthreads();
        SCAN_STEP(n + 1, 1, ucB, glB);
        if (n + 3 < 128) {
#pragma unroll
            for (int mt = 0; mt < 4; ++mt) ucB[mt] = *(const f32x4*)(UCp + (size_t)(n + 3) * 8192 + mt * 256);
            glB = GL[n + 3]; }
        __syncthreads();
    }
#undef SCAN_STEP
#undef SCAN_LD
}


template <class Epi, bool UP, class Order>
__device__ __forceinline__ void moe_gemm(const Ctx& c, const bf16_t* A, const float* Wl, const Order& S, const Epi& E) {
    constexpr int K = UP ? D : EH, NW = UP ? 1024 : D, NSTEP = K / 64, STG = 49152;
    int tid = threadIdx.x; asm volatile("" : "+v"(tid));
    const int wid = __builtin_amdgcn_readfirstlane(tid >> 6), lane = tid & 63, wr = wid >> 2, wc = wid & 3, fr = lane & 15, fq = lane >> 4;
    LAS unsigned char* lds = c.lds;
    const int par = wid & 1, tp = lane + 64 * (wid >> 1);
    const int bk = tp >> 6, bc4 = tp & 63;
    const int ar = tp >> 3, ach = tp & 7;
    const unsigned a_rd0 = (unsigned)((64 * wr + fr) * 128 + (((0 + fq) ^ ((fr >> 1) & 7)) << 4)), a_rd1 = (unsigned)((64 * wr + fr) * 128 + (((4 + fq) ^ ((fr >> 1) & 7)) << 4));
    const unsigned q4 = (lane & 15) >> 2, p4 = lane & 3, qb = fq & 1;
    const unsigned b_base = 16384u + (8u * fq + q4) * 512u + 64u * ((unsigned)wc ^ q4) + 16u * p4;
    const unsigned b00 = b_base + 8u * qb, b01 = b_base + 8u * (1u - qb), b10 = b00 + 4u * 512u, b11 = b01 + 4u * 512u;
    pg8::Unit u;
    for (int ui = 0; S.next(ui, u); ++ui) {
        const int e = S.tb.mt_e[u.pm], j = u.pn - e * S.nN;
        const float* Wb = Wl + (size_t)e * K * NW + (UP ? ((bc4 < 32) ? 128 * j + 4 * bc4 : 512 + 128 * j + 4 * (bc4 - 32)) : 256 * j + 4 * bc4) + (size_t)bk * NW;
        const bf16_t* Ap[4];
#pragma unroll
        for (int i = 0; i < 4; ++i) { const int row = ar + 32 * i; Ap[i] = (UP ? A + (size_t)S.arow(u, row) * K : A + (size_t)(u.pm * 128 + row) * K) + 8 * (ach ^ ((row >> 1) & 7)); }
        f32x4 acc[2][4][2];
#pragma unroll
        for (int b = 0; b < 2; ++b)
#pragma unroll
            for (int m = 0; m < 4; ++m)
#pragma unroll
                for (int n = 0; n < 2; ++n) acc[b][m][n] = (f32x4){0.f, 0.f, 0.f, 0.f};
        f32x4 wv[16]; u32x4 av[4];
#define MOE_LOAD(T) do { _Pragma("unroll") for (int i = 0; i < 16; ++i) wv[i] = *(const f32x4*)(Wb + (size_t)((T) * 64 + 4 * i) * NW); \
        _Pragma("unroll") for (int i = 0; i < 4; ++i) av[i] = *(const u32x4*)(Ap[i] + (T) * 64); } while (0)
#define MOE_WRITE(T) do { LAS unsigned char* sb = lds + ((T) & 1) * STG; \
        _Pragma("unroll") for (int i = 0; i < 4; ++i) *(LAS u32x4*)(sb + (ar + 32 * i) * 128 + ach * 16) = av[i]; \
        _Pragma("unroll") for (int i = 0; i < 16; ++i) { const int kk = bk + 4 * i; u32x2 w2; w2.x = cvt_pk_bf16(wv[i][0], wv[i][1]); w2.y = cvt_pk_bf16(wv[i][2], wv[i][3]); \
            *(LAS u32x2*)(sb + 16384 + kk * 512 + ((8 * bc4) ^ ((((kk >> 3) & 1) << 3) | ((kk & 3) << 6)))) = w2; } } while (0)
        if (par == 0) { MOE_LOAD(0); MOE_WRITE(0); if (2 < NSTEP) MOE_LOAD(2); }
        else { if (1 < NSTEP) MOE_LOAD(1); }
        for (int t = 0; t < NSTEP; ++t) {
            __syncthreads();
            if (((t + 1) & 1) == par) { if (t + 1 < NSTEP) MOE_WRITE(t + 1); if (t + 3 < NSTEP) MOE_LOAD(t + 3); }
            const unsigned so = (unsigned)(t & 1) * STG;
#pragma unroll
            for (int s2 = 0; s2 < 2; ++s2) {
                bf16x8 Bf[2][2];
#pragma unroll
                for (int bj = 0; bj < 2; ++bj) { Bf[bj][0] = tr_pair(lds + so + b00 + 256 * bj + 16384 * s2, lds + so + b10 + 256 * bj + 16384 * s2);
                                                 Bf[bj][1] = tr_pair(lds + so + b01 + 256 * bj + 16384 * s2, lds + so + b11 + 256 * bj + 16384 * s2); }
                bf16x8 Af[4];
#pragma unroll
                for (int m = 0; m < 4; ++m) Af[m] = *(const LAS bf16x8*)(lds + so + (s2 ? a_rd1 : a_rd0) + m * 2048);
#pragma unroll
                for (int bj = 0; bj < 2; ++bj)
#pragma unroll
                    for (int m = 0; m < 4; ++m)
#pragma unroll
                        for (int n = 0; n < 2; ++n) acc[bj][m][n] = __builtin_amdgcn_mfma_f32_16x16x32_bf16(Bf[bj][n], Af[m], acc[bj][m][n], 0, 0, 0);
            }
        }
#undef MOE_LOAD
#undef MOE_WRITE
        E(acc, u, wr, wc, fr, fq);
        if constexpr (UP) asm volatile("s_waitcnt vmcnt(0)" ::: "memory");
        __syncthreads();
        if constexpr (UP) { if (tid == 0) { __builtin_amdgcn_fence(__ATOMIC_RELEASE, "agent"); asm volatile("s_waitcnt vmcnt(0)" ::: "memory");
            (void)__hip_atomic_fetch_add(S.done + u.pm, 1u, __ATOMIC_RELAXED, __HIP_MEMORY_SCOPE_AGENT); } }
    }
}

__device__ __forceinline__ void phase_local(const Ctx& c, const Params& p, int L) {
    const bf16_t* U = (const bf16_t*)(p.ws + WS_U);
    const int gw = c.bid * 8 + c.wave, GW = c.G * 8, lane = c.lane;
    for (int rep = 0; rep < 1 + (p.pad == 1); ++rep)
    for (int unit = c.bid; unit < 768; unit += c.G) gdn_chunk_local(c, p, L, unit);
    for (int rep = 0; rep < 1 + (p.pad == 2); ++rep) {
        bf16_t* YB = (bf16_t*)(p.ws + WS_YBR) + (size_t)1 * T * 768;
        const float* cbw = p.conv_b_w + (size_t)L * 31 * 768; const float* cbb = p.conv_b_b + L * 768; const float* lg = p.ln_b_g + L * 768; const float* lb = p.ln_b_b + L * 768;
        LAS unsigned char* glu = c.lds;
        LAS unsigned char* cbs = c.lds + 70656;
        for (int tile = c.bid; tile < T / 16; tile += c.G) {
            const int t0 = tile * 16;
            for (int it = c.tid; it < 46 * 96; it += NTHREADS) { const int rr = it / 96, c8 = it - rr * 96, tt = t0 - 30 + rr; u32x4 w = (u32x4){0u, 0u, 0u, 0u};
                if (tt >= 0) { const u32x4 ga = *(const u32x4*)(U + (size_t)tt * NU + UC_B + 8 * c8), gb = *(const u32x4*)(U + (size_t)tt * NU + UC_B + 768 + 8 * c8);
                    w.x = cvt_pk_bf16(bflo(ga.x) * sigmoidf_(bflo(gb.x)), bfhi(ga.x) * sigmoidf_(bfhi(gb.x))); w.y = cvt_pk_bf16(bflo(ga.y) * sigmoidf_(bflo(gb.y)), bfhi(ga.y) * sigmoidf_(bfhi(gb.y)));
                    w.z = cvt_pk_bf16(bflo(ga.z) * sigmoidf_(bflo(gb.z)), bfhi(ga.z) * sigmoidf_(bfhi(gb.z))); w.w = cvt_pk_bf16(bflo(ga.w) * sigmoidf_(bflo(gb.w)), bfhi(ga.w) * sigmoidf_(bfhi(gb.w))); }
                *(LAS u32x4*)(glu + rr * 1536 + c8 * 16) = w; }
            __syncthreads();
            if (c.tid < 384) {
                float w0[31], w1[31], a0[16], a1[16];
#pragma unroll
                for (int j = 0; j < 31; ++j) { const float2 wv = *(const float2*)(cbw + j * 768 + 2 * c.tid); w0[j] = wv.x; w1[j] = wv.y; }
#pragma unroll
                for (int t = 0; t < 16; ++t) { a0[t] = 0.f; a1[t] = 0.f; }
#pragma unroll
                for (int rr = 0; rr < 46; ++rr) { const unsigned g2 = *(const LAS unsigned*)(glu + rr * 1536 + c.tid * 4); const float lo = bflo(g2), hi = bfhi(g2);
#pragma unroll
                    for (int t = 0; t < 16; ++t) { const int j = rr - t; if (j >= 0 && j <= 30) { a0[t] += w0[j] * lo; a1[t] += w1[j] * hi; } } }
                const float2 bv = *(const float2*)(cbb + 2 * c.tid);
#pragma unroll
                for (int t = 0; t < 16; ++t) *(LAS f32x2*)(cbs + t * 3072 + c.tid * 8) = (f32x2){a0[t] + bv.x, a1[t] + bv.y};
            }
            __syncthreads();
            for (int i = 0; i < 2; ++i) { const int tl = c.wave * 2 + i; f32x2 v[6]; float sm = 0.f;
#pragma unroll
                for (int k = 0; k < 6; ++k) { v[k] = *(const LAS f32x2*)(cbs + tl * 3072 + (lane + 64 * k) * 8); sm += v[k].x + v[k].y; }
                const float mu = wave_sum(sm, lane) * (1.0f / 768.f); float vs = 0.f;
#pragma unroll
                for (int k = 0; k < 6; ++k) { const float d0 = v[k].x - mu, d1 = v[k].y - mu; vs += d0 * d0 + d1 * d1; }
                const float rs = rsqrtf(wave_sum(vs, lane) * (1.0f / 768.f) + 1e-5f);
#pragma unroll
                for (int k = 0; k < 6; ++k) { const int ch = 2 * (lane + 64 * k); const float2 gg = *(const float2*)(lg + ch), bb = *(const float2*)(lb + ch);
                    const float y0 = (v[k].x - mu) * rs * gg.x + bb.x, y1 = (v[k].y - mu) * rs * gg.y + bb.y;
                    *(unsigned*)(YB + (size_t)(t0 + tl) * 768 + ch) = cvt_pk_bf16(siluf_(y0), siluf_(y1)); } }
            __syncthreads();
        }
    }
    for (int rep = 0; rep < 1 + (p.pad == 3); ++rep) {
        bf16_t* QR = (bf16_t*)(p.ws + WS_QR); bf16_t* KR = (bf16_t*)(p.ws + WS_KR);
        int rtid = c.tid; asm volatile("" : "+v"(rtid));
        for (int it = c.bid * NTHREADS + rtid; it < T * 8; it += c.G * NTHREADS) {
            const int t = it >> 3, c8 = it & 7; const float ps = (float)p.pos[t]; float cs[8], sn[8];
#pragma unroll
            for (int i = 0; i < 8; ++i) {
                double rev = (double)ps * (double)ROPE_INV[8 * c8 + i] * 0.15915494309189535; rev -= floor(rev);
                const float fr = (float)rev; cs[i] = __builtin_amdgcn_cosf(fr); sn[i] = __builtin_amdgcn_sinf(fr); }
            for (int hb = 0; hb < 36; hb += 4) {
                u32x4 x1[4], x2[4];
#pragma unroll
                for (int j = 0; j < 4; ++j) { const int hv = hb + j, isk = hv >= 18, hh = hv - 18 * isk; const bf16_t* src = U + (size_t)t * NU + UC_C + isk * 2304 + hh * 128 + 8 * c8;
                    x1[j] = *(const u32x4*)src; x2[j] = *(const u32x4*)(src + 64); }
#pragma unroll
                for (int j = 0; j < 4; ++j) { const int hv = hb + j, isk = hv >= 18, hh = hv - 18 * isk; const float sc = isk ? 1.0f : 0.08838834764831845f;
                    float a[8], b[8];
                    a[0] = bflo(x1[j].x); a[1] = bfhi(x1[j].x); a[2] = bflo(x1[j].y); a[3] = bfhi(x1[j].y); a[4] = bflo(x1[j].z); a[5] = bfhi(x1[j].z); a[6] = bflo(x1[j].w); a[7] = bfhi(x1[j].w);
                    b[0] = bflo(x2[j].x); b[1] = bfhi(x2[j].x); b[2] = bflo(x2[j].y); b[3] = bfhi(x2[j].y); b[4] = bflo(x2[j].z); b[5] = bfhi(x2[j].z); b[6] = bflo(x2[j].w); b[7] = bfhi(x2[j].w);
                    float o1[8], o2[8];
#pragma unroll
                    for (int i = 0; i < 8; ++i) { o1[i] = (a[i] * cs[i] - b[i] * sn[i]) * sc; o2[i] = (b[i] * cs[i] + a[i] * sn[i]) * sc; }
                    bf16_t* dst = (isk ? KR : QR) + (size_t)t * 2304 + hh * 128 + 8 * c8;
                    u32x4 w1, w2; w1.x = cvt_pk_bf16(o1[0], o1[1]); w1.y = cvt_pk_bf16(o1[2], o1[3]); w1.z = cvt_pk_bf16(o1[4], o1[5]); w1.w = cvt_pk_bf16(o1[6], o1[7]);
                    w2.x = cvt_pk_bf16(o2[0], o2[1]); w2.y = cvt_pk_bf16(o2[2], o2[3]); w2.z = cvt_pk_bf16(o2[4], o2[5]); w2.w = cvt_pk_bf16(o2[6], o2[7]);
                    *(u32x4*)dst = w1; *(u32x4*)(dst + 64) = w2; }
            }
        }
    }
    for (int rep = 0; rep < 1 + (p.pad == 4); ++rep) {
        bf16_t* YD = (bf16_t*)(p.ws + WS_YBR) + (size_t)3 * T * 768;
        const bf16_t* PWT = (const bf16_t*)(p.ws + WS_PWT) + (size_t)L * 4 * 192 * 192;
        LAS unsigned char* pim = c.lds;
        const int m = lane & 15, q = lane >> 4;
        for (int tile = c.bid; tile < T / 32; tile += c.G) {
            const int t0 = tile * 32;
            for (int it = c.tid; it < 32 * 96; it += NTHREADS) { const int rr = it / 96, c8 = it - rr * 96, t = t0 + rr, g = c8 / 24, w = 2 << g, cnt = (t + 1) < w ? (t + 1) : w;
                float sacc[8];
#pragma unroll
                for (int i = 0; i < 8; ++i) sacc[i] = 0.f;
                const bf16_t* up = U + (size_t)t * NU + UC_D + 8 * c8; u32x4 x0 = (u32x4){0u, 0u, 0u, 0u};
#pragma unroll
                for (int d = 0; d < 16; ++d) { if (d >= cnt) break; const u32x4 xv = *(const u32x4*)(up - (size_t)d * NU); if (d == 0) x0 = xv;
                    sacc[0] += bflo(xv.x); sacc[1] += bfhi(xv.x); sacc[2] += bflo(xv.y); sacc[3] += bfhi(xv.y); sacc[4] += bflo(xv.z); sacc[5] += bfhi(xv.z); sacc[6] += bflo(xv.w); sacc[7] += bfhi(xv.w); }
                const float ic = 1.0f / (float)cnt; u32x4 o;
                o.x = cvt_pk_bf16(sacc[0] * ic - bflo(x0.x), sacc[1] * ic - bfhi(x0.x)); o.y = cvt_pk_bf16(sacc[2] * ic - bflo(x0.y), sacc[3] * ic - bfhi(x0.y));
                o.z = cvt_pk_bf16(sacc[4] * ic - bflo(x0.z), sacc[5] * ic - bfhi(x0.z)); o.w = cvt_pk_bf16(sacc[6] * ic - bflo(x0.w), sacc[7] * ic - bfhi(x0.w));
                *(LAS u32x4*)(pim + rr * 1536 + ((c8 ^ (rr & 15)) << 4)) = o; }
            __syncthreads();
            f32x4 pa0[6], pa1[6];
#pragma unroll
            for (int pr = 0; pr < 6; ++pr) { const int pair = c.wave * 6 + pr, g = pair / 12, ntl = pair - g * 12;
                f32x4 acc0 = (f32x4){0.f, 0.f, 0.f, 0.f}, acc1 = (f32x4){0.f, 0.f, 0.f, 0.f};
                const bf16_t* bp = PWT + (size_t)(g * 192 + 16 * ntl + m) * 192 + 8 * q;
#pragma unroll
                for (int s6 = 0; s6 < 6; ++s6) { const bf16x8 bv = *(const bf16x8*)(bp + 32 * s6); const int ch = g * 24 + 4 * s6 + q;
                    const bf16x8 a0v = *(const LAS bf16x8*)(pim + m * 1536 + ((ch ^ m) << 4)), a1v = *(const LAS bf16x8*)(pim + (16 + m) * 1536 + ((ch ^ m) << 4));
                    acc0 = __builtin_amdgcn_mfma_f32_16x16x32_bf16(a0v, bv, acc0, 0, 0, 0); acc1 = __builtin_amdgcn_mfma_f32_16x16x32_bf16(a1v, bv, acc1, 0, 0, 0); }
                pa0[pr] = acc0; pa1[pr] = acc1; }
#pragma unroll
            for (int pr = 0; pr < 6; ++pr) { const int pair = c.wave * 6 + pr, g = pair / 12, ntl = pair - g * 12;
                bf16_t* yp = YD + (size_t)(t0 + 4 * q) * 768 + g * 192 + 16 * ntl + m;
#pragma unroll
                for (int jj = 0; jj < 4; ++jj) { yp[(size_t)jj * 768] = f2bf(pa0[pr][jj]); yp[(size_t)(16 + jj) * 768] = f2bf(pa1[pr][jj]); } }
            __syncthreads();
        }
    }
}

__device__ __forceinline__ unsigned off_b(unsigned row, unsigned ch) { return 256u * row + 16u * (ch ^ (((row & 3) << 2) | ((row >> 2) & 3))); }
#define ATT_PV4(OFF, A, DT0) do { \
    _Pragma("unroll") for (int i4 = 0; i4 < 4; ++i4) { \
        const bf16x8 vt = tr_pair(Vs + (vb0 + 32u * (unsigned)(((DT0) + i4) ^ cm0) + (OFF)), Vs + (vb1 + 32u * (unsigned)(((DT0) + i4) ^ cm1) + (OFF))); \
        O[(DT0) + i4] = __builtin_amdgcn_mfma_f32_16x16x32_bf16(vt, Pb[A], O[(DT0) + i4], 0, 0, 0); } } while (0)
#define ATT_PV(OFF, A) do { ATT_PV4(OFF, A, 0); ATT_PV4(OFF, A, 4); } while (0)
struct AttnRegs { u32x4 kv[8], vv[8]; bf16x8 Qb[4]; };
__device__ __forceinline__ void attn_issue_k(const Ctx& c, const Params& p, int u, AttnRegs& r) {
    const int h = u % 6, rbi = (u / 6) & 63, g = u / 384;
    const int dl = g == 0 ? 1 : (g == 1 ? 4 : 16), nb = 64 / dl, rs = rbi / nb, b = rbi % nb, gh = g * 6 + h;
    const bf16_t* KR = (const bf16_t*)(p.ws + WS_KR);
#pragma unroll
    for (int it = 0; it < 8; ++it) { const int pc = c.tid + 512 * it, j = pc >> 4, ch = pc & 15, pos = 128 * (b - 1) + j;
        r.kv[it] = (u32x4){0u, 0u, 0u, 0u};
        if (pos >= 0) { const size_t t = (size_t)pos * dl + rs; r.kv[it] = *(const u32x4*)(KR + t * 2304 + gh * 128 + 8 * ch); } }
}
__device__ __forceinline__ void attn_issue_vq(const Ctx& c, const Params& p, int u, AttnRegs& r) {
    const int h = u % 6, rbi = (u / 6) & 63, g = u / 384;
    const int dl = g == 0 ? 1 : (g == 1 ? 4 : 16), nb = 64 / dl, rs = rbi / nb, b = rbi % nb, gh = g * 6 + h;
    const bf16_t* U = (const bf16_t*)(p.ws + WS_U); const bf16_t* QR = (const bf16_t*)(p.ws + WS_QR);
    const int lane = c.lane, n = lane & 15, qd = lane >> 4;
#pragma unroll
    for (int it = 0; it < 8; ++it) { const int pc = c.tid + 512 * it, j = pc >> 4, ch = pc & 15, pos = 128 * (b - 1) + j;
        r.vv[it] = (u32x4){0u, 0u, 0u, 0u};
        if (pos >= 0) { const size_t t = (size_t)pos * dl + rs; r.vv[it] = *(const u32x4*)(U + t * NU + UC_C + 4608 + gh * 128 + 8 * ch); } }
    const int iq = 16 * c.wave + n; const size_t tq = (size_t)(128 * b + iq) * dl + rs;
#pragma unroll
    for (int s = 0; s < 4; ++s) r.Qb[s] = *(const bf16x8*)(QR + tq * 2304 + gh * 128 + 32 * s + 8 * qd);
}
__device__ __forceinline__ void attn_stage(const Ctx& c, const AttnRegs& r) {
    LAS unsigned char* Ks = c.lds; LAS unsigned char* Vs = c.lds + 65536;
#pragma unroll
    for (int it = 0; it < 8; ++it) { const int pc = c.tid + 512 * it, j = pc >> 4, ch = pc & 15;
        *(LAS u32x4*)(Ks + off_b(j, ch)) = r.kv[it]; *(LAS u32x4*)(Vs + off_b((j & ~31) + invperm32(j & 31), ch)) = r.vv[it]; }
}
__device__ __forceinline__ void attn_compute(const Ctx& c, const Params& p, int u, AttnRegs& ar, int un) {
    const int h = u % 6, rbi = (u / 6) & 63, g = u / 384;
    const int dl = g == 0 ? 1 : (g == 1 ? 4 : 16), nb = 64 / dl, r = rbi / nb, b = rbi % nb;
    LAS unsigned char* Ks = c.lds; LAS unsigned char* Vs = c.lds + 65536;
    const int lane = c.lane, n = lane & 15, qd = lane >> 4;
    const int iq = 16 * c.wave + n;
    const size_t tq = (size_t)(128 * b + iq) * dl + r;
    const int f = c.wave & ~1;
    f32x4 S[10];
    {
        const unsigned mask = ((n & 3) << 2) | ((n >> 2) & 3);
        unsigned ka[4];
#pragma unroll
        for (int s = 0; s < 4; ++s) ka[s] = 256u * n + 16u * ((4 * s + qd) ^ mask) + (unsigned)f * 4096u;
#pragma unroll
        for (int jj = 0; jj < 10; ++jj) { f32x4 acc = (f32x4){0.f, 0.f, 0.f, 0.f};
#pragma unroll
            for (int s = 0; s < 4; ++s) acc = __builtin_amdgcn_mfma_f32_16x16x32_bf16(*(const LAS bf16x8*)(Ks + ka[s] + jj * 4096), ar.Qb[s], acc, 0, 0, 0);
            S[jj] = acc; }
    }
    float mx = -INFINITY;
#pragma unroll
    for (int jj = 0; jj < 10; ++jj)
#pragma unroll
        for (int e = 0; e < 4; ++e) { const int j = 16 * (f + jj) + 4 * qd + e; const bool ok = (j >= iq) && (j <= iq + 128) && (b > 0 || j >= 128);
            S[jj][e] = ok ? S[jj][e] : -INFINITY; mx = fmaxf(mx, S[jj][e]); }
    mx = fmaxf(mx, shx(mx, 16, lane)); mx = fmaxf(mx, shx(mx, 32, lane));
    float l = 0.f;
#pragma unroll
    for (int jj = 0; jj < 10; ++jj)
#pragma unroll
        for (int e = 0; e < 4; ++e) { const float pv = __expf(S[jj][e] - mx); S[jj][e] = pv; l += pv; }
    l += shx(l, 16, lane); l += shx(l, 32, lane);
    bf16x8 Pb[5];
#pragma unroll
    for (int a = 0; a < 5; ++a) Pb[a] = pack_bf16x8(S[2 * a], S[2 * a + 1]);
    if (un < 1152) attn_issue_vq(c, p, un, ar);
    f32x4 O[8];
#pragma unroll
    for (int dt = 0; dt < 8; ++dt) O[dt] = (f32x4){0.f, 0.f, 0.f, 0.f};
    {
        const unsigned q = (lane & 15) >> 2, pp = lane & 3;
        const unsigned m0 = (q << 2) | ((2 * qd + 0) & 3), m1 = (q << 2) | ((2 * qd + 1) & 3);
        const unsigned cm0 = m0 >> 1, cm1 = m1 >> 1;
        const unsigned vbase = (unsigned)(f >> 1) * 8192u + 8u * (pp & 1);
        const unsigned vb0 = vbase + 256u * (8 * qd + 0 + q) + 16u * ((pp >> 1) ^ (m0 & 1)), vb1 = vbase + 256u * (8 * qd + 4 + q) + 16u * ((pp >> 1) ^ (m1 & 1));
        ATT_PV(0, 0); ATT_PV(8192, 1); ATT_PV(16384, 2); ATT_PV(24576, 3); ATT_PV(32768, 4);
    }
    {
        const float il = 1.0f / l;
        bf16_t* op = (bf16_t*)(p.ws + WS_ATTO) + ((size_t)g * T + tq) * 768 + h * 128 + 4 * qd;
#pragma unroll
        for (int dt = 0; dt < 8; ++dt) { u32x2 w; w.x = cvt_pk_bf16(O[dt][0] * il, O[dt][1] * il); w.y = cvt_pk_bf16(O[dt][2] * il, O[dt][3] * il); *(u32x2*)(op + 16 * dt) = w; }
        if (qd == 0) ((float*)(p.ws + WS_LSE))[((size_t)g * T + tq) * 8 + h] = mx + logf(l);
    }
}

struct GateOrder {
    int Gn, j;
    __device__ bool next(int i, pg8::Unit& u) const { const int id = i * Gn + j; if (id >= 1024) return false; u.pm = id & 31; u.pn = 48 + (id >> 5); return true; }
    __device__ __forceinline__ int arow(const pg8::Unit& u, int r) const { return u.pm * 256 + r; }
};
__device__ __forceinline__ void phase_attn_gdn(const Ctx& c, const Params& p, int L) {
    const bf16_t* U = (const bf16_t*)(p.ws + WS_U);
    const int lane = c.lane;
    const int nrec = (c.G >= 24) ? 12 : 0;
    if (nrec) { if (c.bid < nrec) { gdn_scan(c, p, c.bid);
            return; } }
    else { for (int h = c.bid; h < 12; h += c.G) gdn_scan(c, p, h); }
    {
        const int Gn = c.G - nrec, j = c.bid - nrec, heavy = (Gn > 0 && Gn < 1024) ? (1024 % Gn) : 0, na = Gn - heavy;
        for (int rep = 0; rep < 1 + (p.pad == 5); ++rep) {
            int u = 1152, us = 1;
            if (na > 0) { if (j >= heavy) { u = j - heavy; us = na; } } else { u = j; us = Gn; }
            AttnRegs ar;
            if (u < 1152) { attn_issue_k(c, p, u, ar); attn_issue_vq(c, p, u, ar); }
            while (u < 1152) {
                attn_stage(c, ar);
                __syncthreads();
                const int un = u + us;
                if (un < 1152) attn_issue_k(c, p, un, ar);
                attn_compute(c, p, u, ar, un);
                __syncthreads();
                u = un;
            }
        }
    }
    for (int rep = 0; rep < 1 + (p.pad == 6); ++rep) {
        pg8::Gemm g{(const bf16_t*)(p.ws + WS_H), (const bf16_t*)(p.ws + WS_WINT) + (size_t)L * NU * D, D}; GateOrder S{c.G - nrec, c.bid - nrec};
        EpiU E{(bf16_t*)(p.ws + WS_U)}; pg8::gemm_phase<EpiU, GateOrder, false>(c.lds, g, S, E);
    }
}

__device__ __forceinline__ void phase_combine(const Ctx& c, const Params& p, int L) {
    const bf16_t* U = (const bf16_t*)(p.ws + WS_U); const bf16_t* AO = (const bf16_t*)(p.ws + WS_ATTO); const float* LSE = (const float*)(p.ws + WS_LSE);
    const bf16_t* OG = (const bf16_t*)(p.ws + WS_OGDN); bf16_t* YA = (bf16_t*)(p.ws + WS_YBR); bf16_t* YC = YA + (size_t)2 * T * 768;
    const float* gn = p.gdn_norm_g + L * 128; const int lane = c.lane;
    for (int it0 = (c.bid * 8 + c.wave) * 4; it0 < T * 6; it0 += c.G * 8 * 4) {
        float l0[4], l1[4], l2[4]; unsigned a0[4], a1[4], a2[4], z2[4]; float2 og[4]; size_t o[4];
#pragma unroll
        for (int i = 0; i < 4; ++i) { const int it = it0 + i, t = it / 6, h = it % 6; o[i] = (size_t)t * 768 + h * 128 + 2 * lane;
            l0[i] = LSE[(size_t)t * 8 + h]; l1[i] = LSE[((size_t)T + t) * 8 + h]; l2[i] = LSE[((size_t)2 * T + t) * 8 + h];
            a0[i] = *(const unsigned*)(AO + o[i]); a1[i] = *(const unsigned*)(AO + (size_t)T * 768 + o[i]); a2[i] = *(const unsigned*)(AO + (size_t)2 * T * 768 + o[i]);
            { const unsigned ow = *(const unsigned*)(OG + o[i]); og[i] = make_float2(bflo(ow), bfhi(ow)); } z2[i] = *(const unsigned*)(U + (size_t)t * NU + UC_Z + h * 128 + 2 * lane); }
#pragma unroll
        for (int i = 0; i < 4; ++i) {
            const float mx = fmaxf(l0[i], fmaxf(l1[i], l2[i])); const float e0 = __expf(l0[i] - mx), e1 = __expf(l1[i] - mx), e2 = __expf(l2[i] - mx); const float is = 1.0f / (e0 + e1 + e2);
            *(unsigned*)(YC + o[i]) = cvt_pk_bf16((e0 * bflo(a0[i]) + e1 * bflo(a1[i]) + e2 * bflo(a2[i])) * is, (e0 * bfhi(a0[i]) + e1 * bfhi(a1[i]) + e2 * bfhi(a2[i])) * is);
            const float ss = wave_sum(og[i].x * og[i].x + og[i].y * og[i].y, lane); const float r = rsqrtf(ss * (1.0f / 128.f) + 1e-6f);
            *(unsigned*)(YA + o[i]) = cvt_pk_bf16(og[i].x * r * gn[2 * lane] * siluf_(bflo(z2[i])), og[i].y * r * gn[2 * lane + 1] * siluf_(bfhi(z2[i]))); }
    }
}

__device__ __forceinline__ void phase_norm2_router(const Ctx& c, const Params& p, int L) {
    const float* XB = (const float*)(p.ws + WS_XB); bf16_t* H = (bf16_t*)(p.ws + WS_H); const float* g2 = p.norm2_g + L * D;
    const bf16_t* WH = (const bf16_t*)(p.ws + WS_WRT) + (size_t)L * 2 * 80 * 2048; const bf16_t* WL = WH + 80 * 2048;
    unsigned* cnt = (unsigned*)(p.ws + WS_CTL + CTL_CNT) + L * 64; int* TOK = (int*)(p.ws + WS_TOK); float* WTS = (float*)(p.ws + WS_WSL);
    LAS float* lgp = (LAS float*)c.lds;
    LAS float* ssp = (LAS float*)c.lds + 2 * 4 * 16 * 80;
    const int lane = c.lane, m = lane & 15, q = lane >> 4, tl = c.wave >> 2, kq = c.wave & 3;
    for (int tp = c.bid; tp < T / 32; tp += c.G) {
        const int task = tp * 2 + tl;
        const int t = task * 16 + m; const float* xr = XB + (size_t)t * D + 512 * kq + 8 * q; const float* gr = g2 + 512 * kq + 8 * q;
        float ss = 0.f;
#pragma unroll 8
        for (int s = 0; s < 16; ++s) { const float4 a = *(const float4*)(xr + 32 * s), b = *(const float4*)(xr + 32 * s + 4);
            ss += a.x * a.x + a.y * a.y + a.z * a.z + a.w * a.w + b.x * b.x + b.y * b.y + b.z * b.z + b.w * b.w; }
        ss += shx(ss, 16, lane); ss += shx(ss, 32, lane);
        if (q == 0) ssp[(tl * 4 + kq) * 16 + m] = ss;
        __syncthreads();
        ss = ssp[(tl * 4 + 0) * 16 + m] + ssp[(tl * 4 + 1) * 16 + m] + ssp[(tl * 4 + 2) * 16 + m] + ssp[(tl * 4 + 3) * 16 + m];
        const float rstd = rsqrtf(ss * (1.0f / D) + 1e-6f);
        f32x4 acc[5];
#pragma unroll
        for (int nt = 0; nt < 5; ++nt) acc[nt] = (f32x4){0.f, 0.f, 0.f, 0.f};
        float4 na = *(const float4*)(xr), nb = *(const float4*)(xr + 4), nga = *(const float4*)(gr), ngb = *(const float4*)(gr + 4);
        bf16x8 nbh[5], nbl[5];
#pragma unroll
        for (int nt = 0; nt < 5; ++nt) { const size_t wo = (size_t)(16 * nt + m) * 2048 + 512 * kq + 8 * q; nbh[nt] = *(const bf16x8*)(WH + wo); nbl[nt] = *(const bf16x8*)(WL + wo); }
        for (int s = 0; s < 16; ++s) {
            const float4 a = na, b = nb, ga = nga, gb = ngb; bf16x8 bh[5], bl[5];
#pragma unroll
            for (int nt = 0; nt < 5; ++nt) { bh[nt] = nbh[nt]; bl[nt] = nbl[nt]; }
            if (s + 1 < 16) { const int s1 = s + 1;
                na = *(const float4*)(xr + 32 * s1); nb = *(const float4*)(xr + 32 * s1 + 4); nga = *(const float4*)(gr + 32 * s1); ngb = *(const float4*)(gr + 32 * s1 + 4);
#pragma unroll
                for (int nt = 0; nt < 5; ++nt) { const size_t wo = (size_t)(16 * nt + m) * 2048 + 512 * kq + 32 * s1 + 8 * q; nbh[nt] = *(const bf16x8*)(WH + wo); nbl[nt] = *(const bf16x8*)(WL + wo); } }
            float h[8]; h[0] = a.x * rstd * ga.x; h[1] = a.y * rstd * ga.y; h[2] = a.z * rstd * ga.z; h[3] = a.w * rstd * ga.w; h[4] = b.x * rstd * gb.x; h[5] = b.y * rstd * gb.y; h[6] = b.z * rstd * gb.z; h[7] = b.w * rstd * gb.w;
            u32x4 hi; hi.x = cvt_pk_bf16(h[0], h[1]); hi.y = cvt_pk_bf16(h[2], h[3]); hi.z = cvt_pk_bf16(h[4], h[5]); hi.w = cvt_pk_bf16(h[6], h[7]);
            u32x4 lo; lo.x = cvt_pk_bf16(h[0] - bflo(hi.x), h[1] - bfhi(hi.x)); lo.y = cvt_pk_bf16(h[2] - bflo(hi.y), h[3] - bfhi(hi.y));
            lo.z = cvt_pk_bf16(h[4] - bflo(hi.z), h[5] - bfhi(hi.z)); lo.w = cvt_pk_bf16(h[6] - bflo(hi.w), h[7] - bfhi(hi.w));
            const bf16x8 ah = __builtin_bit_cast(bf16x8, hi), al = __builtin_bit_cast(bf16x8, lo);
#pragma unroll
            for (int nt = 0; nt < 5; ++nt) {
                acc[nt] = __builtin_amdgcn_mfma_f32_16x16x32_bf16(ah, bh[nt], acc[nt], 0, 0, 0);
                acc[nt] = __builtin_amdgcn_mfma_f32_16x16x32_bf16(ah, bl[nt], acc[nt], 0, 0, 0);
                acc[nt] = __builtin_amdgcn_mfma_f32_16x16x32_bf16(al, bh[nt], acc[nt], 0, 0, 0); }
            *(u32x4*)(H + (size_t)t * D + 512 * kq + 32 * s + 8 * q) = hi;
        }
        LAS float* lgw = lgp + (tl * 4 + kq) * (16 * 80);
#pragma unroll
        for (int nt = 0; nt < 5; ++nt)
#pragma unroll
            for (int jj = 0; jj < 4; ++jj) lgw[(4 * q + jj) * 80 + 16 * nt + m] = acc[nt][jj];
        __syncthreads();
        if (kq == 0) {
            for (int i = lane; i < 16 * 80; i += 64) lgw[i] = lgw[i] + lgw[i + 16 * 80] + lgw[i + 2 * 16 * 80] + lgw[i + 3 * 16 * 80];
            asm volatile("s_waitcnt lgkmcnt(0)" ::: "memory");
        }
        if (kq == 0)
        if (lane < 16) {
            const int tt = task * 16 + lane; const LAS float* l = lgw + lane * 80;
            float gl[8]; float gm = -INFINITY; int gi = 0;
#pragma unroll
            for (int j = 0; j < 8; ++j) { gl[j] = l[j] + p.rg_b[L * 8 + j]; if (gl[j] > gm) { gm = gl[j]; gi = j; } }
            float gs = 0.f;
#pragma unroll
            for (int j = 0; j < 8; ++j) gs += expf(gl[j] - gm);
            const float gp = 1.0f / gs;
            float el[8]; float em = -INFINITY; int i1 = 0;
#pragma unroll
            for (int j = 0; j < 8; ++j) { el[j] = l[8 + gi * 8 + j] + p.re_b[L * 64 + gi * 8 + j]; if (el[j] > em) { em = el[j]; i1 = j; } }
            float e2m = -INFINITY; int i2 = 0;
#pragma unroll
            for (int j = 0; j < 8; ++j) { if (j != i1 && el[j] > e2m) { e2m = el[j]; i2 = j; } }
            const float p2 = expf(e2m - em);
            const float w1 = gp / (1.0f + p2), w2 = gp * p2 / (1.0f + p2);
            const int e1 = gi * 8 + i1, e2 = gi * 8 + i2;
            const unsigned q1 = atomicAdd(&cnt[e1], 1u); TOK[e1 * 8192 + q1] = tt * 2; WTS[e1 * 8192 + q1] = w1;
            const unsigned q2 = atomicAdd(&cnt[e2], 1u); TOK[e2 * 8192 + q2] = tt * 2 + 1; WTS[e2 * 8192 + q2] = w2;
        }
        __syncthreads();
    }
}

__device__ __forceinline__ MoeTab moe_tables(const Ctx& c, const Params& p, int L, int nN) {
    LAS int* base = (LAS int*)(c.lds + LDS_MISC + 1024);
    LAS int* mt_e = base, * mt_p0 = base + 192, * cn = base + 384, * nm = base + 448, * first = base + 452, * ut = base + 520;
    const unsigned* cnt = (const unsigned*)(p.ws + WS_CTL + CTL_CNT) + L * 64;
    __syncthreads();
    if (c.tid < 64) cn[c.tid] = (int)cnt[c.tid];
    __syncthreads();
    if (c.tid == 0) { int n = 0; for (int e = 0; e < 64; ++e) { first[e] = n; const int ntile = (cn[e] + 127) >> 7; for (int i = 0; i < ntile; ++i) { mt_e[n] = e; mt_p0[n] = i * 128; ++n; } } nm[0] = n; }
    __syncthreads();
    if (c.tid < 64) { const int e = c.tid, f0 = first[e], ntile = (cn[e] + 127) >> 7; int o = f0 * nN;
        for (int j = 0; j < nN; ++j) for (int m = 0; m < ntile; ++m) ut[o++] = ((f0 + m) << 4) | j; }
    else if (c.tid < 128) { const int e = c.tid - 64, f0 = first[e], ntile = (cn[e] + 127) >> 7; int o = 768 + f0 * 8;
        for (int j = 0; j < 8; ++j) for (int m = 0; m < ntile; ++m) ut[o++] = ((f0 + m) << 4) | j; }
    __syncthreads();
    MoeTab tb; tb.mt_e = mt_e; tb.mt_p0 = mt_p0; tb.cnt = cn; tb.ut = ut; tb.nmt = nm[0]; return tb;
}

__device__ __forceinline__ void phase_final(const Ctx& c, const Params& p) {
    const float* XB = (const float*)(p.ws + WS_XB); const bf16_t* Y = (const bf16_t*)(p.ws + WS_YMOE);
    for (int t = c.bid * 8 + c.wave; t < T; t += c.G * 8) {
        float4 xv[8]; float ss = 0.f;
#pragma unroll
        for (int q = 0; q < 8; ++q) { const int col = q * 256 + c.lane * 4;
            const float4 a = *(const float4*)(XB + (size_t)t * D + col); const u32x2 y0 = *(const u32x2*)(Y + (size_t)(2 * t) * D + col), y1 = *(const u32x2*)(Y + (size_t)(2 * t + 1) * D + col);
            float4 v; v.x = a.x + (bflo(y0.x) + bflo(y1.x)); v.y = a.y + (bfhi(y0.x) + bfhi(y1.x)); v.z = a.z + (bflo(y0.y) + bflo(y1.y)); v.w = a.w + (bfhi(y0.y) + bfhi(y1.y));
            xv[q] = v; ss += v.x * v.x + v.y * v.y + v.z * v.z + v.w * v.w; }
        const float rstd = rsqrtf(wave_sum(ss, c.lane) * (1.0f / D) + 1e-6f);
#pragma unroll
        for (int q = 0; q < 8; ++q) { const int col = q * 256 + c.lane * 4; const float4 g = *(const float4*)(p.final_g + col);
            float4 o; o.x = xv[q].x * rstd * g.x; o.y = xv[q].y * rstd * g.y; o.z = xv[q].z * rstd * g.z; o.w = xv[q].w * rstd * g.w;
            *(float4*)(p.out + (size_t)t * D + col) = o; }
    }
}

constexpr int NPH_LAYER = 10, NPHASES = 1 + NL * NPH_LAYER + 1;
static_assert(NL == 2, "LAYER_BODY is instantiated twice");
#define LAYER_BODY(L) {         const int b = 1 + L * NPH_LAYER; \
        if (PHON(1) && IN(b + 0)) { for (int rep = 0; rep < 1 + PROBED(b + 0); ++rep) { FRESH(); phase_norm1(c, p, L); } SEAM(b + 0); } \
        if (PHON(2) && IN(b + 1)) { for (int rep = 0; rep < 1 + PROBED(b + 1); ++rep) { FRESH(); \
            pg8::Gemm g{(const bf16_t*)(p.ws + WS_H), (const bf16_t*)(p.ws + WS_WINT) + (size_t)L * NU * D, D}; pg8::StaticOrder S; S.init(T, UC_G, c.G, c.bid); \
            EpiU E{(bf16_t*)(p.ws + WS_U)}; pg8::gemm_phase<EpiU, pg8::StaticOrder, false>(c.lds, g, S, E); } SEAM(b + 1); } \
        if (PHON(3) && IN(b + 2)) { for (int rep = 0; rep < 1 + PROBED(b + 2); ++rep) { FRESH(); phase_local(c, p, L); } SEAM(b + 2); } \
        if (PHON(4) && IN(b + 3)) { for (int rep = 0; rep < 1 + PROBED(b + 3); ++rep) { FRESH(); phase_attn_gdn(c, p, L); } SEAM(b + 3); } \
        if (PHON(5) && IN(b + 4)) { for (int rep = 0; rep < 1 + PROBED(b + 4); ++rep) { FRESH(); phase_combine(c, p, L); } SEAM(b + 4); } \
        if (PHON(6) && IN(b + 5)) { for (int rep = 0; rep < 1 + PROBED(b + 5); ++rep) { FRESH(); \
            pg8::Gemm g{(const bf16_t*)(p.ws + WS_YBR), (const bf16_t*)(p.ws + WS_WBRT) + (size_t)L * 4 * D * 768, 768}; MergeOrder S{c.G, c.bid}; \
            EpiMerge E{(const bf16_t*)(p.ws + WS_U), (float*)(p.ws + WS_M32), (bf16_t*)(p.ws + WS_MERGED)}; pg8::gemm_phase<EpiMerge, MergeOrder, false>(c.lds, g, S, E); } SEAM(b + 5); } \
        if (PHON(7) && IN(b + 6)) { for (int rep = 0; rep < 1 + PROBED(b + 6); ++rep) { FRESH(); \
            pg8::Gemm g{(const bf16_t*)(p.ws + WS_MERGED), (const bf16_t*)(p.ws + WS_WOUTT) + (size_t)L * D * D, D}; pg8::StaticOrder S; S.init(T, D, c.G, c.bid); \
            EpiRes E{L == 0 ? p.x : (const float*)(p.ws + WS_XA), (float*)(p.ws + WS_XB)}; pg8::gemm_phase<EpiRes, pg8::StaticOrder, false>(c.lds, g, S, E); } SEAM(b + 6); } \
        if (PHON(8) && IN(b + 7)) { FRESH(); phase_norm2_router(c, p, L); SEAM(b + 7); } \
        if (PHON(9) && IN(b + 8)) { FRESH(); \
            const MoeTab tb = moe_tables(c, p, L, 4); \
            unsigned* mtd = (unsigned*)(p.ws + WS_CTL + CTL_MTDONE) + L * 192; unsigned* qh = (unsigned*)(p.ws + WS_CTL + CTL_QHEAD) + L * 128; \
            { MoeOrder S{tb, 4, c.G, c.bid, (const int*)(p.ws + WS_TOK), mtd}; \
              EpiUp E{(bf16_t*)(p.ws + WS_HID)}; moe_gemm<EpiUp, true, MoeOrder>(c, (const bf16_t*)(p.ws + WS_H), p.w_up + (size_t)L * NE * D * 1024, S, E); } \
            { MoeTab tb2 = tb; tb2.ut = tb.ut + 768; LAS int* slot = (LAS int*)(c.lds + LDS_MISC + 768); if (c.tid == 0) slot[1] = 0; \
              MoeDownQueue S{tb2, 8, c.G, c.bid, qh, mtd, slot, (const int*)(p.ws + WS_TOK)}; \
              EpiDown E{tb, (const int*)(p.ws + WS_TOK), (const float*)(p.ws + WS_WSL), (bf16_t*)(p.ws + WS_YMOE)}; moe_gemm<EpiDown, false, MoeDownQueue>(c, (const bf16_t*)(p.ws + WS_HID), p.w_down + (size_t)L * NE * EH * D, S, E); } \
            SEAM(b + 8); } \
 }
__global__ void __launch_bounds__(NTHREADS, 2) fwd(Params p0) {
    extern __shared__ __attribute__((aligned(16))) unsigned char lds_raw[];
    Ctx c; c.tid = threadIdx.x; c.lane = c.tid & 63; c.wave = __builtin_amdgcn_readfirstlane(c.tid >> 6); c.bid = blockIdx.x; c.G = gridDim.x; c.lds = (LAS unsigned char*)lds_raw;
    volatile LAS unsigned* misc = (volatile LAS unsigned*)(c.lds + LDS_MISC);
    if (c.tid < 4) misc[c.tid] = 0u;
    if (c.tid == 0) {
        LAS unsigned long long* tab = (LAS unsigned long long*)(c.lds + LDS_PTAB);
        tab[0] = (unsigned long long)p0.x; tab[1] = (unsigned long long)p0.pos; tab[2] = (unsigned long long)p0.norm1_g; tab[3] = (unsigned long long)p0.w_in; tab[4] = (unsigned long long)p0.conv_a_w;
        tab[5] = (unsigned long long)p0.a_log; tab[6] = (unsigned long long)p0.dt_bias; tab[7] = (unsigned long long)p0.gdn_norm_g; tab[8] = (unsigned long long)p0.conv_b_w; tab[9] = (unsigned long long)p0.conv_b_b;
        tab[10] = (unsigned long long)p0.ln_b_g; tab[11] = (unsigned long long)p0.ln_b_b; tab[12] = (unsigned long long)p0.pool_w; tab[13] = (unsigned long long)p0.pool_scale; tab[14] = (unsigned long long)p0.w_branch;
        tab[15] = (unsigned long long)p0.w_out; tab[16] = (unsigned long long)p0.norm2_g; tab[17] = (unsigned long long)p0.rg_w; tab[18] = (unsigned long long)p0.rg_b; tab[19] = (unsigned long long)p0.re_w;
        tab[20] = (unsigned long long)p0.re_b; tab[21] = (unsigned long long)p0.w_up; tab[22] = (unsigned long long)p0.w_down; tab[23] = (unsigned long long)p0.final_g; tab[24] = (unsigned long long)p0.out;
    }
    __syncthreads();
    const int lo = p0.ph_lo, hi = p0.ph_hi, probe = p0.probe, psub = p0.pad; unsigned char* const wsb = p0.ws;
    const bool multi = (hi - lo) > 1;
    XcdBarrier bar; bar.bar = (unsigned*)(wsb + WS_CTL); bar.x = 0; bar.st = misc;
    if (multi) bar = xcd_barrier_post((unsigned*)(wsb + WS_CTL), misc);
#if MK_ONE_LAUNCH
#define IN(k) true
#else
#define IN(k) (lo <= (k) && (k) < hi)
#endif
#define PROBED(k) (PROBE_PHASE >= 0 && probe == (k))
#define FRESH() int _t = threadIdx.x; asm volatile("" : "+v"(_t)); c.tid = _t; c.lane = _t & 63; \
    { int _b = blockIdx.x, _g = gridDim.x, _w = __builtin_amdgcn_readfirstlane(_t >> 6); asm volatile("" : "+s"(_b), "+s"(_g), "+s"(_w)); c.bid = _b; c.G = _g; c.wave = _w; } \
    unsigned char* _ws = wsb; asm volatile("" : "+s"(_ws)); Params p = load_params(c, _ws, lo, hi); p.pad = psub
#define SEAM(k) do { if (IN((k) + 1)) { XcdBarrier _bb; _bb.bar = (unsigned*)(wsb + WS_CTL); _bb.x = xb_xcc_id(); _bb.st = misc; asm volatile("" : "+s"(_bb.bar)); xcd_barrier(_bb); } } while (0)
#ifndef PHMASK
#define PHMASK 0xFFFFF
#endif
#define PHON(k) ((PHMASK >> (k)) & 1)
    if (PHON(0) && IN(0)) { for (int rep = 0; rep < 1 + PROBED(0); ++rep) { FRESH(); phase_convert(c, p); } SEAM(0); }
    for (int L = 0; L < NL; ++L) LAYER_BODY(L)
    if (PHON(11) && IN(NPHASES - 1)) { FRESH(); phase_final(c, p); }
#undef IN
#undef SEAM
}

extern "C" void kernel_launch(void* const* d_in, const int* in_sizes, int n_in, void* d_out, int out_size, void* d_ws, size_t ws_size, hipStream_t stream) {
    static int grid = 0;
    if (grid == 0) {
        if (n_in != 24 || out_size != T * D || ws_size < WS_END) { fprintf(stderr, "kernel_launch: unexpected shapes (n_in %d, out %d, ws %zu < %zu)\n", n_in, out_size, ws_size, (size_t)WS_END); grid = -1; return; }
        int dev = 0, cus = 0, per_cu = 0;
        if (hipGetDevice(&dev) != hipSuccess || hipDeviceGetAttribute(&cus, hipDeviceAttributeMultiprocessorCount, dev) != hipSuccess) { grid = -1; return; }
        if (hipFuncSetAttribute((const void*)fwd, hipFuncAttributeMaxDynamicSharedMemorySize, LDS_BYTES) != hipSuccess) { fprintf(stderr, "kernel_launch: hipFuncSetAttribute failed\n"); grid = -1; return; }
        if (hipOccupancyMaxActiveBlocksPerMultiprocessor(&per_cu, (const void*)fwd, NTHREADS, LDS_BYTES) != hipSuccess || per_cu < 1) { fprintf(stderr, "kernel_launch: occupancy query says %d\n", per_cu); (void)hipGetLastError(); }
        grid = cus;
    }
    if (grid < 0) return;
    (void)hipMemsetAsync((char*)d_ws + WS_CTL, 0, CTL_BYTES, stream);
    Params p{};
    p.x = (const float*)d_in[0]; p.pos = (const int*)d_in[1]; p.norm1_g = (const float*)d_in[2]; p.w_in = (const float*)d_in[3]; p.conv_a_w = (const float*)d_in[4];
    p.a_log = (const float*)d_in[5]; p.dt_bias = (const float*)d_in[6]; p.gdn_norm_g = (const float*)d_in[7]; p.conv_b_w = (const float*)d_in[8]; p.conv_b_b = (const float*)d_in[9];
    p.ln_b_g = (const float*)d_in[10]; p.ln_b_b = (const float*)d_in[11]; p.pool_w = (const float*)d_in[12]; p.pool_scale = (const float*)d_in[13]; p.w_branch = (const float*)d_in[14];
    p.w_out = (const float*)d_in[15]; p.norm2_g = (const float*)d_in[16]; p.rg_w = (const float*)d_in[17]; p.rg_b = (const float*)d_in[18]; p.re_w = (const float*)d_in[19];
    p.re_b = (const float*)d_in[20]; p.w_up = (const float*)d_in[21]; p.w_down = (const float*)d_in[22]; p.final_g = (const float*)d_in[23];
    p.out = (float*)d_out; p.ws = (unsigned char*)d_ws; p.probe = PROBE_PHASE; p.pad = PROBE_SUB;
#if MK_ONE_LAUNCH
    p.ph_lo = 0; p.ph_hi = NPHASES;
    hipLaunchKernelGGL(fwd, dim3(grid), dim3(NTHREADS), LDS_BYTES, stream, p);
#else
    for (int ph = 0; ph < NPHASES; ++ph) { p.ph_lo = ph; p.ph_hi = ph + 1; hipLaunchKernelGGL(fwd, dim3(grid), dim3(NTHREADS), LDS_BYTES, stream, p); }
#endif
}
```

```cpp
#include <hip/hip_runtime.h>
#include <cstdio>
#include <cstdint>

#ifndef PROBE_SUB
#define PROBE_SUB 0
#endif
#ifndef PROBE_PHASE
#define PROBE_PHASE -1
#endif
#ifndef MK_ONE_LAUNCH
#define MK_ONE_LAUNCH 1
#endif

#define LAS __attribute__((address_space(3)))
#define GAS __attribute__((address_space(1)))
typedef unsigned short bf16_t;
typedef short bf16x8 __attribute__((ext_vector_type(8)));
typedef float f32x4 __attribute__((ext_vector_type(4)));
typedef unsigned u32x4 __attribute__((ext_vector_type(4)));
typedef unsigned u32x2 __attribute__((ext_vector_type(2)));
typedef short s16x4 __attribute__((ext_vector_type(4)));
typedef float f32x2 __attribute__((ext_vector_type(2)));

constexpr int T = 8192, D = 2048, NL = 2;
constexpr int NIN = 20492, NU = 20480;
constexpr int UC_QKV = 0, UC_Z = 2304, UC_B = 3072, UC_C = 4608, UC_D = 11520, UC_G = 12288;
constexpr int NE = 64, EH = 512;
constexpr int NTHREADS = 512;
constexpr int LDS_STAGE = 131072;
constexpr int LDS_MISC = LDS_STAGE;
constexpr int LDS_OSTG = LDS_STAGE + 8192;
constexpr int LDS_BYTES = LDS_OSTG + 16384;

constexpr size_t al256(size_t x) { return (x + 255) & ~(size_t)255; }
constexpr size_t WS_CTL = 0;
constexpr size_t CTL_BYTES = 65536;
constexpr size_t CTL_CNT = 32768;
constexpr size_t CTL_MTDONE = 36864;
constexpr size_t CTL_QHEAD = 40960;
constexpr size_t WS_WINT = WS_CTL + CTL_BYTES;
constexpr size_t WS_WBRT = WS_WINT + (size_t)NL * NU * D * 2;
constexpr size_t WS_WOUTT = WS_WBRT + (size_t)NL * 4 * D * 768 * 2;
constexpr size_t WS_WUPT = WS_WOUTT + (size_t)NL * D * D * 2;
constexpr size_t WS_WDNT = WS_WUPT + (size_t)NL * NE * 1024 * D * 2;
constexpr size_t WS_H = WS_WDNT + (size_t)NL * NE * D * EH * 2;
constexpr size_t WS_U = WS_H + (size_t)T * D * 2;
constexpr size_t WS_XA = WS_U + (size_t)T * NU * 2;
constexpr size_t WS_XB = WS_XA + (size_t)T * D * 4;
constexpr size_t WS_BETA = WS_XB + (size_t)T * D * 4;
constexpr size_t WS_GLOG = WS_BETA + (size_t)T * 8 * 4;
constexpr int GB_WC = 0, GB_QD = 16384, GB_KDT = 32768, GB_QK = 49152, GB_BYTES = 57344;
constexpr size_t WS_GBLK = WS_GLOG + (size_t)T * 8 * 4;
constexpr size_t WS_UCP = WS_GBLK + (size_t)768 * GB_BYTES;
constexpr size_t WS_GL = WS_UCP + (size_t)768 * 8192 * 4;
constexpr size_t WS_OGDN = WS_GL + 4096;
constexpr size_t WS_QR = WS_OGDN + (size_t)T * 768 * 4;
constexpr size_t WS_KR = WS_QR + (size_t)T * 2304 * 2;
constexpr size_t WS_ATTO = WS_KR + (size_t)T * 2304 * 2;
constexpr size_t WS_LSE = WS_ATTO + (size_t)3 * T * 768 * 2;
constexpr size_t WS_YBR = WS_LSE + (size_t)3 * T * 8 * 4;
constexpr size_t WS_M32 = WS_YBR + (size_t)4 * T * 768 * 2;
constexpr size_t WS_MERGED = WS_M32 + (size_t)T * D * 4;
constexpr size_t WS_TOK = WS_MERGED + (size_t)T * D * 2;
constexpr size_t WS_WTS = WS_TOK + (size_t)NE * 8192 * 4;
constexpr size_t WS_HID = WS_WTS + (size_t)T * 2 * 4;
constexpr size_t WS_YMOE = WS_HID + (size_t)32768 * EH * 2;
constexpr size_t WS_PWT = WS_YMOE + (size_t)T * 2 * D * 4;
constexpr size_t WS_WRT = WS_PWT + (size_t)NL * 4 * 192 * 192 * 2;
constexpr size_t WS_WSM = WS_WRT + (size_t)NL * 2 * 80 * 2048 * 2;
constexpr size_t WS_WSL = WS_WSM + (size_t)NL * 12 * 2048 * 4;
constexpr size_t WS_END = WS_WSL + (size_t)NE * 8192 * 4;

__constant__ float ROPE_INV[64] = {1.000000000e+00f, 8.659643531e-01f, 7.498942018e-01f, 6.493816376e-01f, 5.623413324e-01f, 4.869675338e-01f, 4.216965139e-01f, 3.651741147e-01f, 3.162277639e-01f, 2.738419771e-01f, 2.371373773e-01f, 2.053525001e-01f, 1.778279394e-01f, 1.539926529e-01f, 1.333521456e-01f, 1.154781953e-01f, 1.000000015e-01f, 8.659642935e-02f, 7.498942316e-02f, 6.493816525e-02f, 5.623413250e-02f, 4.869675264e-02f, 4.216964915e-02f, 3.651741147e-02f, 3.162277490e-02f, 2.738419548e-02f, 2.371373773e-02f, 2.053525113e-02f, 1.778279431e-02f, 1.539926510e-02f, 1.333521400e-02f, 1.154781971e-02f, 9.999999776e-03f, 8.659643121e-03f, 7.498942316e-03f, 6.493816152e-03f, 5.623413250e-03f, 4.869675264e-03f, 4.216964822e-03f, 3.651741194e-03f, 3.162277630e-03f, 2.738419687e-03f, 2.371373819e-03f, 2.053525066e-03f, 1.778279431e-03f, 1.539926510e-03f, 1.333521446e-03f, 1.154782018e-03f, 1.000000047e-03f, 8.659643354e-04f, 7.498941850e-04f, 6.493816036e-04f, 5.623413017e-04f, 4.869675322e-04f, 4.216965172e-04f, 3.651741135e-04f, 3.162277571e-04f, 2.738419571e-04f, 2.371373703e-04f, 2.053525095e-04f, 1.778279402e-04f, 1.539926598e-04f, 1.333521504e-04f, 1.154782003e-04f};

__device__ __forceinline__ float bf2f(unsigned short b) { return __uint_as_float(((unsigned)b) << 16); }
__device__ __forceinline__ float bflo(unsigned w) { return __uint_as_float(w << 16); }
__device__ __forceinline__ float bfhi(unsigned w) { return __uint_as_float(w & 0xffff0000u); }
typedef __bf16 bf16x2_t __attribute__((ext_vector_type(2)));
__device__ __forceinline__ unsigned cvt_pk_bf16(float lo, float hi) { bf16x2_t v; v.x = (__bf16)lo; v.y = (__bf16)hi; return __builtin_bit_cast(unsigned, v); }
__device__ __forceinline__ bf16_t f2bf(float f) { return (bf16_t)(cvt_pk_bf16(f, 0.f) & 0xffffu); }
__device__ __forceinline__ float shx(float v, int o, int lane) { return __int_as_float(__builtin_amdgcn_ds_bpermute((lane ^ o) << 2, __float_as_int(v))); }
__device__ __forceinline__ float wave_sum(float v, int lane) {
#pragma unroll
    for (int o = 32; o; o >>= 1) v += shx(v, o, lane);
    return v; }
__device__ __forceinline__ float wave_max(float v, int lane) {
#pragma unroll
    for (int o = 32; o; o >>= 1) v = fmaxf(v, shx(v, o, lane));
    return v; }
__device__ __forceinline__ float sigmoidf_(float x) { return 1.0f / (1.0f + __expf(-x)); }
__device__ __forceinline__ float siluf_(float x) { return x / (1.0f + __expf(-x)); }
__device__ __forceinline__ float silu_fast(float x) { return x * __builtin_amdgcn_rcpf(1.0f + __expf(-x)); }

__device__ __forceinline__ bf16x8 tr_pair(const LAS unsigned char* p0, const LAS unsigned char* p1) {
    const s16x4 a = __builtin_amdgcn_ds_read_tr16_b64_v4i16((LAS s16x4*)p0), b = __builtin_amdgcn_ds_read_tr16_b64_v4i16((LAS s16x4*)p1);
    return __builtin_shufflevector(a, b, 0, 1, 2, 3, 4, 5, 6, 7); }
#define XB_TMO      128
#define XB_XCNT(j)  (256  + 64 * (j))
#define XB_XSUB(j)  (1280 + 64 * (j))
#define XB_XGEN(j)  (2304 + 64 * (j))
#define XB_TOP      3328
#define XB_TOPGEN   3392
#define XCD_BAR_WORDS 3456
#define XB_SPIN_CAP (1u << 18)
__device__ __forceinline__ unsigned xb_ld(unsigned* p)              { return __hip_atomic_load(p, __ATOMIC_RELAXED, __HIP_MEMORY_SCOPE_AGENT); }
__device__ __forceinline__ unsigned xb_add(unsigned* p, unsigned v) { return __hip_atomic_fetch_add(p, v, __ATOMIC_RELAXED, __HIP_MEMORY_SCOPE_AGENT); }
__device__ __forceinline__ unsigned xb_xcc_id() { return (unsigned)__builtin_amdgcn_s_getreg((3 << 11) | 20) & 0xFu; }
#define XB_SPIN(cond, bar) do { unsigned _sp = 0; while (cond) { __builtin_amdgcn_s_sleep(1); \
    if ((++_sp & 255u) == 0u) { if (xb_ld(&(bar)[XB_TMO])) break; if (_sp > XB_SPIN_CAP) { atomicAdd(&(bar)[XB_TMO], 1u); break; } } } } while (0)
struct XcdBarrier { unsigned* bar; unsigned x; volatile LAS unsigned* st; };
__device__ __forceinline__ XcdBarrier xcd_barrier_post(unsigned* bar, volatile LAS unsigned* st) {
    XcdBarrier b; b.bar = bar; b.x = xb_xcc_id(); b.st = st;
    if (threadIdx.x == 0) (void)xb_add(&bar[XB_XCNT(b.x)], 1u);
    return b;
}
__device__ __forceinline__ void xcd_barrier_complete(unsigned* bar, unsigned x, unsigned& nloc, unsigned& nx) {
    const unsigned G = gridDim.x * gridDim.y * gridDim.z;
    unsigned sum, cnt, mine, sp = 0u;
    for (;;) {
        sum = 0u; cnt = 0u; mine = 0u;
#pragma unroll
        for (unsigned j = 0; j < 16; ++j) { const unsigned c = xb_ld(&bar[XB_XCNT(j)]); sum += c; cnt += (c > 0u) ? 1u : 0u; mine = (j == x) ? c : mine; }
        if (sum == G) break;
        __builtin_amdgcn_s_sleep(1);
        if ((++sp & 255u) == 0u) { if (xb_ld(&bar[XB_TMO])) break; if (sp > XB_SPIN_CAP) { atomicAdd(&bar[XB_TMO], 1u); break; } }
    }
    nloc = mine > 0u ? mine : 1u; nx = cnt > 0u ? cnt : 1u;
}
__device__ __forceinline__ void xcd_barrier(const XcdBarrier& b) {
    asm volatile("s_waitcnt vmcnt(0)" ::: "memory");
    __syncthreads();
    if (threadIdx.x == 0) {
        unsigned* bar = b.bar;
        __builtin_amdgcn_s_waitcnt(0);
        unsigned nloc = b.st[0], nx = b.st[1];
        if (nloc == 0u) { xcd_barrier_complete(bar, b.x, nloc, nx); b.st[0] = nloc; b.st[1] = nx; }
        const unsigned old = xb_add(&bar[XB_XSUB(b.x)], 1u);
        const unsigned gen = old / nloc;
        if (old + 1u == (gen + 1u) * nloc) {
            __builtin_amdgcn_fence(__ATOMIC_RELEASE, "agent");
            asm volatile("s_waitcnt vmcnt(0)" ::: "memory");
            const unsigned og = xb_add(&bar[XB_TOP], 1u);
            const unsigned tg = og / nx;
            if (og + 1u == (tg + 1u) * nx) xb_add(&bar[XB_TOPGEN], 1u);
            else XB_SPIN(xb_ld(&bar[XB_TOPGEN]) == tg, bar);
            __builtin_amdgcn_fence(__ATOMIC_ACQUIRE, "agent");
            xb_add(&bar[XB_XGEN(b.x)], 1u);
            asm volatile("s_waitcnt vmcnt(0)" ::: "memory");
        } else {
            XB_SPIN(xb_ld(&bar[XB_XGEN(b.x)]) == gen, bar);
            __builtin_amdgcn_fence(__ATOMIC_ACQUIRE, "agent");
            asm volatile("s_waitcnt vmcnt(0)" ::: "memory");
        }
    }
    __syncthreads();
}

namespace pg8 {
constexpr int BM = 256, BK = 64, HALF = 128, HTB = HALF * BK * 2, STAGE_BYTES = 8 * HTB, NXCD = 8, WGM = 8;
__host__ __device__ __forceinline__ int lds_byte(int r, int c) { const int st = (r >> 4) * 2 + (c >> 5), rr = r & 15, cc = c & 31, ob = rr * 64 + cc * 2; return st * 1024 + (ob ^ (((ob >> 9) & 1) << 5)); }
__host__ __device__ __forceinline__ void stage_rc(int b, int& R, int& C) { const int st = b / 1024, sb = b % 1024, swz = sb ^ (((sb >> 9) & 1) << 5); R = (st >> 1) * 16 + swz / 64; C = (st & 1) * 32 + (swz % 64) / 2; }
__host__ __device__ __forceinline__ int perm32(int rho) { const int n = rho >> 4, i = rho & 15; return 8 * (i >> 2) + 4 * n + (i & 3); }
struct Unit { int pm, pn; };
struct Gemm { const bf16_t* A; const bf16_t* Bt; int K; };
struct StaticOrder {
    int nM, nN, nwg, G, c;
    __device__ void init(int M, int N, int G_, int c_) { nM = M / BM; nN = N / BM; nwg = nM * nN; G = G_; c = c_; }
    __device__ bool next(int i, Unit& u) const {
        const long L = (long)i * G + c; if (L >= nwg) return false;
        int wgid = (int)L; { const int q = nwg / NXCD, r = nwg % NXCD, xcd = wgid % NXCD, off = wgid / NXCD; wgid = (xcd < r ? xcd * (q + 1) : r * (q + 1) + (xcd - r) * q) + off; }
        const int nig = WGM * nN, gid = wgid / nig, fm = gid * WGM, gsz = (nM - fm) < WGM ? (nM - fm) : WGM;
        u.pm = fm + ((wgid % nig) % gsz); u.pn = (wgid % nig) / gsz; return true;
    }
    __device__ __forceinline__ int arow(const Unit& u, int r) const { return u.pm * BM + r; }
};

template <class Epi, class Sched, bool GATHER>
__device__ __forceinline__ void gemm_phase(LAS unsigned char* lds, const Gemm g, const Sched& S, const Epi& E) {
    int tid = threadIdx.x; asm volatile("" : "+v"(tid));
    const int wid = __builtin_amdgcn_readfirstlane(tid >> 6), lane = tid & 63, wr = wid >> 2, wc = wid & 3, fr = lane & 15, fq = lane >> 4;
    const int K = g.K, nt = K / BK;
    unsigned voffA[2], voffB[2]; int RA[2], CA[2];
#pragma unroll
    for (int i = 0; i < 2; ++i) { int R, C; stage_rc(tid * 16 + i * 8192, R, C); const int Rb = Epi::PERM ? ((R & ~31) + perm32(R & 31)) : R;
        voffA[i] = (unsigned)(R * K + C) * 2u; voffB[i] = (unsigned)(Rb * K + C) * 2u; RA[i] = R; CA[i] = C; }
    const size_t kstep = (size_t)(BK * 2);
    const size_t hstep = (size_t)HALF * K * 2;
    const size_t tstep = 2 * hstep;
    const unsigned ldsw = (unsigned)wid * 1024u;
    const int aoff = lds_byte(wr * 64 + fr, fq * 8), boff = lds_byte(wc * 32 + fr, fq * 8);
#define PG8_SA(b, h) (((b) * 2 + (h)) * HTB)
#define PG8_SB(b, h) ((4 + (b) * 2 + (h)) * HTB)
#define PG8_STAGE(bufoff, gbase, voff) do { _Pragma("unroll") for (int _i = 0; _i < 2; ++_i) \
        __builtin_amdgcn_global_load_lds((const unsigned*)((const char*)(gbase) + (voff)[_i]), (LAS unsigned*)(lds + (bufoff) + ldsw + _i * 8192), 16, 0, 0); } while (0)
#define PG8_STAGE2(bufoff, gbase, o0, o1) do { \
        __builtin_amdgcn_global_load_lds((const unsigned*)((const char*)(gbase) + (o0)), (LAS unsigned*)(lds + (bufoff) + ldsw), 16, 0, 0); \
        __builtin_amdgcn_global_load_lds((const unsigned*)((const char*)(gbase) + (o1)), (LAS unsigned*)(lds + (bufoff) + ldsw + 8192), 16, 0, 0); } while (0)
#define PG8_LDA(dst, b, h) do { _Pragma("unroll") for (int m = 0; m < 4; ++m) _Pragma("unroll") for (int k = 0; k < 2; ++k) dst[m][k] = *(const LAS bf16x8*)(lds + PG8_SA(b, h) + aoff + m * 2048 + k * 1024); } while (0)
#define PG8_LDB(dst, b, h) do { _Pragma("unroll") for (int n = 0; n < 2; ++n) _Pragma("unroll") for (int k = 0; k < 2; ++k) dst[n][k] = *(const LAS bf16x8*)(lds + PG8_SB(b, h) + boff + n * 2048 + k * 1024); } while (0)
#define PG8_MMA(ai, bj, At, Bt) do { __builtin_amdgcn_s_setprio(1); _Pragma("unroll") for (int m = 0; m < 4; ++m) _Pragma("unroll") for (int n = 0; n < 2; ++n) _Pragma("unroll") for (int k = 0; k < 2; ++k) \
        acc[ai][bj][m][n] = __builtin_amdgcn_mfma_f32_16x16x32_bf16(Bt[n][k], At[m][k], acc[ai][bj][m][n], 0, 0, 0); __builtin_amdgcn_s_setprio(0); } while (0)
#define PG8_WAIT_V(n) asm volatile("s_waitcnt vmcnt(" #n ")" ::: "memory")
#define PG8_WAIT_L(n) asm volatile("s_waitcnt lgkmcnt(" #n ")" ::: "memory")
#define PG8_BAR __builtin_amdgcn_s_barrier()
#define PG8_SCHED __builtin_amdgcn_sched_barrier(0)
    Unit cur, nxt; int ui = 0;
    if (!S.next(0, cur)) return;
    f32x4 acc[2][2][4][2];
#pragma unroll
    for (int a = 0; a < 2; ++a)
#pragma unroll
        for (int b = 0; b < 2; ++b)
#pragma unroll
            for (int m = 0; m < 4; ++m)
#pragma unroll
                for (int n = 0; n < 2; ++n) acc[a][b][m][n] = (f32x4){0.f, 0.f, 0.f, 0.f};
    bf16x8 At[4][2], B0[2][2], B1[2][2];
    unsigned c00 = 0, c01 = 0, c10 = 0, c11 = 0, n00 = 0, n01 = 0, n10 = 0, n11 = 0;
    if constexpr (GATHER) {
        c00 = (unsigned)(S.arow(cur, RA[0]) * K + CA[0]) * 2u; c01 = (unsigned)(S.arow(cur, RA[1]) * K + CA[1]) * 2u;
        c10 = (unsigned)(S.arow(cur, HALF + RA[0]) * K + CA[0]) * 2u; c11 = (unsigned)(S.arow(cur, HALF + RA[1]) * K + CA[1]) * 2u;
    }
    const char* cA = GATHER ? (const char*)g.A : (const char*)g.A + (size_t)cur.pm * tstep; const char* cB = (const char*)g.Bt + (size_t)cur.pn * tstep;
    if constexpr (GATHER) {
        PG8_STAGE(PG8_SB(0, 0), cB, voffB); PG8_STAGE2(PG8_SA(0, 0), cA, c00, c01); PG8_STAGE(PG8_SB(0, 1), cB + hstep, voffB); PG8_STAGE2(PG8_SA(0, 1), cA, c10, c11);
    } else {
        PG8_STAGE(PG8_SB(0, 0), cB, voffB); PG8_STAGE(PG8_SB(0, 1), cB + hstep, voffB); PG8_STAGE(PG8_SA(0, 0), cA, voffA); PG8_STAGE(PG8_SA(0, 1), cA + hstep, voffA);
    }
    if (wr == 1) PG8_BAR;
    if constexpr (GATHER) PG8_WAIT_V(4); else PG8_WAIT_V(2);
    PG8_BAR;
    if constexpr (GATHER) {
        PG8_STAGE(PG8_SB(1, 0), cB + kstep, voffB); PG8_STAGE2(PG8_SA(1, 0), cA + kstep, c00, c01); PG8_STAGE(PG8_SB(1, 1), cB + hstep + kstep, voffB);
    } else {
        PG8_STAGE(PG8_SB(1, 0), cB + kstep, voffB); PG8_STAGE(PG8_SA(1, 0), cA + kstep, voffA); PG8_STAGE(PG8_SB(1, 1), cB + hstep + kstep, voffB);
    }
    PG8_WAIT_V(6); PG8_BAR;
    for (;;) {
        const bool has_next = S.next(ui + 1, nxt);
        if constexpr (GATHER) {
            if (has_next) {
                n00 = (unsigned)(S.arow(nxt, RA[0]) * K + CA[0]) * 2u; n01 = (unsigned)(S.arow(nxt, RA[1]) * K + CA[1]) * 2u;
                n10 = (unsigned)(S.arow(nxt, HALF + RA[0]) * K + CA[0]) * 2u; n11 = (unsigned)(S.arow(nxt, HALF + RA[1]) * K + CA[1]) * 2u;
            } else { n00 = c00; n01 = c01; n10 = c10; n11 = c11; }
        }
        const char* nA = GATHER ? cA : (has_next ? (const char*)g.A + (size_t)nxt.pm * tstep : cA);
        const char* nB = has_next ? (const char*)g.Bt + (size_t)nxt.pn * tstep : cB;
        for (int t = 0; t < nt; t += 2) {
            const bool last = (t == nt - 2);
            const char* a1 = cA + (size_t)(t + 1) * kstep;
            const char* a2 = last ? nA : cA + (size_t)(t + 2) * kstep; const char* b2 = last ? nB : cB + (size_t)(t + 2) * kstep;
            const char* a3 = a2 + kstep; const char* b3 = b2 + kstep;
            unsigned s00 = 0, s01 = 0, s10 = 0, s11 = 0;
            if constexpr (GATHER) { s00 = last ? n00 : c00; s01 = last ? n01 : c01; s10 = last ? n10 : c10; s11 = last ? n11 : c11; }
            if constexpr (!GATHER) {
            PG8_LDB(B0, 0, 0); PG8_LDB(B1, 0, 1); PG8_SCHED; PG8_LDA(At, 0, 0); PG8_STAGE(PG8_SA(1, 1), a1 + hstep, voffA);
            PG8_WAIT_V(8); PG8_WAIT_L(0); PG8_BAR; PG8_MMA(0, 0, At, B0); PG8_MMA(0, 1, At, B1); PG8_BAR; PG8_SCHED;
            PG8_LDA(At, 0, 1); PG8_STAGE(PG8_SB(0, 0), b2, voffB); PG8_STAGE(PG8_SB(0, 1), b2 + hstep, voffB); PG8_STAGE(PG8_SA(0, 0), a2, voffA);
            PG8_WAIT_V(8); PG8_WAIT_L(0); PG8_BAR; PG8_MMA(1, 0, At, B0); PG8_MMA(1, 1, At, B1); PG8_BAR; PG8_SCHED;
            PG8_LDB(B0, 1, 0); PG8_LDB(B1, 1, 1); PG8_SCHED; PG8_LDA(At, 1, 0); PG8_STAGE(PG8_SA(0, 1), a2 + hstep, voffA);
            PG8_WAIT_V(8); PG8_WAIT_L(0); PG8_BAR; PG8_MMA(0, 0, At, B0); PG8_MMA(0, 1, At, B1); PG8_BAR; PG8_SCHED;
            PG8_LDA(At, 1, 1); PG8_STAGE(PG8_SB(1, 0), b3, voffB); PG8_STAGE(PG8_SB(1, 1), b3 + hstep, voffB); PG8_STAGE(PG8_SA(1, 0), a3, voffA);
            PG8_WAIT_V(8); PG8_WAIT_L(0); PG8_BAR; PG8_MMA(1, 0, At, B0); PG8_MMA(1, 1, At, B1); PG8_BAR; PG8_SCHED;
            } else {
            PG8_LDB(B0, 0, 0); PG8_SCHED; PG8_LDA(At, 0, 0);
            if constexpr (GATHER) PG8_STAGE2(PG8_SA(1, 1), a1, c10, c11); else PG8_STAGE(PG8_SA(1, 1), a1 + hstep, voffA);
            PG8_WAIT_L(8); PG8_BAR; PG8_WAIT_L(0); PG8_MMA(0, 0, At, B0); PG8_BAR; PG8_SCHED;
            PG8_LDB(B1, 0, 1); PG8_STAGE(PG8_SB(0, 0), b2, voffB);
            PG8_BAR; PG8_WAIT_L(0); PG8_MMA(0, 1, At, B1); PG8_BAR;
            PG8_LDA(At, 0, 1);
            if constexpr (GATHER) PG8_STAGE2(PG8_SA(0, 0), a2, s00, s01); else PG8_STAGE(PG8_SA(0, 0), a2, voffA);
            PG8_BAR; PG8_WAIT_L(0); PG8_MMA(1, 0, At, B0); PG8_BAR; PG8_SCHED;
            PG8_STAGE(PG8_SB(0, 1), b2 + hstep, voffB);
            PG8_WAIT_V(6); PG8_BAR; PG8_MMA(1, 1, At, B1); PG8_BAR;
            PG8_LDB(B0, 1, 0); PG8_SCHED; PG8_LDA(At, 1, 0);
            if constexpr (GATHER) PG8_STAGE2(PG8_SA(0, 1), a2, s10, s11); else PG8_STAGE(PG8_SA(0, 1), a2 + hstep, voffA);
            PG8_WAIT_L(8); PG8_BAR; PG8_WAIT_L(0); PG8_MMA(0, 0, At, B0); PG8_BAR; PG8_SCHED;
            PG8_LDB(B1, 1, 1); PG8_STAGE(PG8_SB(1, 0), b3, voffB);
            PG8_BAR; PG8_WAIT_L(0); PG8_MMA(0, 1, At, B1); PG8_BAR;
            PG8_LDA(At, 1, 1);
            if constexpr (GATHER) PG8_STAGE2(PG8_SA(1, 0), a3, s00, s01); else PG8_STAGE(PG8_SA(1, 0), a3, voffA);
            PG8_BAR; PG8_WAIT_L(0); PG8_MMA(1, 0, At, B0); PG8_BAR; PG8_SCHED;
            PG8_STAGE(PG8_SB(1, 1), b3 + hstep, voffB);
            PG8_WAIT_V(6); PG8_BAR; PG8_MMA(1, 1, At, B1); PG8_BAR;
                    }
        }
        if (wr == 0) PG8_BAR;
        E(acc, cur, wr, wc, fr, fq);
        if (!has_next) break;
#pragma unroll
        for (int a = 0; a < 2; ++a)
#pragma unroll
            for (int b = 0; b < 2; ++b)
#pragma unroll
                for (int m = 0; m < 4; ++m)
#pragma unroll
                    for (int n = 0; n < 2; ++n) acc[a][b][m][n] = (f32x4){0.f, 0.f, 0.f, 0.f};
        cur = nxt; cA = nA; cB = nB; ++ui;
        if constexpr (GATHER) { c00 = n00; c01 = n01; c10 = n10; c11 = n11; }
        if (wr == 1) PG8_BAR;
    }
    PG8_WAIT_V(0);
    PG8_BAR;
#undef PG8_SA
#undef PG8_SB
#undef PG8_STAGE
#undef PG8_STAGE2
#undef PG8_LDA
#undef PG8_LDB
#undef PG8_MMA
#undef PG8_WAIT_V
#undef PG8_WAIT_L
#undef PG8_BAR
#undef PG8_SCHED
}
}

struct Params {
    const float* x; const int* pos; const float* norm1_g; const float* w_in; const float* conv_a_w; const float* a_log; const float* dt_bias; const float* gdn_norm_g;
    const float* conv_b_w; const float* conv_b_b; const float* ln_b_g; const float* ln_b_b; const float* pool_w; const float* pool_scale; const float* w_branch; const float* w_out;
    const float* norm2_g; const float* rg_w; const float* rg_b; const float* re_w; const float* re_b; const float* w_up; const float* w_down; const float* final_g;
    float* out; unsigned char* ws; int ph_lo, ph_hi, probe, pad;
};

struct Ctx { int tid, lane, wave, bid, G; LAS unsigned char* lds; };
constexpr int LDS_PTAB = LDS_MISC + 512;
__device__ __forceinline__ const void* lds_ptr_get(const LAS unsigned* tab, int i) {
    const unsigned lo = __builtin_amdgcn_readfirstlane(tab[2 * i]), hi = __builtin_amdgcn_readfirstlane(tab[2 * i + 1]);
    return (const void*)(const GAS char*)(((unsigned long long)hi << 32) | lo); }
__device__ __forceinline__ Params load_params(const Ctx& c, unsigned char* ws, int lo, int hi) {
    unsigned toff = LDS_PTAB; asm volatile("" : "+s"(toff)); const LAS unsigned* tab = (const LAS unsigned*)(c.lds + toff);
    Params q;
    q.x = (const float*)lds_ptr_get(tab, 0); q.pos = (const int*)lds_ptr_get(tab, 1); q.norm1_g = (const float*)lds_ptr_get(tab, 2); q.w_in = (const float*)lds_ptr_get(tab, 3);
    q.conv_a_w = (const float*)lds_ptr_get(tab, 4); q.a_log = (const float*)lds_ptr_get(tab, 5); q.dt_bias = (const float*)lds_ptr_get(tab, 6); q.gdn_norm_g = (const float*)lds_ptr_get(tab, 7);
    q.conv_b_w = (const float*)lds_ptr_get(tab, 8); q.conv_b_b = (const float*)lds_ptr_get(tab, 9); q.ln_b_g = (const float*)lds_ptr_get(tab, 10); q.ln_b_b = (const float*)lds_ptr_get(tab, 11);
    q.pool_w = (const float*)lds_ptr_get(tab, 12); q.pool_scale = (const float*)lds_ptr_get(tab, 13); q.w_branch = (const float*)lds_ptr_get(tab, 14); q.w_out = (const float*)lds_ptr_get(tab, 15);
    q.norm2_g = (const float*)lds_ptr_get(tab, 16); q.rg_w = (const float*)lds_ptr_get(tab, 17); q.rg_b = (const float*)lds_ptr_get(tab, 18); q.re_w = (const float*)lds_ptr_get(tab, 19);
    q.re_b = (const float*)lds_ptr_get(tab, 20); q.w_up = (const float*)lds_ptr_get(tab, 21); q.w_down = (const float*)lds_ptr_get(tab, 22); q.final_g = (const float*)lds_ptr_get(tab, 23);
    q.out = (float*)lds_ptr_get(tab, 24); q.ws = ws; q.ph_lo = lo; q.ph_hi = hi; q.probe = -1; q.pad = 0; return q; }

__device__ __forceinline__ void cvt_tile(const Ctx& c, const float* __restrict__ src, size_t ld, int k0, int n0s, bf16_t* __restrict__ dst, int K, int n0d) {
    LAS float* tile = (LAS float*)c.lds;
    const int tid = c.tid;
#pragma unroll
    for (int rr = 0; rr < 2; ++rr) {
        const int r = (tid >> 4) + rr * 32, cc = (tid & 15) * 4;
        const float4 v = *(const float4*)(src + (size_t)(k0 + r) * ld + n0s + cc);
        tile[r * 65 + cc + 0] = v.x; tile[r * 65 + cc + 1] = v.y; tile[r * 65 + cc + 2] = v.z; tile[r * 65 + cc + 3] = v.w;
    }
    __syncthreads();
    {
        const int n = tid >> 3, ks = tid & 7;
        float f[8];
#pragma unroll
        for (int i = 0; i < 8; ++i) f[i] = tile[(ks * 8 + i) * 65 + n];
        u32x4 w; w.x = cvt_pk_bf16(f[0], f[1]); w.y = cvt_pk_bf16(f[2], f[3]); w.z = cvt_pk_bf16(f[4], f[5]); w.w = cvt_pk_bf16(f[6], f[7]);
        *(u32x4*)(dst + (size_t)(n0d + n) * K + k0 + ks * 8) = w;
    }
    __syncthreads();
}
struct CvtDesc { const float* src; bf16_t* dst; int ld, K; };
__device__ __forceinline__ CvtDesc cvt_desc(const Params& p, int idx) {
    constexpr int T1 = 10240, T2 = 1536, T3 = 1024, TL = T1 + T2 + T3;
    bf16_t* WinT = (bf16_t*)(p.ws + WS_WINT); bf16_t* WbrT = (bf16_t*)(p.ws + WS_WBRT); bf16_t* WoutT = (bf16_t*)(p.ws + WS_WOUTT);
    const int L = idx / TL; int r = idx % TL; CvtDesc d;
    if (r < T1) { const int kt = r % 32, ntile = r / 32, n0d = ntile * 64, n0s = n0d + (n0d >= 3072 ? 12 : 0);
        d.ld = NIN; d.K = D; d.src = p.w_in + (size_t)L * D * NIN + (size_t)(kt * 64) * NIN + n0s; d.dst = WinT + (size_t)L * NU * D + (size_t)n0d * D + kt * 64; return d; }
    r -= T1;
    if (r < T2) { const int kb = r / 384, rr = r % 384, kt = rr % 12, ntile = rr / 12;
        d.ld = D; d.K = 768; d.src = p.w_branch + (size_t)(L * 4 + kb) * 768 * D + (size_t)(kt * 64) * D + ntile * 64; d.dst = WbrT + (size_t)(L * 4 + kb) * D * 768 + (size_t)(ntile * 64) * 768 + kt * 64; return d; }
    r -= T2;
    { const int kt = r % 32, ntile = r / 32;
        d.ld = D; d.K = D; d.src = p.w_out + (size_t)L * D * D + (size_t)(kt * 64) * D + ntile * 64; d.dst = WoutT + (size_t)L * D * D + (size_t)(ntile * 64) * D + kt * 64; return d; }
}
__device__ __forceinline__ void phase_convert(const Ctx& c, const Params& p) {
    constexpr int TL = 10240 + 1536 + 1024;
    {
        const int tid = c.tid, r0 = tid >> 4, cc = (tid & 15) * 4;
        int idx = c.bid; float4 v0 = make_float4(0.f, 0.f, 0.f, 0.f), v1 = v0, m0 = v0, m1 = v0; CvtDesc cur, mid;
        if (idx < NL * TL) { cur = cvt_desc(p, idx); v0 = *(const float4*)(cur.src + (size_t)r0 * cur.ld + cc); v1 = *(const float4*)(cur.src + (size_t)(r0 + 32) * cur.ld + cc); mid = cur; }
        if (idx + c.G < NL * TL) { mid = cvt_desc(p, idx + c.G); m0 = *(const float4*)(mid.src + (size_t)r0 * mid.ld + cc); m1 = *(const float4*)(mid.src + (size_t)(r0 + 32) * mid.ld + cc); }
        int bsel = 0;
        while (idx < NL * TL) {
            const int n2 = idx + 2 * c.G; CvtDesc nxt = mid; float4 n0 = m0, n1 = m1;
            if (n2 < NL * TL) { nxt = cvt_desc(p, n2); n0 = *(const float4*)(nxt.src + (size_t)r0 * nxt.ld + cc); n1 = *(const float4*)(nxt.src + (size_t)(r0 + 32) * nxt.ld + cc); }
            LAS float* tile = (LAS float*)c.lds + bsel * (64 * 65 + 32);
            tile[r0 * 65 + cc + 0] = v0.x; tile[r0 * 65 + cc + 1] = v0.y; tile[r0 * 65 + cc + 2] = v0.z; tile[r0 * 65 + cc + 3] = v0.w;
            tile[(r0 + 32) * 65 + cc + 0] = v1.x; tile[(r0 + 32) * 65 + cc + 1] = v1.y; tile[(r0 + 32) * 65 + cc + 2] = v1.z; tile[(r0 + 32) * 65 + cc + 3] = v1.w;
            __syncthreads();
            { const int n = tid >> 3, ks = tid & 7; float f[8];
#pragma unroll
              for (int i = 0; i < 8; ++i) f[i] = tile[(ks * 8 + i) * 65 + n];
              u32x4 w; w.x = cvt_pk_bf16(f[0], f[1]); w.y = cvt_pk_bf16(f[2], f[3]); w.z = cvt_pk_bf16(f[4], f[5]); w.w = cvt_pk_bf16(f[6], f[7]);
              *(u32x4*)(cur.dst + (size_t)n * cur.K + ks * 8) = w; }
            idx += c.G; cur = mid; v0 = m0; v1 = m1; mid = nxt; m0 = n0; m1 = n1; bsel ^= 1;
        }
        __syncthreads();
    }
    {   float* WSM = (float*)(p.ws + WS_WSM);
        for (int i = c.bid * NTHREADS + c.tid; i < NL * 12 * 2048; i += c.G * NTHREADS) { const int k = i & 2047, j = (i >> 11) % 12, L = i / (12 * 2048);
            WSM[i] = p.w_in[((size_t)L * D + k) * NIN + 3072 + j]; }
    }
    {
        bf16_t* WRT = (bf16_t*)(p.ws + WS_WRT);
        for (int i = c.bid * NTHREADS + c.tid; i < NL * 80 * 2048; i += c.G * NTHREADS) { const int k = i & 2047, j = (i >> 11) % 80, L = i / (80 * 2048);
            const float w = j < 8 ? p.rg_w[((size_t)L * D + k) * 8 + j] : (j < 72 ? p.re_w[((size_t)L * D + k) * 64 + (j - 8)] : 0.f);
            const bf16_t hi = f2bf(w); WRT[((size_t)(L * 2 + 0) * 80 + j) * 2048 + k] = hi; WRT[((size_t)(L * 2 + 1) * 80 + j) * 2048 + k] = f2bf(w - bf2f(hi)); }
    }
    {
        bf16_t* PWT = (bf16_t*)(p.ws + WS_PWT);
        for (int i = c.bid * NTHREADS + c.tid; i < NL * 4 * 192 * 192; i += c.G * NTHREADS) { const int cc = i % 192, e = (i / 192) % 192, lg = i / (192 * 192);
            PWT[i] = f2bf(p.pool_w[(size_t)(lg * 192 + cc) * 192 + e] * p.pool_scale[lg * 192 + e]); }
    }
}

__device__ __forceinline__ void phase_norm1(const Ctx& c, const Params& p, int L) {
    LAS float* wsm = (LAS float*)c.lds;
    { const float4* src = (const float4*)((const float*)(p.ws + WS_WSM) + (size_t)L * 12 * 2048);
      for (int i = c.tid; i < 12 * 2048 / 4; i += NTHREADS) { const float4 v = src[i]; LAS float* d = wsm + 4 * i; d[0] = v.x; d[1] = v.y; d[2] = v.z; d[3] = v.w; } }
    __syncthreads();
    const float* g1 = p.norm1_g + L * D;
    bf16_t* H = (bf16_t*)(p.ws + WS_H); float* XA = (float*)(p.ws + WS_XA); const float* XB = (const float*)(p.ws + WS_XB); const bf16_t* Y = (const bf16_t*)(p.ws + WS_YMOE);
    float* BETA = (float*)(p.ws + WS_BETA); float* GLOG = (float*)(p.ws + WS_GLOG);
    for (int rt = c.bid; rt < T / 32; rt += c.G) {
#pragma unroll 1
        for (int i = 0; i < 4; ++i) {
            const int t = rt * 32 + c.wave * 4 + i;
            int wo = 0; asm volatile("" : "+v"(wo)); const LAS float* wsm_i = wsm + wo;
            float4 xv[8]; float ss = 0.f;
#pragma unroll
            for (int q = 0; q < 8; ++q) {
                const int col = q * 256 + c.lane * 4;
                float4 v;
                if (L == 0) v = *(const float4*)(p.x + (size_t)t * D + col);
                else { const float4 a = *(const float4*)(XB + (size_t)t * D + col); const u32x2 y0 = *(const u32x2*)(Y + (size_t)(2 * t) * D + col), y1 = *(const u32x2*)(Y + (size_t)(2 * t + 1) * D + col);
                    v.x = a.x + (bflo(y0.x) + bflo(y1.x)); v.y = a.y + (bfhi(y0.x) + bfhi(y1.x)); v.z = a.z + (bflo(y0.y) + bflo(y1.y)); v.w = a.w + (bfhi(y0.y) + bfhi(y1.y));
                    *(float4*)(XA + (size_t)t * D + col) = v; }
                xv[q] = v; ss += v.x * v.x + v.y * v.y + v.z * v.z + v.w * v.w;
            }
            ss = wave_sum(ss, c.lane);
            const float rstd = rsqrtf(ss * (1.0f / D) + 1e-6f);
            float dots[12];
#pragma unroll
            for (int j = 0; j < 12; ++j) dots[j] = 0.f;
#pragma unroll
            for (int q = 0; q < 8; ++q) {
                const int col = q * 256 + c.lane * 4;
                const float4 g = *(const float4*)(g1 + col);
                float4 h; h.x = xv[q].x * rstd * g.x; h.y = xv[q].y * rstd * g.y; h.z = xv[q].z * rstd * g.z; h.w = xv[q].w * rstd * g.w;
                uint2 o; o.x = cvt_pk_bf16(h.x, h.y); o.y = cvt_pk_bf16(h.z, h.w);
                *(uint2*)(H + (size_t)t * D + col) = o;
#pragma unroll
                for (int j = 0; j < 12; ++j) { const LAS float* wp = wsm_i + j * 2048 + col; dots[j] += h.x * wp[0] + h.y * wp[1] + h.z * wp[2] + h.w * wp[3]; }
            }
#pragma unroll
            for (int j = 0; j < 12; ++j) dots[j] = wave_sum(dots[j], c.lane);
            if (c.lane < 6) {
                float db = dots[0], dd = dots[6];
#pragma unroll
                for (int j = 1; j < 6; ++j) { if (c.lane == j) { db = dots[j]; dd = dots[6 + j]; } }
                BETA[t * 8 + c.lane] = 1.0f / (1.0f + expf(-db));
                const float xx = dd + p.dt_bias[L * 6 + c.lane];
                const float sp = xx > 20.f ? xx : log1pf(expf(xx));
                GLOG[t * 8 + c.lane] = -expf(p.a_log[L * 6 + c.lane]) * sp;
            }
        }
    }
}

struct EpiU {
    static constexpr bool PERM = true;
    bf16_t* O;
    __device__ __forceinline__ void operator()(const f32x4 (&acc)[2][2][4][2], const pg8::Unit& u, int wr, int wc, int fr, int fq) const {
        const int row0 = u.pm * 256 + wr * 64 + fr, col0 = u.pn * 256 + wc * 32 + 8 * fq; const bool sig = u.pn >= 48;
#pragma unroll
        for (int ai = 0; ai < 2; ++ai)
#pragma unroll
            for (int m = 0; m < 4; ++m) { bf16_t* rowp = O + (size_t)(row0 + ai * 128 + m * 16) * NU + col0;
#pragma unroll
                for (int bj = 0; bj < 2; ++bj) { f32x4 v0 = acc[ai][bj][m][0], v1 = acc[ai][bj][m][1];
                    if (sig) {
#pragma unroll
                        for (int j = 0; j < 4; ++j) { v0[j] = sigmoidf_(v0[j]); v1[j] = sigmoidf_(v1[j]); } }
                    u32x4 w; w.x = cvt_pk_bf16(v0[0], v0[1]); w.y = cvt_pk_bf16(v0[2], v0[3]); w.z = cvt_pk_bf16(v1[0], v1[1]); w.w = cvt_pk_bf16(v1[2], v1[3]);
                    *(u32x4*)(rowp + bj * 128) = w; } }
    }
};
struct MergeOrder {
    int G, c;
    __device__ bool next(int i, pg8::Unit& u) const { const int tile = c + (i >> 2) * G; if (tile >= 256) return false; const int k = i & 3, x = tile & 7, y = tile >> 3;
        u.pm = k * 32 + x * 4 + (y >> 3); u.pn = k * 8 + (y & 7); return true; }
    __device__ __forceinline__ int arow(const pg8::Unit& u, int r) const { return u.pm * 256 + r; }
};
struct EpiMerge {
    static constexpr bool PERM = true;
    const bf16_t* U; float* M32; bf16_t* MG;
    __device__ __forceinline__ void operator()(const f32x4 (&acc)[2][2][4][2], const pg8::Unit& u, int wr, int wc, int fr, int fq) const {
        const int k = u.pm >> 5, tm = u.pm & 31, tn = u.pn & 7;
        const int row0 = tm * 256 + wr * 64 + fr, col0 = tn * 256 + wc * 32 + 8 * fq;
        bf16_t* const MP = (bf16_t*)M32;
#pragma unroll
        for (int ai = 0; ai < 2; ++ai)
#pragma unroll
            for (int mh = 0; mh < 2; ++mh) {
                u32x4 gv[2][2], pv[2][2];
#pragma unroll
                for (int mm = 0; mm < 2; ++mm)
#pragma unroll
                    for (int bj = 0; bj < 2; ++bj) { const size_t row = (size_t)(row0 + ai * 128 + (mh * 2 + mm) * 16); const int col = col0 + bj * 128;
                        gv[mm][bj] = *(const u32x4*)(U + row * NU + UC_G + k * D + col);
                        pv[mm][bj] = (k > 0) ? *(const u32x4*)(MP + row * D + col) : (u32x4){0u, 0u, 0u, 0u}; }
#pragma unroll
                for (int mm = 0; mm < 2; ++mm)
#pragma unroll
                    for (int bj = 0; bj < 2; ++bj) { const int m = mh * 2 + mm; const size_t row = (size_t)(row0 + ai * 128 + m * 16); const int col = col0 + bj * 128;
                        const u32x4 g = gv[mm][bj], pp = pv[mm][bj];
                        f32x4 v0 = acc[ai][bj][m][0], v1 = acc[ai][bj][m][1];
                        v0[0] = v0[0] * bflo(g.x) + bflo(pp.x); v0[1] = v0[1] * bfhi(g.x) + bfhi(pp.x); v0[2] = v0[2] * bflo(g.y) + bflo(pp.y); v0[3] = v0[3] * bfhi(g.y) + bfhi(pp.y);
                        v1[0] = v1[0] * bflo(g.z) + bflo(pp.z); v1[1] = v1[1] * bfhi(g.z) + bfhi(pp.z); v1[2] = v1[2] * bflo(g.w) + bflo(pp.w); v1[3] = v1[3] * bfhi(g.w) + bfhi(pp.w);
                        u32x4 w; w.x = cvt_pk_bf16(v0[0], v0[1]); w.y = cvt_pk_bf16(v0[2], v0[3]); w.z = cvt_pk_bf16(v1[0], v1[1]); w.w = cvt_pk_bf16(v1[2], v1[3]);
                        *(u32x4*)((k < 3 ? MP : MG) + row * D + col) = w; }
            }
    }
};
struct EpiRes {
    static constexpr bool PERM = false;
    const float* X; float* O;
    __device__ __forceinline__ void operator()(const f32x4 (&acc)[2][2][4][2], const pg8::Unit& u, int wr, int wc, int fr, int fq) const {
        const int row0 = u.pm * 256 + wr * 64 + fr, col0 = u.pn * 256 + wc * 32 + 4 * fq;
#pragma unroll
        for (int ai = 0; ai < 2; ++ai)
#pragma unroll
            for (int mh = 0; mh < 2; ++mh) {
                f32x4 xv[2][2][2];
#pragma unroll
                for (int mm = 0; mm < 2; ++mm)
#pragma unroll
                    for (int bj = 0; bj < 2; ++bj)
#pragma unroll
                        for (int n = 0; n < 2; ++n) xv[mm][bj][n] = *(const f32x4*)(X + (size_t)(row0 + ai * 128 + (mh * 2 + mm) * 16) * D + col0 + bj * 128 + n * 16);
#pragma unroll
                for (int mm = 0; mm < 2; ++mm)
#pragma unroll
                    for (int bj = 0; bj < 2; ++bj)
#pragma unroll
                        for (int n = 0; n < 2; ++n) *(f32x4*)(O + (size_t)(row0 + ai * 128 + (mh * 2 + mm) * 16) * D + col0 + bj * 128 + n * 16) = acc[ai][bj][mh * 2 + mm][n] + xv[mm][bj][n];
            }
    }
};
struct MoeTab { const LAS int* mt_e; const LAS int* mt_p0; const LAS int* cnt; const LAS int* ut; int nmt; };
struct MoeOrder {
    MoeTab tb; int nN, G, c; const int* tok; unsigned* done;
    __device__ bool next(int i, pg8::Unit& u) const { const int U = tb.nmt * nN; int Lx;
        if (G % 8 == 0) { const int per = G / 8, x = c % 8, j = c / 8, R = U / G, rem = U - R * G;
            if (i < R) Lx = i * G + x * per + j;
            else if (i == R) { const int px = rem / 8, left = rem - px * 8;
                if (j < px) Lx = R * G + x * px + j; else if (j == px && x < left) Lx = R * G + px * 8 + x; else return false; }
            else return false;
        } else { Lx = i * G + c; if (Lx >= U) return false; }
        const int e = tb.ut[Lx]; u.pm = e >> 4; u.pn = tb.mt_e[u.pm] * nN + (e & 15); return true; }
    __device__ __forceinline__ int arow(const pg8::Unit& u, int r) const { const int e = tb.mt_e[u.pm], pos = tb.mt_p0[u.pm] + r; return pos < tb.cnt[e] ? (tok[e * 8192 + pos] >> 1) : 0; }
};
struct MoeDownQueue {
    MoeTab tb; int nN, G, c; unsigned* qhead; unsigned* done; LAS int* slot; const int* tok;
    __device__ bool next(int, pg8::Unit& u) const {
        __syncthreads();
        if (threadIdx.x == 0) {
            const int U = tb.nmt * 8, per = (G % 8 == 0) ? G / 8 : G, nq = (G % 8 == 0) ? 8 : 1, x0 = (G % 8 == 0) ? c % 8 : 0;
            int xo = slot[1], ent = -1;
            for (; xo < nq; ++xo) { const int x = (x0 + xo) % nq;
                const int q = (int)__hip_atomic_fetch_add(qhead + 16 * x, 1u, __ATOMIC_RELAXED, __HIP_MEMORY_SCOPE_AGENT);
                const int Lq = (q / per) * G + x * per + (q % per);
                if (Lq < U) { ent = tb.ut[Lq]; break; } }
            slot[1] = xo;
            if (ent >= 0) { const int mt = ent >> 4; unsigned sp = 0;
                while (__hip_atomic_load(done + mt, __ATOMIC_RELAXED, __HIP_MEMORY_SCOPE_AGENT) < 4u) { __builtin_amdgcn_s_sleep(2); if (++sp > (1u << 21)) break; }
                __builtin_amdgcn_fence(__ATOMIC_ACQUIRE, "agent"); asm volatile("s_waitcnt vmcnt(0)" ::: "memory"); }
            slot[0] = ent; }
        __syncthreads();
        const int ent = slot[0]; if (ent < 0) return false;
        u.pm = ent >> 4; u.pn = tb.mt_e[u.pm] * 8 + (ent & 15); return true; }
    __device__ __forceinline__ int arow(const pg8::Unit& u, int r) const { return u.pm * 128 + r; }
};
struct EpiUp {
    bf16_t* HID;
    __device__ __forceinline__ void operator()(const f32x4 (&acc)[2][4][2], const pg8::Unit& u, int wr, int wc, int fr, int fq) const {
        const int j = u.pn & 3; const int row0 = u.pm * 128 + wr * 64 + fr, col0 = j * 128 + wc * 32 + 8 * fq;
#pragma unroll
        for (int m = 0; m < 4; ++m) { const f32x4 g0 = acc[0][m][0], g1 = acc[0][m][1], u0 = acc[1][m][0], u1 = acc[1][m][1];
            float h[8];
#pragma unroll
            for (int q = 0; q < 4; ++q) { h[q] = siluf_(g0[q]) * u0[q]; h[4 + q] = siluf_(g1[q]) * u1[q]; }
            u32x4 w; w.x = cvt_pk_bf16(h[0], h[1]); w.y = cvt_pk_bf16(h[2], h[3]); w.z = cvt_pk_bf16(h[4], h[5]); w.w = cvt_pk_bf16(h[6], h[7]);
            *(u32x4*)(HID + (size_t)(row0 + m * 16) * EH + col0) = w; }
    }
};
struct EpiDown {
    MoeTab tb; const int* tok; const float* wsl; bf16_t* Y;
    __device__ __forceinline__ void operator()(const f32x4 (&acc)[2][4][2], const pg8::Unit& u, int wr, int wc, int fr, int fq) const {
        const int e = tb.mt_e[u.pm], p0 = tb.mt_p0[u.pm], ne = tb.cnt[e]; const int col0 = (u.pn & 7) * 256 + wc * 32 + 8 * fq;
        int dst[4]; float w[4];
#pragma unroll
        for (int m = 0; m < 4; ++m) { const int pos = p0 + wr * 64 + fr + m * 16; const int pc = pos < ne ? pos : ne - 1;
            dst[m] = tok[e * 8192 + pc]; w[m] = wsl[e * 8192 + pc]; }
#pragma unroll
        for (int m = 0; m < 4; ++m) { const int pos = p0 + wr * 64 + fr + m * 16;
            if (pos < ne) { bf16_t* yp = Y + (size_t)dst[m] * D + col0; const float ww = w[m];
#pragma unroll
                for (int bj = 0; bj < 2; ++bj) { const f32x4 v0 = acc[bj][m][0] * ww, v1 = acc[bj][m][1] * ww;
                    u32x4 o; o.x = cvt_pk_bf16(v0[0], v0[1]); o.y = cvt_pk_bf16(v0[2], v0[3]); o.z = cvt_pk_bf16(v1[0], v1[1]); o.w = cvt_pk_bf16(v1[2], v1[3]);
                    *(u32x4*)(yp + bj * 128) = o; } } }
    }
};

struct MoeTab2 { const LAS int* rt_e; const LAS int* rt_r0; const LAS int* cnt; const LAS int* first; const LAS int* ut_up; const LAS int* ut_dn; int nrt; };
__device__ __forceinline__ bool moe_deal(int i, int U, int G, int c, int& Lx) {
    if (G % 8 == 0) { const int per = G / 8, x = c % 8, j = c / 8, R = U / G, rem = U - R * G;
        if (i < R) Lx = i * G + x * per + j;
        else if (i == R) { const int px = rem / 8, left = rem - px * 8;
            if (j < px) Lx = R * G + x * px + j; else if (j == px && x < left) Lx = R * G + px * 8 + x; else return false; }
        else return false;
    } else { Lx = i * G + c; if (Lx >= U) return false; }
    return true; }
struct MoeUpOrder2 { MoeTab2 tb; int G, c; unsigned* done;
    __device__ bool next(int i, int& rt, int& j) const { int Lx; if (!moe_deal(i, tb.nrt * 8, G, c, Lx)) return false; const int ent = tb.ut_up[Lx]; rt = ent >> 4; j = ent & 15; return true; } };
struct MoeDownQueue2 { MoeTab2 tb; int G, c; unsigned* qhead; unsigned* done; LAS int* slot; unsigned need;
    __device__ bool next(int, int& rt, int& j) const {
        __syncthreads();
        if (threadIdx.x == 0) {
            const int U = tb.nrt * 16, per = (G % 8 == 0) ? G / 8 : G, nq = (G % 8 == 0) ? 8 : 1, x0 = (G % 8 == 0) ? c % 8 : 0;
            int xo = slot[1], ent = -1;
            for (; xo < nq; ++xo) { const int x = (x0 + xo) % nq;
                const int q = (int)__hip_atomic_fetch_add(qhead + 16 * x, 1u, __ATOMIC_RELAXED, __HIP_MEMORY_SCOPE_AGENT);
                const int Lq = (q / per) * G + x * per + (q % per);
                if (Lq < U) { ent = tb.ut_dn[Lq]; break; } }
            slot[1] = xo;
            if (ent >= 0) { const int r = ent >> 4; unsigned sp = 0;
                while (__hip_atomic_load(done + r, __ATOMIC_RELAXED, __HIP_MEMORY_SCOPE_AGENT) < need) { __builtin_amdgcn_s_sleep(2); if (++sp > (1u << 21)) break; }
                __builtin_amdgcn_fence(__ATOMIC_ACQUIRE, "agent"); asm volatile("s_waitcnt vmcnt(0)" ::: "memory"); }
            slot[0] = ent; }
        __syncthreads();
        const int ent = slot[0]; if (ent < 0) return false;
        rt = ent >> 4; j = ent & 15; return true; } };
struct EpiUp2 { bf16_t* HID;
    __device__ __forceinline__ void operator()(const f32x4 (&acc)[3][4][2], int row0, int nb, int e, int r0, int ne, int j, int wr, int wc, int fr, int fq) const {
        bf16_t* hp = HID + (size_t)(row0 + wr * 64 + fr) * EH + 64 * j + 16 * wc + 4 * fq;
#pragma unroll
        for (int blk = 0; blk < 3; ++blk) if (blk < nb) {
#pragma unroll
            for (int m = 0; m < 4; ++m) { const f32x4 g = acc[blk][m][0], u = acc[blk][m][1];
                u32x2 w; w.x = cvt_pk_bf16(silu_fast(g[0]) * u[0], silu_fast(g[1]) * u[1]); w.y = cvt_pk_bf16(silu_fast(g[2]) * u[2], silu_fast(g[3]) * u[3]);
                *(u32x2*)(hp + (size_t)(blk * 128 + m * 16) * EH) = w; } }
    } };
struct EpiDown2 { const int* tok; const float* wsl; bf16_t* Y;
    __device__ __forceinline__ void operator()(const f32x4 (&acc)[3][4][2], int row0, int nb, int e, int r0, int ne, int j, int wr, int wc, int fr, int fq) const {
        const int col0 = 128 * j + 32 * wc + 8 * fq;
#pragma unroll
        for (int blk = 0; blk < 3; ++blk) if (blk < nb) {
            int dst[4]; float w[4];
#pragma unroll
            for (int m = 0; m < 4; ++m) { const int pos = r0 + blk * 128 + wr * 64 + m * 16 + fr; const int pc = pos < ne ? pos : ne - 1; dst[m] = tok[e * 8192 + pc]; w[m] = wsl[e * 8192 + pc]; }
#pragma unroll
            for (int m = 0; m < 4; ++m) { const int pos = r0 + blk * 128 + wr * 64 + m * 16 + fr;
                if (pos < ne) { const f32x4 v0 = acc[blk][m][0] * w[m], v1 = acc[blk][m][1] * w[m];
                    u32x4 o; o.x = cvt_pk_bf16(v0[0], v0[1]); o.y = cvt_pk_bf16(v0[2], v0[3]); o.z = cvt_pk_bf16(v1[0], v1[1]); o.w = cvt_pk_bf16(v1[2], v1[3]);
                    *(u32x4*)(Y + (size_t)dst[m] * D + col0) = o; } } }
    } };


__device__ __forceinline__ int invperm32(int a) { return a < 16 ? 8 * (a >> 2) + (a & 3) : 8 * ((a - 16) >> 2) + 4 + (a & 3); }
__device__ __forceinline__ bf16x8 pack_bf16x8(const f32x4& a, const f32x4& b) { u32x4 w; w.x = cvt_pk_bf16(a[0], a[1]); w.y = cvt_pk_bf16(a[2], a[3]); w.z = cvt_pk_bf16(b[0], b[1]); w.w = cvt_pk_bf16(b[2], b[3]); return __builtin_bit_cast(bf16x8, w); }
__device__ __forceinline__ void gdn_chunk_local(const Ctx& c, const Params& p, int L, int unit) {
    const int h = unit >> 7, n = unit & 127, t0 = n * 64, tid = c.tid, lane = c.lane;
    const bf16_t* U = (const bf16_t*)(p.ws + WS_U);
    LAS unsigned char* lds = c.lds;
    LAS float* vf = (LAS float*)lds;
    LAS bf16_t* qb = (LAS bf16_t*)(lds + 33280);
    LAS bf16_t* kb = (LAS bf16_t*)(lds + 50688);
    LAS float* Am = (LAS float*)(lds + 68096);
    LAS unsigned char* img = lds + 85504;
    LAS float* gcs = (LAS float*)(lds + 126464);
    const float* cw = p.conv_a_w + (size_t)L * 4 * 2304;
    LAS float* cwl = (LAS float*)(lds + LDS_OSTG);
    for (int i = tid; i < 3 * 4 * 32; i += NTHREADS) { const int c4 = i & 31, j = (i >> 5) & 3, sec = i >> 7;
        const float4 wv4 = *(const float4*)(cw + j * 2304 + sec * 768 + h * 128 + 4 * c4); LAS float* d = cwl + (sec * 4 + j) * 128 + 4 * c4; d[0] = wv4.x; d[1] = wv4.y; d[2] = wv4.z; d[3] = wv4.w; }
    if (tid < 64) {
        float g = ((const float*)(p.ws + WS_GLOG))[(t0 + tid) * 8 + h];
#pragma unroll
        for (int o = 1; o < 64; o <<= 1) { const float v = __int_as_float(__builtin_amdgcn_ds_bpermute(((lane - o) & 63) << 2, __float_as_int(g))); if (lane >= o) g += v; }
        gcs[tid] = g; gcs[64 + tid] = ((const float*)(p.ws + WS_BETA))[(t0 + tid) * 8 + h];
    }
    __syncthreads();
    {
        const int tok = tid >> 3, cg = tid & 7, t = t0 + tok;
        const float eg = __expf(gcs[tok]);
#pragma unroll
        for (int sec = 0; sec < 3; ++sec) {
            const int col = sec * 768 + h * 128 + 16 * cg;
            float a[16];
#pragma unroll
            for (int i = 0; i < 16; ++i) a[i] = 0.f;
            u32x4 xa[4], xb[4];
#pragma unroll
            for (int j = 0; j < 4; ++j) { const int tt = t - 3 + j, tc = tt < 0 ? 0 : tt;
                xa[j] = *(const u32x4*)(U + (size_t)tc * NU + UC_QKV + col); xb[j] = *(const u32x4*)(U + (size_t)tc * NU + UC_QKV + col + 8); }
#pragma unroll
            for (int j = 0; j < 4; ++j) { const float mk = (t - 3 + j) < 0 ? 0.f : 1.f; const u32x4 x0 = xa[j], x1 = xb[j];
                const LAS f32x4* wl = (const LAS f32x4*)(cwl + (sec * 4 + j) * 128 + 16 * cg); const f32x4 w0 = wl[0], w1 = wl[1], w2 = wl[2], w3 = wl[3];
                a[0] += mk * w0[0] * bflo(x0.x); a[1] += mk * w0[1] * bfhi(x0.x); a[2] += mk * w0[2] * bflo(x0.y); a[3] += mk * w0[3] * bfhi(x0.y);
                a[4] += mk * w1[0] * bflo(x0.z); a[5] += mk * w1[1] * bfhi(x0.z); a[6] += mk * w1[2] * bflo(x0.w); a[7] += mk * w1[3] * bfhi(x0.w);
                a[8] += mk * w2[0] * bflo(x1.x); a[9] += mk * w2[1] * bfhi(x1.x); a[10] += mk * w2[2] * bflo(x1.y); a[11] += mk * w2[3] * bfhi(x1.y);
                a[12] += mk * w3[0] * bflo(x1.z); a[13] += mk * w3[1] * bfhi(x1.z); a[14] += mk * w3[2] * bflo(x1.w); a[15] += mk * w3[3] * bfhi(x1.w); }
#pragma unroll
            for (int i = 0; i < 16; ++i) a[i] = siluf_(a[i]);
            if (sec < 2) {
                float sq = 0.f;
#pragma unroll
                for (int i = 0; i < 16; ++i) sq += a[i] * a[i];
                sq += shx(sq, 1, lane); sq += shx(sq, 2, lane); sq += shx(sq, 4, lane);
                const float rn = rsqrtf(sq + 1e-6f) * (sec == 0 ? 0.08838834764831845f : 1.0f);
#pragma unroll
                for (int i = 0; i < 16; ++i) a[i] *= rn;
                LAS bf16_t* dstb = (sec == 0 ? qb : kb) + tok * 136 + 16 * cg;
                u32x4 w;
                w.x = cvt_pk_bf16(a[0], a[1]); w.y = cvt_pk_bf16(a[2], a[3]); w.z = cvt_pk_bf16(a[4], a[5]); w.w = cvt_pk_bf16(a[6], a[7]); *(LAS u32x4*)dstb = w;
                w.x = cvt_pk_bf16(a[8], a[9]); w.y = cvt_pk_bf16(a[10], a[11]); w.z = cvt_pk_bf16(a[12], a[13]); w.w = cvt_pk_bf16(a[14], a[15]); *(LAS u32x4*)(dstb + 8) = w;
                if (sec == 0) {
#pragma unroll
                    for (int g4 = 0; g4 < 4; ++g4) { const int a0 = 16 * cg + 4 * g4, sl = a0 >> 5, pp = invperm32(a0 & 31), chunk = 4 * sl + (pp >> 3), within = pp & 7;
                        u32x2 o; o.x = cvt_pk_bf16(a[4 * g4] * eg, a[4 * g4 + 1] * eg); o.y = cvt_pk_bf16(a[4 * g4 + 2] * eg, a[4 * g4 + 3] * eg);
                        *(LAS u32x2*)(img + tok * 256 + ((chunk ^ (tok & 15)) << 4) + within * 2) = o; }
                }
            } else {
#pragma unroll
                for (int i = 0; i < 16; ++i) vf[tok * 129 + 16 * cg + i] = a[i];
            }
        }
    }
    __syncthreads();
    {
        const float gl = gcs[63];
#pragma unroll
        for (int it = 0; it < 2; ++it) { const int pc = tid + 512 * it, r = pc & 127, ch = pc >> 7, sp = ch >> 2, q = ch & 3; float v[8];
#pragma unroll
            for (int i = 0; i < 8; ++i) { const int cc = 32 * sp + (i < 4 ? 4 * q + i : 16 + 4 * q + (i - 4)); v[i] = bf2f(kb[cc * 136 + r]) * __expf(gl - gcs[cc]); }
            u32x4 w; w.x = cvt_pk_bf16(v[0], v[1]); w.y = cvt_pk_bf16(v[2], v[3]); w.z = cvt_pk_bf16(v[4], v[5]); w.w = cvt_pk_bf16(v[6], v[7]);
            *(LAS u32x4*)(img + 16384 + r * 128 + ((ch ^ ((r >> 1) & 7)) << 4)) = w; }
    }
    {
        const int m = lane & 15, q = lane >> 4;
        for (int i4 = 0; i4 < 4; ++i4) {
            const int id = c.wave * 4 + i4, which = id >> 4, tile = id & 15, mt = tile >> 2, ntl = tile & 3;
            f32x4 acc = (f32x4){0.f, 0.f, 0.f, 0.f};
            if (ntl <= mt) {
                const LAS bf16_t* Ab = which ? qb : kb;
#pragma unroll
                for (int s = 0; s < 4; ++s) { const bf16x8 av = *(const LAS bf16x8*)(Ab + (16 * mt + m) * 136 + 32 * s + 8 * q), bv = *(const LAS bf16x8*)(kb + (16 * ntl + m) * 136 + 32 * s + 8 * q);
                    acc = __builtin_amdgcn_mfma_f32_16x16x32_bf16(av, bv, acc, 0, 0, 0); }
            }
            const int j_ = 16 * ntl + m;
#pragma unroll
            for (int jj = 0; jj < 4; ++jj) { const int i_ = 16 * mt + 4 * q + jj;
                const float dec = (i_ >= j_) ? __expf(gcs[i_] - gcs[j_]) : 0.f;
                if (which == 0) { if (ntl <= mt) Am[j_ * 68 + i_] = (i_ > j_) ? gcs[64 + i_] * acc[jj] * dec : 0.f; }
                else { const int sp = j_ >> 5, pp = invperm32(j_ & 31), chunk = 4 * sp + (pp >> 3), within = pp & 7;
                    *(LAS bf16_t*)(img + 32768 + i_ * 128 + ((chunk ^ ((i_ >> 1) & 7)) << 4) + within * 2) = f2bf((i_ >= j_) ? acc[jj] * dec : 0.f); } }
        }
    }
    __syncthreads();
    float x[64];
    if (tid < 256) {
        if (tid < 128) {
#pragma unroll
            for (int r = 0; r < 64; ++r) x[r] = vf[r * 129 + tid] * gcs[64 + r];
        } else {
#pragma unroll
            for (int r = 0; r < 64; ++r) x[r] = bf2f(kb[r * 136 + (tid - 128)]) * gcs[64 + r] * __expf(gcs[r]);
        }
    }
    __syncthreads();
    if (tid < 256) {
        int zoff = 0; asm volatile("" : "+v"(zoff));
        const LAS float* Amz = Am + zoff;
#pragma unroll
        for (int j = 0; j < 63; ++j) {
            const float xj = x[j];
#pragma unroll
            for (int ib = (j + 1) / 4; ib < 16; ++ib) { const f32x4 a4 = *(const LAS f32x4*)(Amz + j * 68 + 4 * ib);
                if (4 * ib + 0 > j) x[4 * ib + 0] -= a4[0] * xj;
                if (4 * ib + 1 > j) x[4 * ib + 1] -= a4[1] * xj;
                if (4 * ib + 2 > j) x[4 * ib + 2] -= a4[2] * xj;
                if (4 * ib + 3 > j) x[4 * ib + 3] -= a4[3] * xj; }
        }
        if (tid < 128) {
            float* ucp = (float*)(p.ws + WS_UCP) + (size_t)unit * 8192 + (size_t)(tid >> 4) * 1024 + (tid & 15) * 4;
#pragma unroll
            for (int mt = 0; mt < 4; ++mt)
#pragma unroll
                for (int q = 0; q < 4; ++q) *(f32x4*)(ucp + mt * 256 + q * 64) = (f32x4){x[16 * mt + 4 * q], x[16 * mt + 4 * q + 1], x[16 * mt + 4 * q + 2], x[16 * mt + 4 * q + 3]};
        } else {
            const int kc = tid - 128, s = kc >> 5, pp = invperm32(kc & 31), chunk = 4 * s + (pp >> 3), within = pp & 7;
#pragma unroll
            for (int r = 0; r < 64; ++r) *(LAS bf16_t*)(lds + r * 256 + ((chunk ^ (r & 15)) << 4) + within * 2) = f2bf(-x[r]);
        }
    }
    __syncthreads();
    {
        unsigned char* dst = p.ws + WS_GBLK + (size_t)unit * GB_BYTES;
#pragma unroll
        for (int it = 0; it < 7; ++it) { const int pc = tid + 512 * it; const LAS unsigned char* src = pc < 1024 ? lds + pc * 16 : img + (pc - 1024) * 16;
            *(u32x4*)(dst + pc * 16) = *(const LAS u32x4*)src; }
        if (tid == 0) ((float*)(p.ws + WS_GL))[unit] = __expf(gcs[63]);
    }
    __syncthreads();
}


__device__ __forceinline__ void gdn_scan(const Ctx& c, const Params& p, int sidx) {
    const int h = sidx >> 1, half = sidx & 1;
    const unsigned char* blk = p.ws + WS_GBLK + (size_t)h * 128 * GB_BYTES;
    bf16_t* OG = (bf16_t*)(p.ws + WS_OGDN);
    LAS unsigned char* lds = c.lds;
    LAS unsigned char* ost = c.lds + LDS_OSTG;
    if (c.wave >= 4) {
        const int par = (c.wave - 4) >> 1, st = c.tid - 256 - 128 * par;
        const unsigned char* src = blk + (size_t)st * 16;
        u32x4 sr[28];
        if (par == 0) {
#pragma unroll
            for (int i = 0; i < 28; ++i) sr[i] = *(const u32x4*)(src + i * 2048);
#pragma unroll
            for (int i = 0; i < 28; ++i) *(LAS u32x4*)(lds + st * 16 + i * 2048) = sr[i];
#pragma unroll
            for (int i = 0; i < 28; ++i) sr[i] = *(const u32x4*)(src + 2 * (size_t)GB_BYTES + i * 2048);
        } else {
#pragma unroll
            for (int i = 0; i < 28; ++i) sr[i] = *(const u32x4*)(src + (size_t)GB_BYTES + i * 2048);
        }
        __syncthreads();
        for (int n = 0; n < 128; ++n) {
            if (((n + 1) & 1) == par) {
                if (n + 1 < 128) {
#pragma unroll
                    for (int i = 0; i < 28; ++i) *(LAS u32x4*)(lds + ((n + 1) & 1) * GB_BYTES + st * 16 + i * 2048) = sr[i];
                }
                if (n + 3 < 128) {
#pragma unroll
                    for (int i = 0; i < 28; ++i) sr[i] = *(const u32x4*)(src + (size_t)(n + 3) * GB_BYTES + i * 2048);
                }
            } else if (n > 0) {
#pragma unroll
                for (int i = 0; i < 4; ++i) { const int pc = st + 128 * i, r = pc >> 3, ch = pc & 7;
                    *(u32x4*)(OG + (size_t)((n - 1) * 64 + r) * 768 + h * 128 + 64 * half + 8 * ch) = *(const LAS u32x4*)(ost + ((n - 1) & 1) * 8192 + r * 128 + ch * 16); }
            }
            __syncthreads();
        }
        if (par == 0) {
#pragma unroll
            for (int i = 0; i < 4; ++i) { const int pc = st + 128 * i, r = pc >> 3, ch = pc & 7;
                *(u32x4*)(OG + (size_t)(127 * 64 + r) * 768 + h * 128 + 64 * half + 8 * ch) = *(const LAS u32x4*)(ost + 8192 + r * 128 + ch * 16); }
        }
        return;
    }
    const int wg = 4 * half + c.wave;
    const float* UCp = (const float*)(p.ws + WS_UCP) + (size_t)h * 128 * 8192 + (size_t)wg * 1024 + c.lane * 4;
    const float* GL = (const float*)(p.ws + WS_GL) + h * 128;
    const int lane = c.lane, m = lane & 15, q = lane >> 4;
    int o128[4], o64[2];
#pragma unroll
    for (int s = 0; s < 4; ++s) o128[s] = m * 256 + (((4 * s + q) ^ m) << 4);
#pragma unroll
    for (int s = 0; s < 2; ++s) o64[s] = m * 128 + (((4 * s + q) ^ (m >> 1)) << 4);
    f32x4 S[8];
#pragma unroll
    for (int i = 0; i < 8; ++i) S[i] = (f32x4){0.f, 0.f, 0.f, 0.f};
    f32x4 ucA[4], ucB[4]; float glA, glB;
#pragma unroll
    for (int mt = 0; mt < 4; ++mt) { ucA[mt] = *(const f32x4*)(UCp + mt * 256); ucB[mt] = *(const f32x4*)(UCp + 8192 + mt * 256); }
    glA = GL[0]; glB = GL[1];
    __syncthreads();
#define SCAN_LD(pp) (*(const LAS bf16x8*)(pp))
#define SCAN_STEP(NN, BUF, UC, GLV) do { \
        const LAS unsigned char* B = lds + (BUF) * GB_BYTES; \
        bf16x8 Sb[4]; \
        _Pragma("unroll") for (int s = 0; s < 4; ++s) Sb[s] = pack_bf16x8(S[2 * s], S[2 * s + 1]); \
        bf16x8 Aw[16], Aq[16]; \
        _Pragma("unroll") for (int mt = 0; mt < 4; ++mt) _Pragma("unroll") for (int s = 0; s < 4; ++s) Aw[mt * 4 + s] = SCAN_LD(B + GB_WC + mt * 4096 + o128[s]); \
        _Pragma("unroll") for (int mt = 0; mt < 4; ++mt) _Pragma("unroll") for (int s = 0; s < 4; ++s) Aq[mt * 4 + s] = SCAN_LD(B + GB_QD + mt * 4096 + o128[s]); \
        f32x4 vn[4]; \
        _Pragma("unroll") for (int mt = 0; mt < 4; ++mt) vn[mt] = UC[mt]; \
        _Pragma("unroll") for (int s = 0; s < 4; ++s) _Pragma("unroll") for (int mt = 0; mt < 4; ++mt) vn[mt] = __builtin_amdgcn_mfma_f32_16x16x32_bf16(Aw[mt * 4 + s], Sb[s], vn[mt], 0, 0, 0); \
        bf16x8 Ak[16]; \
        _Pragma("unroll") for (int i = 0; i < 8; ++i) _Pragma("unroll") for (int s = 0; s < 2; ++s) Ak[i * 2 + s] = SCAN_LD(B + GB_KDT + i * 2048 + o64[s]); \
        f32x4 Oa[4]; \
        _Pragma("unroll") for (int mt = 0; mt < 4; ++mt) Oa[mt] = (f32x4){0.f, 0.f, 0.f, 0.f}; \
        _Pragma("unroll") for (int s = 0; s < 4; ++s) _Pragma("unroll") for (int mt = 0; mt < 4; ++mt) Oa[mt] = __builtin_amdgcn_mfma_f32_16x16x32_bf16(Aq[mt * 4 + s], Sb[s], Oa[mt], 0, 0, 0); \
        bf16x8 Vb[2]; Vb[0] = pack_bf16x8(vn[0], vn[1]); Vb[1] = pack_bf16x8(vn[2], vn[3]); \
        bf16x8 Ap[8]; \
        _Pragma("unroll") for (int mt = 0; mt < 4; ++mt) _Pragma("unroll") for (int s = 0; s < 2; ++s) Ap[mt * 2 + s] = SCAN_LD(B + GB_QK + mt * 2048 + o64[s]); \
        _Pragma("unroll") for (int i = 0; i < 8; ++i) S[i] = S[i] * (GLV); \
        _Pragma("unroll") for (int s = 0; s < 2; ++s) _Pragma("unroll") for (int i = 0; i < 8; ++i) S[i] = __builtin_amdgcn_mfma_f32_16x16x32_bf16(Ak[i * 2 + s], Vb[s], S[i], 0, 0, 0); \
        _Pragma("unroll") for (int s = 0; s < 2; ++s) _Pragma("unroll") for (int mt = 0; mt < 4; ++mt) Oa[mt] = __builtin_amdgcn_mfma_f32_16x16x32_bf16(Ap[mt * 2 + s], Vb[s], Oa[mt], 0, 0, 0); \
        _Pragma("unroll") for (int mt = 0; mt < 4; ++mt) _Pragma("unroll") for (int jj = 0; jj < 4; ++jj) \
            *(LAS bf16_t*)(ost + (BUF) * 8192 + (16 * mt + 4 * q + jj) * 128 + (16 * c.wave + m) * 2) = f2bf(Oa[mt][jj]); \
    } while (0)
    for (int n = 0; n < 128; n += 2) {
        SCAN_STEP(n, 0, ucA, glA);
        if (n + 2 < 128) {
#pragma unroll
            for (int mt = 0; mt < 4; ++mt) ucA[mt] = *(const f32x4*)(UCp + (size_t)(n + 2) * 8192 + mt * 256);
            glA = GL[n + 2]; }
        __syncthreads();
        SCAN_STEP(n + 1, 1, ucB, glB);
        if (n + 3 < 128) {
#pragma unroll
            for (int mt = 0; mt < 4; ++mt) ucB[mt] = *(const f32x4*)(UCp + (size_t)(n + 3) * 8192 + mt * 256);
            glB = GL[n + 3]; }
        __syncthreads();
    }
#undef SCAN_STEP
#undef SCAN_LD
}


template <class Epi, bool UP, class Order>
__device__ __forceinline__ void moe_gemm(const Ctx& c, const bf16_t* A, const float* Wl, const Order& S, const Epi& E) {
    constexpr int K = UP ? D : EH, NW = UP ? 1024 : D, NSTEP = K / 64, STG = 49152;
    int tid = threadIdx.x; asm volatile("" : "+v"(tid));
    const int wid = __builtin_amdgcn_readfirstlane(tid >> 6), lane = tid & 63, wr = wid >> 2, wc = wid & 3, fr = lane & 15, fq = lane >> 4;
    LAS unsigned char* lds = c.lds;
    const int par = wid & 1, tp = lane + 64 * (wid >> 1);
    const int bk = tp >> 6, bc4 = tp & 63;
    const int ar = tp >> 3, ach = tp & 7;
    const unsigned a_rd0 = (unsigned)((64 * wr + fr) * 128 + (((0 + fq) ^ ((fr >> 1) & 7)) << 4)), a_rd1 = (unsigned)((64 * wr + fr) * 128 + (((4 + fq) ^ ((fr >> 1) & 7)) << 4));
    const unsigned q4 = (lane & 15) >> 2, p4 = lane & 3, qb = fq & 1;
    const unsigned b_base = 16384u + (8u * fq + q4) * 512u + 64u * ((unsigned)wc ^ q4) + 16u * p4;
    const unsigned b00 = b_base + 8u * qb, b01 = b_base + 8u * (1u - qb), b10 = b00 + 4u * 512u, b11 = b01 + 4u * 512u;
    pg8::Unit u;
    for (int ui = 0; S.next(ui, u); ++ui) {
        const int e = S.tb.mt_e[u.pm], j = u.pn - e * S.nN;
        const float* Wb = Wl + (size_t)e * K * NW + (UP ? ((bc4 < 32) ? 128 * j + 4 * bc4 : 512 + 128 * j + 4 * (bc4 - 32)) : 256 * j + 4 * bc4) + (size_t)bk * NW;
        const bf16_t* Ap[4];
#pragma unroll
        for (int i = 0; i < 4; ++i) { const int row = ar + 32 * i; Ap[i] = (UP ? A + (size_t)S.arow(u, row) * K : A + (size_t)(u.pm * 128 + row) * K) + 8 * (ach ^ ((row >> 1) & 7)); }
        f32x4 acc[2][4][2];
#pragma unroll
        for (int b = 0; b < 2; ++b)
#pragma unroll
            for (int m = 0; m < 4; ++m)
#pragma unroll
                for (int n = 0; n < 2; ++n) acc[b][m][n] = (f32x4){0.f, 0.f, 0.f, 0.f};
        f32x4 wv[16]; u32x4 av[4];
#define MOE_LOAD(T) do { _Pragma("unroll") for (int i = 0; i < 16; ++i) wv[i] = *(const f32x4*)(Wb + (size_t)((T) * 64 + 4 * i) * NW); \
        _Pragma("unroll") for (int i = 0; i < 4; ++i) av[i] = *(const u32x4*)(Ap[i] + (T) * 64); } while (0)
#define MOE_WRITE(T) do { LAS unsigned char* sb = lds + ((T) & 1) * STG; \
        _Pragma("unroll") for (int i = 0; i < 4; ++i) *(LAS u32x4*)(sb + (ar + 32 * i) * 128 + ach * 16) = av[i]; \
        _Pragma("unroll") for (int i = 0; i < 16; ++i) { const int kk = bk + 4 * i; u32x2 w2; w2.x = cvt_pk_bf16(wv[i][0], wv[i][1]); w2.y = cvt_pk_bf16(wv[i][2], wv[i][3]); \
            *(LAS u32x2*)(sb + 16384 + kk * 512 + ((8 * bc4) ^ ((((kk >> 3) & 1) << 3) | ((kk & 3) << 6)))) = w2; } } while (0)
        if (par == 0) { MOE_LOAD(0); MOE_WRITE(0); if (2 < NSTEP) MOE_LOAD(2); }
        else { if (1 < NSTEP) MOE_LOAD(1); }
        for (int t = 0; t < NSTEP; ++t) {
            __syncthreads();
            if (((t + 1) & 1) == par) { if (t + 1 < NSTEP) MOE_WRITE(t + 1); if (t + 3 < NSTEP) MOE_LOAD(t + 3); }
            const unsigned so = (unsigned)(t & 1) * STG;
#pragma unroll
            for (int s2 = 0; s2 < 2; ++s2) {
                bf16x8 Bf[2][2];
#pragma unroll
                for (int bj = 0; bj < 2; ++bj) { Bf[bj][0] = tr_pair(lds + so + b00 + 256 * bj + 16384 * s2, lds + so + b10 + 256 * bj + 16384 * s2);
                                                 Bf[bj][1] = tr_pair(lds + so + b01 + 256 * bj + 16384 * s2, lds + so + b11 + 256 * bj + 16384 * s2); }
                bf16x8 Af[4];
#pragma unroll
                for (int m = 0; m < 4; ++m) Af[m] = *(const LAS bf16x8*)(lds + so + (s2 ? a_rd1 : a_rd0) + m * 2048);
#pragma unroll
                for (int bj = 0; bj < 2; ++bj)
#pragma unroll
                    for (int m = 0; m < 4; ++m)
#pragma unroll
                        for (int n = 0; n < 2; ++n) acc[bj][m][n] = __builtin_amdgcn_mfma_f32_16x16x32_bf16(Bf[bj][n], Af[m], acc[bj][m][n], 0, 0, 0);
            }
        }
#undef MOE_LOAD
#undef MOE_WRITE
        E(acc, u, wr, wc, fr, fq);
        if constexpr (UP) asm volatile("s_waitcnt vmcnt(0)" ::: "memory");
        __syncthreads();
        if constexpr (UP) { if (tid == 0) { __builtin_amdgcn_fence(__ATOMIC_RELEASE, "agent"); asm volatile("s_waitcnt vmcnt(0)" ::: "memory");
            (void)__hip_atomic_fetch_add(S.done + u.pm, 1u, __ATOMIC_RELAXED, __HIP_MEMORY_SCOPE_AGENT); } }
    }
}

__device__ __forceinline__ void m2_rd_b(bf16x8& b0, bf16x8& b1, unsigned a0, unsigned a1) {
    s16x4 x0, x1, x2, x3;
    asm volatile("ds_read_b64_tr_b16 %0, %4\n\tds_read_b64_tr_b16 %1, %4 offset:1024\n\tds_read_b64_tr_b16 %2, %5\n\tds_read_b64_tr_b16 %3, %5 offset:1024\n\ts_waitcnt lgkmcnt(0)"
                 : "=&v"(x0), "=&v"(x1), "=&v"(x2), "=&v"(x3) : "v"(a0), "v"(a1) : "memory");
    b0 = __builtin_shufflevector(x0, x1, 0, 1, 2, 3, 4, 5, 6, 7); b1 = __builtin_shufflevector(x2, x3, 0, 1, 2, 3, 4, 5, 6, 7); }
__device__ __forceinline__ void m2_rd_a4(bf16x8 (&a)[4], unsigned addr) {
    asm volatile("ds_read_b128 %0, %4\n\tds_read_b128 %1, %4 offset:2048\n\tds_read_b128 %2, %4 offset:4096\n\tds_read_b128 %3, %4 offset:6144\n\ts_waitcnt lgkmcnt(0)"
                 : "=&v"(a[0]), "=&v"(a[1]), "=&v"(a[2]), "=&v"(a[3]) : "v"(addr) : "memory"); }
template <bool UP, int MODE, class Order, class Epi>
__device__ __forceinline__ void moe_gemm2(const Ctx& c, const bf16_t* A, const float* Wl, const int* tok, const Order& S, const Epi& E) {
    constexpr int K = UP ? D : EH, NW = UP ? 1024 : D, NSTEP = K / 64;
    constexpr unsigned ASTG = 49152u, BOFF = 98304u, BSTG = 16384u;
    int tid = threadIdx.x; asm volatile("" : "+v"(tid));
    const int wid = __builtin_amdgcn_readfirstlane(tid >> 6), lane = tid & 63, wr = wid >> 2, wc = wid & 3, fr = lane & 15, fq = lane >> 4;
    LAS unsigned char* lds = c.lds; const unsigned ldsb = (unsigned)(unsigned long long)lds;
    const int par = wid & 1, gi = wid >> 1, tp = lane + 64 * gi;
    const int bk = tp >> 5, bc = tp & 31;
    const int pimg = UP ? (((bc & 15) >> 2) * 8 + (bc & 3) * 2 + (bc >> 4)) : bc;
    const unsigned bw0 = (unsigned)(bk * 256) + (unsigned)((8 * pimg) ^ ((bk & 3) << 6));
    const unsigned a_rd0 = (unsigned)((64 * wr + fr) * 128 + (((0 + fq) ^ ((fr >> 1) & 7)) << 4)), a_rd1 = (unsigned)((64 * wr + fr) * 128 + (((4 + fq) ^ ((fr >> 1) & 7)) << 4));
    const unsigned q4 = (lane & 15) >> 2, p4 = lane & 3, qb = fq & 1;
    const unsigned b_base = BOFF + (8u * fq + q4) * 256u + 64u * ((unsigned)wc ^ q4) + 16u * p4;
    const unsigned b00 = b_base + 8u * qb, b01 = b_base + 8u * (1u - qb);
    const int drow = lane >> 3; const unsigned dch = (unsigned)(((lane & 7) ^ ((4 * (gi & 1) + (lane >> 4)) & 7)) << 4);
    int rt, j;
    for (int ui = 0; S.next(ui, rt, j); ++ui) {
        const int e = S.tb.rt_e[rt], r0 = S.tb.rt_r0[rt], ne = S.tb.cnt[e], row0 = S.tb.first[e] * 128 + r0;
        const int rows = (ne - r0) < 384 ? (ne - r0) : 384, nb = (rows + 127) >> 7;
        const float* Wb = Wl + (size_t)e * K * NW + (UP ? ((bc < 16) ? 64 * j + 4 * bc : 512 + 64 * j + 4 * (bc - 16)) : 128 * j + 4 * bc) + (size_t)bk * NW;
        unsigned aoff[12];
#pragma unroll
        for (int i = 0; i < 12; ++i) { const int pos = r0 + 8 * (4 * i + gi) + drow; int ar;
            if constexpr (UP) { ar = 0; if (pos < ne) ar = tok[e * 8192 + pos] >> 1; } else ar = row0 - r0 + pos;
            aoff[i] = (unsigned)ar * (unsigned)(K * 2) + dch; }
        f32x4 acc[3][4][2];
#pragma unroll
        for (int b = 0; b < 3; ++b)
#pragma unroll
            for (int m = 0; m < 4; ++m)
#pragma unroll
                for (int n = 0; n < 2; ++n) acc[b][m][n] = (f32x4){0.f, 0.f, 0.f, 0.f};
        f32x4 wv[8];
        if constexpr (MODE & 1) { _Pragma("unroll") for (int i = 0; i < 8; ++i) wv[i] = (f32x4){1.f, 1.f, 1.f, 1.f}; }
#define M2_LOAD(T) do { if constexpr (!(MODE & 1)) { _Pragma("unroll") for (int i = 0; i < 8; ++i) wv[i] = *(const f32x4*)(Wb + (size_t)((T) * 64 + 8 * i) * NW); } } while (0)
#define M2_WRITE(T) do { LAS unsigned char* sb = lds + BOFF + ((T) & 1) * BSTG; \
        _Pragma("unroll") for (int i = 0; i < 8; ++i) { u32x2 w2; w2.x = cvt_pk_bf16(wv[i][0], wv[i][1]); w2.y = cvt_pk_bf16(wv[i][2], wv[i][3]); \
            *(LAS u32x2*)(sb + (bw0 ^ (unsigned)((i & 1) << 3)) + i * 2048) = w2; } } while (0)
#define M2_DMA(T) do { LAS unsigned char* sa = lds + ((T) & 1) * ASTG + gi * 1024; const char* ga = (const char*)A + (T) * 128; \
        _Pragma("unroll") for (int i = 0; i < 12; ++i) if ((i >> 2) < nb && !(MODE & 2)) __builtin_amdgcn_global_load_lds((const unsigned*)(ga + aoff[i]), (LAS unsigned*)(sa + i * 4096), 16, 0, 0); } while (0)
        __syncthreads();
        if (par == 0) { M2_LOAD(0); M2_WRITE(0); M2_LOAD(2); }
        else { M2_LOAD(1); M2_DMA(0); asm volatile("s_waitcnt vmcnt(0)" ::: "memory"); }
        for (int t = 0; t < NSTEP; ++t) {
            asm volatile("s_waitcnt lgkmcnt(0)" ::: "memory"); __builtin_amdgcn_s_barrier(); asm volatile("" ::: "memory");
            if (((t + 1) & 1) == par) { if (t + 1 < NSTEP) M2_WRITE(t + 1); if (t + 3 < NSTEP) M2_LOAD(t + 3); }
            else { if (t + 1 < NSTEP) M2_DMA(t + 1); }
            const unsigned sa = (unsigned)(t & 1) * ASTG, sbo = (unsigned)(t & 1) * BSTG;
#pragma unroll
            for (int s2 = 0; s2 < ((MODE & 4) ? 0 : 2); ++s2) {
                bf16x8 Bf[2];
                m2_rd_b(Bf[0], Bf[1], ldsb + sbo + b00 + 8192 * s2, ldsb + sbo + b01 + 8192 * s2);
#pragma unroll
                for (int blk = 0; blk < 3; ++blk) if (blk < nb) {
                    bf16x8 Af[4];
                    m2_rd_a4(Af, ldsb + sa + blk * 16384 + (s2 ? a_rd1 : a_rd0));
#pragma unroll
                    for (int m = 0; m < 4; ++m)
#pragma unroll
                        for (int n = 0; n < 2; ++n) acc[blk][m][n] = __builtin_amdgcn_mfma_f32_16x16x32_bf16(Bf[n], Af[m], acc[blk][m][n], 0, 0, 0);
                }
            }
            if (((t + 1) & 1) != par) asm volatile("s_waitcnt vmcnt(0)" ::: "memory");
        }
#undef M2_LOAD
#undef M2_WRITE
#undef M2_DMA
        E(acc, row0, nb, e, r0, ne, j, wr, wc, fr, fq);
        if constexpr (UP) { asm volatile("s_waitcnt vmcnt(0)" ::: "memory");
            __syncthreads();
            if (tid == 0) { __builtin_amdgcn_fence(__ATOMIC_RELEASE, "agent"); asm volatile("s_waitcnt vmcnt(0)" ::: "memory");
                (void)__hip_atomic_fetch_add(S.done + rt, 1u, __ATOMIC_RELAXED, __HIP_MEMORY_SCOPE_AGENT); } }
    }
}

__device__ __forceinline__ void phase_local(const Ctx& c, const Params& p, int L) {
    const bf16_t* U = (const bf16_t*)(p.ws + WS_U);
    const int gw = c.bid * 8 + c.wave, GW = c.G * 8, lane = c.lane;
    for (int rep = 0; rep < 1 + (p.pad == 1); ++rep)
    for (int unit = c.bid; unit < 768; unit += c.G) gdn_chunk_local(c, p, L, unit);
    for (int rep = 0; rep < 1 + (p.pad == 2); ++rep) {
        bf16_t* YB = (bf16_t*)(p.ws + WS_YBR) + (size_t)1 * T * 768;
        const float* cbw = p.conv_b_w + (size_t)L * 31 * 768; const float* cbb = p.conv_b_b + L * 768; const float* lg = p.ln_b_g + L * 768; const float* lb = p.ln_b_b + L * 768;
        LAS unsigned char* glu = c.lds;
        LAS unsigned char* cbs = c.lds + 70656;
        for (int tile = c.bid; tile < T / 16; tile += c.G) {
            const int t0 = tile * 16;
            for (int it = c.tid; it < 46 * 96; it += NTHREADS) { const int rr = it / 96, c8 = it - rr * 96, tt = t0 - 30 + rr; u32x4 w = (u32x4){0u, 0u, 0u, 0u};
                if (tt >= 0) { const u32x4 ga = *(const u32x4*)(U + (size_t)tt * NU + UC_B + 8 * c8), gb = *(const u32x4*)(U + (size_t)tt * NU + UC_B + 768 + 8 * c8);
                    w.x = cvt_pk_bf16(bflo(ga.x) * sigmoidf_(bflo(gb.x)), bfhi(ga.x) * sigmoidf_(bfhi(gb.x))); w.y = cvt_pk_bf16(bflo(ga.y) * sigmoidf_(bflo(gb.y)), bfhi(ga.y) * sigmoidf_(bfhi(gb.y)));
                    w.z = cvt_pk_bf16(bflo(ga.z) * sigmoidf_(bflo(gb.z)), bfhi(ga.z) * sigmoidf_(bfhi(gb.z))); w.w = cvt_pk_bf16(bflo(ga.w) * sigmoidf_(bflo(gb.w)), bfhi(ga.w) * sigmoidf_(bfhi(gb.w))); }
                *(LAS u32x4*)(glu + rr * 1536 + c8 * 16) = w; }
            __syncthreads();
            if (c.tid < 384) {
                float w0[31], w1[31], a0[16], a1[16];
#pragma unroll
                for (int j = 0; j < 31; ++j) { const float2 wv = *(const float2*)(cbw + j * 768 + 2 * c.tid); w0[j] = wv.x; w1[j] = wv.y; }
#pragma unroll
                for (int t = 0; t < 16; ++t) { a0[t] = 0.f; a1[t] = 0.f; }
#pragma unroll
                for (int rr = 0; rr < 46; ++rr) { const unsigned g2 = *(const LAS unsigned*)(glu + rr * 1536 + c.tid * 4); const float lo = bflo(g2), hi = bfhi(g2);
#pragma unroll
                    for (int t = 0; t < 16; ++t) { const int j = rr - t; if (j >= 0 && j <= 30) { a0[t] += w0[j] * lo; a1[t] += w1[j] * hi; } } }
                const float2 bv = *(const float2*)(cbb + 2 * c.tid);
#pragma unroll
                for (int t = 0; t < 16; ++t) *(LAS f32x2*)(cbs + t * 3072 + c.tid * 8) = (f32x2){a0[t] + bv.x, a1[t] + bv.y};
            }
            __syncthreads();
            for (int i = 0; i < 2; ++i) { const int tl = c.wave * 2 + i; f32x2 v[6]; float sm = 0.f;
#pragma unroll
                for (int k = 0; k < 6; ++k) { v[k] = *(const LAS f32x2*)(cbs + tl * 3072 + (lane + 64 * k) * 8); sm += v[k].x + v[k].y; }
                const float mu = wave_sum(sm, lane) * (1.0f / 768.f); float vs = 0.f;
#pragma unroll
                for (int k = 0; k < 6; ++k) { const float d0 = v[k].x - mu, d1 = v[k].y - mu; vs += d0 * d0 + d1 * d1; }
                const float rs = rsqrtf(wave_sum(vs, lane) * (1.0f / 768.f) + 1e-5f);
#pragma unroll
                for (int k = 0; k < 6; ++k) { const int ch = 2 * (lane + 64 * k); const float2 gg = *(const float2*)(lg + ch), bb = *(const float2*)(lb + ch);
                    const float y0 = (v[k].x - mu) * rs * gg.x + bb.x, y1 = (v[k].y - mu) * rs * gg.y + bb.y;
                    *(unsigned*)(YB + (size_t)(t0 + tl) * 768 + ch) = cvt_pk_bf16(siluf_(y0), siluf_(y1)); } }
            __syncthreads();
        }
    }
    for (int rep = 0; rep < 1 + (p.pad == 3); ++rep) {
        bf16_t* QR = (bf16_t*)(p.ws + WS_QR); bf16_t* KR = (bf16_t*)(p.ws + WS_KR);
        int rtid = c.tid; asm volatile("" : "+v"(rtid));
        for (int it = c.bid * NTHREADS + rtid; it < T * 8; it += c.G * NTHREADS) {
            const int t = it >> 3, c8 = it & 7; const float ps = (float)p.pos[t]; float cs[8], sn[8];
#pragma unroll
            for (int i = 0; i < 8; ++i) {
                double rev = (double)ps * (double)ROPE_INV[8 * c8 + i] * 0.15915494309189535; rev -= floor(rev);
                const float fr = (float)rev; cs[i] = __builtin_amdgcn_cosf(fr); sn[i] = __builtin_amdgcn_sinf(fr); }
            for (int hb = 0; hb < 36; hb += 4) {
                u32x4 x1[4], x2[4];
#pragma unroll
                for (int j = 0; j < 4; ++j) { const int hv = hb + j, isk = hv >= 18, hh = hv - 18 * isk; const bf16_t* src = U + (size_t)t * NU + UC_C + isk * 2304 + hh * 128 + 8 * c8;
                    x1[j] = *(const u32x4*)src; x2[j] = *(const u32x4*)(src + 64); }
#pragma unroll
                for (int j = 0; j < 4; ++j) { const int hv = hb + j, isk = hv >= 18, hh = hv - 18 * isk; const float sc = isk ? 1.0f : 0.08838834764831845f;
                    float a[8], b[8];
                    a[0] = bflo(x1[j].x); a[1] = bfhi(x1[j].x); a[2] = bflo(x1[j].y); a[3] = bfhi(x1[j].y); a[4] = bflo(x1[j].z); a[5] = bfhi(x1[j].z); a[6] = bflo(x1[j].w); a[7] = bfhi(x1[j].w);
                    b[0] = bflo(x2[j].x); b[1] = bfhi(x2[j].x); b[2] = bflo(x2[j].y); b[3] = bfhi(x2[j].y); b[4] = bflo(x2[j].z); b[5] = bfhi(x2[j].z); b[6] = bflo(x2[j].w); b[7] = bfhi(x2[j].w);
                    float o1[8], o2[8];
#pragma unroll
                    for (int i = 0; i < 8; ++i) { o1[i] = (a[i] * cs[i] - b[i] * sn[i]) * sc; o2[i] = (b[i] * cs[i] + a[i] * sn[i]) * sc; }
                    bf16_t* dst = (isk ? KR : QR) + (size_t)t * 2304 + hh * 128 + 8 * c8;
                    u32x4 w1, w2; w1.x = cvt_pk_bf16(o1[0], o1[1]); w1.y = cvt_pk_bf16(o1[2], o1[3]); w1.z = cvt_pk_bf16(o1[4], o1[5]); w1.w = cvt_pk_bf16(o1[6], o1[7]);
                    w2.x = cvt_pk_bf16(o2[0], o2[1]); w2.y = cvt_pk_bf16(o2[2], o2[3]); w2.z = cvt_pk_bf16(o2[4], o2[5]); w2.w = cvt_pk_bf16(o2[6], o2[7]);
                    *(u32x4*)dst = w1; *(u32x4*)(dst + 64) = w2; }
            }
        }
    }
    for (int rep = 0; rep < 1 + (p.pad == 4); ++rep) {
        bf16_t* YD = (bf16_t*)(p.ws + WS_YBR) + (size_t)3 * T * 768;
        const bf16_t* PWT = (const bf16_t*)(p.ws + WS_PWT) + (size_t)L * 4 * 192 * 192;
        LAS unsigned char* pim = c.lds;
        const int m = lane & 15, q = lane >> 4;
        for (int tile = c.bid; tile < T / 32; tile += c.G) {
            const int t0 = tile * 32;
            for (int it = c.tid; it < 32 * 96; it += NTHREADS) { const int rr = it / 96, c8 = it - rr * 96, t = t0 + rr, g = c8 / 24, w = 2 << g, cnt = (t + 1) < w ? (t + 1) : w;
                float sacc[8];
#pragma unroll
                for (int i = 0; i < 8; ++i) sacc[i] = 0.f;
                const bf16_t* up = U + (size_t)t * NU + UC_D + 8 * c8; u32x4 x0 = (u32x4){0u, 0u, 0u, 0u};
#pragma unroll
                for (int d = 0; d < 16; ++d) { if (d >= cnt) break; const u32x4 xv = *(const u32x4*)(up - (size_t)d * NU); if (d == 0) x0 = xv;
                    sacc[0] += bflo(xv.x); sacc[1] += bfhi(xv.x); sacc[2] += bflo(xv.y); sacc[3] += bfhi(xv.y); sacc[4] += bflo(xv.z); sacc[5] += bfhi(xv.z); sacc[6] += bflo(xv.w); sacc[7] += bfhi(xv.w); }
                const float ic = 1.0f / (float)cnt; u32x4 o;
                o.x = cvt_pk_bf16(sacc[0] * ic - bflo(x0.x), sacc[1] * ic - bfhi(x0.x)); o.y = cvt_pk_bf16(sacc[2] * ic - bflo(x0.y), sacc[3] * ic - bfhi(x0.y));
                o.z = cvt_pk_bf16(sacc[4] * ic - bflo(x0.z), sacc[5] * ic - bfhi(x0.z)); o.w = cvt_pk_bf16(sacc[6] * ic - bflo(x0.w), sacc[7] * ic - bfhi(x0.w));
                *(LAS u32x4*)(pim + rr * 1536 + ((c8 ^ (rr & 15)) << 4)) = o; }
            __syncthreads();
            f32x4 pa0[6], pa1[6];
#pragma unroll
            for (int pr = 0; pr < 6; ++pr) { const int pair = c.wave * 6 + pr, g = pair / 12, ntl = pair - g * 12;
                f32x4 acc0 = (f32x4){0.f, 0.f, 0.f, 0.f}, acc1 = (f32x4){0.f, 0.f, 0.f, 0.f};
                const bf16_t* bp = PWT + (size_t)(g * 192 + 16 * ntl + m) * 192 + 8 * q;
#pragma unroll
                for (int s6 = 0; s6 < 6; ++s6) { const bf16x8 bv = *(const bf16x8*)(bp + 32 * s6); const int ch = g * 24 + 4 * s6 + q;
                    const bf16x8 a0v = *(const LAS bf16x8*)(pim + m * 1536 + ((ch ^ m) << 4)), a1v = *(const LAS bf16x8*)(pim + (16 + m) * 1536 + ((ch ^ m) << 4));
                    acc0 = __builtin_amdgcn_mfma_f32_16x16x32_bf16(a0v, bv, acc0, 0, 0, 0); acc1 = __builtin_amdgcn_mfma_f32_16x16x32_bf16(a1v, bv, acc1, 0, 0, 0); }
                pa0[pr] = acc0; pa1[pr] = acc1; }
#pragma unroll
            for (int pr = 0; pr < 6; ++pr) { const int pair = c.wave * 6 + pr, g = pair / 12, ntl = pair - g * 12;
                bf16_t* yp = YD + (size_t)(t0 + 4 * q) * 768 + g * 192 + 16 * ntl + m;
#pragma unroll
                for (int jj = 0; jj < 4; ++jj) { yp[(size_t)jj * 768] = f2bf(pa0[pr][jj]); yp[(size_t)(16 + jj) * 768] = f2bf(pa1[pr][jj]); } }
            __syncthreads();
        }
    }
}

__device__ __forceinline__ unsigned off_b(unsigned row, unsigned ch) { return 256u * row + 16u * (ch ^ (((row & 3) << 2) | ((row >> 2) & 3))); }
#define ATT_PV4(OFF, A, DT0) do { \
    _Pragma("unroll") for (int i4 = 0; i4 < 4; ++i4) { \
        const bf16x8 vt = tr_pair(Vs + (vb0 + 32u * (unsigned)(((DT0) + i4) ^ cm0) + (OFF)), Vs + (vb1 + 32u * (unsigned)(((DT0) + i4) ^ cm1) + (OFF))); \
        O[(DT0) + i4] = __builtin_amdgcn_mfma_f32_16x16x32_bf16(vt, Pb[A], O[(DT0) + i4], 0, 0, 0); } } while (0)
#define ATT_PV(OFF, A) do { ATT_PV4(OFF, A, 0); ATT_PV4(OFF, A, 4); } while (0)
struct AttnRegs { u32x4 kv[8], vv[8]; bf16x8 Qb[4]; };
__device__ __forceinline__ void attn_issue_k(const Ctx& c, const Params& p, int u, AttnRegs& r) {
    const int h = u % 6, rbi = (u / 6) & 63, g = u / 384;
    const int dl = g == 0 ? 1 : (g == 1 ? 4 : 16), nb = 64 / dl, rs = rbi / nb, b = rbi % nb, gh = g * 6 + h;
    const bf16_t* KR = (const bf16_t*)(p.ws + WS_KR);
#pragma unroll
    for (int it = 0; it < 8; ++it) { const int pc = c.tid + 512 * it, j = pc >> 4, ch = pc & 15, pos = 128 * (b - 1) + j;
        r.kv[it] = (u32x4){0u, 0u, 0u, 0u};
        if (pos >= 0) { const size_t t = (size_t)pos * dl + rs; r.kv[it] = *(const u32x4*)(KR + t * 2304 + gh * 128 + 8 * ch); } }
}
__device__ __forceinline__ void attn_issue_vq(const Ctx& c, const Params& p, int u, AttnRegs& r) {
    const int h = u % 6, rbi = (u / 6) & 63, g = u / 384;
    const int dl = g == 0 ? 1 : (g == 1 ? 4 : 16), nb = 64 / dl, rs = rbi / nb, b = rbi % nb, gh = g * 6 + h;
    const bf16_t* U = (const bf16_t*)(p.ws + WS_U); const bf16_t* QR = (const bf16_t*)(p.ws + WS_QR);
    const int lane = c.lane, n = lane & 15, qd = lane >> 4;
#pragma unroll
    for (int it = 0; it < 8; ++it) { const int pc = c.tid + 512 * it, j = pc >> 4, ch = pc & 15, pos = 128 * (b - 1) + j;
        r.vv[it] = (u32x4){0u, 0u, 0u, 0u};
        if (pos >= 0) { const size_t t = (size_t)pos * dl + rs; r.vv[it] = *(const u32x4*)(U + t * NU + UC_C + 4608 + gh * 128 + 8 * ch); } }
    const int iq = 16 * c.wave + n; const size_t tq = (size_t)(128 * b + iq) * dl + rs;
#pragma unroll
    for (int s = 0; s < 4; ++s) r.Qb[s] = *(const bf16x8*)(QR + tq * 2304 + gh * 128 + 32 * s + 8 * qd);
}
__device__ __forceinline__ void attn_stage(const Ctx& c, const AttnRegs& r) {
    LAS unsigned char* Ks = c.lds; LAS unsigned char* Vs = c.lds + 65536;
#pragma unroll
    for (int it = 0; it < 8; ++it) { const int pc = c.tid + 512 * it, j = pc >> 4, ch = pc & 15;
        *(LAS u32x4*)(Ks + off_b(j, ch)) = r.kv[it]; *(LAS u32x4*)(Vs + off_b((j & ~31) + invperm32(j & 31), ch)) = r.vv[it]; }
}
__device__ __forceinline__ void attn_compute(const Ctx& c, const Params& p, int u, AttnRegs& ar, int un) {
    const int h = u % 6, rbi = (u / 6) & 63, g = u / 384;
    const int dl = g == 0 ? 1 : (g == 1 ? 4 : 16), nb = 64 / dl, r = rbi / nb, b = rbi % nb;
    LAS unsigned char* Ks = c.lds; LAS unsigned char* Vs = c.lds + 65536;
    const int lane = c.lane, n = lane & 15, qd = lane >> 4;
    const int iq = 16 * c.wave + n;
    const size_t tq = (size_t)(128 * b + iq) * dl + r;
    const int f = c.wave & ~1;
    f32x4 S[10];
    {
        const unsigned mask = ((n & 3) << 2) | ((n >> 2) & 3);
        unsigned ka[4];
#pragma unroll
        for (int s = 0; s < 4; ++s) ka[s] = 256u * n + 16u * ((4 * s + qd) ^ mask) + (unsigned)f * 4096u;
#pragma unroll
        for (int jj = 0; jj < 10; ++jj) { f32x4 acc = (f32x4){0.f, 0.f, 0.f, 0.f};
#pragma unroll
            for (int s = 0; s < 4; ++s) acc = __builtin_amdgcn_mfma_f32_16x16x32_bf16(*(const LAS bf16x8*)(Ks + ka[s] + jj * 4096), ar.Qb[s], acc, 0, 0, 0);
            S[jj] = acc; }
    }
    float mx = -INFINITY;
#pragma unroll
    for (int jj = 0; jj < 10; ++jj)
#pragma unroll
        for (int e = 0; e < 4; ++e) { const int j = 16 * (f + jj) + 4 * qd + e; const bool ok = (j >= iq) && (j <= iq + 128) && (b > 0 || j >= 128);
            S[jj][e] = ok ? S[jj][e] : -INFINITY; mx = fmaxf(mx, S[jj][e]); }
    mx = fmaxf(mx, shx(mx, 16, lane)); mx = fmaxf(mx, shx(mx, 32, lane));
    float l = 0.f;
#pragma unroll
    for (int jj = 0; jj < 10; ++jj)
#pragma unroll
        for (int e = 0; e < 4; ++e) { const float pv = __expf(S[jj][e] - mx); S[jj][e] = pv; l += pv; }
    l += shx(l, 16, lane); l += shx(l, 32, lane);
    bf16x8 Pb[5];
#pragma unroll
    for (int a = 0; a < 5; ++a) Pb[a] = pack_bf16x8(S[2 * a], S[2 * a + 1]);
    if (un < 1152) attn_issue_vq(c, p, un, ar);
    f32x4 O[8];
#pragma unroll
    for (int dt = 0; dt < 8; ++dt) O[dt] = (f32x4){0.f, 0.f, 0.f, 0.f};
    {
        const unsigned q = (lane & 15) >> 2, pp = lane & 3;
        const unsigned m0 = (q << 2) | ((2 * qd + 0) & 3), m1 = (q << 2) | ((2 * qd + 1) & 3);
        const unsigned cm0 = m0 >> 1, cm1 = m1 >> 1;
        const unsigned vbase = (unsigned)(f >> 1) * 8192u + 8u * (pp & 1);
        const unsigned vb0 = vbase + 256u * (8 * qd + 0 + q) + 16u * ((pp >> 1) ^ (m0 & 1)), vb1 = vbase + 256u * (8 * qd + 4 + q) + 16u * ((pp >> 1) ^ (m1 & 1));
        ATT_PV(0, 0); ATT_PV(8192, 1); ATT_PV(16384, 2); ATT_PV(24576, 3); ATT_PV(32768, 4);
    }
    {
        const float il = 1.0f / l;
        bf16_t* op = (bf16_t*)(p.ws + WS_ATTO) + ((size_t)g * T + tq) * 768 + h * 128 + 4 * qd;
#pragma unroll
        for (int dt = 0; dt < 8; ++dt) { u32x2 w; w.x = cvt_pk_bf16(O[dt][0] * il, O[dt][1] * il); w.y = cvt_pk_bf16(O[dt][2] * il, O[dt][3] * il); *(u32x2*)(op + 16 * dt) = w; }
        if (qd == 0) ((float*)(p.ws + WS_LSE))[((size_t)g * T + tq) * 8 + h] = mx + logf(l);
    }
}

struct GateOrder {
    int Gn, j;
    __device__ bool next(int i, pg8::Unit& u) const { const int id = i * Gn + j; if (id >= 1024) return false; u.pm = id & 31; u.pn = 48 + (id >> 5); return true; }
    __device__ __forceinline__ int arow(const pg8::Unit& u, int r) const { return u.pm * 256 + r; }
};
__device__ __forceinline__ void phase_attn_gdn(const Ctx& c, const Params& p, int L) {
    const bf16_t* U = (const bf16_t*)(p.ws + WS_U);
    const int lane = c.lane;
    const int nrec = (c.G >= 24) ? 12 : 0;
    if (nrec) { if (c.bid < nrec) { gdn_scan(c, p, c.bid);
            return; } }
    else { for (int h = c.bid; h < 12; h += c.G) gdn_scan(c, p, h); }
    {
        const int Gn = c.G - nrec, j = c.bid - nrec, heavy = (Gn > 0 && Gn < 1024) ? (1024 % Gn) : 0, na = Gn - heavy;
        for (int rep = 0; rep < 1 + (p.pad == 5); ++rep) {
            int u = 1152, us = 1;
            if (na > 0) { if (j >= heavy) { u = j - heavy; us = na; } } else { u = j; us = Gn; }
            AttnRegs ar;
            if (u < 1152) { attn_issue_k(c, p, u, ar); attn_issue_vq(c, p, u, ar); }
            while (u < 1152) {
                attn_stage(c, ar);
                __syncthreads();
                const int un = u + us;
                if (un < 1152) attn_issue_k(c, p, un, ar);
                attn_compute(c, p, u, ar, un);
                __syncthreads();
                u = un;
            }
        }
    }
    for (int rep = 0; rep < 1 + (p.pad == 6); ++rep) {
        pg8::Gemm g{(const bf16_t*)(p.ws + WS_H), (const bf16_t*)(p.ws + WS_WINT) + (size_t)L * NU * D, D}; GateOrder S{c.G - nrec, c.bid - nrec};
        EpiU E{(bf16_t*)(p.ws + WS_U)}; pg8::gemm_phase<EpiU, GateOrder, false>(c.lds, g, S, E);
    }
}

__device__ __forceinline__ void phase_combine(const Ctx& c, const Params& p, int L) {
    const bf16_t* U = (const bf16_t*)(p.ws + WS_U); const bf16_t* AO = (const bf16_t*)(p.ws + WS_ATTO); const float* LSE = (const float*)(p.ws + WS_LSE);
    const bf16_t* OG = (const bf16_t*)(p.ws + WS_OGDN); bf16_t* YA = (bf16_t*)(p.ws + WS_YBR); bf16_t* YC = YA + (size_t)2 * T * 768;
    const float* gn = p.gdn_norm_g + L * 128; const int lane = c.lane;
    for (int it0 = (c.bid * 8 + c.wave) * 4; it0 < T * 6; it0 += c.G * 8 * 4) {
        float l0[4], l1[4], l2[4]; unsigned a0[4], a1[4], a2[4], z2[4]; float2 og[4]; size_t o[4];
#pragma unroll
        for (int i = 0; i < 4; ++i) { const int it = it0 + i, t = it / 6, h = it % 6; o[i] = (size_t)t * 768 + h * 128 + 2 * lane;
            l0[i] = LSE[(size_t)t * 8 + h]; l1[i] = LSE[((size_t)T + t) * 8 + h]; l2[i] = LSE[((size_t)2 * T + t) * 8 + h];
            a0[i] = *(const unsigned*)(AO + o[i]); a1[i] = *(const unsigned*)(AO + (size_t)T * 768 + o[i]); a2[i] = *(const unsigned*)(AO + (size_t)2 * T * 768 + o[i]);
            { const unsigned ow = *(const unsigned*)(OG + o[i]); og[i] = make_float2(bflo(ow), bfhi(ow)); } z2[i] = *(const unsigned*)(U + (size_t)t * NU + UC_Z + h * 128 + 2 * lane); }
#pragma unroll
        for (int i = 0; i < 4; ++i) {
            const float mx = fmaxf(l0[i], fmaxf(l1[i], l2[i])); const float e0 = __expf(l0[i] - mx), e1 = __expf(l1[i] - mx), e2 = __expf(l2[i] - mx); const float is = 1.0f / (e0 + e1 + e2);
            *(unsigned*)(YC + o[i]) = cvt_pk_bf16((e0 * bflo(a0[i]) + e1 * bflo(a1[i]) + e2 * bflo(a2[i])) * is, (e0 * bfhi(a0[i]) + e1 * bfhi(a1[i]) + e2 * bfhi(a2[i])) * is);
            const float ss = wave_sum(og[i].x * og[i].x + og[i].y * og[i].y, lane); const float r = rsqrtf(ss * (1.0f / 128.f) + 1e-6f);
            *(unsigned*)(YA + o[i]) = cvt_pk_bf16(og[i].x * r * gn[2 * lane] * siluf_(bflo(z2[i])), og[i].y * r * gn[2 * lane + 1] * siluf_(bfhi(z2[i]))); }
    }
}

__device__ __forceinline__ void phase_norm2_router(const Ctx& c, const Params& p, int L) {
    const float* XB = (const float*)(p.ws + WS_XB); bf16_t* H = (bf16_t*)(p.ws + WS_H); const float* g2 = p.norm2_g + L * D;
    const bf16_t* WH = (const bf16_t*)(p.ws + WS_WRT) + (size_t)L * 2 * 80 * 2048; const bf16_t* WL = WH + 80 * 2048;
    unsigned* cnt = (unsigned*)(p.ws + WS_CTL + CTL_CNT) + L * 64; int* TOK = (int*)(p.ws + WS_TOK); float* WTS = (float*)(p.ws + WS_WSL);
    LAS float* lgp = (LAS float*)c.lds;
    LAS float* ssp = (LAS float*)c.lds + 2 * 4 * 16 * 80;
    const int lane = c.lane, m = lane & 15, q = lane >> 4, tl = c.wave >> 2, kq = c.wave & 3;
    for (int tp = c.bid; tp < T / 32; tp += c.G) {
        const int task = tp * 2 + tl;
        const int t = task * 16 + m; const float* xr = XB + (size_t)t * D + 512 * kq + 8 * q; const float* gr = g2 + 512 * kq + 8 * q;
        float ss = 0.f;
#pragma unroll 8
        for (int s = 0; s < 16; ++s) { const float4 a = *(const float4*)(xr + 32 * s), b = *(const float4*)(xr + 32 * s + 4);
            ss += a.x * a.x + a.y * a.y + a.z * a.z + a.w * a.w + b.x * b.x + b.y * b.y + b.z * b.z + b.w * b.w; }
        ss += shx(ss, 16, lane); ss += shx(ss, 32, lane);
        if (q == 0) ssp[(tl * 4 + kq) * 16 + m] = ss;
        __syncthreads();
        ss = ssp[(tl * 4 + 0) * 16 + m] + ssp[(tl * 4 + 1) * 16 + m] + ssp[(tl * 4 + 2) * 16 + m] + ssp[(tl * 4 + 3) * 16 + m];
        const float rstd = rsqrtf(ss * (1.0f / D) + 1e-6f);
        f32x4 acc[5];
#pragma unroll
        for (int nt = 0; nt < 5; ++nt) acc[nt] = (f32x4){0.f, 0.f, 0.f, 0.f};
        float4 na = *(const float4*)(xr), nb = *(const float4*)(xr + 4), nga = *(const float4*)(gr), ngb = *(const float4*)(gr + 4);
        bf16x8 nbh[5], nbl[5];
#pragma unroll
        for (int nt = 0; nt < 5; ++nt) { const size_t wo = (size_t)(16 * nt + m) * 2048 + 512 * kq + 8 * q; nbh[nt] = *(const bf16x8*)(WH + wo); nbl[nt] = *(const bf16x8*)(WL + wo); }
        for (int s = 0; s < 16; ++s) {
            const float4 a = na, b = nb, ga = nga, gb = ngb; bf16x8 bh[5], bl[5];
#pragma unroll
            for (int nt = 0; nt < 5; ++nt) { bh[nt] = nbh[nt]; bl[nt] = nbl[nt]; }
            if (s + 1 < 16) { const int s1 = s + 1;
                na = *(const float4*)(xr + 32 * s1); nb = *(const float4*)(xr + 32 * s1 + 4); nga = *(const float4*)(gr + 32 * s1); ngb = *(const float4*)(gr + 32 * s1 + 4);
#pragma unroll
                for (int nt = 0; nt < 5; ++nt) { const size_t wo = (size_t)(16 * nt + m) * 2048 + 512 * kq + 32 * s1 + 8 * q; nbh[nt] = *(const bf16x8*)(WH + wo); nbl[nt] = *(const bf16x8*)(WL + wo); } }
            float h[8]; h[0] = a.x * rstd * ga.x; h[1] = a.y * rstd * ga.y; h[2] = a.z * rstd * ga.z; h[3] = a.w * rstd * ga.w; h[4] = b.x * rstd * gb.x; h[5] = b.y * rstd * gb.y; h[6] = b.z * rstd * gb.z; h[7] = b.w * rstd * gb.w;
            u32x4 hi; hi.x = cvt_pk_bf16(h[0], h[1]); hi.y = cvt_pk_bf16(h[2], h[3]); hi.z = cvt_pk_bf16(h[4], h[5]); hi.w = cvt_pk_bf16(h[6], h[7]);
            u32x4 lo; lo.x = cvt_pk_bf16(h[0] - bflo(hi.x), h[1] - bfhi(hi.x)); lo.y = cvt_pk_bf16(h[2] - bflo(hi.y), h[3] - bfhi(hi.y));
            lo.z = cvt_pk_bf16(h[4] - bflo(hi.z), h[5] - bfhi(hi.z)); lo.w = cvt_pk_bf16(h[6] - bflo(hi.w), h[7] - bfhi(hi.w));
            const bf16x8 ah = __builtin_bit_cast(bf16x8, hi), al = __builtin_bit_cast(bf16x8, lo);
#pragma unroll
            for (int nt = 0; nt < 5; ++nt) {
                acc[nt] = __builtin_amdgcn_mfma_f32_16x16x32_bf16(ah, bh[nt], acc[nt], 0, 0, 0);
                acc[nt] = __builtin_amdgcn_mfma_f32_16x16x32_bf16(ah, bl[nt], acc[nt], 0, 0, 0);
                acc[nt] = __builtin_amdgcn_mfma_f32_16x16x32_bf16(al, bh[nt], acc[nt], 0, 0, 0); }
            *(u32x4*)(H + (size_t)t * D + 512 * kq + 32 * s + 8 * q) = hi;
        }
        LAS float* lgw = lgp + (tl * 4 + kq) * (16 * 80);
#pragma unroll
        for (int nt = 0; nt < 5; ++nt)
#pragma unroll
            for (int jj = 0; jj < 4; ++jj) lgw[(4 * q + jj) * 80 + 16 * nt + m] = acc[nt][jj];
        __syncthreads();
        if (kq == 0) {
            for (int i = lane; i < 16 * 80; i += 64) lgw[i] = lgw[i] + lgw[i + 16 * 80] + lgw[i + 2 * 16 * 80] + lgw[i + 3 * 16 * 80];
            asm volatile("s_waitcnt lgkmcnt(0)" ::: "memory");
        }
        if (kq == 0)
        if (lane < 16) {
            const int tt = task * 16 + lane; const LAS float* l = lgw + lane * 80;
            float gl[8]; float gm = -INFINITY; int gi = 0;
#pragma unroll
            for (int j = 0; j < 8; ++j) { gl[j] = l[j] + p.rg_b[L * 8 + j]; if (gl[j] > gm) { gm = gl[j]; gi = j; } }
            float gs = 0.f;
#pragma unroll
            for (int j = 0; j < 8; ++j) gs += expf(gl[j] - gm);
            const float gp = 1.0f / gs;
            float el[8]; float em = -INFINITY; int i1 = 0;
#pragma unroll
            for (int j = 0; j < 8; ++j) { el[j] = l[8 + gi * 8 + j] + p.re_b[L * 64 + gi * 8 + j]; if (el[j] > em) { em = el[j]; i1 = j; } }
            float e2m = -INFINITY; int i2 = 0;
#pragma unroll
            for (int j = 0; j < 8; ++j) { if (j != i1 && el[j] > e2m) { e2m = el[j]; i2 = j; } }
            const float p2 = expf(e2m - em);
            const float w1 = gp / (1.0f + p2), w2 = gp * p2 / (1.0f + p2);
            const int e1 = gi * 8 + i1, e2 = gi * 8 + i2;
            const unsigned q1 = atomicAdd(&cnt[e1], 1u); TOK[e1 * 8192 + q1] = tt * 2; WTS[e1 * 8192 + q1] = w1;
            const unsigned q2 = atomicAdd(&cnt[e2], 1u); TOK[e2 * 8192 + q2] = tt * 2 + 1; WTS[e2 * 8192 + q2] = w2;
        }
        __syncthreads();
    }
}

__device__ __forceinline__ MoeTab moe_tables(const Ctx& c, const Params& p, int L, int nN) {
    LAS int* base = (LAS int*)(c.lds + LDS_MISC + 1024);
    LAS int* mt_e = base, * mt_p0 = base + 192, * cn = base + 384, * nm = base + 448, * first = base + 452, * ut = base + 520;
    const unsigned* cnt = (const unsigned*)(p.ws + WS_CTL + CTL_CNT) + L * 64;
    __syncthreads();
    if (c.tid < 64) cn[c.tid] = (int)cnt[c.tid];
    __syncthreads();
    if (c.tid == 0) { int n = 0; for (int e = 0; e < 64; ++e) { first[e] = n; const int ntile = (cn[e] + 127) >> 7; for (int i = 0; i < ntile; ++i) { mt_e[n] = e; mt_p0[n] = i * 128; ++n; } } nm[0] = n; }
    __syncthreads();
    if (c.tid < 64) { const int e = c.tid, f0 = first[e], ntile = (cn[e] + 127) >> 7; int o = f0 * nN;
        for (int j = 0; j < nN; ++j) for (int m = 0; m < ntile; ++m) ut[o++] = ((f0 + m) << 4) | j; }
    else if (c.tid < 128) { const int e = c.tid - 64, f0 = first[e], ntile = (cn[e] + 127) >> 7; int o = 768 + f0 * 8;
        for (int j = 0; j < 8; ++j) for (int m = 0; m < ntile; ++m) ut[o++] = ((f0 + m) << 4) | j; }
    __syncthreads();
    MoeTab tb; tb.mt_e = mt_e; tb.mt_p0 = mt_p0; tb.cnt = cn; tb.ut = ut; tb.nmt = nm[0]; return tb;
}

__device__ __forceinline__ MoeTab2 moe_tables2(const Ctx& c, const Params& p, int L) {
    LAS int* base = (LAS int*)(c.lds + LDS_MISC + 1024);
    LAS int* rt_e = base, * rt_r0 = base + 128, * cn = base + 256, * nm = base + 320, * first = base + 324, * rfirst = base + 392, * ut_up = base + 456, * ut_dn = base + 456 + 864;
    const unsigned* cnt = (const unsigned*)(p.ws + WS_CTL + CTL_CNT) + L * 64;
    __syncthreads();
    if (c.tid < 64) cn[c.tid] = (int)cnt[c.tid];
    __syncthreads();
    if (c.tid == 0) { int n = 0, f = 0; for (int e = 0; e < 64; ++e) { first[e] = f; f += (cn[e] + 127) >> 7; rfirst[e] = n; const int ns = (cn[e] + 383) / 384; for (int i = 0; i < ns; ++i) { rt_e[n] = e; rt_r0[n] = i * 384; ++n; } } nm[0] = n; }
    __syncthreads();
    if (c.tid < 64) { const int e = c.tid, f0 = rfirst[e], ns = (cn[e] + 383) / 384; int o = f0 * 8;
        for (int i = 0; i < ns; ++i) for (int j = 0; j < 8; ++j) ut_up[o++] = ((f0 + i) << 4) | j; }
    else if (c.tid < 128) { const int e = c.tid - 64, f0 = rfirst[e], ns = (cn[e] + 383) / 384; int o = f0 * 16;
        for (int i = 0; i < ns; ++i) for (int j = 0; j < 16; ++j) ut_dn[o++] = ((f0 + i) << 4) | j; }
    __syncthreads();
    MoeTab2 tb; tb.rt_e = rt_e; tb.rt_r0 = rt_r0; tb.cnt = cn; tb.first = first; tb.ut_up = ut_up; tb.ut_dn = ut_dn; tb.nrt = nm[0]; return tb;
}

__device__ __forceinline__ void phase_final(const Ctx& c, const Params& p) {
    const float* XB = (const float*)(p.ws + WS_XB); const bf16_t* Y = (const bf16_t*)(p.ws + WS_YMOE);
    for (int t = c.bid * 8 + c.wave; t < T; t += c.G * 8) {
        float4 xv[8]; float ss = 0.f;
#pragma unroll
        for (int q = 0; q < 8; ++q) { const int col = q * 256 + c.lane * 4;
            const float4 a = *(const float4*)(XB + (size_t)t * D + col); const u32x2 y0 = *(const u32x2*)(Y + (size_t)(2 * t) * D + col), y1 = *(const u32x2*)(Y + (size_t)(2 * t + 1) * D + col);
            float4 v; v.x = a.x + (bflo(y0.x) + bflo(y1.x)); v.y = a.y + (bfhi(y0.x) + bfhi(y1.x)); v.z = a.z + (bflo(y0.y) + bflo(y1.y)); v.w = a.w + (bfhi(y0.y) + bfhi(y1.y));
            xv[q] = v; ss += v.x * v.x + v.y * v.y + v.z * v.z + v.w * v.w; }
        const float rstd = rsqrtf(wave_sum(ss, c.lane) * (1.0f / D) + 1e-6f);
#pragma unroll
        for (int q = 0; q < 8; ++q) { const int col = q * 256 + c.lane * 4; const float4 g = *(const float4*)(p.final_g + col);
            float4 o; o.x = xv[q].x * rstd * g.x; o.y = xv[q].y * rstd * g.y; o.z = xv[q].z * rstd * g.z; o.w = xv[q].w * rstd * g.w;
            *(float4*)(p.out + (size_t)t * D + col) = o; }
    }
}

constexpr int NPH_LAYER = 10, NPHASES = 1 + NL * NPH_LAYER + 1;
static_assert(NL == 2, "LAYER_BODY is instantiated twice");
#ifndef MOE_PROBE
#define MOE_PROBE -1
#endif
#if MOE_PROBE >= 0
#define MOE_PROBE_RUN { unsigned* mtd = (unsigned*)(p.ws + WS_CTL + 38400) + L * 192; unsigned* qh = (unsigned*)(p.ws + WS_CTL + CTL_QHEAD + 1024) + L * 128; \
            if (!(MOE_PROBE & 8)) { MoeUpOrder2 S{tb, c.G, c.bid, mtd}; EpiUp2 E{(bf16_t*)(p.ws + WS_HID)}; \
              moe_gemm2<true, (MOE_PROBE & 7), MoeUpOrder2, EpiUp2>(c, (const bf16_t*)(p.ws + WS_H), p.w_up + (size_t)L * NE * D * 1024, (const int*)(p.ws + WS_TOK), S, E); } \
            if (!(MOE_PROBE & 16)) { LAS int* slot = (LAS int*)(c.lds + LDS_MISC + 768); if (c.tid == 0) slot[1] = 0; \
              MoeDownQueue2 S{tb, c.G, c.bid, qh, mtd, slot, (MOE_PROBE & 8) ? 0u : 8u}; EpiDown2 E{(const int*)(p.ws + WS_TOK), (const float*)(p.ws + WS_WSL), (bf16_t*)(p.ws + WS_YMOE)}; \
              moe_gemm2<false, (MOE_PROBE & 7), MoeDownQueue2, EpiDown2>(c, (const bf16_t*)(p.ws + WS_HID), p.w_down + (size_t)L * NE * EH * D, (const int*)(p.ws + WS_TOK), S, E); } \
            SEAM(b + 7); }
#else
#define MOE_PROBE_RUN
#endif
#define LAYER_BODY(L) {         const int b = 1 + L * NPH_LAYER; \
        if (PHON(1) && IN(b + 0)) { for (int rep = 0; rep < 1 + PROBED(b + 0); ++rep) { FRESH(); phase_norm1(c, p, L); } SEAM(b + 0); } \
        if (PHON(2) && IN(b + 1)) { for (int rep = 0; rep < 1 + PROBED(b + 1); ++rep) { FRESH(); \
            pg8::Gemm g{(const bf16_t*)(p.ws + WS_H), (const bf16_t*)(p.ws + WS_WINT) + (size_t)L * NU * D, D}; pg8::StaticOrder S; S.init(T, UC_G, c.G, c.bid); \
            EpiU E{(bf16_t*)(p.ws + WS_U)}; pg8::gemm_phase<EpiU, pg8::StaticOrder, false>(c.lds, g, S, E); } SEAM(b + 1); } \
        if (PHON(3) && IN(b + 2)) { for (int rep = 0; rep < 1 + PROBED(b + 2); ++rep) { FRESH(); phase_local(c, p, L); } SEAM(b + 2); } \
        if (PHON(4) && IN(b + 3)) { for (int rep = 0; rep < 1 + PROBED(b + 3); ++rep) { FRESH(); phase_attn_gdn(c, p, L); } SEAM(b + 3); } \
        if (PHON(5) && IN(b + 4)) { for (int rep = 0; rep < 1 + PROBED(b + 4); ++rep) { FRESH(); phase_combine(c, p, L); } SEAM(b + 4); } \
        if (PHON(6) && IN(b + 5)) { for (int rep = 0; rep < 1 + PROBED(b + 5); ++rep) { FRESH(); \
            pg8::Gemm g{(const bf16_t*)(p.ws + WS_YBR), (const bf16_t*)(p.ws + WS_WBRT) + (size_t)L * 4 * D * 768, 768}; MergeOrder S{c.G, c.bid}; \
            EpiMerge E{(const bf16_t*)(p.ws + WS_U), (float*)(p.ws + WS_M32), (bf16_t*)(p.ws + WS_MERGED)}; pg8::gemm_phase<EpiMerge, MergeOrder, false>(c.lds, g, S, E); } SEAM(b + 5); } \
        if (PHON(7) && IN(b + 6)) { for (int rep = 0; rep < 1 + PROBED(b + 6); ++rep) { FRESH(); \
            pg8::Gemm g{(const bf16_t*)(p.ws + WS_MERGED), (const bf16_t*)(p.ws + WS_WOUTT) + (size_t)L * D * D, D}; pg8::StaticOrder S; S.init(T, D, c.G, c.bid); \
            EpiRes E{L == 0 ? p.x : (const float*)(p.ws + WS_XA), (float*)(p.ws + WS_XB)}; pg8::gemm_phase<EpiRes, pg8::StaticOrder, false>(c.lds, g, S, E); } SEAM(b + 6); } \
        if (PHON(8) && IN(b + 7)) { FRESH(); phase_norm2_router(c, p, L); SEAM(b + 7); } \
        if (PHON(9) && IN(b + 8)) { FRESH(); \
            const MoeTab2 tb = moe_tables2(c, p, L); \
            MOE_PROBE_RUN \
            unsigned* mtd = (unsigned*)(p.ws + WS_CTL + CTL_MTDONE) + L * 192; unsigned* qh = (unsigned*)(p.ws + WS_CTL + CTL_QHEAD) + L * 128; \
            { MoeUpOrder2 S{tb, c.G, c.bid, mtd}; EpiUp2 E{(bf16_t*)(p.ws + WS_HID)}; \
              moe_gemm2<true, 0, MoeUpOrder2, EpiUp2>(c, (const bf16_t*)(p.ws + WS_H), p.w_up + (size_t)L * NE * D * 1024, (const int*)(p.ws + WS_TOK), S, E); } \
            { LAS int* slot = (LAS int*)(c.lds + LDS_MISC + 768); if (c.tid == 0) slot[1] = 0; \
              MoeDownQueue2 S{tb, c.G, c.bid, qh, mtd, slot, 8u}; EpiDown2 E{(const int*)(p.ws + WS_TOK), (const float*)(p.ws + WS_WSL), (bf16_t*)(p.ws + WS_YMOE)}; \
              moe_gemm2<false, 0, MoeDownQueue2, EpiDown2>(c, (const bf16_t*)(p.ws + WS_HID), p.w_down + (size_t)L * NE * EH * D, (const int*)(p.ws + WS_TOK), S, E); } \
            SEAM(b + 8); } \
 }
__global__ void __launch_bounds__(NTHREADS, 2) fwd(Params p0) {
    extern __shared__ __attribute__((aligned(16))) unsigned char lds_raw[];
    Ctx c; c.tid = threadIdx.x; c.lane = c.tid & 63; c.wave = __builtin_amdgcn_readfirstlane(c.tid >> 6); c.bid = blockIdx.x; c.G = gridDim.x; c.lds = (LAS unsigned char*)lds_raw;
    volatile LAS unsigned* misc = (volatile LAS unsigned*)(c.lds + LDS_MISC);
    if (c.tid < 4) misc[c.tid] = 0u;
    if (c.tid == 0) {
        LAS unsigned long long* tab = (LAS unsigned long long*)(c.lds + LDS_PTAB);
        tab[0] = (unsigned long long)p0.x; tab[1] = (unsigned long long)p0.pos; tab[2] = (unsigned long long)p0.norm1_g; tab[3] = (unsigned long long)p0.w_in; tab[4] = (unsigned long long)p0.conv_a_w;
        tab[5] = (unsigned long long)p0.a_log; tab[6] = (unsigned long long)p0.dt_bias; tab[7] = (unsigned long long)p0.gdn_norm_g; tab[8] = (unsigned long long)p0.conv_b_w; tab[9] = (unsigned long long)p0.conv_b_b;
        tab[10] = (unsigned long long)p0.ln_b_g; tab[11] = (unsigned long long)p0.ln_b_b; tab[12] = (unsigned long long)p0.pool_w; tab[13] = (unsigned long long)p0.pool_scale; tab[14] = (unsigned long long)p0.w_branch;
        tab[15] = (unsigned long long)p0.w_out; tab[16] = (unsigned long long)p0.norm2_g; tab[17] = (unsigned long long)p0.rg_w; tab[18] = (unsigned long long)p0.rg_b; tab[19] = (unsigned long long)p0.re_w;
        tab[20] = (unsigned long long)p0.re_b; tab[21] = (unsigned long long)p0.w_up; tab[22] = (unsigned long long)p0.w_down; tab[23] = (unsigned long long)p0.final_g; tab[24] = (unsigned long long)p0.out;
    }
    __syncthreads();
    const int lo = p0.ph_lo, hi = p0.ph_hi, probe = p0.probe, psub = p0.pad; unsigned char* const wsb = p0.ws;
    const bool multi = (hi - lo) > 1;
    XcdBarrier bar; bar.bar = (unsigned*)(wsb + WS_CTL); bar.x = 0; bar.st = misc;
    if (multi) bar = xcd_barrier_post((unsigned*)(wsb + WS_CTL), misc);
#if MK_ONE_LAUNCH
#define IN(k) true
#else
#define IN(k) (lo <= (k) && (k) < hi)
#endif
#define PROBED(k) (PROBE_PHASE >= 0 && probe == (k))
#define FRESH() int _t = threadIdx.x; asm volatile("" : "+v"(_t)); c.tid = _t; c.lane = _t & 63; \
    { int _b = blockIdx.x, _g = gridDim.x, _w = __builtin_amdgcn_readfirstlane(_t >> 6); asm volatile("" : "+s"(_b), "+s"(_g), "+s"(_w)); c.bid = _b; c.G = _g; c.wave = _w; } \
    unsigned long long _wsi = (unsigned long long)wsb; asm volatile("" : "+s"(_wsi)); unsigned char* _ws = (unsigned char*)(GAS unsigned char*)_wsi; Params p = load_params(c, _ws, lo, hi); p.pad = psub
#define SEAM(k) do { if (IN((k) + 1)) { XcdBarrier _bb; unsigned long long _bi = (unsigned long long)(wsb + WS_CTL); asm volatile("" : "+s"(_bi)); _bb.bar = (unsigned*)(GAS unsigned*)_bi; _bb.x = xb_xcc_id(); _bb.st = misc; xcd_barrier(_bb); } } while (0)
#ifndef PHMASK
#define PHMASK 0xFFFFF
#endif
#define PHON(k) ((PHMASK >> (k)) & 1)
    if (PHON(0) && IN(0)) { for (int rep = 0; rep < 1 + PROBED(0); ++rep) { FRESH(); phase_convert(c, p); } SEAM(0); }
    for (int L = 0; L < NL; ++L) LAYER_BODY(L)
    if (PHON(11) && IN(NPHASES - 1)) { FRESH(); phase_final(c, p); }
#undef IN
#undef SEAM
}

extern "C" void kernel_launch(void* const* d_in, const int* in_sizes, int n_in, void* d_out, int out_size, void* d_ws, size_t ws_size, hipStream_t stream) {
    static int grid = 0;
    if (grid == 0) {
        if (n_in != 24 || out_size != T * D || ws_size < WS_END) { fprintf(stderr, "kernel_launch: unexpected shapes (n_in %d, out %d, ws %zu < %zu)\n", n_in, out_size, ws_size, (size_t)WS_END); grid = -1; return; }
        int dev = 0, cus = 0, per_cu = 0;
        if (hipGetDevice(&dev) != hipSuccess || hipDeviceGetAttribute(&cus, hipDeviceAttributeMultiprocessorCount, dev) != hipSuccess) { grid = -1; return; }
        if (hipFuncSetAttribute((const void*)fwd, hipFuncAttributeMaxDynamicSharedMemorySize, LDS_BYTES) != hipSuccess) { fprintf(stderr, "kernel_launch: hipFuncSetAttribute failed\n"); grid = -1; return; }
        if (hipOccupancyMaxActiveBlocksPerMultiprocessor(&per_cu, (const void*)fwd, NTHREADS, LDS_BYTES) != hipSuccess || per_cu < 1) { fprintf(stderr, "kernel_launch: occupancy query says %d\n", per_cu); (void)hipGetLastError(); }
        grid = cus;
    }
    if (grid < 0) return;
    (void)hipMemsetAsync((char*)d_ws + WS_CTL, 0, CTL_BYTES, stream);
    Params p{};
    p.x = (const float*)d_in[0]; p.pos = (const int*)d_in[1]; p.norm1_g = (const float*)d_in[2]; p.w_in = (const float*)d_in[3]; p.conv_a_w = (const float*)d_in[4];
    p.a_log = (const float*)d_in[5]; p.dt_bias = (const float*)d_in[6]; p.gdn_norm_g = (const float*)d_in[7]; p.conv_b_w = (const float*)d_in[8]; p.conv_b_b = (const float*)d_in[9];
    p.ln_b_g = (const float*)d_in[10]; p.ln_b_b = (const float*)d_in[11]; p.pool_w = (const float*)d_in[12]; p.pool_scale = (const float*)d_in[13]; p.w_branch = (const float*)d_in[14];
    p.w_out = (const float*)d_in[15]; p.norm2_g = (const float*)d_in[16]; p.rg_w = (const float*)d_in[17]; p.rg_b = (const float*)d_in[18]; p.re_w = (const float*)d_in[19];
    p.re_b = (const float*)d_in[20]; p.w_up = (const float*)d_in[21]; p.w_down = (const float*)d_in[22]; p.final_g = (const float*)d_in[23];
    p.out = (float*)d_out; p.ws = (unsigned char*)d_ws; p.probe = PROBE_PHASE; p.pad = PROBE_SUB;
#if MK_ONE_LAUNCH
    p.ph_lo = 0; p.ph_hi = NPHASES;
    hipLaunchKernelGGL(fwd, dim3(grid), dim3(NTHREADS), LDS_BYTES, stream, p);
#else
    for (int ph = 0; ph < NPHASES; ++ph) { p.ph_lo = ph; p.ph_hi = ph + 1; hipLaunchKernelGGL(fwd, dim3(grid), dim3(NTHREADS), LDS_BYTES, stream, p); }
#endif
}
```

```cpp
#include <hip/hip_runtime.h>
#include <cstdio>
#include <cstdint>

#ifndef PROBE_SUB
#define PROBE_SUB 0
#endif
#ifndef PROBE_PHASE
#define PROBE_PHASE -1
#endif
#ifndef MK_ONE_LAUNCH
#define MK_ONE_LAUNCH 1
#endif

#define LAS __attribute__((address_space(3)))
#define GAS __attribute__((address_space(1)))
#define WG_BAR_LDS() do { asm volatile("s_waitcnt lgkmcnt(0)" ::: "memory"); __builtin_amdgcn_s_barrier(); asm volatile("" ::: "memory"); } while (0)
typedef unsigned short bf16_t;
typedef short bf16x8 __attribute__((ext_vector_type(8)));
typedef float f32x4 __attribute__((ext_vector_type(4)));
typedef unsigned u32x4 __attribute__((ext_vector_type(4)));
typedef unsigned u32x2 __attribute__((ext_vector_type(2)));
typedef short s16x4 __attribute__((ext_vector_type(4)));
typedef float f32x2 __attribute__((ext_vector_type(2)));

constexpr int T = 8192, D = 2048, NL = 2;
constexpr int NIN = 20492, NU = 20480;
constexpr int UC_QKV = 0, UC_Z = 2304, UC_B = 3072, UC_C = 4608, UC_D = 11520, UC_G = 12288;
constexpr int NE = 64, EH = 512;
constexpr int NTHREADS = 512;
constexpr int LDS_STAGE = 131072;
constexpr int LDS_MISC = LDS_STAGE;
constexpr int LDS_OSTG = LDS_STAGE + 8192;
constexpr int LDS_BYTES = LDS_OSTG + 16384;

constexpr size_t al256(size_t x) { return (x + 255) & ~(size_t)255; }
constexpr size_t WS_CTL = 0;
constexpr size_t CTL_BYTES = 65536;
constexpr size_t CTL_CNT = 32768;
constexpr size_t CTL_MTDONE = 36864;
constexpr size_t CTL_QHEAD = 40960;
constexpr size_t WS_WINT = WS_CTL + CTL_BYTES;
constexpr size_t WS_WBRT = WS_WINT + (size_t)NL * NU * D * 2;
constexpr size_t WS_WOUTT = WS_WBRT + (size_t)NL * 4 * D * 768 * 2;
constexpr size_t WS_WUPT = WS_WOUTT + (size_t)NL * D * D * 2;
constexpr size_t WS_WDNT = WS_WUPT + (size_t)NL * NE * 1024 * D * 2;
constexpr size_t WS_H = WS_WDNT + (size_t)NL * NE * D * EH * 2;
constexpr size_t WS_U = WS_H + (size_t)T * D * 2;
constexpr size_t WS_XA = WS_U + (size_t)T * NU * 2;
constexpr size_t WS_XB = WS_XA + (size_t)T * D * 4;
constexpr size_t WS_BETA = WS_XB + (size_t)T * D * 4;
constexpr size_t WS_GLOG = WS_BETA + (size_t)T * 8 * 4;
constexpr int GB_WC = 0, GB_QD = 16384, GB_KDT = 32768, GB_QK = 49152, GB_BYTES = 57344;
constexpr size_t WS_GBLK = WS_GLOG + (size_t)T * 8 * 4;
constexpr size_t WS_UCP = WS_GBLK + (size_t)768 * GB_BYTES;
constexpr size_t WS_GL = WS_UCP + (size_t)768 * 8192 * 4;
constexpr size_t WS_OGDN = WS_GL + 4096;
constexpr size_t WS_QR = WS_OGDN + (size_t)T * 768 * 4;
constexpr size_t WS_KR = WS_QR + (size_t)T * 2304 * 2;
constexpr size_t WS_ATTO = WS_KR + (size_t)T * 2304 * 2;
constexpr size_t WS_LSE = WS_ATTO + (size_t)3 * T * 768 * 2;
constexpr size_t WS_YBR = WS_LSE + (size_t)3 * T * 8 * 4;
constexpr size_t WS_M32 = WS_YBR + (size_t)4 * T * 768 * 2;
constexpr size_t WS_MERGED = WS_M32 + (size_t)T * D * 4;
constexpr size_t WS_TOK = WS_MERGED + (size_t)T * D * 2;
constexpr size_t WS_WTS = WS_TOK + (size_t)NE * 8192 * 4;
constexpr size_t WS_HID = WS_WTS + (size_t)T * 2 * 4;
constexpr size_t WS_YMOE = WS_HID + (size_t)32768 * EH * 2;
constexpr size_t WS_PWT = WS_YMOE + (size_t)T * 2 * D * 4;
constexpr size_t WS_WRT = WS_PWT + (size_t)NL * 4 * 192 * 192 * 2;
constexpr size_t WS_WSM = WS_WRT + (size_t)NL * 2 * 80 * 2048 * 2;
constexpr size_t WS_WSL = WS_WSM + (size_t)NL * 12 * 2048 * 4;
constexpr size_t WS_END = WS_WSL + (size_t)NE * 8192 * 4;

__constant__ float ROPE_INV[64] = {1.000000000e+00f, 8.659643531e-01f, 7.498942018e-01f, 6.493816376e-01f, 5.623413324e-01f, 4.869675338e-01f, 4.216965139e-01f, 3.651741147e-01f, 3.162277639e-01f, 2.738419771e-01f, 2.371373773e-01f, 2.053525001e-01f, 1.778279394e-01f, 1.539926529e-01f, 1.333521456e-01f, 1.154781953e-01f, 1.000000015e-01f, 8.659642935e-02f, 7.498942316e-02f, 6.493816525e-02f, 5.623413250e-02f, 4.869675264e-02f, 4.216964915e-02f, 3.651741147e-02f, 3.162277490e-02f, 2.738419548e-02f, 2.371373773e-02f, 2.053525113e-02f, 1.778279431e-02f, 1.539926510e-02f, 1.333521400e-02f, 1.154781971e-02f, 9.999999776e-03f, 8.659643121e-03f, 7.498942316e-03f, 6.493816152e-03f, 5.623413250e-03f, 4.869675264e-03f, 4.216964822e-03f, 3.651741194e-03f, 3.162277630e-03f, 2.738419687e-03f, 2.371373819e-03f, 2.053525066e-03f, 1.778279431e-03f, 1.539926510e-03f, 1.333521446e-03f, 1.154782018e-03f, 1.000000047e-03f, 8.659643354e-04f, 7.498941850e-04f, 6.493816036e-04f, 5.623413017e-04f, 4.869675322e-04f, 4.216965172e-04f, 3.651741135e-04f, 3.162277571e-04f, 2.738419571e-04f, 2.371373703e-04f, 2.053525095e-04f, 1.778279402e-04f, 1.539926598e-04f, 1.333521504e-04f, 1.154782003e-04f};

__device__ __forceinline__ float bf2f(unsigned short b) { return __uint_as_float(((unsigned)b) << 16); }
__device__ __forceinline__ float bflo(unsigned w) { return __uint_as_float(w << 16); }
__device__ __forceinline__ float bfhi(unsigned w) { return __uint_as_float(w & 0xffff0000u); }
typedef __bf16 bf16x2_t __attribute__((ext_vector_type(2)));
__device__ __forceinline__ unsigned cvt_pk_bf16(float lo, float hi) { bf16x2_t v; v.x = (__bf16)lo; v.y = (__bf16)hi; return __builtin_bit_cast(unsigned, v); }
__device__ __forceinline__ bf16_t f2bf(float f) { return (bf16_t)(cvt_pk_bf16(f, 0.f) & 0xffffu); }
__device__ __forceinline__ float shx(float v, int o, int lane) { return __int_as_float(__builtin_amdgcn_ds_bpermute((lane ^ o) << 2, __float_as_int(v))); }
__device__ __forceinline__ float wave_sum(float v, int lane) {
#pragma unroll
    for (int o = 32; o; o >>= 1) v += shx(v, o, lane);
    return v; }
__device__ __forceinline__ float wave_max(float v, int lane) {
#pragma unroll
    for (int o = 32; o; o >>= 1) v = fmaxf(v, shx(v, o, lane));
    return v; }
__device__ __forceinline__ float sigmoidf_(float x) { return 1.0f / (1.0f + __expf(-x)); }
__device__ __forceinline__ float siluf_(float x) { return x / (1.0f + __expf(-x)); }
__device__ __forceinline__ float silu_fast(float x) { return x * __builtin_amdgcn_rcpf(1.0f + __expf(-x)); }

__device__ __forceinline__ bf16x8 tr_pair(const LAS unsigned char* p0, const LAS unsigned char* p1) {
    const s16x4 a = __builtin_amdgcn_ds_read_tr16_b64_v4i16((LAS s16x4*)p0), b = __builtin_amdgcn_ds_read_tr16_b64_v4i16((LAS s16x4*)p1);
    return __builtin_shufflevector(a, b, 0, 1, 2, 3, 4, 5, 6, 7); }
#define XB_TMO      128
#define XB_XCNT(j)  (256  + 64 * (j))
#define XB_XSUB(j)  (1280 + 64 * (j))
#define XB_XGEN(j)  (2304 + 64 * (j))
#define XB_TOP      3328
#define XB_TOPGEN   3392
#define XCD_BAR_WORDS 3456
#define XB_SPIN_CAP (1u << 18)
__device__ __forceinline__ unsigned xb_ld(unsigned* p)              { return __hip_atomic_load(p, __ATOMIC_RELAXED, __HIP_MEMORY_SCOPE_AGENT); }
__device__ __forceinline__ unsigned xb_add(unsigned* p, unsigned v) { return __hip_atomic_fetch_add(p, v, __ATOMIC_RELAXED, __HIP_MEMORY_SCOPE_AGENT); }
__device__ __forceinline__ unsigned xb_xcc_id() { return (unsigned)__builtin_amdgcn_s_getreg((3 << 11) | 20) & 0xFu; }
#define XB_SPIN(cond, bar) do { unsigned _sp = 0; while (cond) { __builtin_amdgcn_s_sleep(1); \
    if ((++_sp & 255u) == 0u) { if (xb_ld(&(bar)[XB_TMO])) break; if (_sp > XB_SPIN_CAP) { atomicAdd(&(bar)[XB_TMO], 1u); break; } } } } while (0)
struct XcdBarrier { unsigned* bar; unsigned x; volatile LAS unsigned* st; };
__device__ __forceinline__ XcdBarrier xcd_barrier_post(unsigned* bar, volatile LAS unsigned* st) {
    XcdBarrier b; b.bar = bar; b.x = xb_xcc_id(); b.st = st;
    if (threadIdx.x == 0) (void)xb_add(&bar[XB_XCNT(b.x)], 1u);
    return b;
}
__device__ __forceinline__ void xcd_barrier_complete(unsigned* bar, unsigned x, unsigned& nloc, unsigned& nx) {
    const unsigned G = gridDim.x * gridDim.y * gridDim.z;
    unsigned sum, cnt, mine, sp = 0u;
    for (;;) {
        sum = 0u; cnt = 0u; mine = 0u;
#pragma unroll
        for (unsigned j = 0; j < 16; ++j) { const unsigned c = xb_ld(&bar[XB_XCNT(j)]); sum += c; cnt += (c > 0u) ? 1u : 0u; mine = (j == x) ? c : mine; }
        if (sum == G) break;
        __builtin_amdgcn_s_sleep(1);
        if ((++sp & 255u) == 0u) { if (xb_ld(&bar[XB_TMO])) break; if (sp > XB_SPIN_CAP) { atomicAdd(&bar[XB_TMO], 1u); break; } }
    }
    nloc = mine > 0u ? mine : 1u; nx = cnt > 0u ? cnt : 1u;
}
__device__ __forceinline__ void xcd_barrier(const XcdBarrier& b) {
    asm volatile("s_waitcnt vmcnt(0)" ::: "memory");
    __syncthreads();
    if (threadIdx.x == 0) {
        unsigned* bar = b.bar;
        __builtin_amdgcn_s_waitcnt(0);
        unsigned nloc = b.st[0], nx = b.st[1];
        if (nloc == 0u) { xcd_barrier_complete(bar, b.x, nloc, nx); b.st[0] = nloc; b.st[1] = nx; }
        const unsigned old = xb_add(&bar[XB_XSUB(b.x)], 1u);
        const unsigned gen = old / nloc;
        if (old + 1u == (gen + 1u) * nloc) {
            __builtin_amdgcn_fence(__ATOMIC_RELEASE, "agent");
            asm volatile("s_waitcnt vmcnt(0)" ::: "memory");
            const unsigned og = xb_add(&bar[XB_TOP], 1u);
            const unsigned tg = og / nx;
            if (og + 1u == (tg + 1u) * nx) xb_add(&bar[XB_TOPGEN], 1u);
            else XB_SPIN(xb_ld(&bar[XB_TOPGEN]) == tg, bar);
            __builtin_amdgcn_fence(__ATOMIC_ACQUIRE, "agent");
            xb_add(&bar[XB_XGEN(b.x)], 1u);
            asm volatile("s_waitcnt vmcnt(0)" ::: "memory");
        } else {
            XB_SPIN(xb_ld(&bar[XB_XGEN(b.x)]) == gen, bar);
            __builtin_amdgcn_fence(__ATOMIC_ACQUIRE, "agent");
            asm volatile("s_waitcnt vmcnt(0)" ::: "memory");
        }
    }
    __syncthreads();
}

namespace pg8 {
constexpr int BM = 256, BK = 64, HALF = 128, HTB = HALF * BK * 2, STAGE_BYTES = 8 * HTB, NXCD = 8, WGM = 8;
__host__ __device__ __forceinline__ int lds_byte(int r, int c) { const int st = (r >> 4) * 2 + (c >> 5), rr = r & 15, cc = c & 31, ob = rr * 64 + cc * 2; return st * 1024 + (ob ^ (((ob >> 9) & 1) << 5)); }
__host__ __device__ __forceinline__ void stage_rc(int b, int& R, int& C) { const int st = b / 1024, sb = b % 1024, swz = sb ^ (((sb >> 9) & 1) << 5); R = (st >> 1) * 16 + swz / 64; C = (st & 1) * 32 + (swz % 64) / 2; }
__host__ __device__ __forceinline__ int perm32(int rho) { const int n = rho >> 4, i = rho & 15; return 8 * (i >> 2) + 4 * n + (i & 3); }
struct Unit { int pm, pn; };
struct Gemm { const bf16_t* A; const bf16_t* Bt; int K; };
struct StaticOrder {
    int nM, nN, nwg, G, c;
    __device__ void init(int M, int N, int G_, int c_) { nM = M / BM; nN = N / BM; nwg = nM * nN; G = G_; c = c_; }
    __device__ bool next(int i, Unit& u) const {
        const long L = (long)i * G + c; if (L >= nwg) return false;
        int wgid = (int)L; { const int q = nwg / NXCD, r = nwg % NXCD, xcd = wgid % NXCD, off = wgid / NXCD; wgid = (xcd < r ? xcd * (q + 1) : r * (q + 1) + (xcd - r) * q) + off; }
        const int nig = WGM * nN, gid = wgid / nig, fm = gid * WGM, gsz = (nM - fm) < WGM ? (nM - fm) : WGM;
        u.pm = fm + ((wgid % nig) % gsz); u.pn = (wgid % nig) / gsz; return true;
    }
    __device__ __forceinline__ int arow(const Unit& u, int r) const { return u.pm * BM + r; }
};

template <class Epi, class Sched, bool GATHER>
__device__ __forceinline__ void gemm_phase(LAS unsigned char* lds, const Gemm g, const Sched& S, const Epi& E) {
    int tid = threadIdx.x; asm volatile("" : "+v"(tid));
    const int wid = __builtin_amdgcn_readfirstlane(tid >> 6), lane = tid & 63, wr = wid >> 2, wc = wid & 3, fr = lane & 15, fq = lane >> 4;
    const int K = g.K, nt = K / BK;
    unsigned voffA[2], voffB[2]; int RA[2], CA[2];
#pragma unroll
    for (int i = 0; i < 2; ++i) { int R, C; stage_rc(tid * 16 + i * 8192, R, C); const int Rb = Epi::PERM ? ((R & ~31) + perm32(R & 31)) : R;
        voffA[i] = (unsigned)(R * K + C) * 2u; voffB[i] = (unsigned)(Rb * K + C) * 2u; RA[i] = R; CA[i] = C; }
    const size_t kstep = (size_t)(BK * 2);
    const size_t hstep = (size_t)HALF * K * 2;
    const size_t tstep = 2 * hstep;
    const unsigned ldsw = (unsigned)wid * 1024u;
    const int aoff = lds_byte(wr * 64 + fr, fq * 8), boff = lds_byte(wc * 32 + fr, fq * 8);
#define PG8_SA(b, h) (((b) * 2 + (h)) * HTB)
#define PG8_SB(b, h) ((4 + (b) * 2 + (h)) * HTB)
#define PG8_STAGE(bufoff, gbase, voff) do { _Pragma("unroll") for (int _i = 0; _i < 2; ++_i) \
        __builtin_amdgcn_global_load_lds((const unsigned*)((const char*)(gbase) + (voff)[_i]), (LAS unsigned*)(lds + (bufoff) + ldsw + _i * 8192), 16, 0, 0); } while (0)
#define PG8_STAGE2(bufoff, gbase, o0, o1) do { \
        __builtin_amdgcn_global_load_lds((const unsigned*)((const char*)(gbase) + (o0)), (LAS unsigned*)(lds + (bufoff) + ldsw), 16, 0, 0); \
        __builtin_amdgcn_global_load_lds((const unsigned*)((const char*)(gbase) + (o1)), (LAS unsigned*)(lds + (bufoff) + ldsw + 8192), 16, 0, 0); } while (0)
#define PG8_LDA(dst, b, h) do { _Pragma("unroll") for (int m = 0; m < 4; ++m) _Pragma("unroll") for (int k = 0; k < 2; ++k) dst[m][k] = *(const LAS bf16x8*)(lds + PG8_SA(b, h) + aoff + m * 2048 + k * 1024); } while (0)
#define PG8_LDB(dst, b, h) do { _Pragma("unroll") for (int n = 0; n < 2; ++n) _Pragma("unroll") for (int k = 0; k < 2; ++k) dst[n][k] = *(const LAS bf16x8*)(lds + PG8_SB(b, h) + boff + n * 2048 + k * 1024); } while (0)
#define PG8_MMA(ai, bj, At, Bt) do { __builtin_amdgcn_s_setprio(1); _Pragma("unroll") for (int m = 0; m < 4; ++m) _Pragma("unroll") for (int n = 0; n < 2; ++n) _Pragma("unroll") for (int k = 0; k < 2; ++k) \
        acc[ai][bj][m][n] = __builtin_amdgcn_mfma_f32_16x16x32_bf16(Bt[n][k], At[m][k], acc[ai][bj][m][n], 0, 0, 0); __builtin_amdgcn_s_setprio(0); } while (0)
#define PG8_WAIT_V(n) asm volatile("s_waitcnt vmcnt(" #n ")" ::: "memory")
#define PG8_WAIT_L(n) asm volatile("s_waitcnt lgkmcnt(" #n ")" ::: "memory")
#define PG8_BAR __builtin_amdgcn_s_barrier()
#define PG8_SCHED __builtin_amdgcn_sched_barrier(0)
    Unit cur, nxt; int ui = 0;
    if (!S.next(0, cur)) return;
    f32x4 acc[2][2][4][2];
#pragma unroll
    for (int a = 0; a < 2; ++a)
#pragma unroll
        for (int b = 0; b < 2; ++b)
#pragma unroll
            for (int m = 0; m < 4; ++m)
#pragma unroll
                for (int n = 0; n < 2; ++n) acc[a][b][m][n] = (f32x4){0.f, 0.f, 0.f, 0.f};
    bf16x8 At[4][2], B0[2][2], B1[2][2];
    unsigned c00 = 0, c01 = 0, c10 = 0, c11 = 0, n00 = 0, n01 = 0, n10 = 0, n11 = 0;
    if constexpr (GATHER) {
        c00 = (unsigned)(S.arow(cur, RA[0]) * K + CA[0]) * 2u; c01 = (unsigned)(S.arow(cur, RA[1]) * K + CA[1]) * 2u;
        c10 = (unsigned)(S.arow(cur, HALF + RA[0]) * K + CA[0]) * 2u; c11 = (unsigned)(S.arow(cur, HALF + RA[1]) * K + CA[1]) * 2u;
    }
    const char* cA = GATHER ? (const char*)g.A : (const char*)g.A + (size_t)cur.pm * tstep; const char* cB = (const char*)g.Bt + (size_t)cur.pn * tstep;
    if constexpr (GATHER) {
        PG8_STAGE(PG8_SB(0, 0), cB, voffB); PG8_STAGE2(PG8_SA(0, 0), cA, c00, c01); PG8_STAGE(PG8_SB(0, 1), cB + hstep, voffB); PG8_STAGE2(PG8_SA(0, 1), cA, c10, c11);
    } else {
        PG8_STAGE(PG8_SB(0, 0), cB, voffB); PG8_STAGE(PG8_SB(0, 1), cB + hstep, voffB); PG8_STAGE(PG8_SA(0, 0), cA, voffA); PG8_STAGE(PG8_SA(0, 1), cA + hstep, voffA);
    }
    if (wr == 1) PG8_BAR;
    if constexpr (GATHER) PG8_WAIT_V(4); else PG8_WAIT_V(2);
    PG8_BAR;
    if constexpr (GATHER) {
        PG8_STAGE(PG8_SB(1, 0), cB + kstep, voffB); PG8_STAGE2(PG8_SA(1, 0), cA + kstep, c00, c01); PG8_STAGE(PG8_SB(1, 1), cB + hstep + kstep, voffB);
    } else {
        PG8_STAGE(PG8_SB(1, 0), cB + kstep, voffB); PG8_STAGE(PG8_SA(1, 0), cA + kstep, voffA); PG8_STAGE(PG8_SB(1, 1), cB + hstep + kstep, voffB);
    }
    PG8_WAIT_V(6); PG8_BAR;
    for (;;) {
        const bool has_next = S.next(ui + 1, nxt);
        if constexpr (GATHER) {
            if (has_next) {
                n00 = (unsigned)(S.arow(nxt, RA[0]) * K + CA[0]) * 2u; n01 = (unsigned)(S.arow(nxt, RA[1]) * K + CA[1]) * 2u;
                n10 = (unsigned)(S.arow(nxt, HALF + RA[0]) * K + CA[0]) * 2u; n11 = (unsigned)(S.arow(nxt, HALF + RA[1]) * K + CA[1]) * 2u;
            } else { n00 = c00; n01 = c01; n10 = c10; n11 = c11; }
        }
        const char* nA = GATHER ? cA : (has_next ? (const char*)g.A + (size_t)nxt.pm * tstep : cA);
        const char* nB = has_next ? (const char*)g.Bt + (size_t)nxt.pn * tstep : cB;
        for (int t = 0; t < nt; t += 2) {
            const bool last = (t == nt - 2);
            const char* a1 = cA + (size_t)(t + 1) * kstep;
            const char* a2 = last ? nA : cA + (size_t)(t + 2) * kstep; const char* b2 = last ? nB : cB + (size_t)(t + 2) * kstep;
            const char* a3 = a2 + kstep; const char* b3 = b2 + kstep;
            unsigned s00 = 0, s01 = 0, s10 = 0, s11 = 0;
            if constexpr (GATHER) { s00 = last ? n00 : c00; s01 = last ? n01 : c01; s10 = last ? n10 : c10; s11 = last ? n11 : c11; }
            if constexpr (!GATHER) {
            PG8_LDB(B0, 0, 0); PG8_LDB(B1, 0, 1); PG8_SCHED; PG8_LDA(At, 0, 0); PG8_STAGE(PG8_SA(1, 1), a1 + hstep, voffA);
            PG8_WAIT_V(8); PG8_WAIT_L(0); PG8_BAR; PG8_MMA(0, 0, At, B0); PG8_MMA(0, 1, At, B1); PG8_BAR; PG8_SCHED;
            PG8_LDA(At, 0, 1); PG8_STAGE(PG8_SB(0, 0), b2, voffB); PG8_STAGE(PG8_SB(0, 1), b2 + hstep, voffB); PG8_STAGE(PG8_SA(0, 0), a2, voffA);
            PG8_WAIT_V(8); PG8_WAIT_L(0); PG8_BAR; PG8_MMA(1, 0, At, B0); PG8_MMA(1, 1, At, B1); PG8_BAR; PG8_SCHED;
            PG8_LDB(B0, 1, 0); PG8_LDB(B1, 1, 1); PG8_SCHED; PG8_LDA(At, 1, 0); PG8_STAGE(PG8_SA(0, 1), a2 + hstep, voffA);
            PG8_WAIT_V(8); PG8_WAIT_L(0); PG8_BAR; PG8_MMA(0, 0, At, B0); PG8_MMA(0, 1, At, B1); PG8_BAR; PG8_SCHED;
            PG8_LDA(At, 1, 1); PG8_STAGE(PG8_SB(1, 0), b3, voffB); PG8_STAGE(PG8_SB(1, 1), b3 + hstep, voffB); PG8_STAGE(PG8_SA(1, 0), a3, voffA);
            PG8_WAIT_V(8); PG8_WAIT_L(0); PG8_BAR; PG8_MMA(1, 0, At, B0); PG8_MMA(1, 1, At, B1); PG8_BAR; PG8_SCHED;
            } else {
            PG8_LDB(B0, 0, 0); PG8_SCHED; PG8_LDA(At, 0, 0);
            if constexpr (GATHER) PG8_STAGE2(PG8_SA(1, 1), a1, c10, c11); else PG8_STAGE(PG8_SA(1, 1), a1 + hstep, voffA);
            PG8_WAIT_L(8); PG8_BAR; PG8_WAIT_L(0); PG8_MMA(0, 0, At, B0); PG8_BAR; PG8_SCHED;
            PG8_LDB(B1, 0, 1); PG8_STAGE(PG8_SB(0, 0), b2, voffB);
            PG8_BAR; PG8_WAIT_L(0); PG8_MMA(0, 1, At, B1); PG8_BAR;
            PG8_LDA(At, 0, 1);
            if constexpr (GATHER) PG8_STAGE2(PG8_SA(0, 0), a2, s00, s01); else PG8_STAGE(PG8_SA(0, 0), a2, voffA);
            PG8_BAR; PG8_WAIT_L(0); PG8_MMA(1, 0, At, B0); PG8_BAR; PG8_SCHED;
            PG8_STAGE(PG8_SB(0, 1), b2 + hstep, voffB);
            PG8_WAIT_V(6); PG8_BAR; PG8_MMA(1, 1, At, B1); PG8_BAR;
            PG8_LDB(B0, 1, 0); PG8_SCHED; PG8_LDA(At, 1, 0);
            if constexpr (GATHER) PG8_STAGE2(PG8_SA(0, 1), a2, s10, s11); else PG8_STAGE(PG8_SA(0, 1), a2 + hstep, voffA);
            PG8_WAIT_L(8); PG8_BAR; PG8_WAIT_L(0); PG8_MMA(0, 0, At, B0); PG8_BAR; PG8_SCHED;
            PG8_LDB(B1, 1, 1); PG8_STAGE(PG8_SB(1, 0), b3, voffB);
            PG8_BAR; PG8_WAIT_L(0); PG8_MMA(0, 1, At, B1); PG8_BAR;
            PG8_LDA(At, 1, 1);
            if constexpr (GATHER) PG8_STAGE2(PG8_SA(1, 0), a3, s00, s01); else PG8_STAGE(PG8_SA(1, 0), a3, voffA);
            PG8_BAR; PG8_WAIT_L(0); PG8_MMA(1, 0, At, B0); PG8_BAR; PG8_SCHED;
            PG8_STAGE(PG8_SB(1, 1), b3 + hstep, voffB);
            PG8_WAIT_V(6); PG8_BAR; PG8_MMA(1, 1, At, B1); PG8_BAR;
                    }
        }
        if (wr == 0) PG8_BAR;
        E(acc, cur, wr, wc, fr, fq);
        if (!has_next) break;
#pragma unroll
        for (int a = 0; a < 2; ++a)
#pragma unroll
            for (int b = 0; b < 2; ++b)
#pragma unroll
                for (int m = 0; m < 4; ++m)
#pragma unroll
                    for (int n = 0; n < 2; ++n) acc[a][b][m][n] = (f32x4){0.f, 0.f, 0.f, 0.f};
        cur = nxt; cA = nA; cB = nB; ++ui;
        if constexpr (GATHER) { c00 = n00; c01 = n01; c10 = n10; c11 = n11; }
        if (wr == 1) PG8_BAR;
    }
    PG8_WAIT_V(0);
    PG8_BAR;
#undef PG8_SA
#undef PG8_SB
#undef PG8_STAGE
#undef PG8_STAGE2
#undef PG8_LDA
#undef PG8_LDB
#undef PG8_MMA
#undef PG8_WAIT_V
#undef PG8_WAIT_L
#undef PG8_BAR
#undef PG8_SCHED
}
}

struct Params {
    const float* x; const int* pos; const float* norm1_g; const float* w_in; const float* conv_a_w; const float* a_log; const float* dt_bias; const float* gdn_norm_g;
    const float* conv_b_w; const float* conv_b_b; const float* ln_b_g; const float* ln_b_b; const float* pool_w; const float* pool_scale; const float* w_branch; const float* w_out;
    const float* norm2_g; const float* rg_w; const float* rg_b; const float* re_w; const float* re_b; const float* w_up; const float* w_down; const float* final_g;
    float* out; unsigned char* ws; int ph_lo, ph_hi, probe, pad;
};

struct Ctx { int tid, lane, wave, bid, G; LAS unsigned char* lds; };
constexpr int LDS_PTAB = LDS_MISC + 512;
__device__ __forceinline__ const void* lds_ptr_get(const LAS unsigned* tab, int i) {
    const unsigned lo = __builtin_amdgcn_readfirstlane(tab[2 * i]), hi = __builtin_amdgcn_readfirstlane(tab[2 * i + 1]);
    return (const void*)(const GAS char*)(((unsigned long long)hi << 32) | lo); }
__device__ __forceinline__ Params load_params(const Ctx& c, unsigned char* ws, int lo, int hi) {
    unsigned toff = LDS_PTAB; asm volatile("" : "+s"(toff)); const LAS unsigned* tab = (const LAS unsigned*)(c.lds + toff);
    Params q;
    q.x = (const float*)lds_ptr_get(tab, 0); q.pos = (const int*)lds_ptr_get(tab, 1); q.norm1_g = (const float*)lds_ptr_get(tab, 2); q.w_in = (const float*)lds_ptr_get(tab, 3);
    q.conv_a_w = (const float*)lds_ptr_get(tab, 4); q.a_log = (const float*)lds_ptr_get(tab, 5); q.dt_bias = (const float*)lds_ptr_get(tab, 6); q.gdn_norm_g = (const float*)lds_ptr_get(tab, 7);
    q.conv_b_w = (const float*)lds_ptr_get(tab, 8); q.conv_b_b = (const float*)lds_ptr_get(tab, 9); q.ln_b_g = (const float*)lds_ptr_get(tab, 10); q.ln_b_b = (const float*)lds_ptr_get(tab, 11);
    q.pool_w = (const float*)lds_ptr_get(tab, 12); q.pool_scale = (const float*)lds_ptr_get(tab, 13); q.w_branch = (const float*)lds_ptr_get(tab, 14); q.w_out = (const float*)lds_ptr_get(tab, 15);
    q.norm2_g = (const float*)lds_ptr_get(tab, 16); q.rg_w = (const float*)lds_ptr_get(tab, 17); q.rg_b = (const float*)lds_ptr_get(tab, 18); q.re_w = (const float*)lds_ptr_get(tab, 19);
    q.re_b = (const float*)lds_ptr_get(tab, 20); q.w_up = (const float*)lds_ptr_get(tab, 21); q.w_down = (const float*)lds_ptr_get(tab, 22); q.final_g = (const float*)lds_ptr_get(tab, 23);
    q.out = (float*)lds_ptr_get(tab, 24); q.ws = ws; q.ph_lo = lo; q.ph_hi = hi; q.probe = -1; q.pad = 0; return q; }

__device__ __forceinline__ void cvt_tile(const Ctx& c, const float* __restrict__ src, size_t ld, int k0, int n0s, bf16_t* __restrict__ dst, int K, int n0d) {
    LAS float* tile = (LAS float*)c.lds;
    const int tid = c.tid;
#pragma unroll
    for (int rr = 0; rr < 2; ++rr) {
        const int r = (tid >> 4) + rr * 32, cc = (tid & 15) * 4;
        const float4 v = *(const float4*)(src + (size_t)(k0 + r) * ld + n0s + cc);
        tile[r * 65 + cc + 0] = v.x; tile[r * 65 + cc + 1] = v.y; tile[r * 65 + cc + 2] = v.z; tile[r * 65 + cc + 3] = v.w;
    }
    __syncthreads();
    {
        const int n = tid >> 3, ks = tid & 7;
        float f[8];
#pragma unroll
        for (int i = 0; i < 8; ++i) f[i] = tile[(ks * 8 + i) * 65 + n];
        u32x4 w; w.x = cvt_pk_bf16(f[0], f[1]); w.y = cvt_pk_bf16(f[2], f[3]); w.z = cvt_pk_bf16(f[4], f[5]); w.w = cvt_pk_bf16(f[6], f[7]);
        *(u32x4*)(dst + (size_t)(n0d + n) * K + k0 + ks * 8) = w;
    }
    __syncthreads();
}
struct CvtDesc { const float* src; bf16_t* dst; int ld, K; };
__device__ __forceinline__ CvtDesc cvt_desc(const Params& p, int idx) {
    constexpr int T1 = 10240, T2 = 1536, T3 = 1024, TL = T1 + T2 + T3;
    bf16_t* WinT = (bf16_t*)(p.ws + WS_WINT); bf16_t* WbrT = (bf16_t*)(p.ws + WS_WBRT); bf16_t* WoutT = (bf16_t*)(p.ws + WS_WOUTT);
    const int L = idx / TL; int r = idx % TL; CvtDesc d;
    if (r < T1) { const int kt = r % 32, ntile = r / 32, n0d = ntile * 64, n0s = n0d + (n0d >= 3072 ? 12 : 0);
        d.ld = NIN; d.K = D; d.src = p.w_in + (size_t)L * D * NIN + (size_t)(kt * 64) * NIN + n0s; d.dst = WinT + (size_t)L * NU * D + (size_t)n0d * D + kt * 64; return d; }
    r -= T1;
    if (r < T2) { const int kb = r / 384, rr = r % 384, kt = rr % 12, ntile = rr / 12;
        d.ld = D; d.K = 768; d.src = p.w_branch + (size_t)(L * 4 + kb) * 768 * D + (size_t)(kt * 64) * D + ntile * 64; d.dst = WbrT + (size_t)(L * 4 + kb) * D * 768 + (size_t)(ntile * 64) * 768 + kt * 64; return d; }
    r -= T2;
    { const int kt = r % 32, ntile = r / 32;
        d.ld = D; d.K = D; d.src = p.w_out + (size_t)L * D * D + (size_t)(kt * 64) * D + ntile * 64; d.dst = WoutT + (size_t)L * D * D + (size_t)(ntile * 64) * D + kt * 64; return d; }
}
__device__ __forceinline__ void phase_convert(const Ctx& c, const Params& p) {
    constexpr int TL = 10240 + 1536 + 1024;
    {
        const int tid = c.tid, r0 = tid >> 4, cc = (tid & 15) * 4;
        int idx = c.bid; float4 v0 = make_float4(0.f, 0.f, 0.f, 0.f), v1 = v0, m0 = v0, m1 = v0; CvtDesc cur, mid;
        if (idx < NL * TL) { cur = cvt_desc(p, idx); v0 = *(const float4*)(cur.src + (size_t)r0 * cur.ld + cc); v1 = *(const float4*)(cur.src + (size_t)(r0 + 32) * cur.ld + cc); mid = cur; }
        if (idx + c.G < NL * TL) { mid = cvt_desc(p, idx + c.G); m0 = *(const float4*)(mid.src + (size_t)r0 * mid.ld + cc); m1 = *(const float4*)(mid.src + (size_t)(r0 + 32) * mid.ld + cc); }
        int bsel = 0;
        while (idx < NL * TL) {
            const int n2 = idx + 2 * c.G; CvtDesc nxt = mid; float4 n0 = m0, n1 = m1;
            if (n2 < NL * TL) { nxt = cvt_desc(p, n2); n0 = *(const float4*)(nxt.src + (size_t)r0 * nxt.ld + cc); n1 = *(const float4*)(nxt.src + (size_t)(r0 + 32) * nxt.ld + cc); }
            LAS float* tile = (LAS float*)c.lds + bsel * (64 * 65 + 32);
            tile[r0 * 65 + cc + 0] = v0.x; tile[r0 * 65 + cc + 1] = v0.y; tile[r0 * 65 + cc + 2] = v0.z; tile[r0 * 65 + cc + 3] = v0.w;
            tile[(r0 + 32) * 65 + cc + 0] = v1.x; tile[(r0 + 32) * 65 + cc + 1] = v1.y; tile[(r0 + 32) * 65 + cc + 2] = v1.z; tile[(r0 + 32) * 65 + cc + 3] = v1.w;
            __syncthreads();
            { const int n = tid >> 3, ks = tid & 7; float f[8];
#pragma unroll
              for (int i = 0; i < 8; ++i) f[i] = tile[(ks * 8 + i) * 65 + n];
              u32x4 w; w.x = cvt_pk_bf16(f[0], f[1]); w.y = cvt_pk_bf16(f[2], f[3]); w.z = cvt_pk_bf16(f[4], f[5]); w.w = cvt_pk_bf16(f[6], f[7]);
              *(u32x4*)(cur.dst + (size_t)n * cur.K + ks * 8) = w; }
            idx += c.G; cur = mid; v0 = m0; v1 = m1; mid = nxt; m0 = n0; m1 = n1; bsel ^= 1;
        }
        __syncthreads();
    }
    {   float* WSM = (float*)(p.ws + WS_WSM);
        for (int i = c.bid * NTHREADS + c.tid; i < NL * 12 * 2048; i += c.G * NTHREADS) { const int k = i & 2047, j = (i >> 11) % 12, L = i / (12 * 2048);
            WSM[i] = p.w_in[((size_t)L * D + k) * NIN + 3072 + j]; }
    }
    {
        bf16_t* WRT = (bf16_t*)(p.ws + WS_WRT);
        for (int i = c.bid * NTHREADS + c.tid; i < NL * 80 * 2048; i += c.G * NTHREADS) { const int k = i & 2047, j = (i >> 11) % 80, L = i / (80 * 2048);
            const float w = j < 8 ? p.rg_w[((size_t)L * D + k) * 8 + j] : (j < 72 ? p.re_w[((size_t)L * D + k) * 64 + (j - 8)] : 0.f);
            const bf16_t hi = f2bf(w); WRT[((size_t)(L * 2 + 0) * 80 + j) * 2048 + k] = hi; WRT[((size_t)(L * 2 + 1) * 80 + j) * 2048 + k] = f2bf(w - bf2f(hi)); }
    }
    {
        bf16_t* PWT = (bf16_t*)(p.ws + WS_PWT);
        for (int i = c.bid * NTHREADS + c.tid; i < NL * 4 * 192 * 192; i += c.G * NTHREADS) { const int cc = i % 192, e = (i / 192) % 192, lg = i / (192 * 192);
            PWT[i] = f2bf(p.pool_w[(size_t)(lg * 192 + cc) * 192 + e] * p.pool_scale[lg * 192 + e]); }
    }
}

__device__ __forceinline__ void phase_norm1(const Ctx& c, const Params& p, int L) {
    LAS float* wsm = (LAS float*)c.lds;
    { const float4* src = (const float4*)((const float*)(p.ws + WS_WSM) + (size_t)L * 12 * 2048);
      for (int i = c.tid; i < 12 * 2048 / 4; i += NTHREADS) { const float4 v = src[i]; LAS float* d = wsm + 4 * i; d[0] = v.x; d[1] = v.y; d[2] = v.z; d[3] = v.w; } }
    __syncthreads();
    const float* g1 = p.norm1_g + L * D;
    bf16_t* H = (bf16_t*)(p.ws + WS_H); float* XA = (float*)(p.ws + WS_XA); const float* XB = (const float*)(p.ws + WS_XB); const bf16_t* Y = (const bf16_t*)(p.ws + WS_YMOE);
    float* BETA = (float*)(p.ws + WS_BETA); float* GLOG = (float*)(p.ws + WS_GLOG);
    for (int rt = c.bid; rt < T / 32; rt += c.G) {
#pragma unroll 1
        for (int i = 0; i < 4; ++i) {
            const int t = rt * 32 + c.wave * 4 + i;
            int wo = 0; asm volatile("" : "+v"(wo)); const LAS float* wsm_i = wsm + wo;
            float4 xv[8]; float ss = 0.f;
#pragma unroll
            for (int q = 0; q < 8; ++q) {
                const int col = q * 256 + c.lane * 4;
                float4 v;
                if (L == 0) v = *(const float4*)(p.x + (size_t)t * D + col);
                else { const float4 a = *(const float4*)(XB + (size_t)t * D + col); const u32x2 y0 = *(const u32x2*)(Y + (size_t)(2 * t) * D + col), y1 = *(const u32x2*)(Y + (size_t)(2 * t + 1) * D + col);
                    v.x = a.x + (bflo(y0.x) + bflo(y1.x)); v.y = a.y + (bfhi(y0.x) + bfhi(y1.x)); v.z = a.z + (bflo(y0.y) + bflo(y1.y)); v.w = a.w + (bfhi(y0.y) + bfhi(y1.y));
                    *(float4*)(XA + (size_t)t * D + col) = v; }
                xv[q] = v; ss += v.x * v.x + v.y * v.y + v.z * v.z + v.w * v.w;
            }
            ss = wave_sum(ss, c.lane);
            const float rstd = rsqrtf(ss * (1.0f / D) + 1e-6f);
            float dots[12];
#pragma unroll
            for (int j = 0; j < 12; ++j) dots[j] = 0.f;
#pragma unroll
            for (int q = 0; q < 8; ++q) {
                const int col = q * 256 + c.lane * 4;
                const float4 g = *(const float4*)(g1 + col);
                float4 h; h.x = xv[q].x * rstd * g.x; h.y = xv[q].y * rstd * g.y; h.z = xv[q].z * rstd * g.z; h.w = xv[q].w * rstd * g.w;
                uint2 o; o.x = cvt_pk_bf16(h.x, h.y); o.y = cvt_pk_bf16(h.z, h.w);
                *(uint2*)(H + (size_t)t * D + col) = o;
#pragma unroll
                for (int j = 0; j < 12; ++j) { const LAS float* wp = wsm_i + j * 2048 + col; dots[j] += h.x * wp[0] + h.y * wp[1] + h.z * wp[2] + h.w * wp[3]; }
            }
#pragma unroll
            for (int j = 0; j < 12; ++j) dots[j] = wave_sum(dots[j], c.lane);
            if (c.lane < 6) {
                float db = dots[0], dd = dots[6];
#pragma unroll
                for (int j = 1; j < 6; ++j) { if (c.lane == j) { db = dots[j]; dd = dots[6 + j]; } }
                BETA[t * 8 + c.lane] = 1.0f / (1.0f + expf(-db));
                const float xx = dd + p.dt_bias[L * 6 + c.lane];
                const float sp = xx > 20.f ? xx : log1pf(expf(xx));
                GLOG[t * 8 + c.lane] = -expf(p.a_log[L * 6 + c.lane]) * sp;
            }
        }
    }
}

struct EpiU {
    static constexpr bool PERM = true;
    bf16_t* O;
    __device__ __forceinline__ void operator()(const f32x4 (&acc)[2][2][4][2], const pg8::Unit& u, int wr, int wc, int fr, int fq) const {
        const int row0 = u.pm * 256 + wr * 64 + fr, col0 = u.pn * 256 + wc * 32 + 8 * fq; const bool sig = u.pn >= 48;
#pragma unroll
        for (int ai = 0; ai < 2; ++ai)
#pragma unroll
            for (int m = 0; m < 4; ++m) { bf16_t* rowp = O + (size_t)(row0 + ai * 128 + m * 16) * NU + col0;
#pragma unroll
                for (int bj = 0; bj < 2; ++bj) { f32x4 v0 = acc[ai][bj][m][0], v1 = acc[ai][bj][m][1];
                    if (sig) {
#pragma unroll
                        for (int j = 0; j < 4; ++j) { v0[j] = sigmoidf_(v0[j]); v1[j] = sigmoidf_(v1[j]); } }
                    u32x4 w; w.x = cvt_pk_bf16(v0[0], v0[1]); w.y = cvt_pk_bf16(v0[2], v0[3]); w.z = cvt_pk_bf16(v1[0], v1[1]); w.w = cvt_pk_bf16(v1[2], v1[3]);
                    *(u32x4*)(rowp + bj * 128) = w; } }
    }
};
struct MergeOrder {
    int G, c;
    __device__ bool next(int i, pg8::Unit& u) const { const int tile = c + (i >> 2) * G; if (tile >= 256) return false; const int k = i & 3, x = tile & 7, y = tile >> 3;
        u.pm = k * 32 + x * 4 + (y >> 3); u.pn = k * 8 + (y & 7); return true; }
    __device__ __forceinline__ int arow(const pg8::Unit& u, int r) const { return u.pm * 256 + r; }
};
struct EpiMerge {
    static constexpr bool PERM = true;
    const bf16_t* U; float* M32; bf16_t* MG;
    __device__ __forceinline__ void operator()(const f32x4 (&acc)[2][2][4][2], const pg8::Unit& u, int wr, int wc, int fr, int fq) const {
        const int k = u.pm >> 5, tm = u.pm & 31, tn = u.pn & 7;
        const int row0 = tm * 256 + wr * 64 + fr, col0 = tn * 256 + wc * 32 + 8 * fq;
        bf16_t* const MP = (bf16_t*)M32;
#pragma unroll
        for (int ai = 0; ai < 2; ++ai)
#pragma unroll
            for (int mh = 0; mh < 2; ++mh) {
                u32x4 gv[2][2], pv[2][2];
#pragma unroll
                for (int mm = 0; mm < 2; ++mm)
#pragma unroll
                    for (int bj = 0; bj < 2; ++bj) { const size_t row = (size_t)(row0 + ai * 128 + (mh * 2 + mm) * 16); const int col = col0 + bj * 128;
                        gv[mm][bj] = *(const u32x4*)(U + row * NU + UC_G + k * D + col);
                        pv[mm][bj] = (k > 0) ? *(const u32x4*)(MP + row * D + col) : (u32x4){0u, 0u, 0u, 0u}; }
#pragma unroll
                for (int mm = 0; mm < 2; ++mm)
#pragma unroll
                    for (int bj = 0; bj < 2; ++bj) { const int m = mh * 2 + mm; const size_t row = (size_t)(row0 + ai * 128 + m * 16); const int col = col0 + bj * 128;
                        const u32x4 g = gv[mm][bj], pp = pv[mm][bj];
                        f32x4 v0 = acc[ai][bj][m][0], v1 = acc[ai][bj][m][1];
                        v0[0] = v0[0] * bflo(g.x) + bflo(pp.x); v0[1] = v0[1] * bfhi(g.x) + bfhi(pp.x); v0[2] = v0[2] * bflo(g.y) + bflo(pp.y); v0[3] = v0[3] * bfhi(g.y) + bfhi(pp.y);
                        v1[0] = v1[0] * bflo(g.z) + bflo(pp.z); v1[1] = v1[1] * bfhi(g.z) + bfhi(pp.z); v1[2] = v1[2] * bflo(g.w) + bflo(pp.w); v1[3] = v1[3] * bfhi(g.w) + bfhi(pp.w);
                        u32x4 w; w.x = cvt_pk_bf16(v0[0], v0[1]); w.y = cvt_pk_bf16(v0[2], v0[3]); w.z = cvt_pk_bf16(v1[0], v1[1]); w.w = cvt_pk_bf16(v1[2], v1[3]);
                        *(u32x4*)((k < 3 ? MP : MG) + row * D + col) = w; }
            }
    }
};
struct EpiRes {
    static constexpr bool PERM = false;
    const float* X; float* O;
    __device__ __forceinline__ void operator()(const f32x4 (&acc)[2][2][4][2], const pg8::Unit& u, int wr, int wc, int fr, int fq) const {
        const int row0 = u.pm * 256 + wr * 64 + fr, col0 = u.pn * 256 + wc * 32 + 4 * fq;
#pragma unroll
        for (int ai = 0; ai < 2; ++ai)
#pragma unroll
            for (int mh = 0; mh < 2; ++mh) {
                f32x4 xv[2][2][2];
#pragma unroll
                for (int mm = 0; mm < 2; ++mm)
#pragma unroll
                    for (int bj = 0; bj < 2; ++bj)
#pragma unroll
                        for (int n = 0; n < 2; ++n) xv[mm][bj][n] = *(const f32x4*)(X + (size_t)(row0 + ai * 128 + (mh * 2 + mm) * 16) * D + col0 + bj * 128 + n * 16);
#pragma unroll
                for (int mm = 0; mm < 2; ++mm)
#pragma unroll
                    for (int bj = 0; bj < 2; ++bj)
#pragma unroll
                        for (int n = 0; n < 2; ++n) *(f32x4*)(O + (size_t)(row0 + ai * 128 + (mh * 2 + mm) * 16) * D + col0 + bj * 128 + n * 16) = acc[ai][bj][mh * 2 + mm][n] + xv[mm][bj][n];
            }
    }
};
struct MoeTab { const LAS int* mt_e; const LAS int* mt_p0; const LAS int* cnt; const LAS int* ut; int nmt; };
struct MoeOrder {
    MoeTab tb; int nN, G, c; const int* tok; unsigned* done;
    __device__ bool next(int i, pg8::Unit& u) const { const int U = tb.nmt * nN; int Lx;
        if (G % 8 == 0) { const int per = G / 8, x = c % 8, j = c / 8, R = U / G, rem = U - R * G;
            if (i < R) Lx = i * G + x * per + j;
            else if (i == R) { const int px = rem / 8, left = rem - px * 8;
                if (j < px) Lx = R * G + x * px + j; else if (j == px && x < left) Lx = R * G + px * 8 + x; else return false; }
            else return false;
        } else { Lx = i * G + c; if (Lx >= U) return false; }
        const int e = tb.ut[Lx]; u.pm = e >> 4; u.pn = tb.mt_e[u.pm] * nN + (e & 15); return true; }
    __device__ __forceinline__ int arow(const pg8::Unit& u, int r) const { const int e = tb.mt_e[u.pm], pos = tb.mt_p0[u.pm] + r; return pos < tb.cnt[e] ? (tok[e * 8192 + pos] >> 1) : 0; }
};
struct MoeDownQueue {
    MoeTab tb; int nN, G, c; unsigned* qhead; unsigned* done; LAS int* slot; const int* tok;
    __device__ bool next(int, pg8::Unit& u) const {
        __syncthreads();
        if (threadIdx.x == 0) {
            const int U = tb.nmt * 8, per = (G % 8 == 0) ? G / 8 : G, nq = (G % 8 == 0) ? 8 : 1, x0 = (G % 8 == 0) ? c % 8 : 0;
            int xo = slot[1], ent = -1;
            for (; xo < nq; ++xo) { const int x = (x0 + xo) % nq;
                const int q = (int)__hip_atomic_fetch_add(qhead + 16 * x, 1u, __ATOMIC_RELAXED, __HIP_MEMORY_SCOPE_AGENT);
                const int Lq = (q / per) * G + x * per + (q % per);
                if (Lq < U) { ent = tb.ut[Lq]; break; } }
            slot[1] = xo;
            if (ent >= 0) { const int mt = ent >> 4; unsigned sp = 0;
                while (__hip_atomic_load(done + mt, __ATOMIC_RELAXED, __HIP_MEMORY_SCOPE_AGENT) < 4u) { __builtin_amdgcn_s_sleep(2); if (++sp > (1u << 21)) break; }
                __builtin_amdgcn_fence(__ATOMIC_ACQUIRE, "agent"); asm volatile("s_waitcnt vmcnt(0)" ::: "memory"); }
            slot[0] = ent; }
        __syncthreads();
        const int ent = slot[0]; if (ent < 0) return false;
        u.pm = ent >> 4; u.pn = tb.mt_e[u.pm] * 8 + (ent & 15); return true; }
    __device__ __forceinline__ int arow(const pg8::Unit& u, int r) const { return u.pm * 128 + r; }
};
struct EpiUp {
    bf16_t* HID;
    __device__ __forceinline__ void operator()(const f32x4 (&acc)[2][4][2], const pg8::Unit& u, int wr, int wc, int fr, int fq) const {
        const int j = u.pn & 3; const int row0 = u.pm * 128 + wr * 64 + fr, col0 = j * 128 + wc * 32 + 8 * fq;
#pragma unroll
        for (int m = 0; m < 4; ++m) { const f32x4 g0 = acc[0][m][0], g1 = acc[0][m][1], u0 = acc[1][m][0], u1 = acc[1][m][1];
            float h[8];
#pragma unroll
            for (int q = 0; q < 4; ++q) { h[q] = siluf_(g0[q]) * u0[q]; h[4 + q] = siluf_(g1[q]) * u1[q]; }
            u32x4 w; w.x = cvt_pk_bf16(h[0], h[1]); w.y = cvt_pk_bf16(h[2], h[3]); w.z = cvt_pk_bf16(h[4], h[5]); w.w = cvt_pk_bf16(h[6], h[7]);
            *(u32x4*)(HID + (size_t)(row0 + m * 16) * EH + col0) = w; }
    }
};
struct EpiDown {
    MoeTab tb; const int* tok; const float* wsl; bf16_t* Y;
    __device__ __forceinline__ void operator()(const f32x4 (&acc)[2][4][2], const pg8::Unit& u, int wr, int wc, int fr, int fq) const {
        const int e = tb.mt_e[u.pm], p0 = tb.mt_p0[u.pm], ne = tb.cnt[e]; const int col0 = (u.pn & 7) * 256 + wc * 32 + 8 * fq;
        int dst[4]; float w[4];
#pragma unroll
        for (int m = 0; m < 4; ++m) { const int pos = p0 + wr * 64 + fr + m * 16; const int pc = pos < ne ? pos : ne - 1;
            dst[m] = tok[e * 8192 + pc]; w[m] = wsl[e * 8192 + pc]; }
#pragma unroll
        for (int m = 0; m < 4; ++m) { const int pos = p0 + wr * 64 + fr + m * 16;
            if (pos < ne) { bf16_t* yp = Y + (size_t)dst[m] * D + col0; const float ww = w[m];
#pragma unroll
                for (int bj = 0; bj < 2; ++bj) { const f32x4 v0 = acc[bj][m][0] * ww, v1 = acc[bj][m][1] * ww;
                    u32x4 o; o.x = cvt_pk_bf16(v0[0], v0[1]); o.y = cvt_pk_bf16(v0[2], v0[3]); o.z = cvt_pk_bf16(v1[0], v1[1]); o.w = cvt_pk_bf16(v1[2], v1[3]);
                    *(u32x4*)(yp + bj * 128) = o; } } }
    }
};

struct MoeTab2 { const LAS int* rt_e; const LAS int* rt_r0; const LAS int* cnt; const LAS int* first; const LAS int* ut_up; const LAS int* ut_dn; int nrt; };
__device__ __forceinline__ bool moe_deal(int i, int U, int G, int c, int& Lx) {
    if (G % 8 == 0) { const int per = G / 8, x = c % 8, j = c / 8, R = U / G, rem = U - R * G;
        if (i < R) Lx = i * G + x * per + j;
        else if (i == R) { const int px = rem / 8, left = rem - px * 8;
            if (j < px) Lx = R * G + x * px + j; else if (j == px && x < left) Lx = R * G + px * 8 + x; else return false; }
        else return false;
    } else { Lx = i * G + c; if (Lx >= U) return false; }
    return true; }
struct MoeUpOrder2 { MoeTab2 tb; int G, c; unsigned* done;
    __device__ bool next(int i, int& rt, int& j) const { int Lx; if (!moe_deal(i, tb.nrt * 8, G, c, Lx)) return false; const int ent = tb.ut_up[Lx]; rt = ent >> 4; j = ent & 15; return true; } };
struct MoeDownQueue2 { MoeTab2 tb; int G, c; unsigned* qhead; unsigned* done; LAS int* slot; unsigned need;
    __device__ bool next(int, int& rt, int& j) const {
        __syncthreads();
        if (threadIdx.x == 0) {
            const int U = tb.nrt * 16, per = (G % 8 == 0) ? G / 8 : G, nq = (G % 8 == 0) ? 8 : 1, x0 = (G % 8 == 0) ? c % 8 : 0;
            int xo = slot[1], ent = -1;
            for (; xo < nq; ++xo) { const int x = (x0 + xo) % nq;
                const int q = (int)__hip_atomic_fetch_add(qhead + 16 * x, 1u, __ATOMIC_RELAXED, __HIP_MEMORY_SCOPE_AGENT);
                const int Lq = (q / per) * G + x * per + (q % per);
                if (Lq < U) { ent = tb.ut_dn[Lq]; break; } }
            slot[1] = xo;
            if (ent >= 0) { const int r = ent >> 4; unsigned sp = 0;
                while (__hip_atomic_load(done + r, __ATOMIC_RELAXED, __HIP_MEMORY_SCOPE_AGENT) < need) { __builtin_amdgcn_s_sleep(2); if (++sp > (1u << 21)) break; }
                __builtin_amdgcn_fence(__ATOMIC_ACQUIRE, "agent"); asm volatile("s_waitcnt vmcnt(0)" ::: "memory"); }
            slot[0] = ent; }
        __syncthreads();
        const int ent = slot[0]; if (ent < 0) return false;
        rt = ent >> 4; j = ent & 15; return true; } };
struct EpiUp2 { bf16_t* HID;
    __device__ __forceinline__ void operator()(const f32x4 (&acc)[3][4][2], int row0, int nb, int e, int r0, int ne, int j, int wr, int wc, int fr, int fq) const {
        bf16_t* hp = HID + (size_t)(row0 + wr * 64 + fr) * EH + 64 * j + 16 * wc + 4 * fq;
#pragma unroll
        for (int blk = 0; blk < 3; ++blk) if (blk < nb) {
#pragma unroll
            for (int m = 0; m < 4; ++m) { const f32x4 g = acc[blk][m][0], u = acc[blk][m][1];
                u32x2 w; w.x = cvt_pk_bf16(silu_fast(g[0]) * u[0], silu_fast(g[1]) * u[1]); w.y = cvt_pk_bf16(silu_fast(g[2]) * u[2], silu_fast(g[3]) * u[3]);
                *(u32x2*)(hp + (size_t)(blk * 128 + m * 16) * EH) = w; } }
    } };
struct EpiDown2 { const int* tok; const float* wsl; bf16_t* Y;
    __device__ __forceinline__ void operator()(const f32x4 (&acc)[3][4][2], int row0, int nb, int e, int r0, int ne, int j, int wr, int wc, int fr, int fq) const {
        const int col0 = 128 * j + 32 * wc + 8 * fq;
#pragma unroll
        for (int blk = 0; blk < 3; ++blk) if (blk < nb) {
            int dst[4]; float w[4];
#pragma unroll
            for (int m = 0; m < 4; ++m) { const int pos = r0 + blk * 128 + wr * 64 + m * 16 + fr; const int pc = pos < ne ? pos : ne - 1; dst[m] = tok[e * 8192 + pc]; w[m] = wsl[e * 8192 + pc]; }
#pragma unroll
            for (int m = 0; m < 4; ++m) { const int pos = r0 + blk * 128 + wr * 64 + m * 16 + fr;
                if (pos < ne) { const f32x4 v0 = acc[blk][m][0] * w[m], v1 = acc[blk][m][1] * w[m];
                    u32x4 o; o.x = cvt_pk_bf16(v0[0], v0[1]); o.y = cvt_pk_bf16(v0[2], v0[3]); o.z = cvt_pk_bf16(v1[0], v1[1]); o.w = cvt_pk_bf16(v1[2], v1[3]);
                    *(u32x4*)(Y + (size_t)dst[m] * D + col0) = o; } } }
    } };


__device__ __forceinline__ int invperm32(int a) { return a < 16 ? 8 * (a >> 2) + (a & 3) : 8 * ((a - 16) >> 2) + 4 + (a & 3); }
__device__ __forceinline__ bf16x8 pack_bf16x8(const f32x4& a, const f32x4& b) { u32x4 w; w.x = cvt_pk_bf16(a[0], a[1]); w.y = cvt_pk_bf16(a[2], a[3]); w.z = cvt_pk_bf16(b[0], b[1]); w.w = cvt_pk_bf16(b[2], b[3]); return __builtin_bit_cast(bf16x8, w); }
__device__ __forceinline__ void gdn_chunk_local(const Ctx& c, const Params& p, int L, int unit) {
    const int h = unit >> 7, n = unit & 127, t0 = n * 64, tid = c.tid, lane = c.lane;
    const bf16_t* U = (const bf16_t*)(p.ws + WS_U);
    LAS unsigned char* lds = c.lds;
    LAS float* vf = (LAS float*)lds;
    LAS bf16_t* qb = (LAS bf16_t*)(lds + 33280);
    LAS bf16_t* kb = (LAS bf16_t*)(lds + 50688);
    LAS float* Am = (LAS float*)(lds + 68096);
    LAS unsigned char* img = lds + 85504;
    LAS float* gcs = (LAS float*)(lds + 126464);
    const float* cw = p.conv_a_w + (size_t)L * 4 * 2304;
    LAS float* cwl = (LAS float*)(lds + LDS_OSTG);
    for (int i = tid; i < 3 * 4 * 32; i += NTHREADS) { const int c4 = i & 31, j = (i >> 5) & 3, sec = i >> 7;
        const float4 wv4 = *(const float4*)(cw + j * 2304 + sec * 768 + h * 128 + 4 * c4); LAS float* d = cwl + (sec * 4 + j) * 128 + 4 * c4; d[0] = wv4.x; d[1] = wv4.y; d[2] = wv4.z; d[3] = wv4.w; }
    if (tid < 64) {
        float g = ((const float*)(p.ws + WS_GLOG))[(t0 + tid) * 8 + h];
#pragma unroll
        for (int o = 1; o < 64; o <<= 1) { const float v = __int_as_float(__builtin_amdgcn_ds_bpermute(((lane - o) & 63) << 2, __float_as_int(g))); if (lane >= o) g += v; }
        gcs[tid] = g; gcs[64 + tid] = ((const float*)(p.ws + WS_BETA))[(t0 + tid) * 8 + h];
    }
    __syncthreads();
    {
        const int tok = tid >> 3, cg = tid & 7, t = t0 + tok;
        const float eg = __expf(gcs[tok]);
#pragma unroll
        for (int sec = 0; sec < 3; ++sec) {
            const int col = sec * 768 + h * 128 + 16 * cg;
            float a[16];
#pragma unroll
            for (int i = 0; i < 16; ++i) a[i] = 0.f;
            u32x4 xa[4], xb[4];
#pragma unroll
            for (int j = 0; j < 4; ++j) { const int tt = t - 3 + j, tc = tt < 0 ? 0 : tt;
                xa[j] = *(const u32x4*)(U + (size_t)tc * NU + UC_QKV + col); xb[j] = *(const u32x4*)(U + (size_t)tc * NU + UC_QKV + col + 8); }
#pragma unroll
            for (int j = 0; j < 4; ++j) { const float mk = (t - 3 + j) < 0 ? 0.f : 1.f; const u32x4 x0 = xa[j], x1 = xb[j];
                const LAS f32x4* wl = (const LAS f32x4*)(cwl + (sec * 4 + j) * 128 + 16 * cg); const f32x4 w0 = wl[0], w1 = wl[1], w2 = wl[2], w3 = wl[3];
                a[0] += mk * w0[0] * bflo(x0.x); a[1] += mk * w0[1] * bfhi(x0.x); a[2] += mk * w0[2] * bflo(x0.y); a[3] += mk * w0[3] * bfhi(x0.y);
                a[4] += mk * w1[0] * bflo(x0.z); a[5] += mk * w1[1] * bfhi(x0.z); a[6] += mk * w1[2] * bflo(x0.w); a[7] += mk * w1[3] * bfhi(x0.w);
                a[8] += mk * w2[0] * bflo(x1.x); a[9] += mk * w2[1] * bfhi(x1.x); a[10] += mk * w2[2] * bflo(x1.y); a[11] += mk * w2[3] * bfhi(x1.y);
                a[12] += mk * w3[0] * bflo(x1.z); a[13] += mk * w3[1] * bfhi(x1.z); a[14] += mk * w3[2] * bflo(x1.w); a[15] += mk * w3[3] * bfhi(x1.w); }
#pragma unroll
            for (int i = 0; i < 16; ++i) a[i] = siluf_(a[i]);
            if (sec < 2) {
                float sq = 0.f;
#pragma unroll
                for (int i = 0; i < 16; ++i) sq += a[i] * a[i];
                sq += shx(sq, 1, lane); sq += shx(sq, 2, lane); sq += shx(sq, 4, lane);
                const float rn = rsqrtf(sq + 1e-6f) * (sec == 0 ? 0.08838834764831845f : 1.0f);
#pragma unroll
                for (int i = 0; i < 16; ++i) a[i] *= rn;
                LAS bf16_t* dstb = (sec == 0 ? qb : kb) + tok * 136 + 16 * cg;
                u32x4 w;
                w.x = cvt_pk_bf16(a[0], a[1]); w.y = cvt_pk_bf16(a[2], a[3]); w.z = cvt_pk_bf16(a[4], a[5]); w.w = cvt_pk_bf16(a[6], a[7]); *(LAS u32x4*)dstb = w;
                w.x = cvt_pk_bf16(a[8], a[9]); w.y = cvt_pk_bf16(a[10], a[11]); w.z = cvt_pk_bf16(a[12], a[13]); w.w = cvt_pk_bf16(a[14], a[15]); *(LAS u32x4*)(dstb + 8) = w;
                if (sec == 0) {
#pragma unroll
                    for (int g4 = 0; g4 < 4; ++g4) { const int a0 = 16 * cg + 4 * g4, sl = a0 >> 5, pp = invperm32(a0 & 31), chunk = 4 * sl + (pp >> 3), within = pp & 7;
                        u32x2 o; o.x = cvt_pk_bf16(a[4 * g4] * eg, a[4 * g4 + 1] * eg); o.y = cvt_pk_bf16(a[4 * g4 + 2] * eg, a[4 * g4 + 3] * eg);
                        *(LAS u32x2*)(img + tok * 256 + ((chunk ^ (tok & 15)) << 4) + within * 2) = o; }
                }
            } else {
#pragma unroll
                for (int i = 0; i < 16; ++i) vf[tok * 129 + 16 * cg + i] = a[i];
            }
        }
    }
    __syncthreads();
    {
        const float gl = gcs[63];
#pragma unroll
        for (int it = 0; it < 2; ++it) { const int pc = tid + 512 * it, r = pc & 127, ch = pc >> 7, sp = ch >> 2, q = ch & 3; float v[8];
#pragma unroll
            for (int i = 0; i < 8; ++i) { const int cc = 32 * sp + (i < 4 ? 4 * q + i : 16 + 4 * q + (i - 4)); v[i] = bf2f(kb[cc * 136 + r]) * __expf(gl - gcs[cc]); }
            u32x4 w; w.x = cvt_pk_bf16(v[0], v[1]); w.y = cvt_pk_bf16(v[2], v[3]); w.z = cvt_pk_bf16(v[4], v[5]); w.w = cvt_pk_bf16(v[6], v[7]);
            *(LAS u32x4*)(img + 16384 + r * 128 + ((ch ^ ((r >> 1) & 7)) << 4)) = w; }
    }
    {
        const int m = lane & 15, q = lane >> 4;
        for (int i4 = 0; i4 < 4; ++i4) {
            const int id = c.wave * 4 + i4, which = id >> 4, tile = id & 15, mt = tile >> 2, ntl = tile & 3;
            f32x4 acc = (f32x4){0.f, 0.f, 0.f, 0.f};
            if (ntl <= mt) {
                const LAS bf16_t* Ab = which ? qb : kb;
#pragma unroll
                for (int s = 0; s < 4; ++s) { const bf16x8 av = *(const LAS bf16x8*)(Ab + (16 * mt + m) * 136 + 32 * s + 8 * q), bv = *(const LAS bf16x8*)(kb + (16 * ntl + m) * 136 + 32 * s + 8 * q);
                    acc = __builtin_amdgcn_mfma_f32_16x16x32_bf16(av, bv, acc, 0, 0, 0); }
            }
            const int j_ = 16 * ntl + m;
#pragma unroll
            for (int jj = 0; jj < 4; ++jj) { const int i_ = 16 * mt + 4 * q + jj;
                const float dec = (i_ >= j_) ? __expf(gcs[i_] - gcs[j_]) : 0.f;
                if (which == 0) { if (ntl <= mt) Am[j_ * 68 + i_] = (i_ > j_) ? gcs[64 + i_] * acc[jj] * dec : 0.f; }
                else { const int sp = j_ >> 5, pp = invperm32(j_ & 31), chunk = 4 * sp + (pp >> 3), within = pp & 7;
                    *(LAS bf16_t*)(img + 32768 + i_ * 128 + ((chunk ^ ((i_ >> 1) & 7)) << 4) + within * 2) = f2bf((i_ >= j_) ? acc[jj] * dec : 0.f); } }
        }
    }
    __syncthreads();
    float x[64];
    if (tid < 256) {
        if (tid < 128) {
#pragma unroll
            for (int r = 0; r < 64; ++r) x[r] = vf[r * 129 + tid] * gcs[64 + r];
        } else {
#pragma unroll
            for (int r = 0; r < 64; ++r) x[r] = bf2f(kb[r * 136 + (tid - 128)]) * gcs[64 + r] * __expf(gcs[r]);
        }
    }
    __syncthreads();
    if (tid < 256) {
        int zoff = 0; asm volatile("" : "+v"(zoff));
        const LAS float* Amz = Am + zoff;
#pragma unroll
        for (int j = 0; j < 63; ++j) {
            const float xj = x[j];
#pragma unroll
            for (int ib = (j + 1) / 4; ib < 16; ++ib) { const f32x4 a4 = *(const LAS f32x4*)(Amz + j * 68 + 4 * ib);
                if (4 * ib + 0 > j) x[4 * ib + 0] -= a4[0] * xj;
                if (4 * ib + 1 > j) x[4 * ib + 1] -= a4[1] * xj;
                if (4 * ib + 2 > j) x[4 * ib + 2] -= a4[2] * xj;
                if (4 * ib + 3 > j) x[4 * ib + 3] -= a4[3] * xj; }
        }
        if (tid < 128) {
            float* ucp = (float*)(p.ws + WS_UCP) + (size_t)unit * 8192 + (size_t)(tid >> 4) * 1024 + (tid & 15) * 4;
#pragma unroll
            for (int mt = 0; mt < 4; ++mt)
#pragma unroll
                for (int q = 0; q < 4; ++q) *(f32x4*)(ucp + mt * 256 + q * 64) = (f32x4){x[16 * mt + 4 * q], x[16 * mt + 4 * q + 1], x[16 * mt + 4 * q + 2], x[16 * mt + 4 * q + 3]};
        } else {
            const int kc = tid - 128, s = kc >> 5, pp = invperm32(kc & 31), chunk = 4 * s + (pp >> 3), within = pp & 7;
#pragma unroll
            for (int r = 0; r < 64; ++r) *(LAS bf16_t*)(lds + r * 256 + ((chunk ^ (r & 15)) << 4) + within * 2) = f2bf(-x[r]);
        }
    }
    __syncthreads();
    {
        unsigned char* dst = p.ws + WS_GBLK + (size_t)unit * GB_BYTES;
#pragma unroll
        for (int it = 0; it < 7; ++it) { const int pc = tid + 512 * it; const LAS unsigned char* src = pc < 1024 ? lds + pc * 16 : img + (pc - 1024) * 16;
            *(u32x4*)(dst + pc * 16) = *(const LAS u32x4*)src; }
        if (tid == 0) ((float*)(p.ws + WS_GL))[unit] = __expf(gcs[63]);
    }
    __syncthreads();
}


__device__ __forceinline__ void gdn_scan(const Ctx& c, const Params& p, int sidx) {
    const int h = sidx >> 1, half = sidx & 1;
    const unsigned char* blk = p.ws + WS_GBLK + (size_t)h * 128 * GB_BYTES;
    bf16_t* OG = (bf16_t*)(p.ws + WS_OGDN);
    LAS unsigned char* lds = c.lds;
    LAS unsigned char* ost = c.lds + LDS_OSTG;
    if (c.wave >= 4) {
        const int par = (c.wave - 4) >> 1, st = c.tid - 256 - 128 * par;
        const unsigned char* src = blk + (size_t)st * 16;
        u32x4 sr[28];
        if (par == 0) {
#pragma unroll
            for (int i = 0; i < 28; ++i) sr[i] = *(const u32x4*)(src + i * 2048);
#pragma unroll
            for (int i = 0; i < 28; ++i) *(LAS u32x4*)(lds + st * 16 + i * 2048) = sr[i];
#pragma unroll
            for (int i = 0; i < 28; ++i) sr[i] = *(const u32x4*)(src + 2 * (size_t)GB_BYTES + i * 2048);
        } else {
#pragma unroll
            for (int i = 0; i < 28; ++i) sr[i] = *(const u32x4*)(src + (size_t)GB_BYTES + i * 2048);
        }
        __syncthreads();
        for (int n = 0; n < 128; ++n) {
            if (((n + 1) & 1) == par) {
                if (n + 1 < 128) {
#pragma unroll
                    for (int i = 0; i < 28; ++i) *(LAS u32x4*)(lds + ((n + 1) & 1) * GB_BYTES + st * 16 + i * 2048) = sr[i];
                }
                if (n + 3 < 128) {
#pragma unroll
                    for (int i = 0; i < 28; ++i) sr[i] = *(const u32x4*)(src + (size_t)(n + 3) * GB_BYTES + i * 2048);
                }
            } else if (n > 0) {
#pragma unroll
                for (int i = 0; i < 4; ++i) { const int pc = st + 128 * i, r = pc >> 3, ch = pc & 7;
                    *(u32x4*)(OG + (size_t)((n - 1) * 64 + r) * 768 + h * 128 + 64 * half + 8 * ch) = *(const LAS u32x4*)(ost + ((n - 1) & 1) * 8192 + r * 128 + ch * 16); }
            }
            WG_BAR_LDS();
        }
        if (par == 0) {
#pragma unroll
            for (int i = 0; i < 4; ++i) { const int pc = st + 128 * i, r = pc >> 3, ch = pc & 7;
                *(u32x4*)(OG + (size_t)(127 * 64 + r) * 768 + h * 128 + 64 * half + 8 * ch) = *(const LAS u32x4*)(ost + 8192 + r * 128 + ch * 16); }
        }
        return;
    }
    const int wg = 4 * half + c.wave;
    const float* UCp = (const float*)(p.ws + WS_UCP) + (size_t)h * 128 * 8192 + (size_t)wg * 1024 + c.lane * 4;
    const float* GL = (const float*)(p.ws + WS_GL) + h * 128;
    const int lane = c.lane, m = lane & 15, q = lane >> 4;
    int o128[4], o64[2];
#pragma unroll
    for (int s = 0; s < 4; ++s) o128[s] = m * 256 + (((4 * s + q) ^ m) << 4);
#pragma unroll
    for (int s = 0; s < 2; ++s) o64[s] = m * 128 + (((4 * s + q) ^ (m >> 1)) << 4);
    f32x4 S[8];
#pragma unroll
    for (int i = 0; i < 8; ++i) S[i] = (f32x4){0.f, 0.f, 0.f, 0.f};
    f32x4 ucA[4], ucB[4]; float glA, glB;
#pragma unroll
    for (int mt = 0; mt < 4; ++mt) { ucA[mt] = *(const f32x4*)(UCp + mt * 256); ucB[mt] = *(const f32x4*)(UCp + 8192 + mt * 256); }
    glA = GL[0]; glB = GL[1];
    __syncthreads();
#define SCAN_LD(pp) (*(const LAS bf16x8*)(pp))
#define SCAN_STEP(NN, BUF, UC, GLV) do { \
        const LAS unsigned char* B = lds + (BUF) * GB_BYTES; \
        bf16x8 Sb[4]; \
        _Pragma("unroll") for (int s = 0; s < 4; ++s) Sb[s] = pack_bf16x8(S[2 * s], S[2 * s + 1]); \
        bf16x8 Aw[16], Aq[16]; \
        _Pragma("unroll") for (int mt = 0; mt < 4; ++mt) _Pragma("unroll") for (int s = 0; s < 4; ++s) Aw[mt * 4 + s] = SCAN_LD(B + GB_WC + mt * 4096 + o128[s]); \
        _Pragma("unroll") for (int mt = 0; mt < 4; ++mt) _Pragma("unroll") for (int s = 0; s < 4; ++s) Aq[mt * 4 + s] = SCAN_LD(B + GB_QD + mt * 4096 + o128[s]); \
        f32x4 vn[4]; \
        _Pragma("unroll") for (int mt = 0; mt < 4; ++mt) vn[mt] = UC[mt]; \
        _Pragma("unroll") for (int s = 0; s < 4; ++s) _Pragma("unroll") for (int mt = 0; mt < 4; ++mt) vn[mt] = __builtin_amdgcn_mfma_f32_16x16x32_bf16(Aw[mt * 4 + s], Sb[s], vn[mt], 0, 0, 0); \
        bf16x8 Ak[16]; \
        _Pragma("unroll") for (int i = 0; i < 8; ++i) _Pragma("unroll") for (int s = 0; s < 2; ++s) Ak[i * 2 + s] = SCAN_LD(B + GB_KDT + i * 2048 + o64[s]); \
        f32x4 Oa[4]; \
        _Pragma("unroll") for (int mt = 0; mt < 4; ++mt) Oa[mt] = (f32x4){0.f, 0.f, 0.f, 0.f}; \
        _Pragma("unroll") for (int s = 0; s < 4; ++s) _Pragma("unroll") for (int mt = 0; mt < 4; ++mt) Oa[mt] = __builtin_amdgcn_mfma_f32_16x16x32_bf16(Aq[mt * 4 + s], Sb[s], Oa[mt], 0, 0, 0); \
        bf16x8 Vb[2]; Vb[0] = pack_bf16x8(vn[0], vn[1]); Vb[1] = pack_bf16x8(vn[2], vn[3]); \
        bf16x8 Ap[8]; \
        _Pragma("unroll") for (int mt = 0; mt < 4; ++mt) _Pragma("unroll") for (int s = 0; s < 2; ++s) Ap[mt * 2 + s] = SCAN_LD(B + GB_QK + mt * 2048 + o64[s]); \
        _Pragma("unroll") for (int i = 0; i < 8; ++i) S[i] = S[i] * (GLV); \
        _Pragma("unroll") for (int s = 0; s < 2; ++s) _Pragma("unroll") for (int i = 0; i < 8; ++i) S[i] = __builtin_amdgcn_mfma_f32_16x16x32_bf16(Ak[i * 2 + s], Vb[s], S[i], 0, 0, 0); \
        _Pragma("unroll") for (int s = 0; s < 2; ++s) _Pragma("unroll") for (int mt = 0; mt < 4; ++mt) Oa[mt] = __builtin_amdgcn_mfma_f32_16x16x32_bf16(Ap[mt * 2 + s], Vb[s], Oa[mt], 0, 0, 0); \
        _Pragma("unroll") for (int mt = 0; mt < 4; ++mt) _Pragma("unroll") for (int jj = 0; jj < 4; ++jj) \
            *(LAS bf16_t*)(ost + (BUF) * 8192 + (16 * mt + 4 * q + jj) * 128 + (16 * c.wave + m) * 2) = f2bf(Oa[mt][jj]); \
    } while (0)
    for (int n = 0; n < 128; n += 2) {
        SCAN_STEP(n, 0, ucA, glA);
        if (n + 2 < 128) {
#pragma unroll
            for (int mt = 0; mt < 4; ++mt) ucA[mt] = *(const f32x4*)(UCp + (size_t)(n + 2) * 8192 + mt * 256);
            glA = GL[n + 2]; }
        WG_BAR_LDS();
        SCAN_STEP(n + 1, 1, ucB, glB);
        if (n + 3 < 128) {
#pragma unroll
            for (int mt = 0; mt < 4; ++mt) ucB[mt] = *(const f32x4*)(UCp + (size_t)(n + 3) * 8192 + mt * 256);
            glB = GL[n + 3]; }
        WG_BAR_LDS();
    }
#undef SCAN_STEP
#undef SCAN_LD
}


template <class Epi, bool UP, class Order>
__device__ __forceinline__ void moe_gemm(const Ctx& c, const bf16_t* A, const float* Wl, const Order& S, const Epi& E) {
    constexpr int K = UP ? D : EH, NW = UP ? 1024 : D, NSTEP = K / 64, STG = 49152;
    int tid = threadIdx.x; asm volatile("" : "+v"(tid));
    const int wid = __builtin_amdgcn_readfirstlane(tid >> 6), lane = tid & 63, wr = wid >> 2, wc = wid & 3, fr = lane & 15, fq = lane >> 4;
    LAS unsigned char* lds = c.lds;
    const int par = wid & 1, tp = lane + 64 * (wid >> 1);
    const int bk = tp >> 6, bc4 = tp & 63;
    const int ar = tp >> 3, ach = tp & 7;
    const unsigned a_rd0 = (unsigned)((64 * wr + fr) * 128 + (((0 + fq) ^ ((fr >> 1) & 7)) << 4)), a_rd1 = (unsigned)((64 * wr + fr) * 128 + (((4 + fq) ^ ((fr >> 1) & 7)) << 4));
    const unsigned q4 = (lane & 15) >> 2, p4 = lane & 3, qb = fq & 1;
    const unsigned b_base = 16384u + (8u * fq + q4) * 512u + 64u * ((unsigned)wc ^ q4) + 16u * p4;
    const unsigned b00 = b_base + 8u * qb, b01 = b_base + 8u * (1u - qb), b10 = b00 + 4u * 512u, b11 = b01 + 4u * 512u;
    pg8::Unit u;
    for (int ui = 0; S.next(ui, u); ++ui) {
        const int e = S.tb.mt_e[u.pm], j = u.pn - e * S.nN;
        const float* Wb = Wl + (size_t)e * K * NW + (UP ? ((bc4 < 32) ? 128 * j + 4 * bc4 : 512 + 128 * j + 4 * (bc4 - 32)) : 256 * j + 4 * bc4) + (size_t)bk * NW;
        const bf16_t* Ap[4];
#pragma unroll
        for (int i = 0; i < 4; ++i) { const int row = ar + 32 * i; Ap[i] = (UP ? A + (size_t)S.arow(u, row) * K : A + (size_t)(u.pm * 128 + row) * K) + 8 * (ach ^ ((row >> 1) & 7)); }
        f32x4 acc[2][4][2];
#pragma unroll
        for (int b = 0; b < 2; ++b)
#pragma unroll
            for (int m = 0; m < 4; ++m)
#pragma unroll
                for (int n = 0; n < 2; ++n) acc[b][m][n] = (f32x4){0.f, 0.f, 0.f, 0.f};
        f32x4 wv[16]; u32x4 av[4];
#define MOE_LOAD(T) do { _Pragma("unroll") for (int i = 0; i < 16; ++i) wv[i] = *(const f32x4*)(Wb + (size_t)((T) * 64 + 4 * i) * NW); \
        _Pragma("unroll") for (int i = 0; i < 4; ++i) av[i] = *(const u32x4*)(Ap[i] + (T) * 64); } while (0)
#define MOE_WRITE(T) do { LAS unsigned char* sb = lds + ((T) & 1) * STG; \
        _Pragma("unroll") for (int i = 0; i < 4; ++i) *(LAS u32x4*)(sb + (ar + 32 * i) * 128 + ach * 16) = av[i]; \
        _Pragma("unroll") for (int i = 0; i < 16; ++i) { const int kk = bk + 4 * i; u32x2 w2; w2.x = cvt_pk_bf16(wv[i][0], wv[i][1]); w2.y = cvt_pk_bf16(wv[i][2], wv[i][3]); \
            *(LAS u32x2*)(sb + 16384 + kk * 512 + ((8 * bc4) ^ ((((kk >> 3) & 1) << 3) | ((kk & 3) << 6)))) = w2; } } while (0)
        if (par == 0) { MOE_LOAD(0); MOE_WRITE(0); if (2 < NSTEP) MOE_LOAD(2); }
        else { if (1 < NSTEP) MOE_LOAD(1); }
        for (int t = 0; t < NSTEP; ++t) {
            __syncthreads();
            if (((t + 1) & 1) == par) { if (t + 1 < NSTEP) MOE_WRITE(t + 1); if (t + 3 < NSTEP) MOE_LOAD(t + 3); }
            const unsigned so = (unsigned)(t & 1) * STG;
#pragma unroll
            for (int s2 = 0; s2 < 2; ++s2) {
                bf16x8 Bf[2][2];
#pragma unroll
                for (int bj = 0; bj < 2; ++bj) { Bf[bj][0] = tr_pair(lds + so + b00 + 256 * bj + 16384 * s2, lds + so + b10 + 256 * bj + 16384 * s2);
                                                 Bf[bj][1] = tr_pair(lds + so + b01 + 256 * bj + 16384 * s2, lds + so + b11 + 256 * bj + 16384 * s2); }
                bf16x8 Af[4];
#pragma unroll
                for (int m = 0; m < 4; ++m) Af[m] = *(const LAS bf16x8*)(lds + so + (s2 ? a_rd1 : a_rd0) + m * 2048);
#pragma unroll
                for (int bj = 0; bj < 2; ++bj)
#pragma unroll
                    for (int m = 0; m < 4; ++m)
#pragma unroll
                        for (int n = 0; n < 2; ++n) acc[bj][m][n] = __builtin_amdgcn_mfma_f32_16x16x32_bf16(Bf[bj][n], Af[m], acc[bj][m][n], 0, 0, 0);
            }
        }
#undef MOE_LOAD
#undef MOE_WRITE
        E(acc, u, wr, wc, fr, fq);
        if constexpr (UP) asm volatile("s_waitcnt vmcnt(0)" ::: "memory");
        __syncthreads();
        if constexpr (UP) { if (tid == 0) { __builtin_amdgcn_fence(__ATOMIC_RELEASE, "agent"); asm volatile("s_waitcnt vmcnt(0)" ::: "memory");
            (void)__hip_atomic_fetch_add(S.done + u.pm, 1u, __ATOMIC_RELAXED, __HIP_MEMORY_SCOPE_AGENT); } }
    }
}

__device__ __forceinline__ void m2_rd_b(bf16x8& b0, bf16x8& b1, unsigned a0, unsigned a1) {
    s16x4 x0, x1, x2, x3;
    asm volatile("ds_read_b64_tr_b16 %0, %4\n\tds_read_b64_tr_b16 %1, %4 offset:1024\n\tds_read_b64_tr_b16 %2, %5\n\tds_read_b64_tr_b16 %3, %5 offset:1024\n\ts_waitcnt lgkmcnt(0)"
                 : "=&v"(x0), "=&v"(x1), "=&v"(x2), "=&v"(x3) : "v"(a0), "v"(a1) : "memory");
    b0 = __builtin_shufflevector(x0, x1, 0, 1, 2, 3, 4, 5, 6, 7); b1 = __builtin_shufflevector(x2, x3, 0, 1, 2, 3, 4, 5, 6, 7); }
__device__ __forceinline__ void m2_rd_a4(bf16x8 (&a)[4], unsigned addr) {
    asm volatile("ds_read_b128 %0, %4\n\tds_read_b128 %1, %4 offset:2048\n\tds_read_b128 %2, %4 offset:4096\n\tds_read_b128 %3, %4 offset:6144\n\ts_waitcnt lgkmcnt(0)"
                 : "=&v"(a[0]), "=&v"(a[1]), "=&v"(a[2]), "=&v"(a[3]) : "v"(addr) : "memory"); }
__device__ __forceinline__ void m2_rd_ba(bf16x8& b0, bf16x8& b1, bf16x8 (&a)[4], unsigned a0, unsigned a1, unsigned addr) {
    s16x4 x0, x1, x2, x3;
    asm volatile("ds_read_b64_tr_b16 %0, %8\n\tds_read_b64_tr_b16 %1, %8 offset:1024\n\tds_read_b64_tr_b16 %2, %9\n\tds_read_b64_tr_b16 %3, %9 offset:1024\n\t"
                 "ds_read_b128 %4, %10\n\tds_read_b128 %5, %10 offset:2048\n\tds_read_b128 %6, %10 offset:4096\n\tds_read_b128 %7, %10 offset:6144\n\ts_waitcnt lgkmcnt(0)"
                 : "=&v"(x0), "=&v"(x1), "=&v"(x2), "=&v"(x3), "=&v"(a[0]), "=&v"(a[1]), "=&v"(a[2]), "=&v"(a[3]) : "v"(a0), "v"(a1), "v"(addr) : "memory");
    b0 = __builtin_shufflevector(x0, x1, 0, 1, 2, 3, 4, 5, 6, 7); b1 = __builtin_shufflevector(x2, x3, 0, 1, 2, 3, 4, 5, 6, 7); }
template <bool UP, int MODE, class Order, class Epi>
__device__ __forceinline__ void moe_gemm2(const Ctx& c, const bf16_t* A, const float* Wl, const int* tok, const Order& S, const Epi& E) {
    constexpr int K = UP ? D : EH, NW = UP ? 1024 : D, NSTEP = K / 64;
    constexpr unsigned ASTG = 49152u, BOFF = 98304u, BSTG = 16384u;
    int tid = threadIdx.x; asm volatile("" : "+v"(tid));
    const int wid = __builtin_amdgcn_readfirstlane(tid >> 6), lane = tid & 63, wr = wid >> 2, wc = wid & 3, fr = lane & 15, fq = lane >> 4;
    LAS unsigned char* lds = c.lds; const unsigned ldsb = (unsigned)(unsigned long long)lds;
    const int par = wid & 1, gi = wid >> 1, tp = lane + 64 * gi;
    const int bk = tp >> 5, bc = tp & 31;
    const int pimg = UP ? (((bc & 15) >> 2) * 8 + (bc & 3) * 2 + (bc >> 4)) : bc;
    const unsigned bw0 = (unsigned)(bk * 256) + (unsigned)((8 * pimg) ^ ((bk & 3) << 6));
    const unsigned a_rd0 = (unsigned)((64 * wr + fr) * 128 + (((0 + fq) ^ ((fr >> 1) & 7)) << 4)), a_rd1 = (unsigned)((64 * wr + fr) * 128 + (((4 + fq) ^ ((fr >> 1) & 7)) << 4));
    const unsigned q4 = (lane & 15) >> 2, p4 = lane & 3, qb = fq & 1;
    const unsigned b_base = BOFF + (8u * fq + q4) * 256u + 64u * ((unsigned)wc ^ q4) + 16u * p4;
    const unsigned b00 = b_base + 8u * qb, b01 = b_base + 8u * (1u - qb);
    const int drow = lane >> 3; const unsigned dch = (unsigned)(((lane & 7) ^ ((4 * (gi & 1) + (lane >> 4)) & 7)) << 4);
    int rt, j;
    for (int ui = 0; S.next(ui, rt, j); ++ui) {
        const int e = S.tb.rt_e[rt], r0 = S.tb.rt_r0[rt], ne = S.tb.cnt[e], row0 = S.tb.first[e] * 128 + r0;
        const int rows = (ne - r0) < 384 ? (ne - r0) : 384, nb = (rows + 127) >> 7;
        const float* Wb = Wl + (size_t)e * K * NW + (UP ? ((bc < 16) ? 64 * j + 4 * bc : 512 + 64 * j + 4 * (bc - 16)) : 128 * j + 4 * bc) + (size_t)bk * NW;
        unsigned aoff[12];
#pragma unroll
        for (int i = 0; i < 12; ++i) { const int pos = r0 + 8 * (4 * i + gi) + drow; int ar;
            if constexpr (UP) { ar = 0; if (pos < ne) ar = tok[e * 8192 + pos] >> 1; } else ar = row0 - r0 + pos;
            aoff[i] = (unsigned)ar * (unsigned)(K * 2) + dch; }
        f32x4 acc[3][4][2];
#pragma unroll
        for (int b = 0; b < 3; ++b)
#pragma unroll
            for (int m = 0; m < 4; ++m)
#pragma unroll
                for (int n = 0; n < 2; ++n) acc[b][m][n] = (f32x4){0.f, 0.f, 0.f, 0.f};
        f32x4 wv[8];
        if constexpr (MODE & 1) { _Pragma("unroll") for (int i = 0; i < 8; ++i) wv[i] = (f32x4){1.f, 1.f, 1.f, 1.f}; }
#define M2_LOAD(T) do { if constexpr (!(MODE & 1)) { _Pragma("unroll") for (int i = 0; i < 8; ++i) wv[i] = *(const f32x4*)(Wb + (size_t)((T) * 64 + 8 * i) * NW); } } while (0)
#define M2_LOAD2(T, P) do { if constexpr (!(MODE & 1)) { wv[2 * (P)] = *(const f32x4*)(Wb + (size_t)((T) * 64 + 16 * (P)) * NW); wv[2 * (P) + 1] = *(const f32x4*)(Wb + (size_t)((T) * 64 + 16 * (P) + 8) * NW); } } while (0)
#define M2_WRITE(T) do { LAS unsigned char* sb = lds + BOFF + ((T) & 1) * BSTG; \
        _Pragma("unroll") for (int i = 0; i < 8; ++i) { u32x2 w2; w2.x = cvt_pk_bf16(wv[i][0], wv[i][1]); w2.y = cvt_pk_bf16(wv[i][2], wv[i][3]); \
            *(LAS u32x2*)(sb + (bw0 ^ (unsigned)((i & 1) << 3)) + i * 2048) = w2; } } while (0)
#define M2_DMA(T) do { LAS unsigned char* sa = lds + ((T) & 1) * ASTG + gi * 1024; const char* ga = (const char*)A + (T) * 128; \
        _Pragma("unroll") for (int i = 0; i < 12; ++i) if (8 * (4 * i + gi) < rows && !(MODE & 2)) __builtin_amdgcn_global_load_lds((const unsigned*)(ga + aoff[i]), (LAS unsigned*)(sa + i * 4096), 16, 0, 0); } while (0)
        __syncthreads();
        if (par == 0) { M2_LOAD(0); M2_WRITE(0); M2_LOAD(2); }
        else { M2_LOAD(1); M2_DMA(0); asm volatile("s_waitcnt vmcnt(0)" ::: "memory"); }
        for (int t = 0; t < NSTEP; ++t) {
            asm volatile("s_waitcnt lgkmcnt(0)" ::: "memory"); __builtin_amdgcn_s_barrier(); asm volatile("" ::: "memory");
            if (((t + 1) & 1) == par) { if (t + 1 < NSTEP) M2_WRITE(t + 1); if (t + 3 < NSTEP) M2_LOAD(t + 3); }
            else { if (t + 1 < NSTEP) M2_DMA(t + 1); }
            const unsigned sa = (unsigned)(t & 1) * ASTG, sbo = (unsigned)(t & 1) * BSTG;
#pragma unroll
            for (int s2 = 0; s2 < ((MODE & 4) ? 0 : 2); ++s2) {
                bf16x8 Bf[2], Af[4];
                m2_rd_ba(Bf[0], Bf[1], Af, ldsb + sbo + b00 + 8192 * s2, ldsb + sbo + b01 + 8192 * s2, ldsb + sa + (s2 ? a_rd1 : a_rd0));
#pragma unroll
                for (int blk = 0; blk < 3; ++blk) {
                    const int mc = (rows - blk * 128 - wr * 64 + 15) >> 4;
                    if (mc > 0) {
                        if (blk > 0) m2_rd_a4(Af, ldsb + sa + blk * 16384 + (s2 ? a_rd1 : a_rd0));
#pragma unroll
                        for (int m = 0; m < 4; ++m) if (m < mc) {
#pragma unroll
                            for (int n = 0; n < 2; ++n) acc[blk][m][n] = __builtin_amdgcn_mfma_f32_16x16x32_bf16(Bf[n], Af[m], acc[blk][m][n], 0, 0, 0); }
                    }
                }
            }
            if (((t + 1) & 1) != par) asm volatile("s_waitcnt vmcnt(0)" ::: "memory");
        }
#undef M2_LOAD
#undef M2_LOAD2
#undef M2_WRITE
#undef M2_DMA
        E(acc, row0, nb, e, r0, ne, j, wr, wc, fr, fq);
        if constexpr (UP) { asm volatile("s_waitcnt vmcnt(0)" ::: "memory");
            __syncthreads();
            if (tid == 0) { __builtin_amdgcn_fence(__ATOMIC_RELEASE, "agent"); asm volatile("s_waitcnt vmcnt(0)" ::: "memory");
                (void)__hip_atomic_fetch_add(S.done + rt, 1u, __ATOMIC_RELAXED, __HIP_MEMORY_SCOPE_AGENT); } }
    }
}

__device__ __forceinline__ void phase_local(const Ctx& c, const Params& p, int L) {
    const bf16_t* U = (const bf16_t*)(p.ws + WS_U);
    const int gw = c.bid * 8 + c.wave, GW = c.G * 8, lane = c.lane;
    for (int rep = 0; rep < 1 + (p.pad == 1); ++rep)
    for (int unit = c.bid; unit < 768; unit += c.G) gdn_chunk_local(c, p, L, unit);
    for (int rep = 0; rep < 1 + (p.pad == 2); ++rep) {
        bf16_t* YB = (bf16_t*)(p.ws + WS_YBR) + (size_t)1 * T * 768;
        const float* cbw = p.conv_b_w + (size_t)L * 31 * 768; const float* cbb = p.conv_b_b + L * 768; const float* lg = p.ln_b_g + L * 768; const float* lb = p.ln_b_b + L * 768;
        LAS unsigned char* glu = c.lds;
        LAS unsigned char* cbs = c.lds + 70656;
        for (int tile = c.bid; tile < T / 16; tile += c.G) {
            const int t0 = tile * 16;
            for (int it = c.tid; it < 46 * 96; it += NTHREADS) { const int rr = it / 96, c8 = it - rr * 96, tt = t0 - 30 + rr; u32x4 w = (u32x4){0u, 0u, 0u, 0u};
                if (tt >= 0) { const u32x4 ga = *(const u32x4*)(U + (size_t)tt * NU + UC_B + 8 * c8), gb = *(const u32x4*)(U + (size_t)tt * NU + UC_B + 768 + 8 * c8);
                    w.x = cvt_pk_bf16(bflo(ga.x) * sigmoidf_(bflo(gb.x)), bfhi(ga.x) * sigmoidf_(bfhi(gb.x))); w.y = cvt_pk_bf16(bflo(ga.y) * sigmoidf_(bflo(gb.y)), bfhi(ga.y) * sigmoidf_(bfhi(gb.y)));
                    w.z = cvt_pk_bf16(bflo(ga.z) * sigmoidf_(bflo(gb.z)), bfhi(ga.z) * sigmoidf_(bfhi(gb.z))); w.w = cvt_pk_bf16(bflo(ga.w) * sigmoidf_(bflo(gb.w)), bfhi(ga.w) * sigmoidf_(bfhi(gb.w))); }
                *(LAS u32x4*)(glu + rr * 1536 + c8 * 16) = w; }
            __syncthreads();
            if (c.tid < 384) {
                float w0[31], w1[31], a0[16], a1[16];
#pragma unroll
                for (int j = 0; j < 31; ++j) { const float2 wv = *(const float2*)(cbw + j * 768 + 2 * c.tid); w0[j] = wv.x; w1[j] = wv.y; }
#pragma unroll
                for (int t = 0; t < 16; ++t) { a0[t] = 0.f; a1[t] = 0.f; }
#pragma unroll
                for (int rr = 0; rr < 46; ++rr) { const unsigned g2 = *(const LAS unsigned*)(glu + rr * 1536 + c.tid * 4); const float lo = bflo(g2), hi = bfhi(g2);
#pragma unroll
                    for (int t = 0; t < 16; ++t) { const int j = rr - t; if (j >= 0 && j <= 30) { a0[t] += w0[j] * lo; a1[t] += w1[j] * hi; } } }
                const float2 bv = *(const float2*)(cbb + 2 * c.tid);
#pragma unroll
                for (int t = 0; t < 16; ++t) *(LAS f32x2*)(cbs + t * 3072 + c.tid * 8) = (f32x2){a0[t] + bv.x, a1[t] + bv.y};
            }
            __syncthreads();
            for (int i = 0; i < 2; ++i) { const int tl = c.wave * 2 + i; f32x2 v[6]; float sm = 0.f;
#pragma unroll
                for (int k = 0; k < 6; ++k) { v[k] = *(const LAS f32x2*)(cbs + tl * 3072 + (lane + 64 * k) * 8); sm += v[k].x + v[k].y; }
                const float mu = wave_sum(sm, lane) * (1.0f / 768.f); float vs = 0.f;
#pragma unroll
                for (int k = 0; k < 6; ++k) { const float d0 = v[k].x - mu, d1 = v[k].y - mu; vs += d0 * d0 + d1 * d1; }
                const float rs = rsqrtf(wave_sum(vs, lane) * (1.0f / 768.f) + 1e-5f);
#pragma unroll
                for (int k = 0; k < 6; ++k) { const int ch = 2 * (lane + 64 * k); const float2 gg = *(const float2*)(lg + ch), bb = *(const float2*)(lb + ch);
                    const float y0 = (v[k].x - mu) * rs * gg.x + bb.x, y1 = (v[k].y - mu) * rs * gg.y + bb.y;
                    *(unsigned*)(YB + (size_t)(t0 + tl) * 768 + ch) = cvt_pk_bf16(siluf_(y0), siluf_(y1)); } }
            __syncthreads();
        }
    }
    for (int rep = 0; rep < 1 + (p.pad == 3); ++rep) {
        bf16_t* QR = (bf16_t*)(p.ws + WS_QR); bf16_t* KR = (bf16_t*)(p.ws + WS_KR);
        int rtid = c.tid; asm volatile("" : "+v"(rtid));
        for (int it = c.bid * NTHREADS + rtid; it < T * 8; it += c.G * NTHREADS) {
            const int t = it >> 3, c8 = it & 7; const float ps = (float)p.pos[t]; float cs[8], sn[8];
#pragma unroll
            for (int i = 0; i < 8; ++i) {
                double rev = (double)ps * (double)ROPE_INV[8 * c8 + i] * 0.15915494309189535; rev -= floor(rev);
                const float fr = (float)rev; cs[i] = __builtin_amdgcn_cosf(fr); sn[i] = __builtin_amdgcn_sinf(fr); }
            for (int hb = 0; hb < 36; hb += 4) {
                u32x4 x1[4], x2[4];
#pragma unroll
                for (int j = 0; j < 4; ++j) { const int hv = hb + j, isk = hv >= 18, hh = hv - 18 * isk; const bf16_t* src = U + (size_t)t * NU + UC_C + isk * 2304 + hh * 128 + 8 * c8;
                    x1[j] = *(const u32x4*)src; x2[j] = *(const u32x4*)(src + 64); }
#pragma unroll
                for (int j = 0; j < 4; ++j) { const int hv = hb + j, isk = hv >= 18, hh = hv - 18 * isk; const float sc = isk ? 1.0f : 0.08838834764831845f;
                    float a[8], b[8];
                    a[0] = bflo(x1[j].x); a[1] = bfhi(x1[j].x); a[2] = bflo(x1[j].y); a[3] = bfhi(x1[j].y); a[4] = bflo(x1[j].z); a[5] = bfhi(x1[j].z); a[6] = bflo(x1[j].w); a[7] = bfhi(x1[j].w);
                    b[0] = bflo(x2[j].x); b[1] = bfhi(x2[j].x); b[2] = bflo(x2[j].y); b[3] = bfhi(x2[j].y); b[4] = bflo(x2[j].z); b[5] = bfhi(x2[j].z); b[6] = bflo(x2[j].w); b[7] = bfhi(x2[j].w);
                    float o1[8], o2[8];
#pragma unroll
                    for (int i = 0; i < 8; ++i) { o1[i] = (a[i] * cs[i] - b[i] * sn[i]) * sc; o2[i] = (b[i] * cs[i] + a[i] * sn[i]) * sc; }
                    bf16_t* dst = (isk ? KR : QR) + (size_t)t * 2304 + hh * 128 + 8 * c8;
                    u32x4 w1, w2; w1.x = cvt_pk_bf16(o1[0], o1[1]); w1.y = cvt_pk_bf16(o1[2], o1[3]); w1.z = cvt_pk_bf16(o1[4], o1[5]); w1.w = cvt_pk_bf16(o1[6], o1[7]);
                    w2.x = cvt_pk_bf16(o2[0], o2[1]); w2.y = cvt_pk_bf16(o2[2], o2[3]); w2.z = cvt_pk_bf16(o2[4], o2[5]); w2.w = cvt_pk_bf16(o2[6], o2[7]);
                    *(u32x4*)dst = w1; *(u32x4*)(dst + 64) = w2; }
            }
        }
    }
    for (int rep = 0; rep < 1 + (p.pad == 4); ++rep) {
        bf16_t* YD = (bf16_t*)(p.ws + WS_YBR) + (size_t)3 * T * 768;
        const bf16_t* PWT = (const bf16_t*)(p.ws + WS_PWT) + (size_t)L * 4 * 192 * 192;
        LAS unsigned char* pim = c.lds;
        const int m = lane & 15, q = lane >> 4;
        for (int tile = c.bid; tile < T / 32; tile += c.G) {
            const int t0 = tile * 32;
            for (int it = c.tid; it < 32 * 96; it += NTHREADS) { const int rr = it / 96, c8 = it - rr * 96, t = t0 + rr, g = c8 / 24, w = 2 << g, cnt = (t + 1) < w ? (t + 1) : w;
                float sacc[8];
#pragma unroll
                for (int i = 0; i < 8; ++i) sacc[i] = 0.f;
                const bf16_t* up = U + (size_t)t * NU + UC_D + 8 * c8; u32x4 x0 = (u32x4){0u, 0u, 0u, 0u};
#pragma unroll
                for (int d = 0; d < 16; ++d) { if (d >= cnt) break; const u32x4 xv = *(const u32x4*)(up - (size_t)d * NU); if (d == 0) x0 = xv;
                    sacc[0] += bflo(xv.x); sacc[1] += bfhi(xv.x); sacc[2] += bflo(xv.y); sacc[3] += bfhi(xv.y); sacc[4] += bflo(xv.z); sacc[5] += bfhi(xv.z); sacc[6] += bflo(xv.w); sacc[7] += bfhi(xv.w); }
                const float ic = 1.0f / (float)cnt; u32x4 o;
                o.x = cvt_pk_bf16(sacc[0] * ic - bflo(x0.x), sacc[1] * ic - bfhi(x0.x)); o.y = cvt_pk_bf16(sacc[2] * ic - bflo(x0.y), sacc[3] * ic - bfhi(x0.y));
                o.z = cvt_pk_bf16(sacc[4] * ic - bflo(x0.z), sacc[5] * ic - bfhi(x0.z)); o.w = cvt_pk_bf16(sacc[6] * ic - bflo(x0.w), sacc[7] * ic - bfhi(x0.w));
                *(LAS u32x4*)(pim + rr * 1536 + ((c8 ^ (rr & 15)) << 4)) = o; }
            __syncthreads();
            f32x4 pa0[6], pa1[6];
#pragma unroll
            for (int pr = 0; pr < 6; ++pr) { const int pair = c.wave * 6 + pr, g = pair / 12, ntl = pair - g * 12;
                f32x4 acc0 = (f32x4){0.f, 0.f, 0.f, 0.f}, acc1 = (f32x4){0.f, 0.f, 0.f, 0.f};
                const bf16_t* bp = PWT + (size_t)(g * 192 + 16 * ntl + m) * 192 + 8 * q;
#pragma unroll
                for (int s6 = 0; s6 < 6; ++s6) { const bf16x8 bv = *(const bf16x8*)(bp + 32 * s6); const int ch = g * 24 + 4 * s6 + q;
                    const bf16x8 a0v = *(const LAS bf16x8*)(pim + m * 1536 + ((ch ^ m) << 4)), a1v = *(const LAS bf16x8*)(pim + (16 + m) * 1536 + ((ch ^ m) << 4));
                    acc0 = __builtin_amdgcn_mfma_f32_16x16x32_bf16(a0v, bv, acc0, 0, 0, 0); acc1 = __builtin_amdgcn_mfma_f32_16x16x32_bf16(a1v, bv, acc1, 0, 0, 0); }
                pa0[pr] = acc0; pa1[pr] = acc1; }
#pragma unroll
            for (int pr = 0; pr < 6; ++pr) { const int pair = c.wave * 6 + pr, g = pair / 12, ntl = pair - g * 12;
                bf16_t* yp = YD + (size_t)(t0 + 4 * q) * 768 + g * 192 + 16 * ntl + m;
#pragma unroll
                for (int jj = 0; jj < 4; ++jj) { yp[(size_t)jj * 768] = f2bf(pa0[pr][jj]); yp[(size_t)(16 + jj) * 768] = f2bf(pa1[pr][jj]); } }
            __syncthreads();
        }
    }
}

__device__ __forceinline__ unsigned off_b(unsigned row, unsigned ch) { return 256u * row + 16u * (ch ^ (((row & 3) << 2) | ((row >> 2) & 3))); }
#define ATT_PV4(OFF, A, DT0) do { \
    _Pragma("unroll") for (int i4 = 0; i4 < 4; ++i4) { \
        const bf16x8 vt = tr_pair(Vs + (vb0 + 32u * (unsigned)(((DT0) + i4) ^ cm0) + (OFF)), Vs + (vb1 + 32u * (unsigned)(((DT0) + i4) ^ cm1) + (OFF))); \
        O[(DT0) + i4] = __builtin_amdgcn_mfma_f32_16x16x32_bf16(vt, Pb[A], O[(DT0) + i4], 0, 0, 0); } } while (0)
#define ATT_PV(OFF, A) do { ATT_PV4(OFF, A, 0); ATT_PV4(OFF, A, 4); } while (0)
struct AttnRegs { u32x4 kv[8], vv[8]; bf16x8 Qb[4]; };
__device__ __forceinline__ void attn_issue_k(const Ctx& c, const Params& p, int u, AttnRegs& r) {
    const int h = u % 6, rbi = (u / 6) & 63, g = u / 384;
    const int dl = g == 0 ? 1 : (g == 1 ? 4 : 16), nb = 64 / dl, rs = rbi / nb, b = rbi % nb, gh = g * 6 + h;
    const bf16_t* KR = (const bf16_t*)(p.ws + WS_KR);
#pragma unroll
    for (int it = 0; it < 8; ++it) { const int pc = c.tid + 512 * it, j = pc >> 4, ch = pc & 15, pos = 128 * (b - 1) + j;
        r.kv[it] = (u32x4){0u, 0u, 0u, 0u};
        if (pos >= 0) { const size_t t = (size_t)pos * dl + rs; r.kv[it] = *(const u32x4*)(KR + t * 2304 + gh * 128 + 8 * ch); } }
}
__device__ __forceinline__ void attn_issue_vq(const Ctx& c, const Params& p, int u, AttnRegs& r) {
    const int h = u % 6, rbi = (u / 6) & 63, g = u / 384;
    const int dl = g == 0 ? 1 : (g == 1 ? 4 : 16), nb = 64 / dl, rs = rbi / nb, b = rbi % nb, gh = g * 6 + h;
    const bf16_t* U = (const bf16_t*)(p.ws + WS_U); const bf16_t* QR = (const bf16_t*)(p.ws + WS_QR);
    const int lane = c.lane, n = lane & 15, qd = lane >> 4;
#pragma unroll
    for (int it = 0; it < 8; ++it) { const int pc = c.tid + 512 * it, j = pc >> 4, ch = pc & 15, pos = 128 * (b - 1) + j;
        r.vv[it] = (u32x4){0u, 0u, 0u, 0u};
        if (pos >= 0) { const size_t t = (size_t)pos * dl + rs; r.vv[it] = *(const u32x4*)(U + t * NU + UC_C + 4608 + gh * 128 + 8 * ch); } }
    const int iq = 16 * c.wave + n; const size_t tq = (size_t)(128 * b + iq) * dl + rs;
#pragma unroll
    for (int s = 0; s < 4; ++s) r.Qb[s] = *(const bf16x8*)(QR + tq * 2304 + gh * 128 + 32 * s + 8 * qd);
}
__device__ __forceinline__ void attn_stage(const Ctx& c, const AttnRegs& r) {
    LAS unsigned char* Ks = c.lds; LAS unsigned char* Vs = c.lds + 65536;
#pragma unroll
    for (int it = 0; it < 8; ++it) { const int pc = c.tid + 512 * it, j = pc >> 4, ch = pc & 15;
        *(LAS u32x4*)(Ks + off_b(j, ch)) = r.kv[it]; *(LAS u32x4*)(Vs + off_b((j & ~31) + invperm32(j & 31), ch)) = r.vv[it]; }
}
__device__ __forceinline__ void attn_compute(const Ctx& c, const Params& p, int u, AttnRegs& ar, int un) {
    const int h = u % 6, rbi = (u / 6) & 63, g = u / 384;
    const int dl = g == 0 ? 1 : (g == 1 ? 4 : 16), nb = 64 / dl, r = rbi / nb, b = rbi % nb;
    LAS unsigned char* Ks = c.lds; LAS unsigned char* Vs = c.lds + 65536;
    const int lane = c.lane, n = lane & 15, qd = lane >> 4;
    const int iq = 16 * c.wave + n;
    const size_t tq = (size_t)(128 * b + iq) * dl + r;
    const int f = c.wave & ~1;
    f32x4 S[10];
    {
        const unsigned mask = ((n & 3) << 2) | ((n >> 2) & 3);
        unsigned ka[4];
#pragma unroll
        for (int s = 0; s < 4; ++s) ka[s] = 256u * n + 16u * ((4 * s + qd) ^ mask) + (unsigned)f * 4096u;
#pragma unroll
        for (int jj = 0; jj < 10; ++jj) { f32x4 acc = (f32x4){0.f, 0.f, 0.f, 0.f};
#pragma unroll
            for (int s = 0; s < 4; ++s) acc = __builtin_amdgcn_mfma_f32_16x16x32_bf16(*(const LAS bf16x8*)(Ks + ka[s] + jj * 4096), ar.Qb[s], acc, 0, 0, 0);
            S[jj] = acc; }
    }
    float mx = -INFINITY;
#pragma unroll
    for (int jj = 0; jj < 10; ++jj)
#pragma unroll
        for (int e = 0; e < 4; ++e) { const int j = 16 * (f + jj) + 4 * qd + e; const bool ok = (j >= iq) && (j <= iq + 128) && (b > 0 || j >= 128);
            S[jj][e] = ok ? S[jj][e] : -INFINITY; mx = fmaxf(mx, S[jj][e]); }
    mx = fmaxf(mx, shx(mx, 16, lane)); mx = fmaxf(mx, shx(mx, 32, lane));
    float l = 0.f;
#pragma unroll
    for (int jj = 0; jj < 10; ++jj)
#pragma unroll
        for (int e = 0; e < 4; ++e) { const float pv = __expf(S[jj][e] - mx); S[jj][e] = pv; l += pv; }
    l += shx(l, 16, lane); l += shx(l, 32, lane);
    bf16x8 Pb[5];
#pragma unroll
    for (int a = 0; a < 5; ++a) Pb[a] = pack_bf16x8(S[2 * a], S[2 * a + 1]);
    if (un < 1152) attn_issue_vq(c, p, un, ar);
    f32x4 O[8];
#pragma unroll
    for (int dt = 0; dt < 8; ++dt) O[dt] = (f32x4){0.f, 0.f, 0.f, 0.f};
    {
        const unsigned q = (lane & 15) >> 2, pp = lane & 3;
        const unsigned m0 = (q << 2) | ((2 * qd + 0) & 3), m1 = (q << 2) | ((2 * qd + 1) & 3);
        const unsigned cm0 = m0 >> 1, cm1 = m1 >> 1;
        const unsigned vbase = (unsigned)(f >> 1) * 8192u + 8u * (pp & 1);
        const unsigned vb0 = vbase + 256u * (8 * qd + 0 + q) + 16u * ((pp >> 1) ^ (m0 & 1)), vb1 = vbase + 256u * (8 * qd + 4 + q) + 16u * ((pp >> 1) ^ (m1 & 1));
        ATT_PV(0, 0); ATT_PV(8192, 1); ATT_PV(16384, 2); ATT_PV(24576, 3); ATT_PV(32768, 4);
    }
    {
        const float il = 1.0f / l;
        bf16_t* op = (bf16_t*)(p.ws + WS_ATTO) + ((size_t)g * T + tq) * 768 + h * 128 + 4 * qd;
#pragma unroll
        for (int dt = 0; dt < 8; ++dt) { u32x2 w; w.x = cvt_pk_bf16(O[dt][0] * il, O[dt][1] * il); w.y = cvt_pk_bf16(O[dt][2] * il, O[dt][3] * il); *(u32x2*)(op + 16 * dt) = w; }
        if (qd == 0) ((float*)(p.ws + WS_LSE))[((size_t)g * T + tq) * 8 + h] = mx + logf(l);
    }
}

struct GateOrder {
    int Gn, j;
    __device__ bool next(int i, pg8::Unit& u) const { const int id = i * Gn + j; if (id >= 1024) return false; u.pm = id & 31; u.pn = 48 + (id >> 5); return true; }
    __device__ __forceinline__ int arow(const pg8::Unit& u, int r) const { return u.pm * 256 + r; }
};
__device__ __forceinline__ void phase_attn_gdn(const Ctx& c, const Params& p, int L) {
    const bf16_t* U = (const bf16_t*)(p.ws + WS_U);
    const int lane = c.lane;
    const int nrec = (c.G >= 24) ? 12 : 0;
    if (nrec) { if (c.bid < nrec) { gdn_scan(c, p, c.bid);
            return; } }
    else { for (int h = c.bid; h < 12; h += c.G) gdn_scan(c, p, h); }
    {
        const int Gn = c.G - nrec, j = c.bid - nrec, heavy = (Gn > 0 && Gn < 1024) ? (1024 % Gn) : 0, na = Gn - heavy;
        for (int rep = 0; rep < 1 + (p.pad == 5); ++rep) {
            int u = 1152, us = 1;
            if (na > 0) { if (j >= heavy) { u = j - heavy; us = na; } } else { u = j; us = Gn; }
            AttnRegs ar;
            if (u < 1152) { attn_issue_k(c, p, u, ar); attn_issue_vq(c, p, u, ar); }
            while (u < 1152) {
                attn_stage(c, ar);
                __syncthreads();
                const int un = u + us;
                if (un < 1152) attn_issue_k(c, p, un, ar);
                attn_compute(c, p, u, ar, un);
                __syncthreads();
                u = un;
            }
        }
    }
    for (int rep = 0; rep < 1 + (p.pad == 6); ++rep) {
        pg8::Gemm g{(const bf16_t*)(p.ws + WS_H), (const bf16_t*)(p.ws + WS_WINT) + (size_t)L * NU * D, D}; GateOrder S{c.G - nrec, c.bid - nrec};
        EpiU E{(bf16_t*)(p.ws + WS_U)}; pg8::gemm_phase<EpiU, GateOrder, false>(c.lds, g, S, E);
    }
}

__device__ __forceinline__ void phase_combine(const Ctx& c, const Params& p, int L) {
    const bf16_t* U = (const bf16_t*)(p.ws + WS_U); const bf16_t* AO = (const bf16_t*)(p.ws + WS_ATTO); const float* LSE = (const float*)(p.ws + WS_LSE);
    const bf16_t* OG = (const bf16_t*)(p.ws + WS_OGDN); bf16_t* YA = (bf16_t*)(p.ws + WS_YBR); bf16_t* YC = YA + (size_t)2 * T * 768;
    const float* gn = p.gdn_norm_g + L * 128; const int lane = c.lane;
    for (int it0 = (c.bid * 8 + c.wave) * 4; it0 < T * 6; it0 += c.G * 8 * 4) {
        float l0[4], l1[4], l2[4]; unsigned a0[4], a1[4], a2[4], z2[4]; float2 og[4]; size_t o[4];
#pragma unroll
        for (int i = 0; i < 4; ++i) { const int it = it0 + i, t = it / 6, h = it % 6; o[i] = (size_t)t * 768 + h * 128 + 2 * lane;
            l0[i] = LSE[(size_t)t * 8 + h]; l1[i] = LSE[((size_t)T + t) * 8 + h]; l2[i] = LSE[((size_t)2 * T + t) * 8 + h];
            a0[i] = *(const unsigned*)(AO + o[i]); a1[i] = *(const unsigned*)(AO + (size_t)T * 768 + o[i]); a2[i] = *(const unsigned*)(AO + (size_t)2 * T * 768 + o[i]);
            { const unsigned ow = *(const unsigned*)(OG + o[i]); og[i] = make_float2(bflo(ow), bfhi(ow)); } z2[i] = *(const unsigned*)(U + (size_t)t * NU + UC_Z + h * 128 + 2 * lane); }
#pragma unroll
        for (int i = 0; i < 4; ++i) {
            const float mx = fmaxf(l0[i], fmaxf(l1[i], l2[i])); const float e0 = __expf(l0[i] - mx), e1 = __expf(l1[i] - mx), e2 = __expf(l2[i] - mx); const float is = 1.0f / (e0 + e1 + e2);
            *(unsigned*)(YC + o[i]) = cvt_pk_bf16((e0 * bflo(a0[i]) + e1 * bflo(a1[i]) + e2 * bflo(a2[i])) * is, (e0 * bfhi(a0[i]) + e1 * bfhi(a1[i]) + e2 * bfhi(a2[i])) * is);
            const float ss = wave_sum(og[i].x * og[i].x + og[i].y * og[i].y, lane); const float r = rsqrtf(ss * (1.0f / 128.f) + 1e-6f);
            *(unsigned*)(YA + o[i]) = cvt_pk_bf16(og[i].x * r * gn[2 * lane] * siluf_(bflo(z2[i])), og[i].y * r * gn[2 * lane + 1] * siluf_(bfhi(z2[i]))); }
    }
}

__device__ __forceinline__ void phase_norm2_router(const Ctx& c, const Params& p, int L) {
    const float* XB = (const float*)(p.ws + WS_XB); bf16_t* H = (bf16_t*)(p.ws + WS_H); const float* g2 = p.norm2_g + L * D;
    const bf16_t* WH = (const bf16_t*)(p.ws + WS_WRT) + (size_t)L * 2 * 80 * 2048; const bf16_t* WL = WH + 80 * 2048;
    unsigned* cnt = (unsigned*)(p.ws + WS_CTL + CTL_CNT) + L * 64; int* TOK = (int*)(p.ws + WS_TOK); float* WTS = (float*)(p.ws + WS_WSL);
    LAS float* lgp = (LAS float*)c.lds;
    LAS float* ssp = (LAS float*)c.lds + 2 * 4 * 16 * 80;
    const int lane = c.lane, m = lane & 15, q = lane >> 4, tl = c.wave >> 2, kq = c.wave & 3;
    for (int tp = c.bid; tp < T / 32; tp += c.G) {
        const int task = tp * 2 + tl;
        const int t = task * 16 + m; const float* xr = XB + (size_t)t * D + 512 * kq + 8 * q; const float* gr = g2 + 512 * kq + 8 * q;
        float ss = 0.f;
#pragma unroll 8
        for (int s = 0; s < 16; ++s) { const float4 a = *(const float4*)(xr + 32 * s), b = *(const float4*)(xr + 32 * s + 4);
            ss += a.x * a.x + a.y * a.y + a.z * a.z + a.w * a.w + b.x * b.x + b.y * b.y + b.z * b.z + b.w * b.w; }
        ss += shx(ss, 16, lane); ss += shx(ss, 32, lane);
        if (q == 0) ssp[(tl * 4 + kq) * 16 + m] = ss;
        __syncthreads();
        ss = ssp[(tl * 4 + 0) * 16 + m] + ssp[(tl * 4 + 1) * 16 + m] + ssp[(tl * 4 + 2) * 16 + m] + ssp[(tl * 4 + 3) * 16 + m];
        const float rstd = rsqrtf(ss * (1.0f / D) + 1e-6f);
        f32x4 acc[5];
#pragma unroll
        for (int nt = 0; nt < 5; ++nt) acc[nt] = (f32x4){0.f, 0.f, 0.f, 0.f};
        float4 na = *(const float4*)(xr), nb = *(const float4*)(xr + 4), nga = *(const float4*)(gr), ngb = *(const float4*)(gr + 4);
        bf16x8 nbh[5], nbl[5];
#pragma unroll
        for (int nt = 0; nt < 5; ++nt) { const size_t wo = (size_t)(16 * nt + m) * 2048 + 512 * kq + 8 * q; nbh[nt] = *(const bf16x8*)(WH + wo); nbl[nt] = *(const bf16x8*)(WL + wo); }
        for (int s = 0; s < 16; ++s) {
            const float4 a = na, b = nb, ga = nga, gb = ngb; bf16x8 bh[5], bl[5];
#pragma unroll
            for (int nt = 0; nt < 5; ++nt) { bh[nt] = nbh[nt]; bl[nt] = nbl[nt]; }
            if (s + 1 < 16) { const int s1 = s + 1;
                na = *(const float4*)(xr + 32 * s1); nb = *(const float4*)(xr + 32 * s1 + 4); nga = *(const float4*)(gr + 32 * s1); ngb = *(const float4*)(gr + 32 * s1 + 4);
#pragma unroll
                for (int nt = 0; nt < 5; ++nt) { const size_t wo = (size_t)(16 * nt + m) * 2048 + 512 * kq + 32 * s1 + 8 * q; nbh[nt] = *(const bf16x8*)(WH + wo); nbl[nt] = *(const bf16x8*)(WL + wo); } }
            float h[8]; h[0] = a.x * rstd * ga.x; h[1] = a.y * rstd * ga.y; h[2] = a.z * rstd * ga.z; h[3] = a.w * rstd * ga.w; h[4] = b.x * rstd * gb.x; h[5] = b.y * rstd * gb.y; h[6] = b.z * rstd * gb.z; h[7] = b.w * rstd * gb.w;
            u32x4 hi; hi.x = cvt_pk_bf16(h[0], h[1]); hi.y = cvt_pk_bf16(h[2], h[3]); hi.z = cvt_pk_bf16(h[4], h[5]); hi.w = cvt_pk_bf16(h[6], h[7]);
            u32x4 lo; lo.x = cvt_pk_bf16(h[0] - bflo(hi.x), h[1] - bfhi(hi.x)); lo.y = cvt_pk_bf16(h[2] - bflo(hi.y), h[3] - bfhi(hi.y));
            lo.z = cvt_pk_bf16(h[4] - bflo(hi.z), h[5] - bfhi(hi.z)); lo.w = cvt_pk_bf16(h[6] - bflo(hi.w), h[7] - bfhi(hi.w));
            const bf16x8 ah = __builtin_bit_cast(bf16x8, hi), al = __builtin_bit_cast(bf16x8, lo);
#pragma unroll
            for (int nt = 0; nt < 5; ++nt) {
                acc[nt] = __builtin_amdgcn_mfma_f32_16x16x32_bf16(ah, bh[nt], acc[nt], 0, 0, 0);
                acc[nt] = __builtin_amdgcn_mfma_f32_16x16x32_bf16(ah, bl[nt], acc[nt], 0, 0, 0);
                acc[nt] = __builtin_amdgcn_mfma_f32_16x16x32_bf16(al, bh[nt], acc[nt], 0, 0, 0); }
            *(u32x4*)(H + (size_t)t * D + 512 * kq + 32 * s + 8 * q) = hi;
        }
        LAS float* lgw = lgp + (tl * 4 + kq) * (16 * 80);
#pragma unroll
        for (int nt = 0; nt < 5; ++nt)
#pragma unroll
            for (int jj = 0; jj < 4; ++jj) lgw[(4 * q + jj) * 80 + 16 * nt + m] = acc[nt][jj];
        __syncthreads();
        if (kq == 0) {
            for (int i = lane; i < 16 * 80; i += 64) lgw[i] = lgw[i] + lgw[i + 16 * 80] + lgw[i + 2 * 16 * 80] + lgw[i + 3 * 16 * 80];
            asm volatile("s_waitcnt lgkmcnt(0)" ::: "memory");
        }
        if (kq == 0)
        if (lane < 16) {
            const int tt = task * 16 + lane; const LAS float* l = lgw + lane * 80;
            float gl[8]; float gm = -INFINITY; int gi = 0;
#pragma unroll
            for (int j = 0; j < 8; ++j) { gl[j] = l[j] + p.rg_b[L * 8 + j]; if (gl[j] > gm) { gm = gl[j]; gi = j; } }
            float gs = 0.f;
#pragma unroll
            for (int j = 0; j < 8; ++j) gs += expf(gl[j] - gm);
            const float gp = 1.0f / gs;
            float el[8]; float em = -INFINITY; int i1 = 0;
#pragma unroll
            for (int j = 0; j < 8; ++j) { el[j] = l[8 + gi * 8 + j] + p.re_b[L * 64 + gi * 8 + j]; if (el[j] > em) { em = el[j]; i1 = j; } }
            float e2m = -INFINITY; int i2 = 0;
#pragma unroll
            for (int j = 0; j < 8; ++j) { if (j != i1 && el[j] > e2m) { e2m = el[j]; i2 = j; } }
            const float p2 = expf(e2m - em);
            const float w1 = gp / (1.0f + p2), w2 = gp * p2 / (1.0f + p2);
            const int e1 = gi * 8 + i1, e2 = gi * 8 + i2;
            const unsigned q1 = atomicAdd(&cnt[e1], 1u); TOK[e1 * 8192 + q1] = tt * 2; WTS[e1 * 8192 + q1] = w1;
            const unsigned q2 = atomicAdd(&cnt[e2], 1u); TOK[e2 * 8192 + q2] = tt * 2 + 1; WTS[e2 * 8192 + q2] = w2;
        }
        __syncthreads();
    }
}

__device__ __forceinline__ MoeTab moe_tables(const Ctx& c, const Params& p, int L, int nN) {
    LAS int* base = (LAS int*)(c.lds + LDS_MISC + 1024);
    LAS int* mt_e = base, * mt_p0 = base + 192, * cn = base + 384, * nm = base + 448, * first = base + 452, * ut = base + 520;
    const unsigned* cnt = (const unsigned*)(p.ws + WS_CTL + CTL_CNT) + L * 64;
    __syncthreads();
    if (c.tid < 64) cn[c.tid] = (int)cnt[c.tid];
    __syncthreads();
    if (c.tid == 0) { int n = 0; for (int e = 0; e < 64; ++e) { first[e] = n; const int ntile = (cn[e] + 127) >> 7; for (int i = 0; i < ntile; ++i) { mt_e[n] = e; mt_p0[n] = i * 128; ++n; } } nm[0] = n; }
    __syncthreads();
    if (c.tid < 64) { const int e = c.tid, f0 = first[e], ntile = (cn[e] + 127) >> 7; int o = f0 * nN;
        for (int j = 0; j < nN; ++j) for (int m = 0; m < ntile; ++m) ut[o++] = ((f0 + m) << 4) | j; }
    else if (c.tid < 128) { const int e = c.tid - 64, f0 = first[e], ntile = (cn[e] + 127) >> 7; int o = 768 + f0 * 8;
        for (int j = 0; j < 8; ++j) for (int m = 0; m < ntile; ++m) ut[o++] = ((f0 + m) << 4) | j; }
    __syncthreads();
    MoeTab tb; tb.mt_e = mt_e; tb.mt_p0 = mt_p0; tb.cnt = cn; tb.ut = ut; tb.nmt = nm[0]; return tb;
}

__device__ __forceinline__ MoeTab2 moe_tables2(const Ctx& c, const Params& p, int L) {
    LAS int* base = (LAS int*)(c.lds + LDS_MISC + 1024);
    LAS int* rt_e = base, * rt_r0 = base + 128, * cn = base + 256, * nm = base + 320, * first = base + 324, * rfirst = base + 392, * ut_up = base + 456, * ut_dn = base + 456 + 864;
    const unsigned* cnt = (const unsigned*)(p.ws + WS_CTL + CTL_CNT) + L * 64;
    __syncthreads();
    if (c.tid < 64) cn[c.tid] = (int)cnt[c.tid];
    __syncthreads();
    if (c.tid == 0) { int n = 0, f = 0; for (int e = 0; e < 64; ++e) { first[e] = f; f += (cn[e] + 127) >> 7; rfirst[e] = n; const int ns = (cn[e] + 383) / 384; for (int i = 0; i < ns; ++i) { rt_e[n] = e; rt_r0[n] = i * 384; ++n; } } nm[0] = n; }
    __syncthreads();
    if (c.tid < 64) { const int e = c.tid, f0 = rfirst[e], ns = (cn[e] + 383) / 384; int o = f0 * 8;
        for (int i = 0; i < ns; ++i) for (int j = 0; j < 8; ++j) ut_up[o++] = ((f0 + i) << 4) | j; }
    else if (c.tid < 128) { const int e = c.tid - 64, f0 = rfirst[e], ns = (cn[e] + 383) / 384; int o = f0 * 16;
        for (int i = 0; i < ns; ++i) for (int j = 0; j < 16; ++j) ut_dn[o++] = ((f0 + i) << 4) | j; }
    __syncthreads();
    MoeTab2 tb; tb.rt_e = rt_e; tb.rt_r0 = rt_r0; tb.cnt = cn; tb.first = first; tb.ut_up = ut_up; tb.ut_dn = ut_dn; tb.nrt = nm[0]; return tb;
}

__device__ __forceinline__ void phase_final(const Ctx& c, const Params& p) {
    const float* XB = (const float*)(p.ws + WS_XB); const bf16_t* Y = (const bf16_t*)(p.ws + WS_YMOE);
    for (int t = c.bid * 8 + c.wave; t < T; t += c.G * 8) {
        float4 xv[8]; float ss = 0.f;
#pragma unroll
        for (int q = 0; q < 8; ++q) { const int col = q * 256 + c.lane * 4;
            const float4 a = *(const float4*)(XB + (size_t)t * D + col); const u32x2 y0 = *(const u32x2*)(Y + (size_t)(2 * t) * D + col), y1 = *(const u32x2*)(Y + (size_t)(2 * t + 1) * D + col);
            float4 v; v.x = a.x + (bflo(y0.x) + bflo(y1.x)); v.y = a.y + (bfhi(y0.x) + bfhi(y1.x)); v.z = a.z + (bflo(y0.y) + bflo(y1.y)); v.w = a.w + (bfhi(y0.y) + bfhi(y1.y));
            xv[q] = v; ss += v.x * v.x + v.y * v.y + v.z * v.z + v.w * v.w; }
        const float rstd = rsqrtf(wave_sum(ss, c.lane) * (1.0f / D) + 1e-6f);
#pragma unroll
        for (int q = 0; q < 8; ++q) { const int col = q * 256 + c.lane * 4; const float4 g = *(const float4*)(p.final_g + col);
            float4 o; o.x = xv[q].x * rstd * g.x; o.y = xv[q].y * rstd * g.y; o.z = xv[q].z * rstd * g.z; o.w = xv[q].w * rstd * g.w;
            *(float4*)(p.out + (size_t)t * D + col) = o; }
    }
}

constexpr int NPH_LAYER = 10, NPHASES = 1 + NL * NPH_LAYER + 1;
static_assert(NL == 2, "LAYER_BODY is instantiated twice");
#ifndef MOE_PROBE
#define MOE_PROBE -1
#endif
#if MOE_PROBE >= 0
#define MOE_PROBE_RUN { unsigned* mtd = (unsigned*)(p.ws + WS_CTL + 38400) + L * 192; unsigned* qh = (unsigned*)(p.ws + WS_CTL + CTL_QHEAD + 1024) + L * 128; \
            if (!(MOE_PROBE & 8)) { MoeUpOrder2 S{tb, c.G, c.bid, mtd}; EpiUp2 E{(bf16_t*)(p.ws + WS_HID)}; \
              moe_gemm2<true, (MOE_PROBE & 7), MoeUpOrder2, EpiUp2>(c, (const bf16_t*)(p.ws + WS_H), p.w_up + (size_t)L * NE * D * 1024, (const int*)(p.ws + WS_TOK), S, E); } \
            if (!(MOE_PROBE & 16)) { LAS int* slot = (LAS int*)(c.lds + LDS_MISC + 768); if (c.tid == 0) slot[1] = 0; \
              MoeDownQueue2 S{tb, c.G, c.bid, qh, mtd, slot, (MOE_PROBE & 8) ? 0u : 8u}; EpiDown2 E{(const int*)(p.ws + WS_TOK), (const float*)(p.ws + WS_WSL), (bf16_t*)(p.ws + WS_YMOE)}; \
              moe_gemm2<false, (MOE_PROBE & 7), MoeDownQueue2, EpiDown2>(c, (const bf16_t*)(p.ws + WS_HID), p.w_down + (size_t)L * NE * EH * D, (const int*)(p.ws + WS_TOK), S, E); } \
            SEAM(b + 7); }
#else
#define MOE_PROBE_RUN
#endif
#define LAYER_BODY(L) {         const int b = 1 + L * NPH_LAYER; \
        if (PHON(1) && IN(b + 0)) { for (int rep = 0; rep < 1 + PROBED(b + 0); ++rep) { FRESH(); phase_norm1(c, p, L); } SEAM(b + 0); } \
        if (PHON(2) && IN(b + 1)) { for (int rep = 0; rep < 1 + PROBED(b + 1); ++rep) { FRESH(); \
            pg8::Gemm g{(const bf16_t*)(p.ws + WS_H), (const bf16_t*)(p.ws + WS_WINT) + (size_t)L * NU * D, D}; pg8::StaticOrder S; S.init(T, UC_G, c.G, c.bid); \
            EpiU E{(bf16_t*)(p.ws + WS_U)}; pg8::gemm_phase<EpiU, pg8::StaticOrder, false>(c.lds, g, S, E); } SEAM(b + 1); } \
        if (PHON(3) && IN(b + 2)) { for (int rep = 0; rep < 1 + PROBED(b + 2); ++rep) { FRESH(); phase_local(c, p, L); } SEAM(b + 2); } \
        if (PHON(4) && IN(b + 3)) { for (int rep = 0; rep < 1 + PROBED(b + 3); ++rep) { FRESH(); phase_attn_gdn(c, p, L); } SEAM(b + 3); } \
        if (PHON(5) && IN(b + 4)) { for (int rep = 0; rep < 1 + PROBED(b + 4); ++rep) { FRESH(); phase_combine(c, p, L); } SEAM(b + 4); } \
        if (PHON(6) && IN(b + 5)) { for (int rep = 0; rep < 1 + PROBED(b + 5); ++rep) { FRESH(); \
            pg8::Gemm g{(const bf16_t*)(p.ws + WS_YBR), (const bf16_t*)(p.ws + WS_WBRT) + (size_t)L * 4 * D * 768, 768}; MergeOrder S{c.G, c.bid}; \
            EpiMerge E{(const bf16_t*)(p.ws + WS_U), (float*)(p.ws + WS_M32), (bf16_t*)(p.ws + WS_MERGED)}; pg8::gemm_phase<EpiMerge, MergeOrder, false>(c.lds, g, S, E); } SEAM(b + 5); } \
        if (PHON(7) && IN(b + 6)) { for (int rep = 0; rep < 1 + PROBED(b + 6); ++rep) { FRESH(); \
            pg8::Gemm g{(const bf16_t*)(p.ws + WS_MERGED), (const bf16_t*)(p.ws + WS_WOUTT) + (size_t)L * D * D, D}; pg8::StaticOrder S; S.init(T, D, c.G, c.bid); \
            EpiRes E{L == 0 ? p.x : (const float*)(p.ws + WS_XA), (float*)(p.ws + WS_XB)}; pg8::gemm_phase<EpiRes, pg8::StaticOrder, false>(c.lds, g, S, E); } SEAM(b + 6); } \
        if (PHON(8) && IN(b + 7)) { FRESH(); phase_norm2_router(c, p, L); SEAM(b + 7); } \
        if (PHON(9) && IN(b + 8)) { FRESH(); \
            const MoeTab2 tb = moe_tables2(c, p, L); \
            MOE_PROBE_RUN \
            unsigned* mtd = (unsigned*)(p.ws + WS_CTL + CTL_MTDONE) + L * 192; unsigned* qh = (unsigned*)(p.ws + WS_CTL + CTL_QHEAD) + L * 128; \
            { MoeUpOrder2 S{tb, c.G, c.bid, mtd}; EpiUp2 E{(bf16_t*)(p.ws + WS_HID)}; \
              moe_gemm2<true, 0, MoeUpOrder2, EpiUp2>(c, (const bf16_t*)(p.ws + WS_H), p.w_up + (size_t)L * NE * D * 1024, (const int*)(p.ws + WS_TOK), S, E); } \
            { LAS int* slot = (LAS int*)(c.lds + LDS_MISC + 768); if (c.tid == 0) slot[1] = 0; \
              MoeDownQueue2 S{tb, c.G, c.bid, qh, mtd, slot, 8u}; EpiDown2 E{(const int*)(p.ws + WS_TOK), (const float*)(p.ws + WS_WSL), (bf16_t*)(p.ws + WS_YMOE)}; \
              moe_gemm2<false, 0, MoeDownQueue2, EpiDown2>(c, (const bf16_t*)(p.ws + WS_HID), p.w_down + (size_t)L * NE * EH * D, (const int*)(p.ws + WS_TOK), S, E); } \
            SEAM(b + 8); } \
 }
__global__ void __launch_bounds__(NTHREADS, 2) fwd(Params p0) {
    extern __shared__ __attribute__((aligned(16))) unsigned char lds_raw[];
    Ctx c; c.tid = threadIdx.x; c.lane = c.tid & 63; c.wave = __builtin_amdgcn_readfirstlane(c.tid >> 6); c.bid = blockIdx.x; c.G = gridDim.x; c.lds = (LAS unsigned char*)lds_raw;
    volatile LAS unsigned* misc = (volatile LAS unsigned*)(c.lds + LDS_MISC);
    if (c.tid < 4) misc[c.tid] = 0u;
    if (c.tid == 0) {
        LAS unsigned long long* tab = (LAS unsigned long long*)(c.lds + LDS_PTAB);
        tab[0] = (unsigned long long)p0.x; tab[1] = (unsigned long long)p0.pos; tab[2] = (unsigned long long)p0.norm1_g; tab[3] = (unsigned long long)p0.w_in; tab[4] = (unsigned long long)p0.conv_a_w;
        tab[5] = (unsigned long long)p0.a_log; tab[6] = (unsigned long long)p0.dt_bias; tab[7] = (unsigned long long)p0.gdn_norm_g; tab[8] = (unsigned long long)p0.conv_b_w; tab[9] = (unsigned long long)p0.conv_b_b;
        tab[10] = (unsigned long long)p0.ln_b_g; tab[11] = (unsigned long long)p0.ln_b_b; tab[12] = (unsigned long long)p0.pool_w; tab[13] = (unsigned long long)p0.pool_scale; tab[14] = (unsigned long long)p0.w_branch;
        tab[15] = (unsigned long long)p0.w_out; tab[16] = (unsigned long long)p0.norm2_g; tab[17] = (unsigned long long)p0.rg_w; tab[18] = (unsigned long long)p0.rg_b; tab[19] = (unsigned long long)p0.re_w;
        tab[20] = (unsigned long long)p0.re_b; tab[21] = (unsigned long long)p0.w_up; tab[22] = (unsigned long long)p0.w_down; tab[23] = (unsigned long long)p0.final_g; tab[24] = (unsigned long long)p0.out;
    }
    __syncthreads();
    const int lo = p0.ph_lo, hi = p0.ph_hi, probe = p0.probe, psub = p0.pad; unsigned char* const wsb = p0.ws;
    const bool multi = (hi - lo) > 1;
    XcdBarrier bar; bar.bar = (unsigned*)(wsb + WS_CTL); bar.x = 0; bar.st = misc;
    if (multi) bar = xcd_barrier_post((unsigned*)(wsb + WS_CTL), misc);
#if MK_ONE_LAUNCH
#define IN(k) true
#else
#define IN(k) (lo <= (k) && (k) < hi)
#endif
#define PROBED(k) (PROBE_PHASE >= 0 && probe == (k))
#define FRESH() int _t = threadIdx.x; asm volatile("" : "+v"(_t)); c.tid = _t; c.lane = _t & 63; \
    { int _b = blockIdx.x, _g = gridDim.x, _w = __builtin_amdgcn_readfirstlane(_t >> 6); asm volatile("" : "+s"(_b), "+s"(_g), "+s"(_w)); c.bid = _b; c.G = _g; c.wave = _w; } \
    unsigned long long _wsi = (unsigned long long)wsb; asm volatile("" : "+s"(_wsi)); unsigned char* _ws = (unsigned char*)(GAS unsigned char*)_wsi; Params p = load_params(c, _ws, lo, hi); p.pad = psub
#define SEAM(k) do { if (IN((k) + 1)) { XcdBarrier _bb; unsigned long long _bi = (unsigned long long)(wsb + WS_CTL); asm volatile("" : "+s"(_bi)); _bb.bar = (unsigned*)(GAS unsigned*)_bi; _bb.x = xb_xcc_id(); _bb.st = misc; xcd_barrier(_bb); } } while (0)
#ifndef PHMASK
#define PHMASK 0xFFFFF
#endif
#define PHON(k) ((PHMASK >> (k)) & 1)
    if (PHON(0) && IN(0)) { for (int rep = 0; rep < 1 + PROBED(0); ++rep) { FRESH(); phase_convert(c, p); } SEAM(0); }
    for (int L = 0; L < NL; ++L) LAYER_BODY(L)
    if (PHON(11) && IN(NPHASES - 1)) { FRESH(); phase_final(c, p); }
#undef IN
#undef SEAM
}

extern "C" void kernel_launch(void* const* d_in, const int* in_sizes, int n_in, void* d_out, int out_size, void* d_ws, size_t ws_size, hipStream_t stream) {
    static int grid = 0;
    if (grid == 0) {
        if (n_in != 24 || out_size != T * D || ws_size < WS_END) { fprintf(stderr, "kernel_launch: unexpected shapes (n_in %d, out %d, ws %zu < %zu)\n", n_in, out_size, ws_size, (size_t)WS_END); grid = -1; return; }
        int dev = 0, cus = 0, per_cu = 0;
        if (hipGetDevice(&dev) != hipSuccess || hipDeviceGetAttribute(&cus, hipDeviceAttributeMultiprocessorCount, dev) != hipSuccess) { grid = -1; return; }
        if (hipFuncSetAttribute((const void*)fwd, hipFuncAttributeMaxDynamicSharedMemorySize, LDS_BYTES) != hipSuccess) { fprintf(stderr, "kernel_launch: hipFuncSetAttribute failed\n"); grid = -1; return; }
        if (hipOccupancyMaxActiveBlocksPerMultiprocessor(&per_cu, (const void*)fwd, NTHREADS, LDS_BYTES) != hipSuccess || per_cu < 1) { fprintf(stderr, "kernel_launch: occupancy query says %d\n", per_cu); (void)hipGetLastError(); }
        grid = cus;
    }
    if (grid < 0) return;
    (void)hipMemsetAsync((char*)d_ws + WS_CTL, 0, CTL_BYTES, stream);
    Params p{};
    p.x = (const float*)d_in[0]; p.pos = (const int*)d_in[1]; p.norm1_g = (const float*)d_in[2]; p.w_in = (const float*)d_in[3]; p.conv_a_w = (const float*)d_in[4];
    p.a_log = (const float*)d_in[5]; p.dt_bias = (const float*)d_in[6]; p.gdn_norm_g = (const float*)d_in[7]; p.conv_b_w = (const float*)d_in[8]; p.conv_b_b = (const float*)d_in[9];
    p.ln_b_g = (const float*)d_in[10]; p.ln_b_b = (const float*)d_in[11]; p.pool_w = (const float*)d_in[12]; p.pool_scale = (const float*)d_in[13]; p.w_branch = (const float*)d_in[14];
    p.w_out = (const float*)d_in[15]; p.norm2_g = (const float*)d_in[16]; p.rg_w = (const float*)d_in[17]; p.rg_b = (const float*)d_in[18]; p.re_w = (const float*)d_in[19];
    p.re_b = (const float*)d_in[20]; p.w_up = (const float*)d_in[21]; p.w_down = (const float*)d_in[22]; p.final_g = (const float*)d_in[23];
    p.out = (float*)d_out; p.ws = (unsigned char*)d_ws; p.probe = PROBE_PHASE; p.pad = PROBE_SUB;
#if MK_ONE_LAUNCH
    p.ph_lo = 0; p.ph_hi = NPHASES;
    hipLaunchKernelGGL(fwd, dim3(grid), dim3(NTHREADS), LDS_BYTES, stream, p);
#else
    for (int ph = 0; ph < NPHASES; ++ph) { p.ph_lo = ph; p.ph_hi = ph + 1; hipLaunchKernelGGL(fwd, dim3(grid), dim3(NTHREADS), LDS_BYTES, stream, p); }
#endif
}
```

```cpp
#include <hip/hip_runtime.h>
#include <cstdio>
#include <cstdint>

#ifndef PROBE_SUB
#define PROBE_SUB 0
#endif
#ifndef PROBE_PHASE
#define PROBE_PHASE -1
#endif
#ifndef MK_ONE_LAUNCH
#define MK_ONE_LAUNCH 1
#endif

#define LAS __attribute__((address_space(3)))
#define GAS __attribute__((address_space(1)))
#define WG_BAR_LDS() do { asm volatile("s_waitcnt lgkmcnt(0)" ::: "memory"); __builtin_amdgcn_s_barrier(); asm volatile("" ::: "memory"); } while (0)
typedef unsigned short bf16_t;
typedef short bf16x8 __attribute__((ext_vector_type(8)));
typedef float f32x4 __attribute__((ext_vector_type(4)));
typedef unsigned u32x4 __attribute__((ext_vector_type(4)));
typedef unsigned u32x2 __attribute__((ext_vector_type(2)));
typedef short s16x4 __attribute__((ext_vector_type(4)));
typedef float f32x2 __attribute__((ext_vector_type(2)));

constexpr int T = 8192, D = 2048, NL = 2;
constexpr int NIN = 20492, NU = 20480;
constexpr int UC_QKV = 0, UC_Z = 2304, UC_B = 3072, UC_C = 4608, UC_D = 11520, UC_G = 12288;
constexpr int NE = 64, EH = 512;
constexpr int NTHREADS = 512;
constexpr int LDS_STAGE = 131072;
constexpr int LDS_MISC = LDS_STAGE;
constexpr int LDS_OSTG = LDS_STAGE + 8192;
constexpr int LDS_BYTES = LDS_OSTG + 16384;

constexpr size_t al256(size_t x) { return (x + 255) & ~(size_t)255; }
constexpr size_t WS_CTL = 0;
constexpr size_t CTL_BYTES = 65536;
constexpr size_t CTL_CNT = 32768;
constexpr size_t CTL_MTDONE = 36864;
constexpr size_t CTL_QHEAD = 40960;
constexpr size_t WS_WINT = WS_CTL + CTL_BYTES;
constexpr size_t WS_WBRT = WS_WINT + (size_t)NL * NU * D * 2;
constexpr size_t WS_WOUTT = WS_WBRT + (size_t)NL * 4 * D * 768 * 2;
constexpr size_t WS_WUPT = WS_WOUTT + (size_t)NL * D * D * 2;
constexpr size_t WS_WDNT = WS_WUPT + (size_t)NL * NE * 1024 * D * 2;
constexpr size_t WS_H = WS_WDNT + (size_t)NL * NE * D * EH * 2;
constexpr size_t WS_U = WS_H + (size_t)T * D * 2;
constexpr size_t WS_XA = WS_U + (size_t)T * NU * 2;
constexpr size_t WS_XB = WS_XA + (size_t)T * D * 4;
constexpr size_t WS_BETA = WS_XB + (size_t)T * D * 4;
constexpr size_t WS_GLOG = WS_BETA + (size_t)T * 8 * 4;
constexpr int GB_WC = 0, GB_QD = 16384, GB_KDT = 32768, GB_QK = 49152, GB_BYTES = 57344;
constexpr size_t WS_GBLK = WS_GLOG + (size_t)T * 8 * 4;
constexpr size_t WS_UCP = WS_GBLK + (size_t)768 * GB_BYTES;
constexpr size_t WS_GL = WS_UCP + (size_t)768 * 8192 * 4;
constexpr size_t WS_OGDN = WS_GL + 4096;
constexpr size_t WS_QR = WS_OGDN + (size_t)T * 768 * 4;
constexpr size_t WS_KR = WS_QR + (size_t)T * 2304 * 2;
constexpr size_t WS_ATTO = WS_KR + (size_t)T * 2304 * 2;
constexpr size_t WS_LSE = WS_ATTO + (size_t)3 * T * 768 * 2;
constexpr size_t WS_YBR = WS_LSE + (size_t)3 * T * 8 * 4;
constexpr size_t WS_M32 = WS_YBR + (size_t)4 * T * 768 * 2;
constexpr size_t WS_MERGED = WS_M32 + (size_t)T * D * 4;
constexpr size_t WS_TOK = WS_MERGED + (size_t)T * D * 2;
constexpr size_t WS_WTS = WS_TOK + (size_t)NE * 8192 * 4;
constexpr size_t WS_HID = WS_WTS + (size_t)T * 2 * 4;
constexpr size_t WS_YMOE = WS_HID + (size_t)32768 * EH * 2;
constexpr size_t WS_PWT = WS_YMOE + (size_t)T * 2 * D * 4;
constexpr size_t WS_WRT = WS_PWT + (size_t)NL * 4 * 192 * 192 * 2;
constexpr size_t WS_WSM = WS_WRT + (size_t)NL * 2 * 80 * 2048 * 2;
constexpr size_t WS_WSL = WS_WSM + (size_t)NL * 12 * 2048 * 4;
constexpr size_t WS_END = WS_WSL + (size_t)NE * 8192 * 4;

__constant__ float ROPE_INV[64] = {1.000000000e+00f, 8.659643531e-01f, 7.498942018e-01f, 6.493816376e-01f, 5.623413324e-01f, 4.869675338e-01f, 4.216965139e-01f, 3.651741147e-01f, 3.162277639e-01f, 2.738419771e-01f, 2.371373773e-01f, 2.053525001e-01f, 1.778279394e-01f, 1.539926529e-01f, 1.333521456e-01f, 1.154781953e-01f, 1.000000015e-01f, 8.659642935e-02f, 7.498942316e-02f, 6.493816525e-02f, 5.623413250e-02f, 4.869675264e-02f, 4.216964915e-02f, 3.651741147e-02f, 3.162277490e-02f, 2.738419548e-02f, 2.371373773e-02f, 2.053525113e-02f, 1.778279431e-02f, 1.539926510e-02f, 1.333521400e-02f, 1.154781971e-02f, 9.999999776e-03f, 8.659643121e-03f, 7.498942316e-03f, 6.493816152e-03f, 5.623413250e-03f, 4.869675264e-03f, 4.216964822e-03f, 3.651741194e-03f, 3.162277630e-03f, 2.738419687e-03f, 2.371373819e-03f, 2.053525066e-03f, 1.778279431e-03f, 1.539926510e-03f, 1.333521446e-03f, 1.154782018e-03f, 1.000000047e-03f, 8.659643354e-04f, 7.498941850e-04f, 6.493816036e-04f, 5.623413017e-04f, 4.869675322e-04f, 4.216965172e-04f, 3.651741135e-04f, 3.162277571e-04f, 2.738419571e-04f, 2.371373703e-04f, 2.053525095e-04f, 1.778279402e-04f, 1.539926598e-04f, 1.333521504e-04f, 1.154782003e-04f};

__device__ __forceinline__ float bf2f(unsigned short b) { return __uint_as_float(((unsigned)b) << 16); }
__device__ __forceinline__ float bflo(unsigned w) { return __uint_as_float(w << 16); }
__device__ __forceinline__ float bfhi(unsigned w) { return __uint_as_float(w & 0xffff0000u); }
typedef __bf16 bf16x2_t __attribute__((ext_vector_type(2)));
__device__ __forceinline__ unsigned cvt_pk_bf16(float lo, float hi) { bf16x2_t v; v.x = (__bf16)lo; v.y = (__bf16)hi; return __builtin_bit_cast(unsigned, v); }
__device__ __forceinline__ bf16_t f2bf(float f) { return (bf16_t)(cvt_pk_bf16(f, 0.f) & 0xffffu); }
__device__ __forceinline__ float shx(float v, int o, int lane) { return __int_as_float(__builtin_amdgcn_ds_bpermute((lane ^ o) << 2, __float_as_int(v))); }
__device__ __forceinline__ float wave_sum(float v, int lane) {
#pragma unroll
    for (int o = 32; o; o >>= 1) v += shx(v, o, lane);
    return v; }
__device__ __forceinline__ float wave_max(float v, int lane) {
#pragma unroll
    for (int o = 32; o; o >>= 1) v = fmaxf(v, shx(v, o, lane));
    return v; }
__device__ __forceinline__ float sigmoidf_(float x) { return __builtin_amdgcn_rcpf(1.0f + __expf(-x)); }
__device__ __forceinline__ float siluf_(float x) { return x * __builtin_amdgcn_rcpf(1.0f + __expf(-x)); }
__device__ __forceinline__ float silu_fast(float x) { return x * __builtin_amdgcn_rcpf(1.0f + __expf(-x)); }

__device__ __forceinline__ bf16x8 tr_pair(const LAS unsigned char* p0, const LAS unsigned char* p1) {
    const s16x4 a = __builtin_amdgcn_ds_read_tr16_b64_v4i16((LAS s16x4*)p0), b = __builtin_amdgcn_ds_read_tr16_b64_v4i16((LAS s16x4*)p1);
    return __builtin_shufflevector(a, b, 0, 1, 2, 3, 4, 5, 6, 7); }
#define XB_TMO      128
#define XB_XCNT(j)  (256  + 64 * (j))
#define XB_XSUB(j)  (1280 + 64 * (j))
#define XB_XGEN(j)  (2304 + 64 * (j))
#define XB_TOP      3328
#define XB_TOPGEN   3392
#define XCD_BAR_WORDS 3456
#define XB_SPIN_CAP (1u << 18)
__device__ __forceinline__ unsigned xb_ld(unsigned* p)              { return __hip_atomic_load(p, __ATOMIC_RELAXED, __HIP_MEMORY_SCOPE_AGENT); }
__device__ __forceinline__ unsigned xb_add(unsigned* p, unsigned v) { return __hip_atomic_fetch_add(p, v, __ATOMIC_RELAXED, __HIP_MEMORY_SCOPE_AGENT); }
__device__ __forceinline__ unsigned xb_xcc_id() { return (unsigned)__builtin_amdgcn_s_getreg((3 << 11) | 20) & 0xFu; }
#define XB_SPIN(cond, bar) do { unsigned _sp = 0; while (cond) { __builtin_amdgcn_s_sleep(1); \
    if ((++_sp & 255u) == 0u) { if (xb_ld(&(bar)[XB_TMO])) break; if (_sp > XB_SPIN_CAP) { atomicAdd(&(bar)[XB_TMO], 1u); break; } } } } while (0)
struct XcdBarrier { unsigned* bar; unsigned x; volatile LAS unsigned* st; };
__device__ __forceinline__ XcdBarrier xcd_barrier_post(unsigned* bar, volatile LAS unsigned* st) {
    XcdBarrier b; b.bar = bar; b.x = xb_xcc_id(); b.st = st;
    if (threadIdx.x == 0) (void)xb_add(&bar[XB_XCNT(b.x)], 1u);
    return b;
}
__device__ __forceinline__ void xcd_barrier_complete(unsigned* bar, unsigned x, unsigned& nloc, unsigned& nx) {
    const unsigned G = gridDim.x * gridDim.y * gridDim.z;
    unsigned sum, cnt, mine, sp = 0u;
    for (;;) {
        sum = 0u; cnt = 0u; mine = 0u;
#pragma unroll
        for (unsigned j = 0; j < 16; ++j) { const unsigned c = xb_ld(&bar[XB_XCNT(j)]); sum += c; cnt += (c > 0u) ? 1u : 0u; mine = (j == x) ? c : mine; }
        if (sum == G) break;
        __builtin_amdgcn_s_sleep(1);
        if ((++sp & 255u) == 0u) { if (xb_ld(&bar[XB_TMO])) break; if (sp > XB_SPIN_CAP) { atomicAdd(&bar[XB_TMO], 1u); break; } }
    }
    nloc = mine > 0u ? mine : 1u; nx = cnt > 0u ? cnt : 1u;
}
__device__ __forceinline__ void xcd_barrier(const XcdBarrier& b) {
    asm volatile("s_waitcnt vmcnt(0)" ::: "memory");
    __syncthreads();
    if (threadIdx.x == 0) {
        unsigned* bar = b.bar;
        __builtin_amdgcn_s_waitcnt(0);
        unsigned nloc = b.st[0], nx = b.st[1];
        if (nloc == 0u) { xcd_barrier_complete(bar, b.x, nloc, nx); b.st[0] = nloc; b.st[1] = nx; }
        const unsigned old = xb_add(&bar[XB_XSUB(b.x)], 1u);
        const unsigned gen = old / nloc;
        if (old + 1u == (gen + 1u) * nloc) {
            __builtin_amdgcn_fence(__ATOMIC_RELEASE, "agent");
            asm volatile("s_waitcnt vmcnt(0)" ::: "memory");
            const unsigned og = xb_add(&bar[XB_TOP], 1u);
            const unsigned tg = og / nx;
            if (og + 1u == (tg + 1u) * nx) xb_add(&bar[XB_TOPGEN], 1u);
            else XB_SPIN(xb_ld(&bar[XB_TOPGEN]) == tg, bar);
            __builtin_amdgcn_fence(__ATOMIC_ACQUIRE, "agent");
            xb_add(&bar[XB_XGEN(b.x)], 1u);
            asm volatile("s_waitcnt vmcnt(0)" ::: "memory");
        } else {
            XB_SPIN(xb_ld(&bar[XB_XGEN(b.x)]) == gen, bar);
            __builtin_amdgcn_fence(__ATOMIC_ACQUIRE, "agent");
            asm volatile("s_waitcnt vmcnt(0)" ::: "memory");
        }
    }
    __syncthreads();
}

namespace pg8 {
constexpr int BM = 256, BK = 64, HALF = 128, HTB = HALF * BK * 2, STAGE_BYTES = 8 * HTB, NXCD = 8, WGM = 8;
__host__ __device__ __forceinline__ int lds_byte(int r, int c) { const int st = (r >> 4) * 2 + (c >> 5), rr = r & 15, cc = c & 31, ob = rr * 64 + cc * 2; return st * 1024 + (ob ^ (((ob >> 9) & 1) << 5)); }
__host__ __device__ __forceinline__ void stage_rc(int b, int& R, int& C) { const int st = b / 1024, sb = b % 1024, swz = sb ^ (((sb >> 9) & 1) << 5); R = (st >> 1) * 16 + swz / 64; C = (st & 1) * 32 + (swz % 64) / 2; }
__host__ __device__ __forceinline__ int perm32(int rho) { const int n = rho >> 4, i = rho & 15; return 8 * (i >> 2) + 4 * n + (i & 3); }
struct Unit { int pm, pn; };
struct Gemm { const bf16_t* A; const bf16_t* Bt; int K; };
struct StaticOrder {
    int nM, nN, nwg, G, c;
    __device__ void init(int M, int N, int G_, int c_) { nM = M / BM; nN = N / BM; nwg = nM * nN; G = G_; c = c_; }
    __device__ bool next(int i, Unit& u) const {
        const long L = (long)i * G + c; if (L >= nwg) return false;
        int wgid = (int)L; { const int q = nwg / NXCD, r = nwg % NXCD, xcd = wgid % NXCD, off = wgid / NXCD; wgid = (xcd < r ? xcd * (q + 1) : r * (q + 1) + (xcd - r) * q) + off; }
        const int nig = WGM * nN, gid = wgid / nig, fm = gid * WGM, gsz = (nM - fm) < WGM ? (nM - fm) : WGM;
        u.pm = fm + ((wgid % nig) % gsz); u.pn = (wgid % nig) / gsz; return true;
    }
    __device__ __forceinline__ int arow(const Unit& u, int r) const { return u.pm * BM + r; }
};

template <class Epi, class Sched, bool GATHER>
__device__ __forceinline__ void gemm_phase(LAS unsigned char* lds, const Gemm g, const Sched& S, const Epi& E) {
    int tid = threadIdx.x; asm volatile("" : "+v"(tid));
    const int wid = __builtin_amdgcn_readfirstlane(tid >> 6), lane = tid & 63, wr = wid >> 2, wc = wid & 3, fr = lane & 15, fq = lane >> 4;
    const int K = g.K, nt = K / BK;
    unsigned voffA[2], voffB[2]; int RA[2], CA[2];
#pragma unroll
    for (int i = 0; i < 2; ++i) { int R, C; stage_rc(tid * 16 + i * 8192, R, C); const int Rb = Epi::PERM ? ((R & ~31) + perm32(R & 31)) : R;
        voffA[i] = (unsigned)(R * K + C) * 2u; voffB[i] = (unsigned)(Rb * K + C) * 2u; RA[i] = R; CA[i] = C; }
    const size_t kstep = (size_t)(BK * 2);
    const size_t hstep = (size_t)HALF * K * 2;
    const size_t tstep = 2 * hstep;
    const unsigned ldsw = (unsigned)wid * 1024u;
    const int aoff = lds_byte(wr * 64 + fr, fq * 8), boff = lds_byte(wc * 32 + fr, fq * 8);
#define PG8_SA(b, h) (((b) * 2 + (h)) * HTB)
#define PG8_SB(b, h) ((4 + (b) * 2 + (h)) * HTB)
#define PG8_STAGE(bufoff, gbase, voff) do { _Pragma("unroll") for (int _i = 0; _i < 2; ++_i) \
        __builtin_amdgcn_global_load_lds((const unsigned*)((const char*)(gbase) + (voff)[_i]), (LAS unsigned*)(lds + (bufoff) + ldsw + _i * 8192), 16, 0, 0); } while (0)
#define PG8_STAGE2(bufoff, gbase, o0, o1) do { \
        __builtin_amdgcn_global_load_lds((const unsigned*)((const char*)(gbase) + (o0)), (LAS unsigned*)(lds + (bufoff) + ldsw), 16, 0, 0); \
        __builtin_amdgcn_global_load_lds((const unsigned*)((const char*)(gbase) + (o1)), (LAS unsigned*)(lds + (bufoff) + ldsw + 8192), 16, 0, 0); } while (0)
#define PG8_LDA(dst, b, h) do { _Pragma("unroll") for (int m = 0; m < 4; ++m) _Pragma("unroll") for (int k = 0; k < 2; ++k) dst[m][k] = *(const LAS bf16x8*)(lds + PG8_SA(b, h) + aoff + m * 2048 + k * 1024); } while (0)
#define PG8_LDB(dst, b, h) do { _Pragma("unroll") for (int n = 0; n < 2; ++n) _Pragma("unroll") for (int k = 0; k < 2; ++k) dst[n][k] = *(const LAS bf16x8*)(lds + PG8_SB(b, h) + boff + n * 2048 + k * 1024); } while (0)
#define PG8_MMA(ai, bj, At, Bt) do { __builtin_amdgcn_s_setprio(1); _Pragma("unroll") for (int m = 0; m < 4; ++m) _Pragma("unroll") for (int n = 0; n < 2; ++n) _Pragma("unroll") for (int k = 0; k < 2; ++k) \
        acc[ai][bj][m][n] = __builtin_amdgcn_mfma_f32_16x16x32_bf16(Bt[n][k], At[m][k], acc[ai][bj][m][n], 0, 0, 0); __builtin_amdgcn_s_setprio(0); } while (0)
#define PG8_WAIT_V(n) asm volatile("s_waitcnt vmcnt(" #n ")" ::: "memory")
#define PG8_WAIT_L(n) asm volatile("s_waitcnt lgkmcnt(" #n ")" ::: "memory")
#define PG8_BAR __builtin_amdgcn_s_barrier()
#define PG8_SCHED __builtin_amdgcn_sched_barrier(0)
    Unit cur, nxt; int ui = 0;
    if (!S.next(0, cur)) return;
    f32x4 acc[2][2][4][2];
#pragma unroll
    for (int a = 0; a < 2; ++a)
#pragma unroll
        for (int b = 0; b < 2; ++b)
#pragma unroll
            for (int m = 0; m < 4; ++m)
#pragma unroll
                for (int n = 0; n < 2; ++n) acc[a][b][m][n] = (f32x4){0.f, 0.f, 0.f, 0.f};
    bf16x8 At[4][2], B0[2][2], B1[2][2];
    unsigned c00 = 0, c01 = 0, c10 = 0, c11 = 0, n00 = 0, n01 = 0, n10 = 0, n11 = 0;
    if constexpr (GATHER) {
        c00 = (unsigned)(S.arow(cur, RA[0]) * K + CA[0]) * 2u; c01 = (unsigned)(S.arow(cur, RA[1]) * K + CA[1]) * 2u;
        c10 = (unsigned)(S.arow(cur, HALF + RA[0]) * K + CA[0]) * 2u; c11 = (unsigned)(S.arow(cur, HALF + RA[1]) * K + CA[1]) * 2u;
    }
    const char* cA = GATHER ? (const char*)g.A : (const char*)g.A + (size_t)cur.pm * tstep; const char* cB = (const char*)g.Bt + (size_t)cur.pn * tstep;
    if constexpr (GATHER) {
        PG8_STAGE(PG8_SB(0, 0), cB, voffB); PG8_STAGE2(PG8_SA(0, 0), cA, c00, c01); PG8_STAGE(PG8_SB(0, 1), cB + hstep, voffB); PG8_STAGE2(PG8_SA(0, 1), cA, c10, c11);
    } else {
        PG8_STAGE(PG8_SB(0, 0), cB, voffB); PG8_STAGE(PG8_SB(0, 1), cB + hstep, voffB); PG8_STAGE(PG8_SA(0, 0), cA, voffA); PG8_STAGE(PG8_SA(0, 1), cA + hstep, voffA);
    }
    if (wr == 1) PG8_BAR;
    if constexpr (GATHER) PG8_WAIT_V(4); else PG8_WAIT_V(2);
    PG8_BAR;
    if constexpr (GATHER) {
        PG8_STAGE(PG8_SB(1, 0), cB + kstep, voffB); PG8_STAGE2(PG8_SA(1, 0), cA + kstep, c00, c01); PG8_STAGE(PG8_SB(1, 1), cB + hstep + kstep, voffB);
    } else {
        PG8_STAGE(PG8_SB(1, 0), cB + kstep, voffB); PG8_STAGE(PG8_SA(1, 0), cA + kstep, voffA); PG8_STAGE(PG8_SB(1, 1), cB + hstep + kstep, voffB);
    }
    PG8_WAIT_V(6); PG8_BAR;
    for (;;) {
        const bool has_next = S.next(ui + 1, nxt);
        if constexpr (GATHER) {
            if (has_next) {
                n00 = (unsigned)(S.arow(nxt, RA[0]) * K + CA[0]) * 2u; n01 = (unsigned)(S.arow(nxt, RA[1]) * K + CA[1]) * 2u;
                n10 = (unsigned)(S.arow(nxt, HALF + RA[0]) * K + CA[0]) * 2u; n11 = (unsigned)(S.arow(nxt, HALF + RA[1]) * K + CA[1]) * 2u;
            } else { n00 = c00; n01 = c01; n10 = c10; n11 = c11; }
        }
        const char* nA = GATHER ? cA : (has_next ? (const char*)g.A + (size_t)nxt.pm * tstep : cA);
        const char* nB = has_next ? (const char*)g.Bt + (size_t)nxt.pn * tstep : cB;
        for (int t = 0; t < nt; t += 2) {
            const bool last = (t == nt - 2);
            const char* a1 = cA + (size_t)(t + 1) * kstep;
            const char* a2 = last ? nA : cA + (size_t)(t + 2) * kstep; const char* b2 = last ? nB : cB + (size_t)(t + 2) * kstep;
            const char* a3 = a2 + kstep; const char* b3 = b2 + kstep;
            unsigned s00 = 0, s01 = 0, s10 = 0, s11 = 0;
            if constexpr (GATHER) { s00 = last ? n00 : c00; s01 = last ? n01 : c01; s10 = last ? n10 : c10; s11 = last ? n11 : c11; }
            if constexpr (!GATHER) {
            PG8_LDB(B0, 0, 0); PG8_LDB(B1, 0, 1); PG8_SCHED; PG8_LDA(At, 0, 0); PG8_STAGE(PG8_SA(1, 1), a1 + hstep, voffA);
            PG8_WAIT_V(8); PG8_WAIT_L(0); PG8_BAR; PG8_MMA(0, 0, At, B0); PG8_MMA(0, 1, At, B1); PG8_BAR; PG8_SCHED;
            PG8_LDA(At, 0, 1); PG8_STAGE(PG8_SB(0, 0), b2, voffB); PG8_STAGE(PG8_SB(0, 1), b2 + hstep, voffB); PG8_STAGE(PG8_SA(0, 0), a2, voffA);
            PG8_WAIT_V(8); PG8_WAIT_L(0); PG8_BAR; PG8_MMA(1, 0, At, B0); PG8_MMA(1, 1, At, B1); PG8_BAR; PG8_SCHED;
            PG8_LDB(B0, 1, 0); PG8_LDB(B1, 1, 1); PG8_SCHED; PG8_LDA(At, 1, 0); PG8_STAGE(PG8_SA(0, 1), a2 + hstep, voffA);
            PG8_WAIT_V(8); PG8_WAIT_L(0); PG8_BAR; PG8_MMA(0, 0, At, B0); PG8_MMA(0, 1, At, B1); PG8_BAR; PG8_SCHED;
            PG8_LDA(At, 1, 1); PG8_STAGE(PG8_SB(1, 0), b3, voffB); PG8_STAGE(PG8_SB(1, 1), b3 + hstep, voffB); PG8_STAGE(PG8_SA(1, 0), a3, voffA);
            PG8_WAIT_V(8); PG8_WAIT_L(0); PG8_BAR; PG8_MMA(1, 0, At, B0); PG8_MMA(1, 1, At, B1); PG8_BAR; PG8_SCHED;
            } else {
            PG8_LDB(B0, 0, 0); PG8_SCHED; PG8_LDA(At, 0, 0);
            if constexpr (GATHER) PG8_STAGE2(PG8_SA(1, 1), a1, c10, c11); else PG8_STAGE(PG8_SA(1, 1), a1 + hstep, voffA);
            PG8_WAIT_L(8); PG8_BAR; PG8_WAIT_L(0); PG8_MMA(0, 0, At, B0); PG8_BAR; PG8_SCHED;
            PG8_LDB(B1, 0, 1); PG8_STAGE(PG8_SB(0, 0), b2, voffB);
            PG8_BAR; PG8_WAIT_L(0); PG8_MMA(0, 1, At, B1); PG8_BAR;
            PG8_LDA(At, 0, 1);
            if constexpr (GATHER) PG8_STAGE2(PG8_SA(0, 0), a2, s00, s01); else PG8_STAGE(PG8_SA(0, 0), a2, voffA);
            PG8_BAR; PG8_WAIT_L(0); PG8_MMA(1, 0, At, B0); PG8_BAR; PG8_SCHED;
            PG8_STAGE(PG8_SB(0, 1), b2 + hstep, voffB);
            PG8_WAIT_V(6); PG8_BAR; PG8_MMA(1, 1, At, B1); PG8_BAR;
            PG8_LDB(B0, 1, 0); PG8_SCHED; PG8_LDA(At, 1, 0);
            if constexpr (GATHER) PG8_STAGE2(PG8_SA(0, 1), a2, s10, s11); else PG8_STAGE(PG8_SA(0, 1), a2 + hstep, voffA);
            PG8_WAIT_L(8); PG8_BAR; PG8_WAIT_L(0); PG8_MMA(0, 0, At, B0); PG8_BAR; PG8_SCHED;
            PG8_LDB(B1, 1, 1); PG8_STAGE(PG8_SB(1, 0), b3, voffB);
            PG8_BAR; PG8_WAIT_L(0); PG8_MMA(0, 1, At, B1); PG8_BAR;
            PG8_LDA(At, 1, 1);
            if constexpr (GATHER) PG8_STAGE2(PG8_SA(1, 0), a3, s00, s01); else PG8_STAGE(PG8_SA(1, 0), a3, voffA);
            PG8_BAR; PG8_WAIT_L(0); PG8_MMA(1, 0, At, B0); PG8_BAR; PG8_SCHED;
            PG8_STAGE(PG8_SB(1, 1), b3 + hstep, voffB);
            PG8_WAIT_V(6); PG8_BAR; PG8_MMA(1, 1, At, B1); PG8_BAR;
                    }
        }
        if (wr == 0) PG8_BAR;
        E(acc, cur, wr, wc, fr, fq);
        if (!has_next) break;
        bool clr = true; if constexpr (Epi::CARRY) clr = !E.keep(cur);
        if (clr)
#pragma unroll
        for (int a = 0; a < 2; ++a)
#pragma unroll
            for (int b = 0; b < 2; ++b)
#pragma unroll
                for (int m = 0; m < 4; ++m)
#pragma unroll
                    for (int n = 0; n < 2; ++n) acc[a][b][m][n] = (f32x4){0.f, 0.f, 0.f, 0.f};
        cur = nxt; cA = nA; cB = nB; ++ui;
        if constexpr (GATHER) { c00 = n00; c01 = n01; c10 = n10; c11 = n11; }
        if (wr == 1) PG8_BAR;
    }
    PG8_WAIT_V(0);
    PG8_BAR;
#undef PG8_SA
#undef PG8_SB
#undef PG8_STAGE
#undef PG8_STAGE2
#undef PG8_LDA
#undef PG8_LDB
#undef PG8_MMA
#undef PG8_WAIT_V
#undef PG8_WAIT_L
#undef PG8_BAR
#undef PG8_SCHED
}
}

struct Params {
    const float* x; const int* pos; const float* norm1_g; const float* w_in; const float* conv_a_w; const float* a_log; const float* dt_bias; const float* gdn_norm_g;
    const float* conv_b_w; const float* conv_b_b; const float* ln_b_g; const float* ln_b_b; const float* pool_w; const float* pool_scale; const float* w_branch; const float* w_out;
    const float* norm2_g; const float* rg_w; const float* rg_b; const float* re_w; const float* re_b; const float* w_up; const float* w_down; const float* final_g;
    float* out; unsigned char* ws; int ph_lo, ph_hi, probe, pad;
};

struct Ctx { int tid, lane, wave, bid, G; LAS unsigned char* lds; };
constexpr int LDS_PTAB = LDS_MISC + 512;
__device__ __forceinline__ const void* lds_ptr_get(const LAS unsigned* tab, int i) {
    const unsigned lo = __builtin_amdgcn_readfirstlane(tab[2 * i]), hi = __builtin_amdgcn_readfirstlane(tab[2 * i + 1]);
    return (const void*)(const GAS char*)(((unsigned long long)hi << 32) | lo); }
__device__ __forceinline__ Params load_params(const Ctx& c, unsigned char* ws, int lo, int hi) {
    unsigned toff = LDS_PTAB; asm volatile("" : "+s"(toff)); const LAS unsigned* tab = (const LAS unsigned*)(c.lds + toff);
    Params q;
    q.x = (const float*)lds_ptr_get(tab, 0); q.pos = (const int*)lds_ptr_get(tab, 1); q.norm1_g = (const float*)lds_ptr_get(tab, 2); q.w_in = (const float*)lds_ptr_get(tab, 3);
    q.conv_a_w = (const float*)lds_ptr_get(tab, 4); q.a_log = (const float*)lds_ptr_get(tab, 5); q.dt_bias = (const float*)lds_ptr_get(tab, 6); q.gdn_norm_g = (const float*)lds_ptr_get(tab, 7);
    q.conv_b_w = (const float*)lds_ptr_get(tab, 8); q.conv_b_b = (const float*)lds_ptr_get(tab, 9); q.ln_b_g = (const float*)lds_ptr_get(tab, 10); q.ln_b_b = (const float*)lds_ptr_get(tab, 11);
    q.pool_w = (const float*)lds_ptr_get(tab, 12); q.pool_scale = (const float*)lds_ptr_get(tab, 13); q.w_branch = (const float*)lds_ptr_get(tab, 14); q.w_out = (const float*)lds_ptr_get(tab, 15);
    q.norm2_g = (const float*)lds_ptr_get(tab, 16); q.rg_w = (const float*)lds_ptr_get(tab, 17); q.rg_b = (const float*)lds_ptr_get(tab, 18); q.re_w = (const float*)lds_ptr_get(tab, 19);
    q.re_b = (const float*)lds_ptr_get(tab, 20); q.w_up = (const float*)lds_ptr_get(tab, 21); q.w_down = (const float*)lds_ptr_get(tab, 22); q.final_g = (const float*)lds_ptr_get(tab, 23);
    q.out = (float*)lds_ptr_get(tab, 24); q.ws = ws; q.ph_lo = lo; q.ph_hi = hi; q.probe = -1; q.pad = 0; return q; }

__device__ __forceinline__ void cvt_tile(const Ctx& c, const float* __restrict__ src, size_t ld, int k0, int n0s, bf16_t* __restrict__ dst, int K, int n0d) {
    LAS float* tile = (LAS float*)c.lds;
    const int tid = c.tid;
#pragma unroll
    for (int rr = 0; rr < 2; ++rr) {
        const int r = (tid >> 4) + rr * 32, cc = (tid & 15) * 4;
        const float4 v = *(const float4*)(src + (size_t)(k0 + r) * ld + n0s + cc);
        tile[r * 65 + cc + 0] = v.x; tile[r * 65 + cc + 1] = v.y; tile[r * 65 + cc + 2] = v.z; tile[r * 65 + cc + 3] = v.w;
    }
    __syncthreads();
    {
        const int n = tid >> 3, ks = tid & 7;
        float f[8];
#pragma unroll
        for (int i = 0; i < 8; ++i) f[i] = tile[(ks * 8 + i) * 65 + n];
        u32x4 w; w.x = cvt_pk_bf16(f[0], f[1]); w.y = cvt_pk_bf16(f[2], f[3]); w.z = cvt_pk_bf16(f[4], f[5]); w.w = cvt_pk_bf16(f[6], f[7]);
        *(u32x4*)(dst + (size_t)(n0d + n) * K + k0 + ks * 8) = w;
    }
    __syncthreads();
}
struct CvtDesc { const float* src; bf16_t* dst; int ld, K; };
__device__ __forceinline__ CvtDesc cvt_desc(const Params& p, int idx) {
    constexpr int T1 = 10240, T2 = 1536, T3 = 1024, TL = T1 + T2 + T3;
    bf16_t* WinT = (bf16_t*)(p.ws + WS_WINT); bf16_t* WbrT = (bf16_t*)(p.ws + WS_WBRT); bf16_t* WoutT = (bf16_t*)(p.ws + WS_WOUTT);
    const int L = idx / TL; int r = idx % TL; CvtDesc d;
    if (r < T1) { const int kt = r % 32, ntile = r / 32, n0d = ntile * 64, n0s = n0d + (n0d >= 3072 ? 12 : 0);
        d.ld = NIN; d.K = D; d.src = p.w_in + (size_t)L * D * NIN + (size_t)(kt * 64) * NIN + n0s; d.dst = WinT + (size_t)L * NU * D + (size_t)n0d * D + kt * 64; return d; }
    r -= T1;
    if (r < T2) { const int kb = r / 384, rr = r % 384, kt = rr % 12, ntile = rr / 12;
        d.ld = D; d.K = 768; d.src = p.w_branch + (size_t)(L * 4 + kb) * 768 * D + (size_t)(kt * 64) * D + ntile * 64; d.dst = WbrT + (size_t)(L * 4 + kb) * D * 768 + (size_t)(ntile * 64) * 768 + kt * 64; return d; }
    r -= T2;
    { const int kt = r % 32, ntile = r / 32;
        d.ld = D; d.K = D; d.src = p.w_out + (size_t)L * D * D + (size_t)(kt * 64) * D + ntile * 64; d.dst = WoutT + (size_t)L * D * D + (size_t)(ntile * 64) * D + kt * 64; return d; }
}
__device__ __forceinline__ void phase_convert(const Ctx& c, const Params& p) {
    constexpr int TL = 10240 + 1536 + 1024;
    {
        const int tid = c.tid, r0 = tid >> 4, cc = (tid & 15) * 4;
        int idx = c.bid; float4 v0 = make_float4(0.f, 0.f, 0.f, 0.f), v1 = v0, m0 = v0, m1 = v0; CvtDesc cur, mid;
        if (idx < NL * TL) { cur = cvt_desc(p, idx); v0 = *(const float4*)(cur.src + (size_t)r0 * cur.ld + cc); v1 = *(const float4*)(cur.src + (size_t)(r0 + 32) * cur.ld + cc); mid = cur; }
        if (idx + c.G < NL * TL) { mid = cvt_desc(p, idx + c.G); m0 = *(const float4*)(mid.src + (size_t)r0 * mid.ld + cc); m1 = *(const float4*)(mid.src + (size_t)(r0 + 32) * mid.ld + cc); }
        int bsel = 0;
        while (idx < NL * TL) {
            const int n2 = idx + 2 * c.G; CvtDesc nxt = mid; float4 n0 = m0, n1 = m1;
            if (n2 < NL * TL) { nxt = cvt_desc(p, n2); n0 = *(const float4*)(nxt.src + (size_t)r0 * nxt.ld + cc); n1 = *(const float4*)(nxt.src + (size_t)(r0 + 32) * nxt.ld + cc); }
            LAS float* tile = (LAS float*)c.lds + bsel * (64 * 65 + 32);
            tile[r0 * 65 + cc + 0] = v0.x; tile[r0 * 65 + cc + 1] = v0.y; tile[r0 * 65 + cc + 2] = v0.z; tile[r0 * 65 + cc + 3] = v0.w;
            tile[(r0 + 32) * 65 + cc + 0] = v1.x; tile[(r0 + 32) * 65 + cc + 1] = v1.y; tile[(r0 + 32) * 65 + cc + 2] = v1.z; tile[(r0 + 32) * 65 + cc + 3] = v1.w;
            __syncthreads();
            { const int n = tid >> 3, ks = tid & 7; float f[8];
#pragma unroll
              for (int i = 0; i < 8; ++i) f[i] = tile[(ks * 8 + i) * 65 + n];
              u32x4 w; w.x = cvt_pk_bf16(f[0], f[1]); w.y = cvt_pk_bf16(f[2], f[3]); w.z = cvt_pk_bf16(f[4], f[5]); w.w = cvt_pk_bf16(f[6], f[7]);
              *(u32x4*)(cur.dst + (size_t)n * cur.K + ks * 8) = w; }
            idx += c.G; cur = mid; v0 = m0; v1 = m1; mid = nxt; m0 = n0; m1 = n1; bsel ^= 1;
        }
        __syncthreads();
    }
    {   float* WSM = (float*)(p.ws + WS_WSM);
        for (int i = c.bid * NTHREADS + c.tid; i < NL * 12 * 2048; i += c.G * NTHREADS) { const int k = i & 2047, j = (i >> 11) % 12, L = i / (12 * 2048);
            WSM[i] = p.w_in[((size_t)L * D + k) * NIN + 3072 + j]; }
    }
    {
        bf16_t* WRT = (bf16_t*)(p.ws + WS_WRT);
        for (int i = c.bid * NTHREADS + c.tid; i < NL * 80 * 2048; i += c.G * NTHREADS) { const int k = i & 2047, j = (i >> 11) % 80, L = i / (80 * 2048);
            const float w = j < 8 ? p.rg_w[((size_t)L * D + k) * 8 + j] : (j < 72 ? p.re_w[((size_t)L * D + k) * 64 + (j - 8)] : 0.f);
            const bf16_t hi = f2bf(w); WRT[((size_t)(L * 2 + 0) * 80 + j) * 2048 + k] = hi; WRT[((size_t)(L * 2 + 1) * 80 + j) * 2048 + k] = f2bf(w - bf2f(hi)); }
    }
    {
        bf16_t* PWT = (bf16_t*)(p.ws + WS_PWT);
        for (int i = c.bid * NTHREADS + c.tid; i < NL * 4 * 192 * 192; i += c.G * NTHREADS) { const int cc = i % 192, e = (i / 192) % 192, lg = i / (192 * 192);
            PWT[i] = f2bf(p.pool_w[(size_t)(lg * 192 + cc) * 192 + e] * p.pool_scale[lg * 192 + e]); }
    }
}

__device__ __forceinline__ void phase_norm1(const Ctx& c, const Params& p, int L) {
    LAS float* wsm = (LAS float*)c.lds;
    __syncthreads();
    if (L == 0) {
        for (int i = c.tid; i < 12 * 2048; i += NTHREADS) { const int k = i / 12, j = i - 12 * k; wsm[j * 2048 + k] = p.w_in[(size_t)k * NIN + 3072 + j]; }
    } else { const float4* src = (const float4*)((const float*)(p.ws + WS_WSM) + (size_t)L * 12 * 2048);
      for (int i = c.tid; i < 12 * 2048 / 4; i += NTHREADS) { const float4 v = src[i]; LAS float* d = wsm + 4 * i; d[0] = v.x; d[1] = v.y; d[2] = v.z; d[3] = v.w; } }
    __syncthreads();
    const float* g1 = p.norm1_g + L * D;
    bf16_t* H = (bf16_t*)(p.ws + WS_H); bf16_t* XA = (bf16_t*)(p.ws + WS_XA); const bf16_t* XB = (const bf16_t*)(p.ws + WS_XB); const bf16_t* Y = (const bf16_t*)(p.ws + WS_YMOE);
    float* BETA = (float*)(p.ws + WS_BETA); float* GLOG = (float*)(p.ws + WS_GLOG);
    for (int rt = c.bid; rt < T / 32; rt += c.G) {
        u32x4 na[8]; u32x2 nb[8], nc[8];
#define N1_LOAD(TT) do { _Pragma("unroll") for (int q = 0; q < 8; ++q) { const int col = q * 256 + c.lane * 4; \
            if (L == 0) na[q] = *(const u32x4*)(p.x + (size_t)(TT) * D + col); \
            else { const u32x2 xa = *(const u32x2*)(XB + (size_t)(TT) * D + col); na[q].x = xa.x; na[q].y = xa.y; nb[q] = *(const u32x2*)(Y + (size_t)(2 * (TT)) * D + col); nc[q] = *(const u32x2*)(Y + (size_t)(2 * (TT) + 1) * D + col); } } } while (0)
        N1_LOAD(rt * 32 + c.wave * 4);
#pragma unroll 1
        for (int i = 0; i < 4; ++i) {
            const int t = rt * 32 + c.wave * 4 + i;
            u32x4 ra[8]; u32x2 rb[8], rc[8];
#pragma unroll
            for (int q = 0; q < 8; ++q) { ra[q] = na[q]; rb[q] = nb[q]; rc[q] = nc[q]; }
            if (i < 3) N1_LOAD(t + 1);
            int wo = 0; asm volatile("" : "+v"(wo)); const LAS float* wsm_i = wsm + wo;
            float4 xv[8]; float ss = 0.f;
#pragma unroll
            for (int q = 0; q < 8; ++q) {
                const int col = q * 256 + c.lane * 4;
                float4 v;
                if (L == 0) { v.x = __uint_as_float(ra[q].x); v.y = __uint_as_float(ra[q].y); v.z = __uint_as_float(ra[q].z); v.w = __uint_as_float(ra[q].w); }
                else { float4 a; a.x = bflo(ra[q].x); a.y = bfhi(ra[q].x); a.z = bflo(ra[q].y); a.w = bfhi(ra[q].y); const u32x2 y0 = rb[q], y1 = rc[q];
                    v.x = a.x + (bflo(y0.x) + bflo(y1.x)); v.y = a.y + (bfhi(y0.x) + bfhi(y1.x)); v.z = a.z + (bflo(y0.y) + bflo(y1.y)); v.w = a.w + (bfhi(y0.y) + bfhi(y1.y));
                    u32x2 xw; xw.x = cvt_pk_bf16(v.x, v.y); xw.y = cvt_pk_bf16(v.z, v.w); *(u32x2*)(XA + (size_t)t * D + col) = xw; }
                xv[q] = v; ss += v.x * v.x + v.y * v.y + v.z * v.z + v.w * v.w;
            }
            ss = wave_sum(ss, c.lane);
            const float rstd = rsqrtf(ss * (1.0f / D) + 1e-6f);
            float dots[12];
#pragma unroll
            for (int j = 0; j < 12; ++j) dots[j] = 0.f;
#pragma unroll
            for (int q = 0; q < 8; ++q) {
                const int col = q * 256 + c.lane * 4;
                const float4 g = *(const float4*)(g1 + col);
                float4 h; h.x = xv[q].x * rstd * g.x; h.y = xv[q].y * rstd * g.y; h.z = xv[q].z * rstd * g.z; h.w = xv[q].w * rstd * g.w;
                uint2 o; o.x = cvt_pk_bf16(h.x, h.y); o.y = cvt_pk_bf16(h.z, h.w);
                *(uint2*)(H + (size_t)t * D + col) = o;
#pragma unroll
                for (int j = 0; j < 12; ++j) { const LAS float* wp = wsm_i + j * 2048 + col; dots[j] += h.x * wp[0] + h.y * wp[1] + h.z * wp[2] + h.w * wp[3]; }
            }
#pragma unroll
            for (int j = 0; j < 12; ++j) dots[j] = wave_sum(dots[j], c.lane);
            if (c.lane < 6) {
                float db = dots[0], dd = dots[6];
#pragma unroll
                for (int j = 1; j < 6; ++j) { if (c.lane == j) { db = dots[j]; dd = dots[6 + j]; } }
                BETA[t * 8 + c.lane] = 1.0f / (1.0f + expf(-db));
                const float xx = dd + p.dt_bias[L * 6 + c.lane];
                const float sp = xx > 20.f ? xx : log1pf(expf(xx));
                GLOG[t * 8 + c.lane] = -expf(p.a_log[L * 6 + c.lane]) * sp;
            }
        }
    }
}

struct EpiU {
    static constexpr bool PERM = true; static constexpr bool CARRY = false;
    bf16_t* O;
    __device__ __forceinline__ void operator()(const f32x4 (&acc)[2][2][4][2], const pg8::Unit& u, int wr, int wc, int fr, int fq) const {
        const int row0 = u.pm * 256 + wr * 64 + fr, col0 = u.pn * 256 + wc * 32 + 8 * fq; const bool sig = u.pn >= 48;
#pragma unroll
        for (int ai = 0; ai < 2; ++ai)
#pragma unroll
            for (int m = 0; m < 4; ++m) { bf16_t* rowp = O + (size_t)(row0 + ai * 128 + m * 16) * NU + col0;
#pragma unroll
                for (int bj = 0; bj < 2; ++bj) { f32x4 v0 = acc[ai][bj][m][0], v1 = acc[ai][bj][m][1];
                    if (sig) {
#pragma unroll
                        for (int j = 0; j < 4; ++j) { v0[j] = sigmoidf_(v0[j]); v1[j] = sigmoidf_(v1[j]); } }
                    u32x4 w; w.x = cvt_pk_bf16(v0[0], v0[1]); w.y = cvt_pk_bf16(v0[2], v0[3]); w.z = cvt_pk_bf16(v1[0], v1[1]); w.w = cvt_pk_bf16(v1[2], v1[3]);
                    *(u32x4*)(rowp + bj * 128) = w; } }
    }
};
struct MergeOrder {
    int G, c;
    __device__ bool next(int i, pg8::Unit& u) const { const int tile = c + (i >> 2) * G; if (tile >= 256) return false; const int k = i & 3, x = tile & 7, y = tile >> 3;
        u.pm = k * 32 + x * 4 + (y >> 3); u.pn = k * 8 + (y & 7); return true; }
    __device__ __forceinline__ int arow(const pg8::Unit& u, int r) const { return u.pm * 256 + r; }
};
struct EpiMerge {
    static constexpr bool PERM = true; static constexpr bool CARRY = false;
    const bf16_t* U; float* M32; bf16_t* MG;
    __device__ __forceinline__ void operator()(const f32x4 (&acc)[2][2][4][2], const pg8::Unit& u, int wr, int wc, int fr, int fq) const {
        const int k = u.pm >> 5, tm = u.pm & 31, tn = u.pn & 7;
        const int row0 = tm * 256 + wr * 64 + fr, col0 = tn * 256 + wc * 32 + 8 * fq;
        bf16_t* const MP = (bf16_t*)M32;
#pragma unroll
        for (int ai = 0; ai < 2; ++ai)
#pragma unroll
            for (int mh = 0; mh < 2; ++mh) {
                u32x4 gv[2][2], pv[2][2];
#pragma unroll
                for (int mm = 0; mm < 2; ++mm)
#pragma unroll
                    for (int bj = 0; bj < 2; ++bj) { const size_t row = (size_t)(row0 + ai * 128 + (mh * 2 + mm) * 16); const int col = col0 + bj * 128;
                        gv[mm][bj] = *(const u32x4*)(U + row * NU + UC_G + k * D + col);
                        pv[mm][bj] = (k > 0) ? *(const u32x4*)(MP + row * D + col) : (u32x4){0u, 0u, 0u, 0u}; }
#pragma unroll
                for (int mm = 0; mm < 2; ++mm)
#pragma unroll
                    for (int bj = 0; bj < 2; ++bj) { const int m = mh * 2 + mm; const size_t row = (size_t)(row0 + ai * 128 + m * 16); const int col = col0 + bj * 128;
                        const u32x4 g = gv[mm][bj], pp = pv[mm][bj];
                        f32x4 v0 = acc[ai][bj][m][0], v1 = acc[ai][bj][m][1];
                        v0[0] = v0[0] * bflo(g.x) + bflo(pp.x); v0[1] = v0[1] * bfhi(g.x) + bfhi(pp.x); v0[2] = v0[2] * bflo(g.y) + bflo(pp.y); v0[3] = v0[3] * bfhi(g.y) + bfhi(pp.y);
                        v1[0] = v1[0] * bflo(g.z) + bflo(pp.z); v1[1] = v1[1] * bfhi(g.z) + bfhi(pp.z); v1[2] = v1[2] * bflo(g.w) + bflo(pp.w); v1[3] = v1[3] * bfhi(g.w) + bfhi(pp.w);
                        u32x4 w; w.x = cvt_pk_bf16(v0[0], v0[1]); w.y = cvt_pk_bf16(v0[2], v0[3]); w.z = cvt_pk_bf16(v1[0], v1[1]); w.w = cvt_pk_bf16(v1[2], v1[3]);
                        *(u32x4*)((k < 3 ? MP : MG) + row * D + col) = w; }
            }
    }
};
struct EpiMerge3 {
    static constexpr bool PERM = true; static constexpr bool CARRY = true;
    const bf16_t* U; bf16_t* MG;
    __device__ __forceinline__ bool keep(const pg8::Unit& u) const { return (u.pm >> 5) < 3; }
    __device__ __forceinline__ void operator()(f32x4 (&acc)[2][2][4][2], const pg8::Unit& u, int wr, int wc, int fr, int fq) const {
        const int k = u.pm >> 5, tm = u.pm & 31, tn = u.pn & 7;
        const int row0 = tm * 256 + wr * 64 + fr, col0 = tn * 256 + wc * 32 + 8 * fq;
#pragma unroll
        for (int ai = 0; ai < 2; ++ai)
#pragma unroll
            for (int mh = 0; mh < 2; ++mh) {
                u32x4 ga[2][2], gb[2][2];
#pragma unroll
                for (int mm = 0; mm < 2; ++mm)
#pragma unroll
                    for (int bj = 0; bj < 2; ++bj) { const size_t row = (size_t)(row0 + ai * 128 + (mh * 2 + mm) * 16); const int col = col0 + bj * 128;
                        ga[mm][bj] = *(const u32x4*)(U + row * NU + UC_G + k * D + col);
                        gb[mm][bj] = (k < 3) ? *(const u32x4*)(U + row * NU + UC_G + (k + 1) * D + col) : (u32x4){0x3f803f80u, 0x3f803f80u, 0x3f803f80u, 0x3f803f80u}; }
#pragma unroll
                for (int mm = 0; mm < 2; ++mm)
#pragma unroll
                    for (int bj = 0; bj < 2; ++bj) { const int m = mh * 2 + mm; const size_t row = (size_t)(row0 + ai * 128 + m * 16); const int col = col0 + bj * 128;
                        const u32x4 a = ga[mm][bj], b = gb[mm][bj];
                        f32x4& v0 = acc[ai][bj][m][0]; f32x4& v1 = acc[ai][bj][m][1];
#define M3_R(A, B) ((A) * __builtin_amdgcn_rcpf(fmaxf((B), 1e-30f)))
                        v0[0] *= M3_R(bflo(a.x), bflo(b.x)); v0[1] *= M3_R(bfhi(a.x), bfhi(b.x)); v0[2] *= M3_R(bflo(a.y), bflo(b.y)); v0[3] *= M3_R(bfhi(a.y), bfhi(b.y));
                        v1[0] *= M3_R(bflo(a.z), bflo(b.z)); v1[1] *= M3_R(bfhi(a.z), bfhi(b.z)); v1[2] *= M3_R(bflo(a.w), bflo(b.w)); v1[3] *= M3_R(bfhi(a.w), bfhi(b.w));
#undef M3_R
                        if (k == 3) { u32x4 w; w.x = cvt_pk_bf16(v0[0], v0[1]); w.y = cvt_pk_bf16(v0[2], v0[3]); w.z = cvt_pk_bf16(v1[0], v1[1]); w.w = cvt_pk_bf16(v1[2], v1[3]);
                            *(u32x4*)(MG + row * D + col) = w; } }
            }
    }
};
struct EpiRes {
    static constexpr bool PERM = false; static constexpr bool CARRY = false;
    const float* X; float* O;
    __device__ __forceinline__ void operator()(const f32x4 (&acc)[2][2][4][2], const pg8::Unit& u, int wr, int wc, int fr, int fq) const {
        const int row0 = u.pm * 256 + wr * 64 + fr, col0 = u.pn * 256 + wc * 32 + 4 * fq;
#pragma unroll
        for (int ai = 0; ai < 2; ++ai)
#pragma unroll
            for (int mh = 0; mh < 2; ++mh) {
                f32x4 xv[2][2][2];
#pragma unroll
                for (int mm = 0; mm < 2; ++mm)
#pragma unroll
                    for (int bj = 0; bj < 2; ++bj)
#pragma unroll
                        for (int n = 0; n < 2; ++n) xv[mm][bj][n] = *(const f32x4*)(X + (size_t)(row0 + ai * 128 + (mh * 2 + mm) * 16) * D + col0 + bj * 128 + n * 16);
#pragma unroll
                for (int mm = 0; mm < 2; ++mm)
#pragma unroll
                    for (int bj = 0; bj < 2; ++bj)
#pragma unroll
                        for (int n = 0; n < 2; ++n) *(f32x4*)(O + (size_t)(row0 + ai * 128 + (mh * 2 + mm) * 16) * D + col0 + bj * 128 + n * 16) = acc[ai][bj][mh * 2 + mm][n] + xv[mm][bj][n];
            }
    }
};
struct EpiRes2 {
    static constexpr bool PERM = true; static constexpr bool CARRY = false;
    const float* X; const bf16_t* Xh; bf16_t* O;
    __device__ __forceinline__ void operator()(const f32x4 (&acc)[2][2][4][2], const pg8::Unit& u, int wr, int wc, int fr, int fq) const {
        const int row0 = u.pm * 256 + wr * 64 + fr, col0 = u.pn * 256 + wc * 32 + 8 * fq;
#pragma unroll
        for (int ai = 0; ai < 2; ++ai)
#pragma unroll
            for (int mh = 0; mh < 2; ++mh) {
                f32x4 xv[2][2][2];
#pragma unroll
                for (int mm = 0; mm < 2; ++mm)
#pragma unroll
                    for (int bj = 0; bj < 2; ++bj) { const size_t o = (size_t)(row0 + ai * 128 + (mh * 2 + mm) * 16) * D + col0 + bj * 128;
                        if (Xh) { const u32x4 xw = *(const u32x4*)(Xh + o); xv[mm][bj][0] = (f32x4){bflo(xw.x), bfhi(xw.x), bflo(xw.y), bfhi(xw.y)}; xv[mm][bj][1] = (f32x4){bflo(xw.z), bfhi(xw.z), bflo(xw.w), bfhi(xw.w)}; }
                        else { xv[mm][bj][0] = *(const f32x4*)(X + o); xv[mm][bj][1] = *(const f32x4*)(X + o + 4); } }
#pragma unroll
                for (int mm = 0; mm < 2; ++mm)
#pragma unroll
                    for (int bj = 0; bj < 2; ++bj) { const f32x4 v0 = acc[ai][bj][mh * 2 + mm][0] + xv[mm][bj][0], v1 = acc[ai][bj][mh * 2 + mm][1] + xv[mm][bj][1];
                        u32x4 w; w.x = cvt_pk_bf16(v0[0], v0[1]); w.y = cvt_pk_bf16(v0[2], v0[3]); w.z = cvt_pk_bf16(v1[0], v1[1]); w.w = cvt_pk_bf16(v1[2], v1[3]);
                        *(u32x4*)(O + (size_t)(row0 + ai * 128 + (mh * 2 + mm) * 16) * D + col0 + bj * 128) = w; }
            }
    }
};
struct MoeTab { const LAS int* mt_e; const LAS int* mt_p0; const LAS int* cnt; const LAS int* ut; int nmt; };
struct MoeOrder {
    MoeTab tb; int nN, G, c; const int* tok; unsigned* done;
    __device__ bool next(int i, pg8::Unit& u) const { const int U = tb.nmt * nN; int Lx;
        if (G % 8 == 0) { const int per = G / 8, x = c % 8, j = c / 8, R = U / G, rem = U - R * G;
            if (i < R) Lx = i * G + x * per + j;
            else if (i == R) { const int px = rem / 8, left = rem - px * 8;
                if (j < px) Lx = R * G + x * px + j; else if (j == px && x < left) Lx = R * G + px * 8 + x; else return false; }
            else return false;
        } else { Lx = i * G + c; if (Lx >= U) return false; }
        const int e = tb.ut[Lx]; u.pm = e >> 4; u.pn = tb.mt_e[u.pm] * nN + (e & 15); return true; }
    __device__ __forceinline__ int arow(const pg8::Unit& u, int r) const { const int e = tb.mt_e[u.pm], pos = tb.mt_p0[u.pm] + r; return pos < tb.cnt[e] ? (tok[e * 8192 + pos] >> 1) : 0; }
};
struct MoeDownQueue {
    MoeTab tb; int nN, G, c; unsigned* qhead; unsigned* done; LAS int* slot; const int* tok;
    __device__ bool next(int, pg8::Unit& u) const {
        __syncthreads();
        if (threadIdx.x == 0) {
            const int U = tb.nmt * 8, per = (G % 8 == 0) ? G / 8 : G, nq = (G % 8 == 0) ? 8 : 1, x0 = (G % 8 == 0) ? c % 8 : 0;
            int xo = slot[1], ent = -1;
            for (; xo < nq; ++xo) { const int x = (x0 + xo) % nq;
                const int q = (int)__hip_atomic_fetch_add(qhead + 16 * x, 1u, __ATOMIC_RELAXED, __HIP_MEMORY_SCOPE_AGENT);
                const int Lq = (q / per) * G + x * per + (q % per);
                if (Lq < U) { ent = tb.ut[Lq]; break; } }
            slot[1] = xo;
            if (ent >= 0) { const int mt = ent >> 4; unsigned sp = 0;
                while (__hip_atomic_load(done + mt, __ATOMIC_RELAXED, __HIP_MEMORY_SCOPE_AGENT) < 4u) { __builtin_amdgcn_s_sleep(2); if (++sp > (1u << 21)) break; }
                __builtin_amdgcn_fence(__ATOMIC_ACQUIRE, "agent"); asm volatile("s_waitcnt vmcnt(0)" ::: "memory"); }
            slot[0] = ent; }
        __syncthreads();
        const int ent = slot[0]; if (ent < 0) return false;
        u.pm = ent >> 4; u.pn = tb.mt_e[u.pm] * 8 + (ent & 15); return true; }
    __device__ __forceinline__ int arow(const pg8::Unit& u, int r) const { return u.pm * 128 + r; }
};
struct EpiUp {
    bf16_t* HID;
    __device__ __forceinline__ void operator()(const f32x4 (&acc)[2][4][2], const pg8::Unit& u, int wr, int wc, int fr, int fq) const {
        const int j = u.pn & 3; const int row0 = u.pm * 128 + wr * 64 + fr, col0 = j * 128 + wc * 32 + 8 * fq;
#pragma unroll
        for (int m = 0; m < 4; ++m) { const f32x4 g0 = acc[0][m][0], g1 = acc[0][m][1], u0 = acc[1][m][0], u1 = acc[1][m][1];
            float h[8];
#pragma unroll
            for (int q = 0; q < 4; ++q) { h[q] = siluf_(g0[q]) * u0[q]; h[4 + q] = siluf_(g1[q]) * u1[q]; }
            u32x4 w; w.x = cvt_pk_bf16(h[0], h[1]); w.y = cvt_pk_bf16(h[2], h[3]); w.z = cvt_pk_bf16(h[4], h[5]); w.w = cvt_pk_bf16(h[6], h[7]);
            *(u32x4*)(HID + (size_t)(row0 + m * 16) * EH + col0) = w; }
    }
};
struct EpiDown {
    MoeTab tb; const int* tok; const float* wsl; bf16_t* Y;
    __device__ __forceinline__ void operator()(const f32x4 (&acc)[2][4][2], const pg8::Unit& u, int wr, int wc, int fr, int fq) const {
        const int e = tb.mt_e[u.pm], p0 = tb.mt_p0[u.pm], ne = tb.cnt[e]; const int col0 = (u.pn & 7) * 256 + wc * 32 + 8 * fq;
        int dst[4]; float w[4];
#pragma unroll
        for (int m = 0; m < 4; ++m) { const int pos = p0 + wr * 64 + fr + m * 16; const int pc = pos < ne ? pos : ne - 1;
            dst[m] = tok[e * 8192 + pc]; w[m] = wsl[e * 8192 + pc]; }
#pragma unroll
        for (int m = 0; m < 4; ++m) { const int pos = p0 + wr * 64 + fr + m * 16;
            if (pos < ne) { bf16_t* yp = Y + (size_t)dst[m] * D + col0; const float ww = w[m];
#pragma unroll
                for (int bj = 0; bj < 2; ++bj) { const f32x4 v0 = acc[bj][m][0] * ww, v1 = acc[bj][m][1] * ww;
                    u32x4 o; o.x = cvt_pk_bf16(v0[0], v0[1]); o.y = cvt_pk_bf16(v0[2], v0[3]); o.z = cvt_pk_bf16(v1[0], v1[1]); o.w = cvt_pk_bf16(v1[2], v1[3]);
                    *(u32x4*)(yp + bj * 128) = o; } } }
    }
};

struct MoeTab2 { const LAS int* rt_e; const LAS int* rt_r0; const LAS int* cnt; const LAS int* first; const LAS int* ut_up; const LAS int* ut_dn; int nrt; };
__device__ __forceinline__ bool moe_deal(int i, int U, int G, int c, int& Lx) {
    if (G % 8 == 0) { const int per = G / 8, x = c % 8, j = c / 8, R = U / G, rem = U - R * G;
        if (i < R) Lx = i * G + x * per + j;
        else if (i == R) { const int px = rem / 8, left = rem - px * 8;
            if (j < px) Lx = R * G + x * px + j; else if (j == px && x < left) Lx = R * G + px * 8 + x; else return false; }
        else return false;
    } else { Lx = i * G + c; if (Lx >= U) return false; }
    return true; }
struct MoeUpOrder2 { MoeTab2 tb; int G, c; unsigned* done;
    __device__ bool next(int i, int& rt, int& j) const { int Lx; if (!moe_deal(i, tb.nrt * 8, G, c, Lx)) return false; const int ent = tb.ut_up[Lx]; rt = ent >> 4; j = ent & 15; return true; } };
struct MoeDownQueue2 { MoeTab2 tb; int G, c; unsigned* qhead; unsigned* done; LAS int* slot; unsigned need;
    __device__ bool next(int, int& rt, int& j) const {
        __syncthreads();
        if (threadIdx.x == 0) {
            const int U = tb.nrt * 16, per = (G % 8 == 0) ? G / 8 : G, nq = (G % 8 == 0) ? 8 : 1, x0 = (G % 8 == 0) ? c % 8 : 0;
            int xo = slot[1], ent = -1;
            for (; xo < nq; ++xo) { const int x = (x0 + xo) % nq;
                const int q = (int)__hip_atomic_fetch_add(qhead + 16 * x, 1u, __ATOMIC_RELAXED, __HIP_MEMORY_SCOPE_AGENT);
                const int Lq = (q / per) * G + x * per + (q % per);
                if (Lq < U) { ent = tb.ut_dn[Lq]; break; } }
            slot[1] = xo;
            if (ent >= 0) { const int r = ent >> 4; unsigned sp = 0;
                while (__hip_atomic_load(done + r, __ATOMIC_RELAXED, __HIP_MEMORY_SCOPE_AGENT) < need) { __builtin_amdgcn_s_sleep(2); if (++sp > (1u << 21)) break; }
                __builtin_amdgcn_fence(__ATOMIC_ACQUIRE, "agent"); asm volatile("s_waitcnt vmcnt(0)" ::: "memory"); }
            slot[0] = ent; }
        __syncthreads();
        const int ent = slot[0]; if (ent < 0) return false;
        rt = ent >> 4; j = ent & 15; return true; } };
struct EpiUp2 { bf16_t* HID;
    __device__ __forceinline__ void operator()(const f32x4 (&acc)[3][4][2], int row0, int nb, int e, int r0, int ne, int j, int wr, int wc, int fr, int fq) const {
        bf16_t* hp = HID + (size_t)(row0 + wr * 64 + fr) * EH + 64 * j + 16 * wc + 4 * fq;
#pragma unroll
        for (int blk = 0; blk < 3; ++blk) if (blk < nb) {
#pragma unroll
            for (int m = 0; m < 4; ++m) { const f32x4 g = acc[blk][m][0], u = acc[blk][m][1];
                u32x2 w; w.x = cvt_pk_bf16(silu_fast(g[0]) * u[0], silu_fast(g[1]) * u[1]); w.y = cvt_pk_bf16(silu_fast(g[2]) * u[2], silu_fast(g[3]) * u[3]);
                *(u32x2*)(hp + (size_t)(blk * 128 + m * 16) * EH) = w; } }
    } };
struct EpiDown2 { const int* tok; const float* wsl; bf16_t* Y;
    __device__ __forceinline__ void operator()(const f32x4 (&acc)[3][4][2], int row0, int nb, int e, int r0, int ne, int j, int wr, int wc, int fr, int fq) const {
        const int col0 = 128 * j + 32 * wc + 8 * fq;
#pragma unroll
        for (int blk = 0; blk < 3; ++blk) if (blk < nb) {
            int dst[4]; float w[4];
#pragma unroll
            for (int m = 0; m < 4; ++m) { const int pos = r0 + blk * 128 + wr * 64 + m * 16 + fr; const int pc = pos < ne ? pos : ne - 1; dst[m] = tok[e * 8192 + pc]; w[m] = wsl[e * 8192 + pc]; }
#pragma unroll
            for (int m = 0; m < 4; ++m) { const int pos = r0 + blk * 128 + wr * 64 + m * 16 + fr;
                if (pos < ne) { const f32x4 v0 = acc[blk][m][0] * w[m], v1 = acc[blk][m][1] * w[m];
                    u32x4 o; o.x = cvt_pk_bf16(v0[0], v0[1]); o.y = cvt_pk_bf16(v0[2], v0[3]); o.z = cvt_pk_bf16(v1[0], v1[1]); o.w = cvt_pk_bf16(v1[2], v1[3]);
                    *(u32x4*)(Y + (size_t)dst[m] * D + col0) = o; } } }
    } };


__device__ __forceinline__ int invperm32(int a) { return a < 16 ? 8 * (a >> 2) + (a & 3) : 8 * ((a - 16) >> 2) + 4 + (a & 3); }
__device__ __forceinline__ bf16x8 pack_bf16x8(const f32x4& a, const f32x4& b) { u32x4 w; w.x = cvt_pk_bf16(a[0], a[1]); w.y = cvt_pk_bf16(a[2], a[3]); w.z = cvt_pk_bf16(b[0], b[1]); w.w = cvt_pk_bf16(b[2], b[3]); return __builtin_bit_cast(bf16x8, w); }
__device__ __forceinline__ void gdn_chunk_local(const Ctx& c, const Params& p, int L, int unit) {
    const int h = unit >> 7, n = unit & 127, t0 = n * 64, tid = c.tid, lane = c.lane;
    const bf16_t* U = (const bf16_t*)(p.ws + WS_U);
    LAS unsigned char* lds = c.lds;
    LAS float* vf = (LAS float*)lds;
    LAS bf16_t* qb = (LAS bf16_t*)(lds + 33280);
    LAS bf16_t* kb = (LAS bf16_t*)(lds + 50688);
    LAS float* Am = (LAS float*)(lds + 68096);
    LAS unsigned char* img = lds + 85504;
    LAS float* gcs = (LAS float*)(lds + 126464);
    const float* cw = p.conv_a_w + (size_t)L * 4 * 2304;
    LAS float* cwl = (LAS float*)(lds + LDS_OSTG);
    for (int i = tid; i < 3 * 4 * 32; i += NTHREADS) { const int c4 = i & 31, j = (i >> 5) & 3, sec = i >> 7;
        const float4 wv4 = *(const float4*)(cw + j * 2304 + sec * 768 + h * 128 + 4 * c4); LAS float* d = cwl + (sec * 4 + j) * 128 + 4 * c4; d[0] = wv4.x; d[1] = wv4.y; d[2] = wv4.z; d[3] = wv4.w; }
    if (tid < 64) {
        float g = ((const float*)(p.ws + WS_GLOG))[(t0 + tid) * 8 + h];
#pragma unroll
        for (int o = 1; o < 64; o <<= 1) { const float v = __int_as_float(__builtin_amdgcn_ds_bpermute(((lane - o) & 63) << 2, __float_as_int(g))); if (lane >= o) g += v; }
        gcs[tid] = g; gcs[64 + tid] = ((const float*)(p.ws + WS_BETA))[(t0 + tid) * 8 + h];
    }
    __syncthreads();
    {
        const int tok = tid >> 3, cg = tid & 7, t = t0 + tok;
        const float eg = __expf(gcs[tok]);
#pragma unroll
        for (int sec = 0; sec < 3; ++sec) {
            const int col = sec * 768 + h * 128 + 16 * cg;
            float a[16];
#pragma unroll
            for (int i = 0; i < 16; ++i) a[i] = 0.f;
            u32x4 xa[4], xb[4];
#pragma unroll
            for (int j = 0; j < 4; ++j) { const int tt = t - 3 + j, tc = tt < 0 ? 0 : tt;
                xa[j] = *(const u32x4*)(U + (size_t)tc * NU + UC_QKV + col); xb[j] = *(const u32x4*)(U + (size_t)tc * NU + UC_QKV + col + 8); }
#pragma unroll
            for (int j = 0; j < 4; ++j) { const float mk = (t - 3 + j) < 0 ? 0.f : 1.f; const u32x4 x0 = xa[j], x1 = xb[j];
                const LAS f32x4* wl = (const LAS f32x4*)(cwl + (sec * 4 + j) * 128 + 16 * cg); const f32x4 w0 = wl[0], w1 = wl[1], w2 = wl[2], w3 = wl[3];
                a[0] += mk * w0[0] * bflo(x0.x); a[1] += mk * w0[1] * bfhi(x0.x); a[2] += mk * w0[2] * bflo(x0.y); a[3] += mk * w0[3] * bfhi(x0.y);
                a[4] += mk * w1[0] * bflo(x0.z); a[5] += mk * w1[1] * bfhi(x0.z); a[6] += mk * w1[2] * bflo(x0.w); a[7] += mk * w1[3] * bfhi(x0.w);
                a[8] += mk * w2[0] * bflo(x1.x); a[9] += mk * w2[1] * bfhi(x1.x); a[10] += mk * w2[2] * bflo(x1.y); a[11] += mk * w2[3] * bfhi(x1.y);
                a[12] += mk * w3[0] * bflo(x1.z); a[13] += mk * w3[1] * bfhi(x1.z); a[14] += mk * w3[2] * bflo(x1.w); a[15] += mk * w3[3] * bfhi(x1.w); }
#pragma unroll
            for (int i = 0; i < 16; ++i) a[i] = siluf_(a[i]);
            if (sec < 2) {
                float sq = 0.f;
#pragma unroll
                for (int i = 0; i < 16; ++i) sq += a[i] * a[i];
                sq += shx(sq, 1, lane); sq += shx(sq, 2, lane); sq += shx(sq, 4, lane);
                const float rn = rsqrtf(sq + 1e-6f) * (sec == 0 ? 0.08838834764831845f : 1.0f);
#pragma unroll
                for (int i = 0; i < 16; ++i) a[i] *= rn;
                LAS bf16_t* dstb = (sec == 0 ? qb : kb) + tok * 136 + 16 * cg;
                u32x4 w;
                w.x = cvt_pk_bf16(a[0], a[1]); w.y = cvt_pk_bf16(a[2], a[3]); w.z = cvt_pk_bf16(a[4], a[5]); w.w = cvt_pk_bf16(a[6], a[7]); *(LAS u32x4*)dstb = w;
                w.x = cvt_pk_bf16(a[8], a[9]); w.y = cvt_pk_bf16(a[10], a[11]); w.z = cvt_pk_bf16(a[12], a[13]); w.w = cvt_pk_bf16(a[14], a[15]); *(LAS u32x4*)(dstb + 8) = w;
                if (sec == 0) {
#pragma unroll
                    for (int g4 = 0; g4 < 4; ++g4) { const int a0 = 16 * cg + 4 * g4, sl = a0 >> 5, pp = invperm32(a0 & 31), chunk = 4 * sl + (pp >> 3), within = pp & 7;
                        u32x2 o; o.x = cvt_pk_bf16(a[4 * g4] * eg, a[4 * g4 + 1] * eg); o.y = cvt_pk_bf16(a[4 * g4 + 2] * eg, a[4 * g4 + 3] * eg);
                        *(LAS u32x2*)(img + tok * 256 + ((chunk ^ (tok & 15)) << 4) + within * 2) = o; }
                }
            } else {
#pragma unroll
                for (int i = 0; i < 16; ++i) vf[tok * 129 + 16 * cg + i] = a[i];
            }
        }
    }
    __syncthreads();
    {
        const float gl = gcs[63];
#pragma unroll
        for (int it = 0; it < 2; ++it) { const int pc = tid + 512 * it, r = pc & 127, ch = pc >> 7, sp = ch >> 2, q = ch & 3; float v[8];
#pragma unroll
            for (int i = 0; i < 8; ++i) { const int cc = 32 * sp + (i < 4 ? 4 * q + i : 16 + 4 * q + (i - 4)); v[i] = bf2f(kb[cc * 136 + r]) * __expf(gl - gcs[cc]); }
            u32x4 w; w.x = cvt_pk_bf16(v[0], v[1]); w.y = cvt_pk_bf16(v[2], v[3]); w.z = cvt_pk_bf16(v[4], v[5]); w.w = cvt_pk_bf16(v[6], v[7]);
            *(LAS u32x4*)(img + 16384 + r * 128 + ((ch ^ ((r >> 1) & 7)) << 4)) = w; }
    }
    {
        const int m = lane & 15, q = lane >> 4;
        for (int i4 = 0; i4 < 4; ++i4) {
            const int id = c.wave * 4 + i4, which = id >> 4, tile = id & 15, mt = tile >> 2, ntl = tile & 3;
            f32x4 acc = (f32x4){0.f, 0.f, 0.f, 0.f};
            if (ntl <= mt) {
                const LAS bf16_t* Ab = which ? qb : kb;
#pragma unroll
                for (int s = 0; s < 4; ++s) { const bf16x8 av = *(const LAS bf16x8*)(Ab + (16 * mt + m) * 136 + 32 * s + 8 * q), bv = *(const LAS bf16x8*)(kb + (16 * ntl + m) * 136 + 32 * s + 8 * q);
                    acc = __builtin_amdgcn_mfma_f32_16x16x32_bf16(av, bv, acc, 0, 0, 0); }
            }
            const int j_ = 16 * ntl + m;
#pragma unroll
            for (int jj = 0; jj < 4; ++jj) { const int i_ = 16 * mt + 4 * q + jj;
                const float dec = (i_ >= j_) ? __expf(gcs[i_] - gcs[j_]) : 0.f;
                if (which == 0) { if (ntl <= mt) Am[j_ * 68 + i_] = (i_ > j_) ? gcs[64 + i_] * acc[jj] * dec : 0.f; }
                else { const int sp = j_ >> 5, pp = invperm32(j_ & 31), chunk = 4 * sp + (pp >> 3), within = pp & 7;
                    *(LAS bf16_t*)(img + 32768 + i_ * 128 + ((chunk ^ ((i_ >> 1) & 7)) << 4) + within * 2) = f2bf((i_ >= j_) ? acc[jj] * dec : 0.f); } }
        }
    }
    __syncthreads();
    float x[64];
    if (tid < 256) {
        if (tid < 128) {
#pragma unroll
            for (int r = 0; r < 64; ++r) x[r] = vf[r * 129 + tid] * gcs[64 + r];
        } else {
#pragma unroll
            for (int r = 0; r < 64; ++r) x[r] = bf2f(kb[r * 136 + (tid - 128)]) * gcs[64 + r] * __expf(gcs[r]);
        }
    }
    __syncthreads();
    if (tid < 256) {
        int zoff = 0; asm volatile("" : "+v"(zoff));
        const LAS float* Amz = Am + zoff;
#pragma unroll
        for (int j = 0; j < 63; ++j) {
            const float xj = x[j];
#pragma unroll
            for (int ib = (j + 1) / 4; ib < 16; ++ib) { const f32x4 a4 = *(const LAS f32x4*)(Amz + j * 68 + 4 * ib);
                if (4 * ib + 0 > j) x[4 * ib + 0] -= a4[0] * xj;
                if (4 * ib + 1 > j) x[4 * ib + 1] -= a4[1] * xj;
                if (4 * ib + 2 > j) x[4 * ib + 2] -= a4[2] * xj;
                if (4 * ib + 3 > j) x[4 * ib + 3] -= a4[3] * xj; }
        }
        if (tid < 128) {
            float* ucp = (float*)(p.ws + WS_UCP) + (size_t)unit * 8192 + (size_t)(tid >> 4) * 1024 + (tid & 15) * 4;
#pragma unroll
            for (int mt = 0; mt < 4; ++mt)
#pragma unroll
                for (int q = 0; q < 4; ++q) *(f32x4*)(ucp + mt * 256 + q * 64) = (f32x4){x[16 * mt + 4 * q], x[16 * mt + 4 * q + 1], x[16 * mt + 4 * q + 2], x[16 * mt + 4 * q + 3]};
        } else {
            const int kc = tid - 128, s = kc >> 5, pp = invperm32(kc & 31), chunk = 4 * s + (pp >> 3), within = pp & 7;
#pragma unroll
            for (int r = 0; r < 64; ++r) *(LAS bf16_t*)(lds + r * 256 + ((chunk ^ (r & 15)) << 4) + within * 2) = f2bf(-x[r]);
        }
    }
    __syncthreads();
    {
        unsigned char* dst = p.ws + WS_GBLK + (size_t)unit * GB_BYTES;
#pragma unroll
        for (int it = 0; it < 7; ++it) { const int pc = tid + 512 * it; const LAS unsigned char* src = pc < 1024 ? lds + pc * 16 : img + (pc - 1024) * 16;
            *(u32x4*)(dst + pc * 16) = *(const LAS u32x4*)src; }
        if (tid == 0) ((float*)(p.ws + WS_GL))[unit] = __expf(gcs[63]);
    }
    __syncthreads();
}


__device__ __forceinline__ void gdn_scan(const Ctx& c, const Params& p, int sidx) {
    const int h = sidx >> 1, half = sidx & 1;
    const unsigned char* blk = p.ws + WS_GBLK + (size_t)h * 128 * GB_BYTES;
    bf16_t* OG = (bf16_t*)(p.ws + WS_OGDN);
    LAS unsigned char* lds = c.lds;
    LAS unsigned char* ost = c.lds + LDS_OSTG;
    if (c.wave >= 4) {
        const int par = (c.wave - 4) >> 1, st = c.tid - 256 - 128 * par;
        const unsigned char* src = blk + (size_t)st * 16;
        u32x4 sr[28];
        if (par == 0) {
#pragma unroll
            for (int i = 0; i < 28; ++i) sr[i] = *(const u32x4*)(src + i * 2048);
#pragma unroll
            for (int i = 0; i < 28; ++i) *(LAS u32x4*)(lds + st * 16 + i * 2048) = sr[i];
#pragma unroll
            for (int i = 0; i < 28; ++i) sr[i] = *(const u32x4*)(src + 2 * (size_t)GB_BYTES + i * 2048);
        } else {
#pragma unroll
            for (int i = 0; i < 28; ++i) sr[i] = *(const u32x4*)(src + (size_t)GB_BYTES + i * 2048);
        }
        __syncthreads();
        for (int n = 0; n < 128; ++n) {
            if (((n + 1) & 1) == par) {
                if (n + 1 < 128) {
#pragma unroll
                    for (int i = 0; i < 28; ++i) *(LAS u32x4*)(lds + ((n + 1) & 1) * GB_BYTES + st * 16 + i * 2048) = sr[i];
                }
                if (n + 3 < 128) {
#pragma unroll
                    for (int i = 0; i < 28; ++i) sr[i] = *(const u32x4*)(src + (size_t)(n + 3) * GB_BYTES + i * 2048);
                }
            } else if (n > 0) {
#pragma unroll
                for (int i = 0; i < 4; ++i) { const int pc = st + 128 * i, r = pc >> 3, ch = pc & 7;
                    *(u32x4*)(OG + (size_t)((n - 1) * 64 + r) * 768 + h * 128 + 64 * half + 8 * ch) = *(const LAS u32x4*)(ost + ((n - 1) & 1) * 8192 + r * 128 + ch * 16); }
            }
            WG_BAR_LDS();
        }
        if (par == 0) {
#pragma unroll
            for (int i = 0; i < 4; ++i) { const int pc = st + 128 * i, r = pc >> 3, ch = pc & 7;
                *(u32x4*)(OG + (size_t)(127 * 64 + r) * 768 + h * 128 + 64 * half + 8 * ch) = *(const LAS u32x4*)(ost + 8192 + r * 128 + ch * 16); }
        }
        return;
    }
    const int wg = 4 * half + c.wave;
    const float* UCp = (const float*)(p.ws + WS_UCP) + (size_t)h * 128 * 8192 + (size_t)wg * 1024 + c.lane * 4;
    const float* GL = (const float*)(p.ws + WS_GL) + h * 128;
    const int lane = c.lane, m = lane & 15, q = lane >> 4;
    int o128[4], o64[2];
#pragma unroll
    for (int s = 0; s < 4; ++s) o128[s] = m * 256 + (((4 * s + q) ^ m) << 4);
#pragma unroll
    for (int s = 0; s < 2; ++s) o64[s] = m * 128 + (((4 * s + q) ^ (m >> 1)) << 4);
    f32x4 S[8];
#pragma unroll
    for (int i = 0; i < 8; ++i) S[i] = (f32x4){0.f, 0.f, 0.f, 0.f};
    f32x4 ucA[4], ucB[4]; float glA, glB;
#pragma unroll
    for (int mt = 0; mt < 4; ++mt) { ucA[mt] = *(const f32x4*)(UCp + mt * 256); ucB[mt] = *(const f32x4*)(UCp + 8192 + mt * 256); }
    glA = GL[0]; glB = GL[1];
    __syncthreads();
#define SCAN_LD(pp) (*(const LAS bf16x8*)(pp))
#define SCAN_STEP(NN, BUF, UC, GLV) do { \
        const LAS unsigned char* B = lds + (BUF) * GB_BYTES; \
        bf16x8 Sb[4]; \
        _Pragma("unroll") for (int s = 0; s < 4; ++s) Sb[s] = pack_bf16x8(S[2 * s], S[2 * s + 1]); \
        bf16x8 Aw[16], Aq[16]; \
        _Pragma("unroll") for (int mt = 0; mt < 4; ++mt) _Pragma("unroll") for (int s = 0; s < 4; ++s) Aw[mt * 4 + s] = SCAN_LD(B + GB_WC + mt * 4096 + o128[s]); \
        _Pragma("unroll") for (int mt = 0; mt < 4; ++mt) _Pragma("unroll") for (int s = 0; s < 4; ++s) Aq[mt * 4 + s] = SCAN_LD(B + GB_QD + mt * 4096 + o128[s]); \
        f32x4 vn[4]; \
        _Pragma("unroll") for (int mt = 0; mt < 4; ++mt) vn[mt] = UC[mt]; \
        _Pragma("unroll") for (int s = 0; s < 4; ++s) _Pragma("unroll") for (int mt = 0; mt < 4; ++mt) vn[mt] = __builtin_amdgcn_mfma_f32_16x16x32_bf16(Aw[mt * 4 + s], Sb[s], vn[mt], 0, 0, 0); \
        bf16x8 Ak[16]; \
        _Pragma("unroll") for (int i = 0; i < 8; ++i) _Pragma("unroll") for (int s = 0; s < 2; ++s) Ak[i * 2 + s] = SCAN_LD(B + GB_KDT + i * 2048 + o64[s]); \
        f32x4 Oa[4]; \
        _Pragma("unroll") for (int mt = 0; mt < 4; ++mt) Oa[mt] = (f32x4){0.f, 0.f, 0.f, 0.f}; \
        _Pragma("unroll") for (int s = 0; s < 4; ++s) _Pragma("unroll") for (int mt = 0; mt < 4; ++mt) Oa[mt] = __builtin_amdgcn_mfma_f32_16x16x32_bf16(Aq[mt * 4 + s], Sb[s], Oa[mt], 0, 0, 0); \
        bf16x8 Vb[2]; Vb[0] = pack_bf16x8(vn[0], vn[1]); Vb[1] = pack_bf16x8(vn[2], vn[3]); \
        bf16x8 Ap[8]; \
        _Pragma("unroll") for (int mt = 0; mt < 4; ++mt) _Pragma("unroll") for (int s = 0; s < 2; ++s) Ap[mt * 2 + s] = SCAN_LD(B + GB_QK + mt * 2048 + o64[s]); \
        _Pragma("unroll") for (int i = 0; i < 8; ++i) S[i] = S[i] * (GLV); \
        _Pragma("unroll") for (int s = 0; s < 2; ++s) _Pragma("unroll") for (int i = 0; i < 8; ++i) S[i] = __builtin_amdgcn_mfma_f32_16x16x32_bf16(Ak[i * 2 + s], Vb[s], S[i], 0, 0, 0); \
        _Pragma("unroll") for (int s = 0; s < 2; ++s) _Pragma("unroll") for (int mt = 0; mt < 4; ++mt) Oa[mt] = __builtin_amdgcn_mfma_f32_16x16x32_bf16(Ap[mt * 2 + s], Vb[s], Oa[mt], 0, 0, 0); \
        _Pragma("unroll") for (int mt = 0; mt < 4; ++mt) _Pragma("unroll") for (int jj = 0; jj < 4; ++jj) \
            *(LAS bf16_t*)(ost + (BUF) * 8192 + (16 * mt + 4 * q + jj) * 128 + (16 * c.wave + m) * 2) = f2bf(Oa[mt][jj]); \
    } while (0)
    for (int n = 0; n < 128; n += 2) {
        SCAN_STEP(n, 0, ucA, glA);
        if (n + 2 < 128) {
#pragma unroll
            for (int mt = 0; mt < 4; ++mt) ucA[mt] = *(const f32x4*)(UCp + (size_t)(n + 2) * 8192 + mt * 256);
            glA = GL[n + 2]; }
        WG_BAR_LDS();
        SCAN_STEP(n + 1, 1, ucB, glB);
        if (n + 3 < 128) {
#pragma unroll
            for (int mt = 0; mt < 4; ++mt) ucB[mt] = *(const f32x4*)(UCp + (size_t)(n + 3) * 8192 + mt * 256);
            glB = GL[n + 3]; }
        WG_BAR_LDS();
    }
#undef SCAN_STEP
#undef SCAN_LD
}


template <class Epi, bool UP, class Order>
__device__ __forceinline__ void moe_gemm(const Ctx& c, const bf16_t* A, const float* Wl, const Order& S, const Epi& E) {
    constexpr int K = UP ? D : EH, NW = UP ? 1024 : D, NSTEP = K / 64, STG = 49152;
    int tid = threadIdx.x; asm volatile("" : "+v"(tid));
    const int wid = __builtin_amdgcn_readfirstlane(tid >> 6), lane = tid & 63, wr = wid >> 2, wc = wid & 3, fr = lane & 15, fq = lane >> 4;
    LAS unsigned char* lds = c.lds;
    const int par = wid & 1, tp = lane + 64 * (wid >> 1);
    const int bk = tp >> 6, bc4 = tp & 63;
    const int ar = tp >> 3, ach = tp & 7;
    const unsigned a_rd0 = (unsigned)((64 * wr + fr) * 128 + (((0 + fq) ^ ((fr >> 1) & 7)) << 4)), a_rd1 = (unsigned)((64 * wr + fr) * 128 + (((4 + fq) ^ ((fr >> 1) & 7)) << 4));
    const unsigned q4 = (lane & 15) >> 2, p4 = lane & 3, qb = fq & 1;
    const unsigned b_base = 16384u + (8u * fq + q4) * 512u + 64u * ((unsigned)wc ^ q4) + 16u * p4;
    const unsigned b00 = b_base + 8u * qb, b01 = b_base + 8u * (1u - qb), b10 = b00 + 4u * 512u, b11 = b01 + 4u * 512u;
    pg8::Unit u;
    for (int ui = 0; S.next(ui, u); ++ui) {
        const int e = S.tb.mt_e[u.pm], j = u.pn - e * S.nN;
        const float* Wb = Wl + (size_t)e * K * NW + (UP ? ((bc4 < 32) ? 128 * j + 4 * bc4 : 512 + 128 * j + 4 * (bc4 - 32)) : 256 * j + 4 * bc4) + (size_t)bk * NW;
        const bf16_t* Ap[4];
#pragma unroll
        for (int i = 0; i < 4; ++i) { const int row = ar + 32 * i; Ap[i] = (UP ? A + (size_t)S.arow(u, row) * K : A + (size_t)(u.pm * 128 + row) * K) + 8 * (ach ^ ((row >> 1) & 7)); }
        f32x4 acc[2][4][2];
#pragma unroll
        for (int b = 0; b < 2; ++b)
#pragma unroll
            for (int m = 0; m < 4; ++m)
#pragma unroll
                for (int n = 0; n < 2; ++n) acc[b][m][n] = (f32x4){0.f, 0.f, 0.f, 0.f};
        f32x4 wv[16]; u32x4 av[4];
#define MOE_LOAD(T) do { _Pragma("unroll") for (int i = 0; i < 16; ++i) wv[i] = *(const f32x4*)(Wb + (size_t)((T) * 64 + 4 * i) * NW); \
        _Pragma("unroll") for (int i = 0; i < 4; ++i) av[i] = *(const u32x4*)(Ap[i] + (T) * 64); } while (0)
#define MOE_WRITE(T) do { LAS unsigned char* sb = lds + ((T) & 1) * STG; \
        _Pragma("unroll") for (int i = 0; i < 4; ++i) *(LAS u32x4*)(sb + (ar + 32 * i) * 128 + ach * 16) = av[i]; \
        _Pragma("unroll") for (int i = 0; i < 16; ++i) { const int kk = bk + 4 * i; u32x2 w2; w2.x = cvt_pk_bf16(wv[i][0], wv[i][1]); w2.y = cvt_pk_bf16(wv[i][2], wv[i][3]); \
            *(LAS u32x2*)(sb + 16384 + kk * 512 + ((8 * bc4) ^ ((((kk >> 3) & 1) << 3) | ((kk & 3) << 6)))) = w2; } } while (0)
        if (par == 0) { MOE_LOAD(0); MOE_WRITE(0); if (2 < NSTEP) MOE_LOAD(2); }
        else { if (1 < NSTEP) MOE_LOAD(1); }
        for (int t = 0; t < NSTEP; ++t) {
            __syncthreads();
            if (((t + 1) & 1) == par) { if (t + 1 < NSTEP) MOE_WRITE(t + 1); if (t + 3 < NSTEP) MOE_LOAD(t + 3); }
            const unsigned so = (unsigned)(t & 1) * STG;
#pragma unroll
            for (int s2 = 0; s2 < 2; ++s2) {
                bf16x8 Bf[2][2];
#pragma unroll
                for (int bj = 0; bj < 2; ++bj) { Bf[bj][0] = tr_pair(lds + so + b00 + 256 * bj + 16384 * s2, lds + so + b10 + 256 * bj + 16384 * s2);
                                                 Bf[bj][1] = tr_pair(lds + so + b01 + 256 * bj + 16384 * s2, lds + so + b11 + 256 * bj + 16384 * s2); }
                bf16x8 Af[4];
#pragma unroll
                for (int m = 0; m < 4; ++m) Af[m] = *(const LAS bf16x8*)(lds + so + (s2 ? a_rd1 : a_rd0) + m * 2048);
#pragma unroll
                for (int bj = 0; bj < 2; ++bj)
#pragma unroll
                    for (int m = 0; m < 4; ++m)
#pragma unroll
                        for (int n = 0; n < 2; ++n) acc[bj][m][n] = __builtin_amdgcn_mfma_f32_16x16x32_bf16(Bf[bj][n], Af[m], acc[bj][m][n], 0, 0, 0);
            }
        }
#undef MOE_LOAD
#undef MOE_WRITE
        E(acc, u, wr, wc, fr, fq);
        if constexpr (UP) asm volatile("s_waitcnt vmcnt(0)" ::: "memory");
        __syncthreads();
        if constexpr (UP) { if (tid == 0) { __builtin_amdgcn_fence(__ATOMIC_RELEASE, "agent"); asm volatile("s_waitcnt vmcnt(0)" ::: "memory");
            (void)__hip_atomic_fetch_add(S.done + u.pm, 1u, __ATOMIC_RELAXED, __HIP_MEMORY_SCOPE_AGENT); } }
    }
}

__device__ __forceinline__ void m2_rd_b(bf16x8& b0, bf16x8& b1, unsigned a0, unsigned a1) {
    s16x4 x0, x1, x2, x3;
    asm volatile("ds_read_b64_tr_b16 %0, %4\n\tds_read_b64_tr_b16 %1, %4 offset:1024\n\tds_read_b64_tr_b16 %2, %5\n\tds_read_b64_tr_b16 %3, %5 offset:1024\n\ts_waitcnt lgkmcnt(0)"
                 : "=&v"(x0), "=&v"(x1), "=&v"(x2), "=&v"(x3) : "v"(a0), "v"(a1) : "memory");
    b0 = __builtin_shufflevector(x0, x1, 0, 1, 2, 3, 4, 5, 6, 7); b1 = __builtin_shufflevector(x2, x3, 0, 1, 2, 3, 4, 5, 6, 7); }
__device__ __forceinline__ void m2_rd_a4(bf16x8 (&a)[4], unsigned addr) {
    asm volatile("ds_read_b128 %0, %4\n\tds_read_b128 %1, %4 offset:2048\n\tds_read_b128 %2, %4 offset:4096\n\tds_read_b128 %3, %4 offset:6144\n\ts_waitcnt lgkmcnt(0)"
                 : "=&v"(a[0]), "=&v"(a[1]), "=&v"(a[2]), "=&v"(a[3]) : "v"(addr) : "memory"); }
__device__ __forceinline__ void m2_rd_ba(bf16x8& b0, bf16x8& b1, bf16x8 (&a)[4], unsigned a0, unsigned a1, unsigned addr) {
    s16x4 x0, x1, x2, x3;
    asm volatile("ds_read_b64_tr_b16 %0, %8\n\tds_read_b64_tr_b16 %1, %8 offset:1024\n\tds_read_b64_tr_b16 %2, %9\n\tds_read_b64_tr_b16 %3, %9 offset:1024\n\t"
                 "ds_read_b128 %4, %10\n\tds_read_b128 %5, %10 offset:2048\n\tds_read_b128 %6, %10 offset:4096\n\tds_read_b128 %7, %10 offset:6144\n\ts_waitcnt lgkmcnt(0)"
                 : "=&v"(x0), "=&v"(x1), "=&v"(x2), "=&v"(x3), "=&v"(a[0]), "=&v"(a[1]), "=&v"(a[2]), "=&v"(a[3]) : "v"(a0), "v"(a1), "v"(addr) : "memory");
    b0 = __builtin_shufflevector(x0, x1, 0, 1, 2, 3, 4, 5, 6, 7); b1 = __builtin_shufflevector(x2, x3, 0, 1, 2, 3, 4, 5, 6, 7); }
template <bool UP, int MODE, class Order, class Epi>
__device__ __forceinline__ void moe_gemm2(const Ctx& c, const bf16_t* A, const float* Wl, const int* tok, const Order& S, const Epi& E) {
    constexpr int K = UP ? D : EH, NW = UP ? 1024 : D, NSTEP = K / 64;
    constexpr unsigned ASTG = 49152u, BOFF = 98304u, BSTG = 16384u;
    int tid = threadIdx.x; asm volatile("" : "+v"(tid));
    const int wid = __builtin_amdgcn_readfirstlane(tid >> 6), lane = tid & 63, wr = wid >> 2, wc = wid & 3, fr = lane & 15, fq = lane >> 4;
    LAS unsigned char* lds = c.lds; const unsigned ldsb = (unsigned)(unsigned long long)lds;
    const int par = wid & 1, gi = wid >> 1, tp = lane + 64 * gi;
    const int bk = tp >> 5, bc = tp & 31;
    const int pimg = UP ? (((bc & 15) >> 2) * 8 + (bc & 3) * 2 + (bc >> 4)) : bc;
    const unsigned bw0 = (unsigned)(bk * 256) + (unsigned)((8 * pimg) ^ ((bk & 3) << 6));
    const unsigned a_rd0 = (unsigned)((64 * wr + fr) * 128 + (((0 + fq) ^ ((fr >> 1) & 7)) << 4)), a_rd1 = (unsigned)((64 * wr + fr) * 128 + (((4 + fq) ^ ((fr >> 1) & 7)) << 4));
    const unsigned q4 = (lane & 15) >> 2, p4 = lane & 3, qb = fq & 1;
    const unsigned b_base = BOFF + (8u * fq + q4) * 256u + 64u * ((unsigned)wc ^ q4) + 16u * p4;
    const unsigned b00 = b_base + 8u * qb, b01 = b_base + 8u * (1u - qb);
    const int drow = lane >> 3; const unsigned dch = (unsigned)(((lane & 7) ^ ((4 * (gi & 1) + (lane >> 4)) & 7)) << 4);
    int rt, j;
    for (int ui = 0; S.next(ui, rt, j); ++ui) {
        const int e = S.tb.rt_e[rt], r0 = S.tb.rt_r0[rt], ne = S.tb.cnt[e], row0 = S.tb.first[e] * 128 + r0;
        const int rows = (ne - r0) < 384 ? (ne - r0) : 384, nb = (rows + 127) >> 7;
        const float* Wb = Wl + (size_t)e * K * NW + (UP ? ((bc < 16) ? 64 * j + 4 * bc : 512 + 64 * j + 4 * (bc - 16)) : 128 * j + 4 * bc) + (size_t)bk * NW;
        unsigned aoff[12];
#pragma unroll
        for (int i = 0; i < 12; ++i) { const int pos = r0 + 8 * (4 * i + gi) + drow; int ar;
            if constexpr (UP) { ar = 0; if (pos < ne) ar = tok[e * 8192 + pos] >> 1; } else ar = row0 - r0 + pos;
            aoff[i] = (unsigned)ar * (unsigned)(K * 2) + dch; }
        f32x4 acc[3][4][2];
#pragma unroll
        for (int b = 0; b < 3; ++b)
#pragma unroll
            for (int m = 0; m < 4; ++m)
#pragma unroll
                for (int n = 0; n < 2; ++n) acc[b][m][n] = (f32x4){0.f, 0.f, 0.f, 0.f};
        f32x4 wv[8];
        if constexpr (MODE & 1) { _Pragma("unroll") for (int i = 0; i < 8; ++i) wv[i] = (f32x4){1.f, 1.f, 1.f, 1.f}; }
#define M2_LOAD(T) do { if constexpr (!(MODE & 1)) { _Pragma("unroll") for (int i = 0; i < 8; ++i) wv[i] = *(const f32x4*)(Wb + (size_t)((T) * 64 + 8 * i) * NW); } } while (0)
#define M2_LOAD2(T, P) do { if constexpr (!(MODE & 1)) { wv[2 * (P)] = *(const f32x4*)(Wb + (size_t)((T) * 64 + 16 * (P)) * NW); wv[2 * (P) + 1] = *(const f32x4*)(Wb + (size_t)((T) * 64 + 16 * (P) + 8) * NW); } } while (0)
#define M2_WRITE(T) do { LAS unsigned char* sb = lds + BOFF + ((T) & 1) * BSTG; \
        _Pragma("unroll") for (int i = 0; i < 8; ++i) { u32x2 w2; w2.x = cvt_pk_bf16(wv[i][0], wv[i][1]); w2.y = cvt_pk_bf16(wv[i][2], wv[i][3]); \
            *(LAS u32x2*)(sb + (bw0 ^ (unsigned)((i & 1) << 3)) + i * 2048) = w2; } } while (0)
#define M2_DMA(T) do { LAS unsigned char* sa = lds + ((T) & 1) * ASTG + gi * 1024; const char* ga = (const char*)A + (T) * 128; \
        _Pragma("unroll") for (int i = 0; i < 12; ++i) if (8 * (4 * i + gi) < rows && !(MODE & 2)) __builtin_amdgcn_global_load_lds((const unsigned*)(ga + aoff[i]), (LAS unsigned*)(sa + i * 4096), 16, 0, 0); } while (0)
        __syncthreads();
        if (par == 0) { M2_LOAD(0); M2_WRITE(0); M2_LOAD(2); }
        else { M2_LOAD(1); M2_DMA(0); asm volatile("s_waitcnt vmcnt(0)" ::: "memory"); }
        for (int t = 0; t < NSTEP; ++t) {
            asm volatile("s_waitcnt lgkmcnt(0)" ::: "memory"); __builtin_amdgcn_s_barrier(); asm volatile("" ::: "memory");
            if (((t + 1) & 1) == par) { if (t + 1 < NSTEP) M2_WRITE(t + 1); if (t + 3 < NSTEP) M2_LOAD(t + 3); }
            else { if (t + 1 < NSTEP) M2_DMA(t + 1); }
            const unsigned sa = (unsigned)(t & 1) * ASTG, sbo = (unsigned)(t & 1) * BSTG;
#pragma unroll
            for (int s2 = 0; s2 < ((MODE & 4) ? 0 : 2); ++s2) {
                bf16x8 Bf[2], Af[4];
                m2_rd_ba(Bf[0], Bf[1], Af, ldsb + sbo + b00 + 8192 * s2, ldsb + sbo + b01 + 8192 * s2, ldsb + sa + (s2 ? a_rd1 : a_rd0));
#pragma unroll
                for (int blk = 0; blk < 3; ++blk) {
                    const int mc = (rows - blk * 128 - wr * 64 + 15) >> 4;
                    if (mc > 0) {
                        if (blk > 0) m2_rd_a4(Af, ldsb + sa + blk * 16384 + (s2 ? a_rd1 : a_rd0));
#pragma unroll
                        for (int m = 0; m < 4; ++m) if (m < mc) {
#pragma unroll
                            for (int n = 0; n < 2; ++n) acc[blk][m][n] = __builtin_amdgcn_mfma_f32_16x16x32_bf16(Bf[n], Af[m], acc[blk][m][n], 0, 0, 0); }
                    }
                }
            }
            if (((t + 1) & 1) != par) asm volatile("s_waitcnt vmcnt(0)" ::: "memory");
        }
#undef M2_LOAD
#undef M2_LOAD2
#undef M2_WRITE
#undef M2_DMA
        E(acc, row0, nb, e, r0, ne, j, wr, wc, fr, fq);
        if constexpr (UP) { asm volatile("s_waitcnt vmcnt(0)" ::: "memory");
            __syncthreads();
            if (tid == 0) { __builtin_amdgcn_fence(__ATOMIC_RELEASE, "agent"); asm volatile("s_waitcnt vmcnt(0)" ::: "memory");
                (void)__hip_atomic_fetch_add(S.done + rt, 1u, __ATOMIC_RELAXED, __HIP_MEMORY_SCOPE_AGENT); } }
    }
}

__device__ __forceinline__ void phase_local(const Ctx& c, const Params& p, int L) {
    const bf16_t* U = (const bf16_t*)(p.ws + WS_U);
    const int gw = c.bid * 8 + c.wave, GW = c.G * 8, lane = c.lane;
    for (int rep = 0; rep < 1 + (p.pad == 1); ++rep)
    for (int unit = c.bid; unit < 768; unit += c.G) gdn_chunk_local(c, p, L, unit);
    for (int rep = 0; rep < 1 + (p.pad == 2); ++rep) {
        bf16_t* YB = (bf16_t*)(p.ws + WS_YBR) + (size_t)1 * T * 768;
        const float* cbw = p.conv_b_w + (size_t)L * 31 * 768; const float* cbb = p.conv_b_b + L * 768; const float* lg = p.ln_b_g + L * 768; const float* lb = p.ln_b_b + L * 768;
        LAS unsigned char* glu = c.lds;
        LAS unsigned char* cbs = c.lds + 70656;
        for (int tile = c.bid; tile < T / 16; tile += c.G) {
            const int t0 = tile * 16;
            for (int it = c.tid; it < 46 * 96; it += NTHREADS) { const int rr = it / 96, c8 = it - rr * 96, tt = t0 - 30 + rr; u32x4 w = (u32x4){0u, 0u, 0u, 0u};
                if (tt >= 0) { const u32x4 ga = *(const u32x4*)(U + (size_t)tt * NU + UC_B + 8 * c8), gb = *(const u32x4*)(U + (size_t)tt * NU + UC_B + 768 + 8 * c8);
                    w.x = cvt_pk_bf16(bflo(ga.x) * sigmoidf_(bflo(gb.x)), bfhi(ga.x) * sigmoidf_(bfhi(gb.x))); w.y = cvt_pk_bf16(bflo(ga.y) * sigmoidf_(bflo(gb.y)), bfhi(ga.y) * sigmoidf_(bfhi(gb.y)));
                    w.z = cvt_pk_bf16(bflo(ga.z) * sigmoidf_(bflo(gb.z)), bfhi(ga.z) * sigmoidf_(bfhi(gb.z))); w.w = cvt_pk_bf16(bflo(ga.w) * sigmoidf_(bflo(gb.w)), bfhi(ga.w) * sigmoidf_(bfhi(gb.w))); }
                *(LAS u32x4*)(glu + rr * 1536 + c8 * 16) = w; }
            __syncthreads();
            if (c.tid < 384) {
                float w0[31], w1[31], a0[16], a1[16];
#pragma unroll
                for (int j = 0; j < 31; ++j) { const float2 wv = *(const float2*)(cbw + j * 768 + 2 * c.tid); w0[j] = wv.x; w1[j] = wv.y; }
#pragma unroll
                for (int t = 0; t < 16; ++t) { a0[t] = 0.f; a1[t] = 0.f; }
#pragma unroll
                for (int rr = 0; rr < 46; ++rr) { const unsigned g2 = *(const LAS unsigned*)(glu + rr * 1536 + c.tid * 4); const float lo = bflo(g2), hi = bfhi(g2);
#pragma unroll
                    for (int t = 0; t < 16; ++t) { const int j = rr - t; if (j >= 0 && j <= 30) { a0[t] += w0[j] * lo; a1[t] += w1[j] * hi; } } }
                const float2 bv = *(const float2*)(cbb + 2 * c.tid);
#pragma unroll
                for (int t = 0; t < 16; ++t) *(LAS f32x2*)(cbs + t * 3072 + c.tid * 8) = (f32x2){a0[t] + bv.x, a1[t] + bv.y};
            }
            __syncthreads();
            for (int i = 0; i < 2; ++i) { const int tl = c.wave * 2 + i; f32x2 v[6]; float sm = 0.f;
#pragma unroll
                for (int k = 0; k < 6; ++k) { v[k] = *(const LAS f32x2*)(cbs + tl * 3072 + (lane + 64 * k) * 8); sm += v[k].x + v[k].y; }
                const float mu = wave_sum(sm, lane) * (1.0f / 768.f); float vs = 0.f;
#pragma unroll
                for (int k = 0; k < 6; ++k) { const float d0 = v[k].x - mu, d1 = v[k].y - mu; vs += d0 * d0 + d1 * d1; }
                const float rs = rsqrtf(wave_sum(vs, lane) * (1.0f / 768.f) + 1e-5f);
#pragma unroll
                for (int k = 0; k < 6; ++k) { const int ch = 2 * (lane + 64 * k); const float2 gg = *(const float2*)(lg + ch), bb = *(const float2*)(lb + ch);
                    const float y0 = (v[k].x - mu) * rs * gg.x + bb.x, y1 = (v[k].y - mu) * rs * gg.y + bb.y;
                    *(unsigned*)(YB + (size_t)(t0 + tl) * 768 + ch) = cvt_pk_bf16(siluf_(y0), siluf_(y1)); } }
            __syncthreads();
        }
    }
    for (int rep = 0; rep < 1 + (p.pad == 3); ++rep) {
        bf16_t* QR = (bf16_t*)(p.ws + WS_QR); bf16_t* KR = (bf16_t*)(p.ws + WS_KR);
        int rtid = c.tid; asm volatile("" : "+v"(rtid));
        for (int it = c.bid * NTHREADS + rtid; it < T * 8; it += c.G * NTHREADS) {
            const int t = it >> 3, c8 = it & 7; const float ps = (float)p.pos[t]; float cs[8], sn[8];
#pragma unroll
            for (int i = 0; i < 8; ++i) {
                double rev = (double)ps * (double)ROPE_INV[8 * c8 + i] * 0.15915494309189535; rev -= floor(rev);
                const float fr = (float)rev; cs[i] = __builtin_amdgcn_cosf(fr); sn[i] = __builtin_amdgcn_sinf(fr); }
            for (int hb = 0; hb < 36; hb += 4) {
                u32x4 x1[4], x2[4];
#pragma unroll
                for (int j = 0; j < 4; ++j) { const int hv = hb + j, isk = hv >= 18, hh = hv - 18 * isk; const bf16_t* src = U + (size_t)t * NU + UC_C + isk * 2304 + hh * 128 + 8 * c8;
                    x1[j] = *(const u32x4*)src; x2[j] = *(const u32x4*)(src + 64); }
#pragma unroll
                for (int j = 0; j < 4; ++j) { const int hv = hb + j, isk = hv >= 18, hh = hv - 18 * isk; const float sc = isk ? 1.0f : 0.08838834764831845f;
                    float a[8], b[8];
                    a[0] = bflo(x1[j].x); a[1] = bfhi(x1[j].x); a[2] = bflo(x1[j].y); a[3] = bfhi(x1[j].y); a[4] = bflo(x1[j].z); a[5] = bfhi(x1[j].z); a[6] = bflo(x1[j].w); a[7] = bfhi(x1[j].w);
                    b[0] = bflo(x2[j].x); b[1] = bfhi(x2[j].x); b[2] = bflo(x2[j].y); b[3] = bfhi(x2[j].y); b[4] = bflo(x2[j].z); b[5] = bfhi(x2[j].z); b[6] = bflo(x2[j].w); b[7] = bfhi(x2[j].w);
                    float o1[8], o2[8];
#pragma unroll
                    for (int i = 0; i < 8; ++i) { o1[i] = (a[i] * cs[i] - b[i] * sn[i]) * sc; o2[i] = (b[i] * cs[i] + a[i] * sn[i]) * sc; }
                    bf16_t* dst = (isk ? KR : QR) + (size_t)t * 2304 + hh * 128 + 8 * c8;
                    u32x4 w1, w2; w1.x = cvt_pk_bf16(o1[0], o1[1]); w1.y = cvt_pk_bf16(o1[2], o1[3]); w1.z = cvt_pk_bf16(o1[4], o1[5]); w1.w = cvt_pk_bf16(o1[6], o1[7]);
                    w2.x = cvt_pk_bf16(o2[0], o2[1]); w2.y = cvt_pk_bf16(o2[2], o2[3]); w2.z = cvt_pk_bf16(o2[4], o2[5]); w2.w = cvt_pk_bf16(o2[6], o2[7]);
                    *(u32x4*)dst = w1; *(u32x4*)(dst + 64) = w2; }
            }
        }
    }
    for (int rep = 0; rep < 1 + (p.pad == 4); ++rep) {
        bf16_t* YD = (bf16_t*)(p.ws + WS_YBR) + (size_t)3 * T * 768;
        const bf16_t* PWT = (const bf16_t*)(p.ws + WS_PWT) + (size_t)L * 4 * 192 * 192;
        LAS unsigned char* pim = c.lds;
        const int m = lane & 15, q = lane >> 4;
        for (int tile = c.bid; tile < T / 32; tile += c.G) {
            const int t0 = tile * 32;
            for (int it = c.tid; it < 32 * 96; it += NTHREADS) { const int rr = it / 96, c8 = it - rr * 96, t = t0 + rr, g = c8 / 24, w = 2 << g, cnt = (t + 1) < w ? (t + 1) : w;
                float sacc[8];
#pragma unroll
                for (int i = 0; i < 8; ++i) sacc[i] = 0.f;
                const bf16_t* up = U + (size_t)t * NU + UC_D + 8 * c8; u32x4 x0 = (u32x4){0u, 0u, 0u, 0u};
#pragma unroll
                for (int d = 0; d < 16; ++d) { if (d >= cnt) break; const u32x4 xv = *(const u32x4*)(up - (size_t)d * NU); if (d == 0) x0 = xv;
                    sacc[0] += bflo(xv.x); sacc[1] += bfhi(xv.x); sacc[2] += bflo(xv.y); sacc[3] += bfhi(xv.y); sacc[4] += bflo(xv.z); sacc[5] += bfhi(xv.z); sacc[6] += bflo(xv.w); sacc[7] += bfhi(xv.w); }
                const float ic = __builtin_amdgcn_rcpf((float)cnt); u32x4 o;
                o.x = cvt_pk_bf16(sacc[0] * ic - bflo(x0.x), sacc[1] * ic - bfhi(x0.x)); o.y = cvt_pk_bf16(sacc[2] * ic - bflo(x0.y), sacc[3] * ic - bfhi(x0.y));
                o.z = cvt_pk_bf16(sacc[4] * ic - bflo(x0.z), sacc[5] * ic - bfhi(x0.z)); o.w = cvt_pk_bf16(sacc[6] * ic - bflo(x0.w), sacc[7] * ic - bfhi(x0.w));
                *(LAS u32x4*)(pim + rr * 1536 + ((c8 ^ (rr & 15)) << 4)) = o; }
            __syncthreads();
            f32x4 pa0[6], pa1[6];
#pragma unroll
            for (int pr = 0; pr < 6; ++pr) { const int pair = c.wave * 6 + pr, g = pair / 12, ntl = pair - g * 12;
                f32x4 acc0 = (f32x4){0.f, 0.f, 0.f, 0.f}, acc1 = (f32x4){0.f, 0.f, 0.f, 0.f};
                const bf16_t* bp = PWT + (size_t)(g * 192 + 16 * ntl + m) * 192 + 8 * q;
#pragma unroll
                for (int s6 = 0; s6 < 6; ++s6) { const bf16x8 bv = *(const bf16x8*)(bp + 32 * s6); const int ch = g * 24 + 4 * s6 + q;
                    const bf16x8 a0v = *(const LAS bf16x8*)(pim + m * 1536 + ((ch ^ m) << 4)), a1v = *(const LAS bf16x8*)(pim + (16 + m) * 1536 + ((ch ^ m) << 4));
                    acc0 = __builtin_amdgcn_mfma_f32_16x16x32_bf16(a0v, bv, acc0, 0, 0, 0); acc1 = __builtin_amdgcn_mfma_f32_16x16x32_bf16(a1v, bv, acc1, 0, 0, 0); }
                pa0[pr] = acc0; pa1[pr] = acc1; }
#pragma unroll
            for (int pr = 0; pr < 6; ++pr) { const int pair = c.wave * 6 + pr, g = pair / 12, ntl = pair - g * 12;
                bf16_t* yp = YD + (size_t)(t0 + 4 * q) * 768 + g * 192 + 16 * ntl + m;
#pragma unroll
                for (int jj = 0; jj < 4; ++jj) { yp[(size_t)jj * 768] = f2bf(pa0[pr][jj]); yp[(size_t)(16 + jj) * 768] = f2bf(pa1[pr][jj]); } }
            __syncthreads();
        }
    }
}

__device__ __forceinline__ unsigned off_b(unsigned row, unsigned ch) { return 256u * row + 16u * (ch ^ (((row & 3) << 2) | ((row >> 2) & 3))); }
#define ATT_PV4(OFF, A, DT0) do { \
    _Pragma("unroll") for (int i4 = 0; i4 < 4; ++i4) { \
        const bf16x8 vt = tr_pair(Vs + (vb0 + 32u * (unsigned)(((DT0) + i4) ^ cm0) + (OFF)), Vs + (vb1 + 32u * (unsigned)(((DT0) + i4) ^ cm1) + (OFF))); \
        O[(DT0) + i4] = __builtin_amdgcn_mfma_f32_16x16x32_bf16(vt, Pb[A], O[(DT0) + i4], 0, 0, 0); } } while (0)
#define ATT_PV(OFF, A) do { ATT_PV4(OFF, A, 0); ATT_PV4(OFF, A, 4); } while (0)
struct AttnRegs { u32x4 kv[8], vv[8]; bf16x8 Qb[4]; };
__device__ __forceinline__ void attn_issue_k(const Ctx& c, const Params& p, int u, AttnRegs& r) {
    const int h = u % 6, rbi = (u / 6) & 63, g = u / 384;
    const int dl = g == 0 ? 1 : (g == 1 ? 4 : 16), nb = 64 / dl, rs = rbi / nb, b = rbi % nb, gh = g * 6 + h;
    const bf16_t* KR = (const bf16_t*)(p.ws + WS_KR);
#pragma unroll
    for (int it = 0; it < 8; ++it) { const int pc = c.tid + 512 * it, j = pc >> 4, ch = pc & 15, pos = 128 * (b - 1) + j;
        r.kv[it] = (u32x4){0u, 0u, 0u, 0u};
        if (pos >= 0) { const size_t t = (size_t)pos * dl + rs; r.kv[it] = *(const u32x4*)(KR + t * 2304 + gh * 128 + 8 * ch); } }
}
__device__ __forceinline__ void attn_issue_vq(const Ctx& c, const Params& p, int u, AttnRegs& r) {
    const int h = u % 6, rbi = (u / 6) & 63, g = u / 384;
    const int dl = g == 0 ? 1 : (g == 1 ? 4 : 16), nb = 64 / dl, rs = rbi / nb, b = rbi % nb, gh = g * 6 + h;
    const bf16_t* U = (const bf16_t*)(p.ws + WS_U); const bf16_t* QR = (const bf16_t*)(p.ws + WS_QR);
    const int lane = c.lane, n = lane & 15, qd = lane >> 4;
#pragma unroll
    for (int it = 0; it < 8; ++it) { const int pc = c.tid + 512 * it, j = pc >> 4, ch = pc & 15, pos = 128 * (b - 1) + j;
        r.vv[it] = (u32x4){0u, 0u, 0u, 0u};
        if (pos >= 0) { const size_t t = (size_t)pos * dl + rs; r.vv[it] = *(const u32x4*)(U + t * NU + UC_C + 4608 + gh * 128 + 8 * ch); } }
    const int iq = 16 * c.wave + n; const size_t tq = (size_t)(128 * b + iq) * dl + rs;
#pragma unroll
    for (int s = 0; s < 4; ++s) r.Qb[s] = *(const bf16x8*)(QR + tq * 2304 + gh * 128 + 32 * s + 8 * qd);
}
__device__ __forceinline__ void attn_stage(const Ctx& c, const AttnRegs& r) {
    LAS unsigned char* Ks = c.lds; LAS unsigned char* Vs = c.lds + 65536;
#pragma unroll
    for (int it = 0; it < 8; ++it) { const int pc = c.tid + 512 * it, j = pc >> 4, ch = pc & 15;
        *(LAS u32x4*)(Ks + off_b(j, ch)) = r.kv[it]; *(LAS u32x4*)(Vs + off_b((j & ~31) + invperm32(j & 31), ch)) = r.vv[it]; }
}
__device__ __forceinline__ void attn_compute(const Ctx& c, const Params& p, int u, AttnRegs& ar, int un) {
    const int h = u % 6, rbi = (u / 6) & 63, g = u / 384;
    const int dl = g == 0 ? 1 : (g == 1 ? 4 : 16), nb = 64 / dl, r = rbi / nb, b = rbi % nb;
    LAS unsigned char* Ks = c.lds; LAS unsigned char* Vs = c.lds + 65536;
    const int lane = c.lane, n = lane & 15, qd = lane >> 4;
    const int iq = 16 * c.wave + n;
    const size_t tq = (size_t)(128 * b + iq) * dl + r;
    const int f = c.wave & ~1;
    f32x4 S[10];
    {
        const unsigned mask = ((n & 3) << 2) | ((n >> 2) & 3);
        unsigned ka[4];
#pragma unroll
        for (int s = 0; s < 4; ++s) ka[s] = 256u * n + 16u * ((4 * s + qd) ^ mask) + (unsigned)f * 4096u;
#pragma unroll
        for (int jj = 0; jj < 10; ++jj) { f32x4 acc = (f32x4){0.f, 0.f, 0.f, 0.f};
#pragma unroll
            for (int s = 0; s < 4; ++s) acc = __builtin_amdgcn_mfma_f32_16x16x32_bf16(*(const LAS bf16x8*)(Ks + ka[s] + jj * 4096), ar.Qb[s], acc, 0, 0, 0);
            S[jj] = acc; }
    }
    float mx = -INFINITY;
#pragma unroll
    for (int jj = 0; jj < 10; ++jj)
#pragma unroll
        for (int e = 0; e < 4; ++e) { const int j = 16 * (f + jj) + 4 * qd + e; const bool ok = (j >= iq) && (j <= iq + 128) && (b > 0 || j >= 128);
            S[jj][e] = ok ? S[jj][e] : -INFINITY; mx = fmaxf(mx, S[jj][e]); }
    mx = fmaxf(mx, shx(mx, 16, lane)); mx = fmaxf(mx, shx(mx, 32, lane));
    float l = 0.f;
#pragma unroll
    for (int jj = 0; jj < 10; ++jj)
#pragma unroll
        for (int e = 0; e < 4; ++e) { const float pv = __expf(S[jj][e] - mx); S[jj][e] = pv; l += pv; }
    l += shx(l, 16, lane); l += shx(l, 32, lane);
    bf16x8 Pb[5];
#pragma unroll
    for (int a = 0; a < 5; ++a) Pb[a] = pack_bf16x8(S[2 * a], S[2 * a + 1]);
    if (un < 1152) attn_issue_vq(c, p, un, ar);
    f32x4 O[8];
#pragma unroll
    for (int dt = 0; dt < 8; ++dt) O[dt] = (f32x4){0.f, 0.f, 0.f, 0.f};
    {
        const unsigned q = (lane & 15) >> 2, pp = lane & 3;
        const unsigned m0 = (q << 2) | ((2 * qd + 0) & 3), m1 = (q << 2) | ((2 * qd + 1) & 3);
        const unsigned cm0 = m0 >> 1, cm1 = m1 >> 1;
        const unsigned vbase = (unsigned)(f >> 1) * 8192u + 8u * (pp & 1);
        const unsigned vb0 = vbase + 256u * (8 * qd + 0 + q) + 16u * ((pp >> 1) ^ (m0 & 1)), vb1 = vbase + 256u * (8 * qd + 4 + q) + 16u * ((pp >> 1) ^ (m1 & 1));
        ATT_PV(0, 0); ATT_PV(8192, 1); ATT_PV(16384, 2); ATT_PV(24576, 3); ATT_PV(32768, 4);
    }
    {
        const float il = __builtin_amdgcn_rcpf(l);
        bf16_t* op = (bf16_t*)(p.ws + WS_ATTO) + ((size_t)g * T + tq) * 768 + h * 128 + 4 * qd;
#pragma unroll
        for (int dt = 0; dt < 8; ++dt) { u32x2 w; w.x = cvt_pk_bf16(O[dt][0] * il, O[dt][1] * il); w.y = cvt_pk_bf16(O[dt][2] * il, O[dt][3] * il); *(u32x2*)(op + 16 * dt) = w; }
        if (qd == 0) ((float*)(p.ws + WS_LSE))[((size_t)g * T + tq) * 8 + h] = mx + logf(l);
    }
}

struct GateOrder {
    int Gn, j;
    __device__ bool next(int i, pg8::Unit& u) const { const int id = i * Gn + j; if (id >= 1024) return false; u.pm = id & 31; u.pn = 48 + (id >> 5); return true; }
    __device__ __forceinline__ int arow(const pg8::Unit& u, int r) const { return u.pm * 256 + r; }
};
__device__ __forceinline__ void phase_attn_gdn(const Ctx& c, const Params& p, int L) {
    const bf16_t* U = (const bf16_t*)(p.ws + WS_U);
    const int lane = c.lane;
    const int nrec = (c.G >= 24) ? 12 : 0;
    if (nrec) { if (c.bid < nrec) { gdn_scan(c, p, c.bid);
            return; } }
    else { for (int h = c.bid; h < 12; h += c.G) gdn_scan(c, p, h); }
    {
        const int Gn = c.G - nrec, j = c.bid - nrec, heavy = (Gn > 0 && Gn < 1024) ? (1024 % Gn) : 0, na = Gn - heavy;
        for (int rep = 0; rep < 1 + (p.pad == 5); ++rep) {
            int u = 1152, us = 1;
            if (na > 0) { if (j >= heavy) { u = j - heavy; us = na; } } else { u = j; us = Gn; }
            AttnRegs ar;
            if (u < 1152) { attn_issue_k(c, p, u, ar); attn_issue_vq(c, p, u, ar); }
            while (u < 1152) {
                attn_stage(c, ar);
                __syncthreads();
                const int un = u + us;
                if (un < 1152) attn_issue_k(c, p, un, ar);
                attn_compute(c, p, u, ar, un);
                __syncthreads();
                u = un;
            }
        }
    }
    for (int rep = 0; rep < 1 + (p.pad == 6); ++rep) {
        pg8::Gemm g{(const bf16_t*)(p.ws + WS_H), (const bf16_t*)(p.ws + WS_WINT) + (size_t)L * NU * D, D}; GateOrder S{c.G - nrec, c.bid - nrec};
        EpiU E{(bf16_t*)(p.ws + WS_U)}; pg8::gemm_phase<EpiU, GateOrder, false>(c.lds, g, S, E);
    }
}

__device__ __forceinline__ void phase_combine(const Ctx& c, const Params& p, int L) {
    const bf16_t* U = (const bf16_t*)(p.ws + WS_U); const bf16_t* AO = (const bf16_t*)(p.ws + WS_ATTO); const float* LSE = (const float*)(p.ws + WS_LSE);
    const bf16_t* OG = (const bf16_t*)(p.ws + WS_OGDN); bf16_t* YA = (bf16_t*)(p.ws + WS_YBR); bf16_t* YC = YA + (size_t)2 * T * 768;
    const float* gn = p.gdn_norm_g + L * 128; const int lane = c.lane;
    for (int it0 = (c.bid * 8 + c.wave) * 4; it0 < T * 6; it0 += c.G * 8 * 4) {
        float l0[4], l1[4], l2[4]; unsigned a0[4], a1[4], a2[4], z2[4]; float2 og[4]; size_t o[4];
#pragma unroll
        for (int i = 0; i < 4; ++i) { const int it = it0 + i, t = it / 6, h = it % 6; o[i] = (size_t)t * 768 + h * 128 + 2 * lane;
            l0[i] = LSE[(size_t)t * 8 + h]; l1[i] = LSE[((size_t)T + t) * 8 + h]; l2[i] = LSE[((size_t)2 * T + t) * 8 + h];
            a0[i] = *(const unsigned*)(AO + o[i]); a1[i] = *(const unsigned*)(AO + (size_t)T * 768 + o[i]); a2[i] = *(const unsigned*)(AO + (size_t)2 * T * 768 + o[i]);
            { const unsigned ow = *(const unsigned*)(OG + o[i]); og[i] = make_float2(bflo(ow), bfhi(ow)); } z2[i] = *(const unsigned*)(U + (size_t)t * NU + UC_Z + h * 128 + 2 * lane); }
#pragma unroll
        for (int i = 0; i < 4; ++i) {
            const float mx = fmaxf(l0[i], fmaxf(l1[i], l2[i])); const float e0 = __expf(l0[i] - mx), e1 = __expf(l1[i] - mx), e2 = __expf(l2[i] - mx); const float is = __builtin_amdgcn_rcpf(e0 + e1 + e2);
            *(unsigned*)(YC + o[i]) = cvt_pk_bf16((e0 * bflo(a0[i]) + e1 * bflo(a1[i]) + e2 * bflo(a2[i])) * is, (e0 * bfhi(a0[i]) + e1 * bfhi(a1[i]) + e2 * bfhi(a2[i])) * is);
            const float ss = wave_sum(og[i].x * og[i].x + og[i].y * og[i].y, lane); const float r = rsqrtf(ss * (1.0f / 128.f) + 1e-6f);
            *(unsigned*)(YA + o[i]) = cvt_pk_bf16(og[i].x * r * gn[2 * lane] * siluf_(bflo(z2[i])), og[i].y * r * gn[2 * lane + 1] * siluf_(bfhi(z2[i]))); }
    }
}

__device__ __forceinline__ void phase_norm2_router(const Ctx& c, const Params& p, int L) {
    const bf16_t* XB = (const bf16_t*)(p.ws + WS_XB); bf16_t* H = (bf16_t*)(p.ws + WS_H); const float* g2 = p.norm2_g + L * D;
    const bf16_t* WH = (const bf16_t*)(p.ws + WS_WRT) + (size_t)L * 2 * 80 * 2048; const bf16_t* WL = WH + 80 * 2048;
    unsigned* cnt = (unsigned*)(p.ws + WS_CTL + CTL_CNT) + L * 64; int* TOK = (int*)(p.ws + WS_TOK); float* WTS = (float*)(p.ws + WS_WSL);
    LAS float* lgp = (LAS float*)c.lds;
    LAS float* ssp = (LAS float*)c.lds + 2 * 4 * 16 * 80;
    const int lane = c.lane, m = lane & 15, q = lane >> 4, tl = c.wave >> 2, kq = c.wave & 3;
    for (int tp = c.bid; tp < T / 32; tp += c.G) {
        const int task = tp * 2 + tl;
        const int t = task * 16 + m; const bf16_t* xr = XB + (size_t)t * D + 512 * kq + 8 * q; const float* gr = g2 + 512 * kq + 8 * q;
        float ss = 0.f;
#pragma unroll 8
        for (int s = 0; s < 16; ++s) { const u32x4 xw = *(const u32x4*)(xr + 32 * s);
            ss += bflo(xw.x) * bflo(xw.x) + bfhi(xw.x) * bfhi(xw.x) + bflo(xw.y) * bflo(xw.y) + bfhi(xw.y) * bfhi(xw.y) + bflo(xw.z) * bflo(xw.z) + bfhi(xw.z) * bfhi(xw.z) + bflo(xw.w) * bflo(xw.w) + bfhi(xw.w) * bfhi(xw.w); }
        ss += shx(ss, 16, lane); ss += shx(ss, 32, lane);
        if (q == 0) ssp[(tl * 4 + kq) * 16 + m] = ss;
        __syncthreads();
        ss = ssp[(tl * 4 + 0) * 16 + m] + ssp[(tl * 4 + 1) * 16 + m] + ssp[(tl * 4 + 2) * 16 + m] + ssp[(tl * 4 + 3) * 16 + m];
        const float rstd = rsqrtf(ss * (1.0f / D) + 1e-6f);
        f32x4 acc[5];
#pragma unroll
        for (int nt = 0; nt < 5; ++nt) acc[nt] = (f32x4){0.f, 0.f, 0.f, 0.f};
        u32x4 nx = *(const u32x4*)(xr); float4 nga = *(const float4*)(gr), ngb = *(const float4*)(gr + 4);
        bf16x8 nbh[5], nbl[5];
#pragma unroll
        for (int nt = 0; nt < 5; ++nt) { const size_t wo = (size_t)(16 * nt + m) * 2048 + 512 * kq + 8 * q; nbh[nt] = *(const bf16x8*)(WH + wo); nbl[nt] = *(const bf16x8*)(WL + wo); }
        for (int s = 0; s < 16; ++s) {
            const u32x4 xw = nx; const float4 ga = nga, gb = ngb; bf16x8 bh[5], bl[5];
            float4 a, b; a.x = bflo(xw.x); a.y = bfhi(xw.x); a.z = bflo(xw.y); a.w = bfhi(xw.y); b.x = bflo(xw.z); b.y = bfhi(xw.z); b.z = bflo(xw.w); b.w = bfhi(xw.w);
#pragma unroll
            for (int nt = 0; nt < 5; ++nt) { bh[nt] = nbh[nt]; bl[nt] = nbl[nt]; }
            if (s + 1 < 16) { const int s1 = s + 1;
                nx = *(const u32x4*)(xr + 32 * s1); nga = *(const float4*)(gr + 32 * s1); ngb = *(const float4*)(gr + 32 * s1 + 4);
#pragma unroll
                for (int nt = 0; nt < 5; ++nt) { const size_t wo = (size_t)(16 * nt + m) * 2048 + 512 * kq + 32 * s1 + 8 * q; nbh[nt] = *(const bf16x8*)(WH + wo); nbl[nt] = *(const bf16x8*)(WL + wo); } }
            float h[8]; h[0] = a.x * rstd * ga.x; h[1] = a.y * rstd * ga.y; h[2] = a.z * rstd * ga.z; h[3] = a.w * rstd * ga.w; h[4] = b.x * rstd * gb.x; h[5] = b.y * rstd * gb.y; h[6] = b.z * rstd * gb.z; h[7] = b.w * rstd * gb.w;
            u32x4 hi; hi.x = cvt_pk_bf16(h[0], h[1]); hi.y = cvt_pk_bf16(h[2], h[3]); hi.z = cvt_pk_bf16(h[4], h[5]); hi.w = cvt_pk_bf16(h[6], h[7]);
            u32x4 lo; lo.x = cvt_pk_bf16(h[0] - bflo(hi.x), h[1] - bfhi(hi.x)); lo.y = cvt_pk_bf16(h[2] - bflo(hi.y), h[3] - bfhi(hi.y));
            lo.z = cvt_pk_bf16(h[4] - bflo(hi.z), h[5] - bfhi(hi.z)); lo.w = cvt_pk_bf16(h[6] - bflo(hi.w), h[7] - bfhi(hi.w));
            const bf16x8 ah = __builtin_bit_cast(bf16x8, hi), al = __builtin_bit_cast(bf16x8, lo);
#pragma unroll
            for (int nt = 0; nt < 5; ++nt) {
                acc[nt] = __builtin_amdgcn_mfma_f32_16x16x32_bf16(ah, bh[nt], acc[nt], 0, 0, 0);
                acc[nt] = __builtin_amdgcn_mfma_f32_16x16x32_bf16(ah, bl[nt], acc[nt], 0, 0, 0);
                acc[nt] = __builtin_amdgcn_mfma_f32_16x16x32_bf16(al, bh[nt], acc[nt], 0, 0, 0); }
            *(u32x4*)(H + (size_t)t * D + 512 * kq + 32 * s + 8 * q) = hi;
        }
        LAS float* lgw = lgp + (tl * 4 + kq) * (16 * 80);
#pragma unroll
        for (int nt = 0; nt < 5; ++nt)
#pragma unroll
            for (int jj = 0; jj < 4; ++jj) lgw[(4 * q + jj) * 80 + 16 * nt + m] = acc[nt][jj];
        __syncthreads();
        if (kq == 0) {
            for (int i = lane; i < 16 * 80; i += 64) lgw[i] = lgw[i] + lgw[i + 16 * 80] + lgw[i + 2 * 16 * 80] + lgw[i + 3 * 16 * 80];
            asm volatile("s_waitcnt lgkmcnt(0)" ::: "memory");
        }
        if (kq == 0)
        if (lane < 16) {
            const int tt = task * 16 + lane; const LAS float* l = lgw + lane * 80;
            float gl[8]; float gm = -INFINITY; int gi = 0;
#pragma unroll
            for (int j = 0; j < 8; ++j) { gl[j] = l[j] + p.rg_b[L * 8 + j]; if (gl[j] > gm) { gm = gl[j]; gi = j; } }
            float gs = 0.f;
#pragma unroll
            for (int j = 0; j < 8; ++j) gs += expf(gl[j] - gm);
            const float gp = 1.0f / gs;
            float el[8]; float em = -INFINITY; int i1 = 0;
#pragma unroll
            for (int j = 0; j < 8; ++j) { el[j] = l[8 + gi * 8 + j] + p.re_b[L * 64 + gi * 8 + j]; if (el[j] > em) { em = el[j]; i1 = j; } }
            float e2m = -INFINITY; int i2 = 0;
#pragma unroll
            for (int j = 0; j < 8; ++j) { if (j != i1 && el[j] > e2m) { e2m = el[j]; i2 = j; } }
            const float p2 = expf(e2m - em);
            const float w1 = gp / (1.0f + p2), w2 = gp * p2 / (1.0f + p2);
            const int e1 = gi * 8 + i1, e2 = gi * 8 + i2;
            const unsigned q1 = atomicAdd(&cnt[e1], 1u); TOK[e1 * 8192 + q1] = tt * 2; WTS[e1 * 8192 + q1] = w1;
            const unsigned q2 = atomicAdd(&cnt[e2], 1u); TOK[e2 * 8192 + q2] = tt * 2 + 1; WTS[e2 * 8192 + q2] = w2;
        }
        __syncthreads();
    }
}

__device__ __forceinline__ MoeTab moe_tables(const Ctx& c, const Params& p, int L, int nN) {
    LAS int* base = (LAS int*)(c.lds + LDS_MISC + 1024);
    LAS int* mt_e = base, * mt_p0 = base + 192, * cn = base + 384, * nm = base + 448, * first = base + 452, * ut = base + 520;
    const unsigned* cnt = (const unsigned*)(p.ws + WS_CTL + CTL_CNT) + L * 64;
    __syncthreads();
    if (c.tid < 64) cn[c.tid] = (int)cnt[c.tid];
    __syncthreads();
    if (c.tid == 0) { int n = 0; for (int e = 0; e < 64; ++e) { first[e] = n; const int ntile = (cn[e] + 127) >> 7; for (int i = 0; i < ntile; ++i) { mt_e[n] = e; mt_p0[n] = i * 128; ++n; } } nm[0] = n; }
    __syncthreads();
    if (c.tid < 64) { const int e = c.tid, f0 = first[e], ntile = (cn[e] + 127) >> 7; int o = f0 * nN;
        for (int j = 0; j < nN; ++j) for (int m = 0; m < ntile; ++m) ut[o++] = ((f0 + m) << 4) | j; }
    else if (c.tid < 128) { const int e = c.tid - 64, f0 = first[e], ntile = (cn[e] + 127) >> 7; int o = 768 + f0 * 8;
        for (int j = 0; j < 8; ++j) for (int m = 0; m < ntile; ++m) ut[o++] = ((f0 + m) << 4) | j; }
    __syncthreads();
    MoeTab tb; tb.mt_e = mt_e; tb.mt_p0 = mt_p0; tb.cnt = cn; tb.ut = ut; tb.nmt = nm[0]; return tb;
}

__device__ __forceinline__ MoeTab2 moe_tables2(const Ctx& c, const Params& p, int L) {
    LAS int* base = (LAS int*)(c.lds + LDS_MISC + 1024);
    LAS int* rt_e = base, * rt_r0 = base + 128, * cn = base + 256, * nm = base + 320, * first = base + 324, * rfirst = base + 392, * ut_up = base + 456, * ut_dn = base + 456 + 864;
    const unsigned* cnt = (const unsigned*)(p.ws + WS_CTL + CTL_CNT) + L * 64;
    __syncthreads();
    if (c.tid < 64) cn[c.tid] = (int)cnt[c.tid];
    __syncthreads();
    if (c.tid == 0) { int n = 0, f = 0; for (int e = 0; e < 64; ++e) { first[e] = f; f += (cn[e] + 127) >> 7; rfirst[e] = n; const int ns = (cn[e] + 383) / 384; for (int i = 0; i < ns; ++i) { rt_e[n] = e; rt_r0[n] = i * 384; ++n; } } nm[0] = n; }
    __syncthreads();
    if (c.tid < 64) { const int e = c.tid, f0 = rfirst[e], ns = (cn[e] + 383) / 384; int o = f0 * 8;
        for (int i = 0; i < ns; ++i) for (int j = 0; j < 8; ++j) ut_up[o++] = ((f0 + i) << 4) | j; }
    else if (c.tid < 128) { const int e = c.tid - 64, f0 = rfirst[e], ns = (cn[e] + 383) / 384; int o = f0 * 16;
        for (int i = 0; i < ns; ++i) for (int j = 0; j < 16; ++j) ut_dn[o++] = ((f0 + i) << 4) | j; }
    __syncthreads();
    MoeTab2 tb; tb.rt_e = rt_e; tb.rt_r0 = rt_r0; tb.cnt = cn; tb.first = first; tb.ut_up = ut_up; tb.ut_dn = ut_dn; tb.nrt = nm[0]; return tb;
}

__device__ __forceinline__ void phase_final(const Ctx& c, const Params& p) {
    const bf16_t* XB = (const bf16_t*)(p.ws + WS_XB); const bf16_t* Y = (const bf16_t*)(p.ws + WS_YMOE);
    for (int t0 = c.bid * 8 + c.wave; t0 < T; t0 += 2 * c.G * 8) {
        const int t1 = t0 + c.G * 8; const bool two = t1 < T; const int tb = two ? t1 : t0;
        float4 xv[2][8]; float ss[2] = {0.f, 0.f};
#pragma unroll
        for (int k = 0; k < 2; ++k) { const int t = k ? tb : t0;
#pragma unroll
            for (int q = 0; q < 8; ++q) { const int col = q * 256 + c.lane * 4;
                const u32x2 xa = *(const u32x2*)(XB + (size_t)t * D + col), y0 = *(const u32x2*)(Y + (size_t)(2 * t) * D + col), y1 = *(const u32x2*)(Y + (size_t)(2 * t + 1) * D + col);
                float4 v; v.x = bflo(xa.x) + (bflo(y0.x) + bflo(y1.x)); v.y = bfhi(xa.x) + (bfhi(y0.x) + bfhi(y1.x)); v.z = bflo(xa.y) + (bflo(y0.y) + bflo(y1.y)); v.w = bfhi(xa.y) + (bfhi(y0.y) + bfhi(y1.y));
                xv[k][q] = v; ss[k] += v.x * v.x + v.y * v.y + v.z * v.z + v.w * v.w; } }
        const float r0 = rsqrtf(wave_sum(ss[0], c.lane) * (1.0f / D) + 1e-6f), r1 = rsqrtf(wave_sum(ss[1], c.lane) * (1.0f / D) + 1e-6f);
#pragma unroll
        for (int q = 0; q < 8; ++q) { const int col = q * 256 + c.lane * 4; const float4 g = *(const float4*)(p.final_g + col);
            float4 o; o.x = xv[0][q].x * r0 * g.x; o.y = xv[0][q].y * r0 * g.y; o.z = xv[0][q].z * r0 * g.z; o.w = xv[0][q].w * r0 * g.w;
            *(float4*)(p.out + (size_t)t0 * D + col) = o;
            if (two) { float4 o1; o1.x = xv[1][q].x * r1 * g.x; o1.y = xv[1][q].y * r1 * g.y; o1.z = xv[1][q].z * r1 * g.z; o1.w = xv[1][q].w * r1 * g.w;
                *(float4*)(p.out + (size_t)t1 * D + col) = o1; } }
    }
}

constexpr int NPH_LAYER = 10, NPHASES = 1 + NL * NPH_LAYER + 1;
static_assert(NL == 2, "LAYER_BODY is instantiated twice");
#ifndef MOE_PROBE
#define MOE_PROBE -1
#endif
#if MOE_PROBE >= 0
#define MOE_PROBE_RUN { unsigned* mtd = (unsigned*)(p.ws + WS_CTL + 38400) + L * 192; unsigned* qh = (unsigned*)(p.ws + WS_CTL + CTL_QHEAD + 1024) + L * 128; \
            if (!(MOE_PROBE & 8)) { MoeUpOrder2 S{tb, c.G, c.bid, mtd}; EpiUp2 E{(bf16_t*)(p.ws + WS_HID)}; \
              moe_gemm2<true, (MOE_PROBE & 7), MoeUpOrder2, EpiUp2>(c, (const bf16_t*)(p.ws + WS_H), p.w_up + (size_t)L * NE * D * 1024, (const int*)(p.ws + WS_TOK), S, E); } \
            if (!(MOE_PROBE & 16)) { LAS int* slot = (LAS int*)(c.lds + LDS_MISC + 768); if (c.tid == 0) slot[1] = 0; \
              MoeDownQueue2 S{tb, c.G, c.bid, qh, mtd, slot, (MOE_PROBE & 8) ? 0u : 8u}; EpiDown2 E{(const int*)(p.ws + WS_TOK), (const float*)(p.ws + WS_WSL), (bf16_t*)(p.ws + WS_YMOE)}; \
              moe_gemm2<false, (MOE_PROBE & 7), MoeDownQueue2, EpiDown2>(c, (const bf16_t*)(p.ws + WS_HID), p.w_down + (size_t)L * NE * EH * D, (const int*)(p.ws + WS_TOK), S, E); } \
            SEAM(b + 7); }
#else
#define MOE_PROBE_RUN
#endif
#define LAYER_BODY(L) {         const int b = 1 + L * NPH_LAYER; \
        if (PHON(1) && IN(b + 0)) { for (int rep = 0; rep < 1 + PROBED(b + 0); ++rep) { FRESH(); phase_norm1(c, p, L); } SEAM(b + 0); } \
        if (PHON(2) && IN(b + 1)) { for (int rep = 0; rep < 1 + PROBED(b + 1); ++rep) { FRESH(); \
            pg8::Gemm g{(const bf16_t*)(p.ws + WS_H), (const bf16_t*)(p.ws + WS_WINT) + (size_t)L * NU * D, D}; pg8::StaticOrder S; S.init(T, UC_G, c.G, c.bid); \
            EpiU E{(bf16_t*)(p.ws + WS_U)}; pg8::gemm_phase<EpiU, pg8::StaticOrder, false>(c.lds, g, S, E); } SEAM(b + 1); } \
        if (PHON(3) && IN(b + 2)) { for (int rep = 0; rep < 1 + PROBED(b + 2); ++rep) { FRESH(); phase_local(c, p, L); } SEAM(b + 2); } \
        if (PHON(4) && IN(b + 3)) { for (int rep = 0; rep < 1 + PROBED(b + 3); ++rep) { FRESH(); phase_attn_gdn(c, p, L); } SEAM(b + 3); } \
        if (PHON(5) && IN(b + 4)) { for (int rep = 0; rep < 1 + PROBED(b + 4); ++rep) { FRESH(); phase_combine(c, p, L); } SEAM(b + 4); } \
        if (PHON(6) && IN(b + 5)) { for (int rep = 0; rep < 1 + PROBED(b + 5); ++rep) { FRESH(); \
            pg8::Gemm g{(const bf16_t*)(p.ws + WS_YBR), (const bf16_t*)(p.ws + WS_WBRT) + (size_t)L * 4 * D * 768, 768}; MergeOrder S{c.G, c.bid}; \
            EpiMerge3 E{(const bf16_t*)(p.ws + WS_U), (bf16_t*)(p.ws + WS_MERGED)}; pg8::gemm_phase<EpiMerge3, MergeOrder, false>(c.lds, g, S, E); } SEAM(b + 5); } \
        if (PHON(7) && IN(b + 6)) { for (int rep = 0; rep < 1 + PROBED(b + 6); ++rep) { FRESH(); \
            pg8::Gemm g{(const bf16_t*)(p.ws + WS_MERGED), (const bf16_t*)(p.ws + WS_WOUTT) + (size_t)L * D * D, D}; pg8::StaticOrder S; S.init(T, D, c.G, c.bid); \
            EpiRes2 E{p.x, L == 0 ? (const bf16_t*)nullptr : (const bf16_t*)(p.ws + WS_XA), (bf16_t*)(p.ws + WS_XB)}; pg8::gemm_phase<EpiRes2, pg8::StaticOrder, false>(c.lds, g, S, E); } SEAM(b + 6); } \
        if (PHON(8) && IN(b + 7)) { FRESH(); phase_norm2_router(c, p, L); SEAM(b + 7); } \
        if (PHON(9) && IN(b + 8)) { FRESH(); \
            const MoeTab2 tb = moe_tables2(c, p, L); \
            MOE_PROBE_RUN \
            unsigned* mtd = (unsigned*)(p.ws + WS_CTL + CTL_MTDONE) + L * 192; unsigned* qh = (unsigned*)(p.ws + WS_CTL + CTL_QHEAD) + L * 128; \
            { MoeUpOrder2 S{tb, c.G, c.bid, mtd}; EpiUp2 E{(bf16_t*)(p.ws + WS_HID)}; \
              moe_gemm2<true, 0, MoeUpOrder2, EpiUp2>(c, (const bf16_t*)(p.ws + WS_H), p.w_up + (size_t)L * NE * D * 1024, (const int*)(p.ws + WS_TOK), S, E); } \
            { LAS int* slot = (LAS int*)(c.lds + LDS_MISC + 768); if (c.tid == 0) slot[1] = 0; \
              MoeDownQueue2 S{tb, c.G, c.bid, qh, mtd, slot, 8u}; EpiDown2 E{(const int*)(p.ws + WS_TOK), (const float*)(p.ws + WS_WSL), (bf16_t*)(p.ws + WS_YMOE)}; \
              moe_gemm2<false, 0, MoeDownQueue2, EpiDown2>(c, (const bf16_t*)(p.ws + WS_HID), p.w_down + (size_t)L * NE * EH * D, (const int*)(p.ws + WS_TOK), S, E); } \
            SEAM(b + 8); } \
 }
__global__ void __launch_bounds__(NTHREADS, 2) fwd(Params p0) {
    extern __shared__ __attribute__((aligned(16))) unsigned char lds_raw[];
    Ctx c; c.tid = threadIdx.x; c.lane = c.tid & 63; c.wave = __builtin_amdgcn_readfirstlane(c.tid >> 6); c.bid = blockIdx.x; c.G = gridDim.x; c.lds = (LAS unsigned char*)lds_raw;
    volatile LAS unsigned* misc = (volatile LAS unsigned*)(c.lds + LDS_MISC);
    if (c.tid < 4) misc[c.tid] = 0u;
    if (c.tid == 0) {
        LAS unsigned long long* tab = (LAS unsigned long long*)(c.lds + LDS_PTAB);
        tab[0] = (unsigned long long)p0.x; tab[1] = (unsigned long long)p0.pos; tab[2] = (unsigned long long)p0.norm1_g; tab[3] = (unsigned long long)p0.w_in; tab[4] = (unsigned long long)p0.conv_a_w;
        tab[5] = (unsigned long long)p0.a_log; tab[6] = (unsigned long long)p0.dt_bias; tab[7] = (unsigned long long)p0.gdn_norm_g; tab[8] = (unsigned long long)p0.conv_b_w; tab[9] = (unsigned long long)p0.conv_b_b;
        tab[10] = (unsigned long long)p0.ln_b_g; tab[11] = (unsigned long long)p0.ln_b_b; tab[12] = (unsigned long long)p0.pool_w; tab[13] = (unsigned long long)p0.pool_scale; tab[14] = (unsigned long long)p0.w_branch;
        tab[15] = (unsigned long long)p0.w_out; tab[16] = (unsigned long long)p0.norm2_g; tab[17] = (unsigned long long)p0.rg_w; tab[18] = (unsigned long long)p0.rg_b; tab[19] = (unsigned long long)p0.re_w;
        tab[20] = (unsigned long long)p0.re_b; tab[21] = (unsigned long long)p0.w_up; tab[22] = (unsigned long long)p0.w_down; tab[23] = (unsigned long long)p0.final_g; tab[24] = (unsigned long long)p0.out;
    }
    __syncthreads();
    const int lo = p0.ph_lo, hi = p0.ph_hi, probe = p0.probe, psub = p0.pad; unsigned char* const wsb = p0.ws;
    const bool multi = (hi - lo) > 1;
    XcdBarrier bar; bar.bar = (unsigned*)(wsb + WS_CTL); bar.x = 0; bar.st = misc;
    if (multi) bar = xcd_barrier_post((unsigned*)(wsb + WS_CTL), misc);
#if MK_ONE_LAUNCH
#define IN(k) true
#else
#define IN(k) (lo <= (k) && (k) < hi)
#endif
#define PROBED(k) (PROBE_PHASE >= 0 && probe == (k))
#define FRESH() int _t = threadIdx.x; asm volatile("" : "+v"(_t)); c.tid = _t; c.lane = _t & 63; \
    { int _b = blockIdx.x, _g = gridDim.x, _w = __builtin_amdgcn_readfirstlane(_t >> 6); asm volatile("" : "+s"(_b), "+s"(_g), "+s"(_w)); c.bid = _b; c.G = _g; c.wave = _w; } \
    unsigned long long _wsi = (unsigned long long)wsb; asm volatile("" : "+s"(_wsi)); unsigned char* _ws = (unsigned char*)(GAS unsigned char*)_wsi; Params p = load_params(c, _ws, lo, hi); p.pad = psub
#define SEAM(k) do { if (IN((k) + 1)) { XcdBarrier _bb; unsigned long long _bi = (unsigned long long)(wsb + WS_CTL); asm volatile("" : "+s"(_bi)); _bb.bar = (unsigned*)(GAS unsigned*)_bi; _bb.x = xb_xcc_id(); _bb.st = misc; xcd_barrier(_bb); } } while (0)
#ifndef PHMASK
#define PHMASK 0xFFFFF
#endif
#define PHON(k) ((PHMASK >> (k)) & 1)
    if (PHON(0) && IN(0)) { for (int rep = 0; rep < 1 + PROBED(0); ++rep) { FRESH(); phase_convert(c, p); } if (!MK_ONE_LAUNCH) SEAM(0); }
    for (int L = 0; L < NL; ++L) LAYER_BODY(L)
    if (PHON(11) && IN(NPHASES - 1)) { FRESH(); phase_final(c, p); }
#undef IN
#undef SEAM
}

extern "C" void kernel_launch(void* const* d_in, const int* in_sizes, int n_in, void* d_out, int out_size, void* d_ws, size_t ws_size, hipStream_t stream) {
    static int grid = 0;
    if (grid == 0) {
        if (n_in != 24 || out_size != T * D || ws_size < WS_END) { fprintf(stderr, "kernel_launch: unexpected shapes (n_in %d, out %d, ws %zu < %zu)\n", n_in, out_size, ws_size, (size_t)WS_END); grid = -1; return; }
        int dev = 0, cus = 0, per_cu = 0;
        if (hipGetDevice(&dev) != hipSuccess || hipDeviceGetAttribute(&cus, hipDeviceAttributeMultiprocessorCount, dev) != hipSuccess) { grid = -1; return; }
        if (hipFuncSetAttribute((const void*)fwd, hipFuncAttributeMaxDynamicSharedMemorySize, LDS_BYTES) != hipSuccess) { fprintf(stderr, "kernel_launch: hipFuncSetAttribute failed\n"); grid = -1; return; }
        if (hipOccupancyMaxActiveBlocksPerMultiprocessor(&per_cu, (const void*)fwd, NTHREADS, LDS_BYTES) != hipSuccess || per_cu < 1) { fprintf(stderr, "kernel_launch: occupancy query says %d\n", per_cu); (void)hipGetLastError(); }
        grid = cus;
    }
    if (grid < 0) return;
    (void)hipMemsetAsync((char*)d_ws + WS_CTL, 0, CTL_BYTES, stream);
    Params p{};
    p.x = (const float*)d_in[0]; p.pos = (const int*)d_in[1]; p.norm1_g = (const float*)d_in[2]; p.w_in = (const float*)d_in[3]; p.conv_a_w = (const float*)d_in[4];
    p.a_log = (const float*)d_in[5]; p.dt_bias = (const float*)d_in[6]; p.gdn_norm_g = (const float*)d_in[7]; p.conv_b_w = (const float*)d_in[8]; p.conv_b_b = (const float*)d_in[9];
    p.ln_b_g = (const float*)d_in[10]; p.ln_b_b = (const float*)d_in[11]; p.pool_w = (const float*)d_in[12]; p.pool_scale = (const float*)d_in[13]; p.w_branch = (const float*)d_in[14];
    p.w_out = (const float*)d_in[15]; p.norm2_g = (const float*)d_in[16]; p.rg_w = (const float*)d_in[17]; p.rg_b = (const float*)d_in[18]; p.re_w = (const float*)d_in[19];
    p.re_b = (const float*)d_in[20]; p.w_up = (const float*)d_in[21]; p.w_down = (const float*)d_in[22]; p.final_g = (const float*)d_in[23];
    p.out = (float*)d_out; p.ws = (unsigned char*)d_ws; p.probe = PROBE_PHASE; p.pad = PROBE_SUB;
#if MK_ONE_LAUNCH
    p.ph_lo = 0; p.ph_hi = NPHASES;
    hipLaunchKernelGGL(fwd, dim3(grid), dim3(NTHREADS), LDS_BYTES, stream, p);
#else
    for (int ph = 0; ph < NPHASES; ++ph) { p.ph_lo = ph; p.ph_hi = ph + 1; hipLaunchKernelGGL(fwd, dim3(grid), dim3(NTHREADS), LDS_BYTES, stream, p); }
#endif
}
```
